# Optimizing an MI355X kernel written in HIP

```python
import math
import jax, jax.numpy as jnp
from jax import lax
import numpy as np

D_MODEL = 1024
BATCH = 32
SEQ = 256
DEPTH = 4
DEC_BATCH = 2
DEC_SEQ = 2048
PAST_LEN = 512

GRID_W = 64
Q_BLOCK = 128
D_FF = 2816
N_MOD = 9
EPS = 1e-6
ROPE_BASE = 10000.0
A_HEADS = 6
A_KV_HEADS = 2
A_HEAD_DIM = 64
B_HEADS = 4
B_KEY_DIM = 32
B_VAL_DIM = 64
B_GATE_RANK = 16
B_GATE_TAU = 16.0
B_CHUNK = 64
C_HEADS = 4
C_QK_DIM = 48
C_VAL_DIM = 2 * C_QK_DIM

A_WIDTH = A_HEADS * A_HEAD_DIM
B_WIDTH = B_HEADS * B_VAL_DIM
C_WIDTH = C_HEADS * C_VAL_DIM
MIX_WIDTH = A_WIDTH + B_WIDTH + C_WIDTH
PROJ_SPLITS = (A_WIDTH, A_KV_HEADS * A_HEAD_DIM, A_KV_HEADS * A_HEAD_DIM,
               B_HEADS * B_KEY_DIM, B_HEADS * B_KEY_DIM, B_WIDTH, 2 * B_GATE_RANK, B_WIDTH,
               2 * C_HEADS * C_QK_DIM, 2 * C_HEADS * C_QK_DIM, C_WIDTH)
PROJ_WIDTH = sum(PROJ_SPLITS)

kernel_name = 'hybrid_dit_prefix_ctx_step'


def rms_norm(x, g):
    xf = x.astype(jnp.float32)
    y = xf * lax.rsqrt(jnp.mean(xf * xf, axis=-1, keepdims=True) + EPS)
    return (y * g.astype(jnp.float32)).astype(x.dtype)


def modulate(x, shift, scale):
    return x * (1 + scale[:, None, :]) + shift[:, None, :]


def swiglu(h, wg, wu, wd):
    return (jax.nn.silu(h @ wg) * (h @ wu)) @ wd


def rope_1d(x, pos):
    m = x.shape[-1] // 2
    freqs = ROPE_BASE ** (-jnp.arange(m, dtype=jnp.float32) / m)
    ang = pos[:, None] * freqs[None, :]
    cs = jnp.cos(ang)[:, None, :].astype(x.dtype)
    sn = jnp.sin(ang)[:, None, :].astype(x.dtype)
    a, b = x[..., :m], x[..., m:]
    return jnp.concatenate([a * cs - b * sn, a * sn + b * cs], axis=-1)


def rope_2d(x, row, col):
    h = x.shape[-1] // 2
    return jnp.concatenate([rope_1d(x[..., :h], row), rope_1d(x[..., h:], col)], axis=-1)


def map_query_blocks(fn, q):
    B, T = q.shape[:2]
    nb = T // Q_BLOCK
    qb = jnp.moveaxis(q.reshape((B, nb, Q_BLOCK) + q.shape[2:]), 1, 0)
    out = jnp.moveaxis(lax.map(fn, qb), 0, 1)
    return out.reshape((B, T) + out.shape[3:])


def gqa_attention(q, k, v):
    scale = A_HEAD_DIM ** -0.5
    def block(qb):
        s = jnp.einsum('bqhgd,bkhd->bhgqk', qb, k).astype(jnp.float32) * scale
        p = jax.nn.softmax(s, axis=-1).astype(v.dtype)
        return jnp.einsum('bhgqk,bkhd->bqhgd', p, v)
    return map_query_blocks(block, q)


def diff_attention(q, k, v, lam):
    scale = C_QK_DIM ** -0.5
    def block(qb):
        s = jnp.einsum('bqhmd,bkhmd->bhmqk', qb, k).astype(jnp.float32) * scale
        p = jax.nn.softmax(s, axis=-1)
        w = (p[:, :, 0] - lam * p[:, :, 1]).astype(v.dtype)
        return jnp.einsum('bhqk,bkhd->bqhd', w, v)
    return map_query_blocks(block, q)


def gla_scan(q, k, v, log_a, s0):
    B, T, H, dk = q.shape
    dv = v.shape[-1]
    n = T // B_CHUNK
    def chunks(x):
        x = x.astype(jnp.float32).reshape(B, n, B_CHUNK, H, x.shape[-1])
        return jnp.transpose(x, (1, 0, 3, 2, 4))
    qc = chunks(q) * (dk ** -0.5)
    kc, vc, lc = chunks(k), chunks(v), chunks(log_a)
    b = jnp.cumsum(lc, axis=3)
    b_last = b[:, :, :, -1:, :]
    mask = jnp.tril(jnp.ones((B_CHUNK, B_CHUNK), dtype=bool))[:, :, None]
    diff = b[..., :, None, :] - b[..., None, :, :]
    decay = jnp.where(mask, jnp.exp(jnp.where(mask, diff, 0.0)), 0.0)
    scores = jnp.einsum('nbhid,nbhjd,nbhijd->nbhij', qc, kc, decay)
    o_intra = jnp.einsum('nbhij,nbhjv->nbhiv', scores, vc)
    q_dec = qc * jnp.exp(b)
    k_dec = kc * jnp.exp(b_last - b)
    a_last = jnp.exp(b_last[:, :, :, 0, :])
    def step(S, xs):
        qd, kd, vv, al = xs
        o = jnp.einsum('bhid,bhdv->bhiv', qd, S)
        S = al[..., None] * S + jnp.einsum('bhjd,bhjv->bhdv', kd, vv)
        return S, o
    s_fin, o_inter = lax.scan(step, s0.astype(jnp.float32), (q_dec, k_dec, vc, a_last))
    o = jnp.transpose(o_intra + o_inter, (1, 0, 3, 2, 4)).reshape(B, T, H, dv)
    return o.astype(v.dtype), s_fin.astype(v.dtype)


def gla_bidir(q, k, v, log_a_f, log_a_b, s0_f, s0_b):
    o_f, s_f = gla_scan(q, k, v, log_a_f, s0_f)
    flip = lambda x: jnp.flip(x, axis=1)
    o_b, s_b = gla_scan(flip(q), flip(k), flip(v), flip(log_a_b), s0_b)
    return o_f + flip(o_b), s_f, s_b


def token_mix(h, lp, lam_init, ctx, pos):
    B, T, _ = h.shape
    offs = [int(o) for o in np.cumsum(PROJ_SPLITS)[:-1]]
    a_q, a_k, a_v, b_q, b_k, b_v, b_g, b_r, c_q, c_k, c_v = jnp.split(h @ lp['w_in'], offs, axis=-1)
    a_q = rms_norm(a_q.reshape(B, T, A_HEADS, A_HEAD_DIM), lp['g_a_q'])
    a_k = rms_norm(a_k.reshape(B, T, A_KV_HEADS, A_HEAD_DIM), lp['g_a_k'])
    a_v = a_v.reshape(B, T, A_KV_HEADS, A_HEAD_DIM)
    c_q = rms_norm(c_q.reshape(B, T, C_HEADS, 2, C_QK_DIM), lp['g_c_q'])
    c_k = rms_norm(c_k.reshape(B, T, C_HEADS, 2, C_QK_DIM), lp['g_c_k'])
    c_v = c_v.reshape(B, T, C_HEADS, C_VAL_DIM)
    b_q = b_q.reshape(B, T, B_HEADS, B_KEY_DIM)
    b_k = b_k.reshape(B, T, B_HEADS, B_KEY_DIM)
    b_v = b_v.reshape(B, T, B_HEADS, B_VAL_DIM)
    z = jnp.einsum('btsr,srk->btsk', b_g.reshape(B, T, 2, B_GATE_RANK), lp['w_gla_up']) + lp['b_gla']
    log_a = (jax.nn.log_sigmoid(z.astype(jnp.float32)) / B_GATE_TAU).reshape(B, T, 2, B_HEADS, B_KEY_DIM)
    if ctx is None:
        keys_a, vals_a, keys_c, vals_c = a_k, a_v, c_k, c_v
        s0 = jnp.zeros((B, 2, B_HEADS, B_KEY_DIM, B_VAL_DIM), jnp.float32)
    else:
        row, col = pos
        ctx_a_k, ctx_a_v, ctx_c_k, ctx_c_v, s0 = ctx
        L = ctx_a_k.shape[1]
        a_q = rope_2d(a_q, row, col)
        keys_a = jnp.concatenate([rope_2d(a_k, row, col), ctx_a_k], axis=1)
        vals_a = jnp.concatenate([a_v, ctx_a_v], axis=1)
        c_q = rope_2d(c_q.reshape(B, T, 2 * C_HEADS, C_QK_DIM), row, col).reshape(B, T, C_HEADS, 2, C_QK_DIM)
        c_k_lat = rope_2d(c_k.reshape(B, T, 2 * C_HEADS, C_QK_DIM), row, col).reshape(B, T, C_HEADS, 2, C_QK_DIM)
        keys_c = jnp.concatenate([c_k_lat, ctx_c_k.reshape(B, L, C_HEADS, 2, C_QK_DIM)], axis=1)
        vals_c = jnp.concatenate([c_v, ctx_c_v], axis=1)
    out_a = gqa_attention(a_q.reshape(B, T, A_KV_HEADS, A_HEADS // A_KV_HEADS, A_HEAD_DIM),
                          keys_a, vals_a).reshape(B, T, A_WIDTH)
    o_b, s_f, s_b = gla_bidir(b_q, b_k, b_v, log_a[:, :, 0], log_a[:, :, 1], s0[:, 0], s0[:, 1])
    out_b = (rms_norm(o_b, lp['g_gla']) * jax.nn.silu(b_r).reshape(B, T, B_HEADS, B_VAL_DIM)).reshape(B, T, B_WIDTH)
    lq1, lk1, lq2, lk2 = lp['lam_c'].astype(jnp.float32)
    lam = jnp.exp(jnp.sum(lq1 * lk1)) - jnp.exp(jnp.sum(lq2 * lk2)) + lam_init
    out_c = diff_attention(c_q, keys_c, vals_c, lam)
    out_c = (rms_norm(out_c, lp['g_c_out']) * (1.0 - lam_init)).reshape(B, T, C_WIDTH)
    out = jnp.concatenate([out_a, out_b, out_c], axis=-1) @ lp['w_out']
    if ctx is None:
        new_ctx = (a_k, a_v, c_k.reshape(B, T, C_HEADS, 2 * C_QK_DIM), c_v, jnp.stack([s_f, s_b], axis=1))
        return out, new_ctx
    return out, None


def adaln(cond, lp):
    return (jax.nn.silu(cond) @ lp['w_ada'] + lp['b_ada']).reshape(cond.shape[0], N_MOD, D_MODEL)


def trunk_layer(x, mod, lp, lam_init, ctx=None, pos=None):
    sh1, sc1, g1, sh2, sc2, g2, sh3, sc3, g3 = (mod[:, i] for i in range(N_MOD))
    h = modulate(rms_norm(x, lp['g_norm'][0]), sh1, sc1)
    x = x + 0.5 * g1[:, None, :] * swiglu(h, lp['w_ffn_gate'][0], lp['w_ffn_up'][0], lp['w_ffn_down'][0])
    h = modulate(rms_norm(x, lp['g_norm'][1]), sh2, sc2)
    mix, new_ctx = token_mix(h, lp, lam_init, ctx, pos)
    x = x + g2[:, None, :] * mix
    h = modulate(rms_norm(x, lp['g_norm'][2]), sh3, sc3)
    x = x + 0.5 * g3[:, None, :] * swiglu(h, lp['w_ffn_gate'][1], lp['w_ffn_up'][1], lp['w_ffn_down'][1])
    return x, new_ctx


def setup_inputs(seed: int = 0) -> dict:
    key = jax.random.key(seed)
    ks = jax.random.split(key, 32)
    nrm = lambda k, shape, s: jax.random.normal(k, shape, jnp.float32) * s
    gain = lambda k, shape: 1.0 + 0.02 * jax.random.normal(k, shape, jnp.float32)
    return {
        'x_prompt': nrm(ks[0], (BATCH, SEQ, D_MODEL), 1.0),
        'x_sample': nrm(ks[1], (DEC_BATCH, DEC_SEQ, D_MODEL), 1.0),
        'c': nrm(ks[2], (DEC_BATCH, D_MODEL), 1.0),
        'cache_a_k': nrm(ks[3], (DEC_BATCH, DEPTH, PAST_LEN, A_KV_HEADS, A_HEAD_DIM), 1.0),
        'cache_a_v': nrm(ks[4], (DEC_BATCH, DEPTH, PAST_LEN, A_KV_HEADS, A_HEAD_DIM), 1.0),
        'cache_c_k': nrm(ks[5], (DEC_BATCH, DEPTH, PAST_LEN, C_HEADS, 2 * C_QK_DIM), 1.0),
        'cache_c_v': nrm(ks[6], (DEC_BATCH, DEPTH, PAST_LEN, C_HEADS, C_VAL_DIM), 1.0),
        'state_gla': nrm(ks[7], (DEC_BATCH, DEPTH, 2, B_HEADS, B_KEY_DIM, B_VAL_DIM), 2.0),
        'c_ctx': nrm(ks[8], (D_MODEL,), 1.0),
        'w_ada': nrm(ks[9], (DEPTH, D_MODEL, N_MOD * D_MODEL), 0.5 * D_MODEL ** -0.5),
        'b_ada': nrm(ks[10], (DEPTH, N_MOD * D_MODEL), 0.02),
        'g_norm': gain(ks[11], (DEPTH, 3, D_MODEL)),
        'w_ffn_gate': nrm(ks[12], (DEPTH, 2, D_MODEL, D_FF), D_MODEL ** -0.5),
        'w_ffn_up': nrm(ks[13], (DEPTH, 2, D_MODEL, D_FF), D_MODEL ** -0.5),
        'w_ffn_down': nrm(ks[14], (DEPTH, 2, D_FF, D_MODEL), D_FF ** -0.5),
        'w_in': nrm(ks[15], (DEPTH, D_MODEL, PROJ_WIDTH), D_MODEL ** -0.5),
        'g_a_q': gain(ks[16], (DEPTH, A_HEAD_DIM)),
        'g_a_k': gain(ks[17], (DEPTH, A_HEAD_DIM)),
        'w_gla_up': nrm(ks[18], (DEPTH, 2, B_GATE_RANK, B_HEADS * B_KEY_DIM), B_GATE_RANK ** -0.5),
        'b_gla': nrm(ks[19], (DEPTH, 2, B_HEADS * B_KEY_DIM), 0.1),
        'g_gla': gain(ks[20], (DEPTH, B_VAL_DIM)),
        'g_c_q': gain(ks[21], (DEPTH, 2, C_QK_DIM)),
        'g_c_k': gain(ks[22], (DEPTH, 2, C_QK_DIM)),
        'lam_c': nrm(ks[23], (DEPTH, 4, C_QK_DIM), 0.1),
        'g_c_out': gain(ks[24], (DEPTH, C_VAL_DIM)),
        'w_out': nrm(ks[25], (DEPTH, MIX_WIDTH, D_MODEL), MIX_WIDTH ** -0.5),
    }


def reference(x_prompt, x_sample, c, cache_a_k, cache_a_v, cache_c_k, cache_c_v, state_gla, c_ctx,
              w_ada, b_ada, g_norm, w_ffn_gate, w_ffn_up, w_ffn_down, w_in, g_a_q, g_a_k,
              w_gla_up, b_gla, g_gla, g_c_q, g_c_k, lam_c, g_c_out, w_out):
    layers = [dict(w_ada=w_ada[l], b_ada=b_ada[l], g_norm=g_norm[l], w_ffn_gate=w_ffn_gate[l],
                   w_ffn_up=w_ffn_up[l], w_ffn_down=w_ffn_down[l], w_in=w_in[l], g_a_q=g_a_q[l],
                   g_a_k=g_a_k[l], w_gla_up=w_gla_up[l], b_gla=b_gla[l], g_gla=g_gla[l],
                   g_c_q=g_c_q[l], g_c_k=g_c_k[l], lam_c=lam_c[l], g_c_out=g_c_out[l], w_out=w_out[l])
              for l in range(DEPTH)]
    lam_inits = [0.8 - 0.6 * math.exp(-0.3 * l) for l in range(DEPTH)]

    y = x_prompt
    ak, av, ck, cv, sg = [], [], [], [], []
    for l in range(DEPTH):
        mod = adaln(c_ctx[None, :], layers[l])
        y, (k_a, v_a, k_c, v_c, s_g) = trunk_layer(y, mod, layers[l], lam_inits[l])
        ak.append(k_a); av.append(v_a); ck.append(k_c); cv.append(v_c); sg.append(s_g)
    y_prompt = y

    T = x_sample.shape[1]
    ROWS = T // GRID_W
    row = jnp.repeat(jnp.arange(ROWS), GRID_W).astype(jnp.float32)
    col = jnp.tile(jnp.arange(GRID_W), ROWS).astype(jnp.float32)
    z = x_sample
    for l in range(DEPTH):
        mod = adaln(c, layers[l])
        ctx = (cache_a_k[:, l], cache_a_v[:, l], cache_c_k[:, l], cache_c_v[:, l], state_gla[:, l])
        z, _ = trunk_layer(z, mod, layers[l], lam_inits[l], ctx, (row, col))
    y_sample = z

    return (y_prompt, y_sample, jnp.stack(ak, axis=1), jnp.stack(av, axis=1), jnp.stack(ck, axis=1),
            jnp.stack(cv, axis=1), jnp.stack(sg, axis=1))
```

```cpp
#include <hip/hip_runtime.h>
#include <hip/hip_cooperative_groups.h>
#include <cstdio>
#include <cmath>
namespace cg = cooperative_groups;
#ifndef PROBE
#define PROBE 0
#endif

typedef unsigned short bf16_t;
typedef short bf16x8 __attribute__((ext_vector_type(8)));
typedef short s16x4 __attribute__((ext_vector_type(4)));
typedef float f32x4 __attribute__((ext_vector_type(4)));
#define LDSP __attribute__((address_space(3)))
#define DI __device__ __forceinline__

constexpr int DM = 1024, DFF = 2816, NTOK = 12288, NCTX = 8192, PW = 2560, PWP = 2560, PWR = 2592;
constexpr int OFF_AQ = 0, OFF_AK = 384, OFF_AV = 512, OFF_BQ = 640, OFF_BK = 768, OFF_BV = 896,
              OFF_BR = 1152, OFF_CQ = 1408, OFF_CK = 1792, OFF_CV = 2176, OFF_BGW = 2560;
constexpr float EPSN = 1e-6f;
constexpr float LOG2E = 1.4426950408889634f;
constexpr size_t O_YP = 0, O_YS = 8388608, O_AK = 12582912, O_AV = 16777216, O_CK = 20971520, O_CV = 33554432, O_ST = 46137344;

constexpr size_t XCD_BAR_WORDS_C = 3456;
constexpr size_t al256(size_t x) { return (x + 255) & ~(size_t)255; }
constexpr size_t WS_MOD = 0;
constexpr size_t WS_MISC = al256(WS_MOD + 4ull * 3 * 9216 * 4);
constexpr size_t WS_ROPE = WS_MISC + 256;
constexpr size_t WS_WGU = al256(WS_ROPE + (1024 * 2 + 768 * 2) * 4);
constexpr size_t WS_WD = WS_WGU + 8ull * 5632 * 1024 * 2;
constexpr size_t WS_WIN = WS_WD + 8ull * 1024 * 2816 * 2;
constexpr size_t WS_WOUT = WS_WIN + 4ull * PWR * 1024 * 2;
constexpr size_t WS_H = WS_WOUT + 4ull * 1024 * 1024 * 2;
constexpr size_t WS_MIX = WS_H + (size_t)NTOK * 1024 * 2;
constexpr size_t WS_ACT = WS_MIX + (size_t)NTOK * 1024 * 2;
constexpr size_t WS_PROJ = WS_ACT + (size_t)NTOK * DFF * 2;
constexpr size_t WS_QA = WS_PROJ + (size_t)NTOK * PW * 2;
constexpr size_t WS_KA = WS_QA + (size_t)NTOK * 384 * 2;
constexpr size_t WS_QC = WS_KA + (size_t)NTOK * 128 * 2;
constexpr size_t WS_KC = WS_QC + (size_t)NTOK * 512 * 2;
constexpr size_t WS_GB = WS_KC + (size_t)NTOK * 512 * 2;
constexpr size_t WS_ATOT = WS_GB + (size_t)NTOK * 256 * 4;
constexpr size_t WS_U = WS_ATOT + 2 * 192ull * 256 * 4;
constexpr size_t WS_KAC = WS_U + 192ull * 2 * 4 * 2048 * 4;
constexpr size_t WS_VAC = WS_KAC + 2ull * 4 * 512 * 128 * 2;
constexpr size_t WS_KCC = WS_VAC + 2ull * 4 * 512 * 128 * 2;
constexpr size_t WS_VCC = WS_KCC + 2ull * 4 * 512 * 512 * 2;
constexpr size_t WS_BAR = WS_VCC + 2ull * 4 * 512 * 384 * 2;
constexpr size_t WS_ROWSS = al256(WS_BAR + XCD_BAR_WORDS_C * 4);
constexpr size_t WS_BIAS = WS_ROWSS + (size_t)NTOK * 16 * 4;
constexpr size_t WS_END = WS_BIAS + 4ull * 3 * 3 * 5632 * 4;

struct Params {
  const float* in[26];
  float* out;
  char* ws;
  float freqA[16];
  float freqC[12];
  float lam_init[4];
};

DI float bf2f(bf16_t v) { return __uint_as_float(((unsigned)v) << 16); }
DI bf16_t f2bf(float f) { unsigned u = __float_as_uint(f); u += 0x7fffu + ((u >> 16) & 1u); return (bf16_t)(u >> 16); }
typedef float f32x2_t __attribute__((ext_vector_type(2)));
typedef __bf16 bf16x2_t __attribute__((ext_vector_type(2)));
DI unsigned pack2(float lo, float hi) { const f32x2_t v = {lo, hi}; return __builtin_bit_cast(unsigned, __builtin_convertvector(v, bf16x2_t)); }
DI float fast_exp2(float x) { return __builtin_amdgcn_exp2f(x); }
DI float fast_rcp(float x) { return __builtin_amdgcn_rcpf(x); }
DI float silu_f(float g) { return g * fast_rcp(1.f + fast_exp2(-g * LOG2E)); }
DI float sigm_silu_acc(float g) { return g / (1.f + expf(-g)); }
DI void unpack8(uint4 v, float* x) {
  x[0] = __uint_as_float(v.x << 16); x[1] = __uint_as_float(v.x & 0xffff0000u);
  x[2] = __uint_as_float(v.y << 16); x[3] = __uint_as_float(v.y & 0xffff0000u);
  x[4] = __uint_as_float(v.z << 16); x[5] = __uint_as_float(v.z & 0xffff0000u);
  x[6] = __uint_as_float(v.w << 16); x[7] = __uint_as_float(v.w & 0xffff0000u);
}
DI void unpack4(uint2 v, float* x) {
  x[0] = __uint_as_float(v.x << 16); x[1] = __uint_as_float(v.x & 0xffff0000u);
  x[2] = __uint_as_float(v.y << 16); x[3] = __uint_as_float(v.y & 0xffff0000u);
}
DI int otid() { int t = threadIdx.x & 255; asm volatile("" : "+v"(t)); return t; }
DI int ohalf() { return __builtin_amdgcn_readfirstlane((int)(threadIdx.x >> 8)); }
DI int obid() { int b = blockIdx.x * 2 + ohalf(); asm volatile("" : "+s"(b)); return b; }
DI int vnb() { return gridDim.x * 2; }
DI int rtid() { int t = threadIdx.x; asm volatile("" : "+v"(t)); return t; }
DI int cond_of_row(int row) { return row < NCTX ? 0 : 1 + ((row - NCTX) >> 11); }


#define XB_TMO      128
#define XB_XCNT(j)  (256  + 64 * (j))
#define XB_XSUB(j)  (1280 + 64 * (j))
#define XB_XGEN(j)  (2304 + 64 * (j))
#define XB_TOP      3328
#define XB_TOPGEN   3392
#define XCD_BAR_WORDS 3456
#define XB_SPIN_CAP (1u << 22)
DI unsigned xb_ld(unsigned* p) { return __hip_atomic_load(p, __ATOMIC_RELAXED, __HIP_MEMORY_SCOPE_AGENT); }
DI unsigned xb_add(unsigned* p, unsigned v) { return __hip_atomic_fetch_add(p, v, __ATOMIC_RELAXED, __HIP_MEMORY_SCOPE_AGENT); }
DI unsigned xb_xcc_id() { return (unsigned)__builtin_amdgcn_s_getreg((3 << 11) | 20) & 0xFu; }
#define XB_SPIN(cond, bar) do { unsigned _sp = 0; while (cond) { __builtin_amdgcn_s_sleep(1); \
    if ((++_sp & 255u) == 0u) { if (xb_ld(&(bar)[XB_TMO])) break; if (_sp > XB_SPIN_CAP) { atomicAdd(&(bar)[XB_TMO], 1u); break; } } } } while (0)
struct XcdBarrier { unsigned* bar; unsigned x; volatile LDSP unsigned* st; };
DI XcdBarrier xcd_barrier_post(unsigned* bar, volatile LDSP unsigned* st) {
  XcdBarrier b; b.bar = bar; b.x = xb_xcc_id(); b.st = st;
  if (threadIdx.x == 0) (void)xb_add(&bar[XB_XCNT(b.x)], 1u);
  return b;
}
DI void xcd_barrier_complete(unsigned* bar, unsigned x, unsigned& nloc, unsigned& nx) {
  const unsigned G = gridDim.x * gridDim.y * gridDim.z;
  unsigned sum, cnt, mine, sp = 0u;
  for (;;) {
    sum = 0u; cnt = 0u; mine = 0u;
#pragma unroll
    for (unsigned j = 0; j < 16; ++j) { const unsigned c = xb_ld(&bar[XB_XCNT(j)]); sum += c; cnt += (c > 0u) ? 1u : 0u; mine = (j == x) ? c : mine; }
    if (sum == G) break;
    __builtin_amdgcn_s_sleep(1);
    if ((++sp & 255u) == 0u) { if (xb_ld(&bar[XB_TMO])) break; if (sp > XB_SPIN_CAP) { atomicAdd(&bar[XB_TMO], 1u); break; } }
  }
  nloc = mine > 0u ? mine : 1u; nx = cnt > 0u ? cnt : 1u;
}
DI void xcd_barrier(const XcdBarrier& b_) {
  asm volatile("s_waitcnt vmcnt(0)" ::: "memory");
  __syncthreads();
  if (threadIdx.x == 0) {
    XcdBarrier b; b.st = b_.st;
    { unsigned* q = b_.bar; asm volatile("" : "+s"(q)); b.bar = q; }
    { unsigned xx = xb_xcc_id(); asm volatile("" : "+s"(xx)); b.x = xx; }
    unsigned* bar = b.bar;
    __builtin_amdgcn_s_waitcnt(0);
    unsigned nloc = b.st[0], nx = b.st[1];
    if (nloc == 0u) { xcd_barrier_complete(bar, b.x, nloc, nx); b.st[0] = nloc; b.st[1] = nx; }
    const unsigned old = xb_add(&bar[XB_XSUB(b.x)], 1u);
    const unsigned gen = old / nloc;
    if (old + 1u == (gen + 1u) * nloc) {
      __builtin_amdgcn_fence(__ATOMIC_RELEASE, "agent");
      asm volatile("s_waitcnt vmcnt(0)" ::: "memory");
      const unsigned og = xb_add(&bar[XB_TOP], 1u);
      const unsigned tg = og / nx;
      if (og + 1u == (tg + 1u) * nx) xb_add(&bar[XB_TOPGEN], 1u);
      else XB_SPIN(xb_ld(&bar[XB_TOPGEN]) == tg, bar);
      __builtin_amdgcn_fence(__ATOMIC_ACQUIRE, "agent");
      xb_add(&bar[XB_XGEN(b.x)], 1u);
      asm volatile("s_waitcnt vmcnt(0)" ::: "memory");
    } else {
      XB_SPIN(xb_ld(&bar[XB_XGEN(b.x)]) == gen, bar);
      __builtin_amdgcn_fence(__ATOMIC_ACQUIRE, "agent");
      asm volatile("s_waitcnt vmcnt(0)" ::: "memory");
    }
  }
  __syncthreads();
}

DI void transpose_tile(const float* __restrict__ src, int K, int N, bf16_t* __restrict__ dst, int mode, int kt, int nt, float* sm) {
  const int t = otid();
  const int k0 = kt * 64, n0 = nt * 64;
#pragma unroll
  for (int i = 0; i < 4; ++i) {
    const int idx = t + 256 * i, r = idx >> 4, c4 = idx & 15;
    float4 v = make_float4(0.f, 0.f, 0.f, 0.f);
    if (n0 + 4 * c4 < N) v = *(const float4*)(src + (size_t)(k0 + r) * N + n0 + 4 * c4);
    float* d = sm + r * 65 + 4 * c4;
    d[0] = v.x; d[1] = v.y; d[2] = v.z; d[3] = v.w;
  }
  __syncthreads();
#pragma unroll
  for (int i = 0; i < 2; ++i) {
    const int idx = t + 256 * i, nl = idx >> 3, kc = idx & 7;
    const int n = n0 + nl;
    if (n < N) {
      float x[8];
#pragma unroll
      for (int e = 0; e < 8; ++e) x[e] = sm[(8 * kc + e) * 65 + nl];
      uint4 w; w.x = pack2(x[0], x[1]); w.y = pack2(x[2], x[3]); w.z = pack2(x[4], x[5]); w.w = pack2(x[6], x[7]);
      int drow = n;
      if (mode == 1) drow = (n >> 4) * 32 + (n & 15);
      else if (mode == 2) drow = (n >> 4) * 32 + 16 + (n & 15);
      *(uint4*)(dst + (size_t)drow * K + k0 + 8 * kc) = w;
    }
  }
  __syncthreads();
}

DI void adaln_item(const Params& p, int it, float* sm) {
  const int t = otid();
  const int l = it / 72, chunk = it % 72, j0 = chunk * 128;
  float* scond = sm;
  float* red = sm + 3072;
  for (int i = t; i < 3072; i += 256) {
    const int c = i >> 10, k = i & 1023;
    const float v = (c == 0) ? p.in[8][k] : p.in[2][(c - 1) * 1024 + k];
    scond[i] = sigm_silu_acc(v);
  }
  __syncthreads();
  const int cgp = t & 31, kg = t >> 5;
  const float* w = p.in[9] + (size_t)l * 1024 * 9216 + j0 + 4 * cgp;
  float acc[3][4];
#pragma unroll
  for (int c = 0; c < 3; ++c)
#pragma unroll
    for (int e = 0; e < 4; ++e) acc[c][e] = 0.f;
#pragma unroll 8
  for (int kk = 0; kk < 128; ++kk) {
    const int k = kg * 128 + kk;
    const float4 wv = *(const float4*)(w + (size_t)k * 9216);
#pragma unroll
    for (int c = 0; c < 3; ++c) {
      const float s = scond[c * 1024 + k];
      acc[c][0] += s * wv.x; acc[c][1] += s * wv.y; acc[c][2] += s * wv.z; acc[c][3] += s * wv.w;
    }
  }
#pragma unroll
  for (int c = 0; c < 3; ++c)
#pragma unroll
    for (int e = 0; e < 4; ++e) red[(kg * 3 + c) * 128 + 4 * cgp + e] = acc[c][e];
  __syncthreads();
  float* mod = (float*)(p.ws + WS_MOD);
  for (int o = t; o < 384; o += 256) {
    const int c = o >> 7, j = o & 127;
    float s = p.in[10][l * 9216 + j0 + j];
#pragma unroll
    for (int g = 0; g < 8; ++g) s += red[(g * 3 + c) * 128 + j];
    mod[(l * 3 + c) * 9216 + j0 + j] = s;
  }
  __syncthreads();
}

DI void sincos_tab(float pos, float freq, float& cs, float& sn) {
  const double a = (double)pos * (double)freq;
  const double twopi = 6.283185307179586476925286766559;
  const double k = rint(a / twopi);
  const double r = (a - k * twopi) * 0.25;
  const double r2 = r * r;
  double s = r * (1.0 + r2 * (-1.0 / 6 + r2 * (1.0 / 120 + r2 * (-1.0 / 5040 + r2 * (1.0 / 362880 + r2 * (-1.0 / 39916800 + r2 * (1.0 / 6227020800.0)))))));
  double c = 1.0 + r2 * (-0.5 + r2 * (1.0 / 24 + r2 * (-1.0 / 720 + r2 * (1.0 / 40320 + r2 * (-1.0 / 3628800 + r2 * (1.0 / 479001600.0 + r2 * (-1.0 / 87178291200.0)))))));
  double s2 = 2.0 * s * c, c2 = 1.0 - 2.0 * s * s;
  double s4 = 2.0 * s2 * c2, c4 = 1.0 - 2.0 * s2 * s2;
  cs = (float)c4; sn = (float)s4;
}

struct TDesc { const float* src; bf16_t* dst; int K, N, mode, kt, nt; };
DI TDesc tile_desc(const Params& p, int r) {
  TDesc d;
  const int l = r / 5136; r -= l * 5136;
  if (r < 4224) {
    const int f = r / 2112; r -= f * 2112;
    const int which = r / 704; r -= which * 704;
    const int lf = l * 2 + f;
    if (which < 2) { d.src = p.in[which == 0 ? 12 : 13] + (size_t)lf * 1024 * 2816; d.dst = (bf16_t*)(p.ws + WS_WGU) + (size_t)lf * 5632 * 1024; d.K = 1024; d.N = 2816; d.mode = which + 1; d.kt = r / 44; d.nt = r % 44; }
    else { d.src = p.in[14] + (size_t)lf * 2816 * 1024; d.dst = (bf16_t*)(p.ws + WS_WD) + (size_t)lf * 1024 * 2816; d.K = 2816; d.N = 1024; d.mode = 0; d.kt = r / 16; d.nt = r % 16; }
  } else if (r < 4224 + 656) {
    r -= 4224;
    d.src = p.in[15] + (size_t)l * 1024 * PWR; d.dst = (bf16_t*)(p.ws + WS_WIN) + (size_t)l * PWR * 1024; d.K = 1024; d.N = PWR; d.mode = 3; d.kt = r / 41; d.nt = r % 41;
  } else {
    r -= 4224 + 656;
    d.src = p.in[25] + (size_t)l * 1024 * 1024; d.dst = (bf16_t*)(p.ws + WS_WOUT) + (size_t)l * 1024 * 1024; d.K = 1024; d.N = 1024; d.mode = 0; d.kt = r / 16; d.nt = r % 16;
  }
  return d;
}
DI void tile_load(const TDesc& d, int t, f32x4 (&v)[4]) {
  const int k0 = d.kt * 64, n0 = d.nt * 64;
#pragma unroll
  for (int i = 0; i < 4; ++i) {
    const int idx = t + 256 * i, r = idx >> 4, c4 = idx & 15;
    v[i] = (f32x4){0.f, 0.f, 0.f, 0.f};
    if (n0 + 4 * c4 < d.N) v[i] = __builtin_nontemporal_load((const f32x4*)(d.src + (size_t)(k0 + r) * d.N + n0 + 4 * c4));
  }
}
DI void tile_store(const TDesc& d, int t, const f32x4 (&v)[4], float* sm) {
  const int k0 = d.kt * 64, n0 = d.nt * 64;
#pragma unroll
  for (int i = 0; i < 4; ++i) {
    const int idx = t + 256 * i, r = idx >> 4, c4 = idx & 15;
    float* q = sm + r * 65 + 4 * c4;
    q[0] = v[i][0]; q[1] = v[i][1]; q[2] = v[i][2]; q[3] = v[i][3];
  }
  __syncthreads();
#pragma unroll
  for (int i = 0; i < 2; ++i) {
    const int idx = t + 256 * i, nl = idx >> 3, kc = idx & 7;
    const int n = n0 + nl;
    if (n < d.N) {
      float x[8];
#pragma unroll
      for (int e = 0; e < 8; ++e) x[e] = sm[(8 * kc + e) * 65 + nl];
      uint4 w; w.x = pack2(x[0], x[1]); w.y = pack2(x[2], x[3]); w.z = pack2(x[4], x[5]); w.w = pack2(x[6], x[7]);
      int drow = n;
      if (d.mode == 1) drow = (n >> 4) * 32 + (n & 15);
      else if (d.mode == 2) drow = (n >> 4) * 32 + 16 + (n & 15);
      else if (d.mode == 3) drow = n < 1152 ? n : (n < 1184 ? OFF_BGW + (n - 1152) : n - 32);
      *(uint4*)(d.dst + (size_t)drow * d.K + k0 + 8 * kc) = w;
    }
  }
  __syncthreads();
}

DI void phase0(const Params& p, float* sm) {
  const int nb = vnb(), bid = obid(), t = otid();
  if (bid < 288) adaln_item(p, bid, sm);
  {
    const int n_tiles = 4 * 5136;
    int r = bid;
    f32x4 cur[4], nxt[4];
    TDesc dc = tile_desc(p, r < n_tiles ? r : 0);
    if (r < n_tiles) tile_load(dc, t, cur);
#pragma unroll 1
    for (; r < n_tiles; r += nb) {
      const int rn = r + nb;
      TDesc dn = tile_desc(p, rn < n_tiles ? rn : 0);
      if (rn < n_tiles) tile_load(dn, t, nxt);
      tile_store(dc, t, cur, sm);
      dc = dn;
#pragma unroll
      for (int i = 0; i < 4; ++i) cur[i] = nxt[i];
    }
  }
  #define gt ((size_t)(blockIdx.x * 512 + rtid()))
  const size_t gs = (size_t)gridDim.x * 512;
  {
    float4* dst = (float4*)p.out;
    const float4* s0 = (const float4*)p.in[0];
    const float4* s1 = (const float4*)p.in[1];
    const size_t n0 = (size_t)NCTX * 256, n1 = (size_t)NTOK * 256;
    for (size_t i = gt; i < n1; i += gs) dst[i] = (i < n0) ? s0[i] : s1[i - n0];
  }
  {
    bf16_t* kac = (bf16_t*)(p.ws + WS_KAC); bf16_t* vac = (bf16_t*)(p.ws + WS_VAC);
    for (size_t i = gt; i < 524288 / 4; i += gs) {
      const float4 a = ((const float4*)p.in[3])[i], b = ((const float4*)p.in[4])[i];
      uint2 wa, wb; wa.x = pack2(a.x, a.y); wa.y = pack2(a.z, a.w); wb.x = pack2(b.x, b.y); wb.y = pack2(b.z, b.w);
      ((uint2*)kac)[i] = wa; ((uint2*)vac)[i] = wb;
    }
    bf16_t* vcc = (bf16_t*)(p.ws + WS_VCC);
    for (size_t i = gt; i < 1572864 / 4; i += gs) {
      const float4 a = ((const float4*)p.in[6])[i];
      uint2 wa; wa.x = pack2(a.x, a.y); wa.y = pack2(a.z, a.w);
      ((uint2*)vcc)[i] = wa;
    }
    bf16_t* kcc = (bf16_t*)(p.ws + WS_KCC);
    for (size_t i = gt; i < 4096ull * 8 * 16; i += gs) {
      const size_t rv = i >> 4; const int g = (int)(i & 15);
      uint2 w = make_uint2(0, 0);
      if (g < 12) { const float4 a = *(const float4*)(p.in[5] + rv * 48 + 4 * g); w.x = pack2(a.x, a.y); w.y = pack2(a.z, a.w); }
      *(uint2*)(kcc + rv * 64 + 4 * g) = w;
    }
  }
  {
    float* rope = (float*)(p.ws + WS_ROPE);
    for (size_t i = gt; i < 1024 + 768; i += gs) {
      if (i < 1024) { const int pos = (int)i >> 4, f = (int)i & 15; float c, s; sincos_tab((float)pos, p.freqA[f], c, s); rope[i] = c; rope[1024 + i] = s; }
      else { const int j = (int)i - 1024; const int pos = j / 12, f = j % 12; float c, s; sincos_tab((float)pos, p.freqC[f], c, s); rope[2048 + j] = c; rope[2048 + 768 + j] = s; }
    }
    if (gt < 4) {
      const float* lc = p.in[23] + gt * 4 * 48;
      float s1 = 0.f, s2 = 0.f;
      for (int d = 0; d < 48; ++d) { s1 += lc[d] * lc[48 + d]; s2 += lc[96 + d] * lc[144 + d]; }
      ((float*)(p.ws + WS_MISC))[gt] = expf(s1) - expf(s2) + p.lam_init[gt];
      ((unsigned*)(p.ws + WS_MISC + 64))[gt] = 0u; ((unsigned*)(p.ws + WS_MISC + 64))[gt + 4] = 0u;
    }
  }
}
#undef gt

DI void norm0_bias_phase(const Params& p) {
  const int tx = rtid(); const int lane = tx & 63;
  const int gw = blockIdx.x * 8 + (tx >> 6), nw = gridDim.x * 8;
  const float* mod = (const float*)(p.ws + WS_MOD);
  {
    const float* g = p.in[11];
    bf16_t* H = (bf16_t*)(p.ws + WS_H);
    float* RS = (float*)(p.ws + WS_ROWSS);
    for (int row = gw; row < NTOK; row += nw) {
      const float* x = p.out + (size_t)row * 1024;
      float4 v[4]; float ss = 0.f;
#pragma unroll
      for (int c = 0; c < 4; ++c) { v[c] = *(const float4*)(x + c * 256 + lane * 4); ss += v[c].x * v[c].x + v[c].y * v[c].y + v[c].z * v[c].z + v[c].w * v[c].w; }
#pragma unroll
      for (int o = 32; o >= 1; o >>= 1) ss += __shfl_xor(ss, o);
      if (lane < 16) RS[(size_t)row * 16 + lane] = lane == 0 ? ss : 0.f;
      const float* mrow = mod + ((size_t)cond_of_row(row)) * 9216;
#pragma unroll
      for (int c = 0; c < 4; ++c) {
        const int j = c * 256 + lane * 4;
        const float4 gg = *(const float4*)(g + j), sc = *(const float4*)(mrow + 1024 + j);
        uint2 w; w.x = pack2(v[c].x * gg.x * (1.f + sc.x), v[c].y * gg.y * (1.f + sc.y)); w.y = pack2(v[c].z * gg.z * (1.f + sc.z), v[c].w * gg.w * (1.f + sc.w));
        *(uint2*)(H + (size_t)row * 1024 + j) = w;
      }
    }
  }
  {
    float* BIAS = (float*)(p.ws + WS_BIAS);
#pragma unroll 1
    for (int grp = 0; grp < 12; ++grp) {
      const int l = grp / 3, sub = grp - l * 3;
      const int ncol = sub == 1 ? PWR : 5632;
      const bf16_t* Wt = sub == 1 ? (const bf16_t*)(p.ws + WS_WIN) + (size_t)l * PWR * 1024 : (const bf16_t*)(p.ws + WS_WGU) + (size_t)(l * 2 + (sub >> 1)) * 5632 * 1024;
      float sh[3][16];
#pragma unroll
      for (int c = 0; c < 3; ++c) {
        const float* sp = mod + ((size_t)l * 3 + c) * 9216 + (size_t)(3 * sub) * 1024 + lane * 16;
#pragma unroll
        for (int q = 0; q < 4; ++q) { const float4 t = *(const float4*)(sp + 4 * q); sh[c][4 * q] = t.x; sh[c][4 * q + 1] = t.y; sh[c][4 * q + 2] = t.z; sh[c][4 * q + 3] = t.w; }
      }
#pragma unroll 2
      for (int n = gw; n < ncol; n += nw) {
        float w[16]; unpack8(*(const uint4*)(Wt + (size_t)n * 1024 + lane * 16), w); unpack8(*(const uint4*)(Wt + (size_t)n * 1024 + lane * 16 + 8), w + 8);
        float d0 = 0.f, d1 = 0.f, d2 = 0.f;
#pragma unroll
        for (int e = 0; e < 16; ++e) { d0 += sh[0][e] * w[e]; d1 += sh[1][e] * w[e]; d2 += sh[2][e] * w[e]; }
#pragma unroll
        for (int o = 32; o >= 1; o >>= 1) { d0 += __shfl_xor(d0, o); d1 += __shfl_xor(d1, o); d2 += __shfl_xor(d2, o); }
        if (lane < 3) BIAS[((size_t)grp * 3 + lane) * 5632 + n] = lane == 0 ? d0 : (lane == 1 ? d1 : d2);
      }
    }
  }
}

enum { EPI_SWIGLU = 0, EPI_RESID = 1, EPI_PROJ = 2 };

template <int EPI>
DI void gemm_phase(const Params& p, const bf16_t* __restrict__ A, int lda, const bf16_t* __restrict__ Bt, int K, int NT,
                   const float* __restrict__ gate_base  , float coef, char* smem) {
  const int tid = otid(), lane = tid & 63, wave = tid >> 6, wm = wave >> 1, wn = wave & 1;
  const int nb = vnb(), xcd = obid() & 7, slot = obid() >> 3, slots = nb >> 3;
  const int per_x = 12 * NT;
  const int nk = K >> 6;
  char* As = smem;
  char* Bs = smem + 32768;
  for (int q = slot; q < per_x; q += slots) {
    const int grp = q / (4 * NT), r = q - grp * 4 * NT, nt = r >> 2, mtl = r & 3, mt = (grp * 4 + mtl) * 8 + xcd;
    const int m0 = mt * 128, n0 = nt * 128;
    f32x4 acc[4][4];
#pragma unroll
    for (int i = 0; i < 4; ++i)
#pragma unroll
      for (int j = 0; j < 4; ++j) acc[i][j] = (f32x4){0.f, 0.f, 0.f, 0.f};
    const bf16_t* Ag = A + (size_t)(m0 + (tid >> 3)) * lda + (tid & 7) * 8;
    const bf16_t* Bg = Bt + (size_t)(n0 + (tid >> 3)) * K + (tid & 7) * 8;
    const int lrow = tid >> 3, lch = tid & 7;
    uint4 ra[4], rb[4];
#pragma unroll
    for (int i = 0; i < 4; ++i) { ra[i] = *(const uint4*)(Ag + (size_t)(32 * i) * lda); rb[i] = *(const uint4*)(Bg + (size_t)(32 * i) * K); }
#pragma unroll
    for (int i = 0; i < 4; ++i) {
      const int row = lrow + 32 * i; const int off = row * 128 + ((lch ^ (row & 7)) << 4);
      *(uint4*)(As + off) = ra[i]; *(uint4*)(Bs + off) = rb[i];
    }
    __syncthreads();
    for (int kt = 0; kt < nk; ++kt) {
      const int cur = kt & 1;
      if (kt + 1 < nk) {
        const int k0 = (kt + 1) * 64;
#pragma unroll
        for (int i = 0; i < 4; ++i) { ra[i] = *(const uint4*)(Ag + (size_t)(32 * i) * lda + k0); rb[i] = *(const uint4*)(Bg + (size_t)(32 * i) * K + k0); }
      }
      const char* as = As + cur * 16384; const char* bs = Bs + cur * 16384;
#pragma unroll
      for (int ks = 0; ks < 2; ++ks) {
        bf16x8 ax[4], bw[4];
        const int ch = ((ks * 4 + (lane >> 4)) ^ (lane & 7)) << 4;
#pragma unroll
        for (int i = 0; i < 4; ++i) {
          ax[i] = *(const bf16x8*)(as + (wm * 64 + i * 16 + (lane & 15)) * 128 + ch);
          bw[i] = *(const bf16x8*)(bs + (wn * 64 + i * 16 + (lane & 15)) * 128 + ch);
        }
#pragma unroll
        for (int mi = 0; mi < 4; ++mi)
#pragma unroll
          for (int ni = 0; ni < 4; ++ni) acc[mi][ni] = __builtin_amdgcn_mfma_f32_16x16x32_bf16(bw[ni], ax[mi], acc[mi][ni], 0, 0, 0);
      }
      if (kt + 1 < nk) {
        const int nxt = cur ^ 1;
#pragma unroll
        for (int i = 0; i < 4; ++i) {
          const int row = lrow + 32 * i; const int off = nxt * 16384 + row * 128 + ((lch ^ (row & 7)) << 4);
          *(uint4*)(As + off) = ra[i]; *(uint4*)(Bs + off) = rb[i];
        }
      }
      __syncthreads();
    }
    const int tok0 = m0 + wm * 64 + (lane & 15);
    const int nc0 = n0 + wn * 64 + (lane >> 4) * 4;
    if (EPI == EPI_SWIGLU) {
      bf16_t* ACT = (bf16_t*)(p.ws + WS_ACT);
#pragma unroll
      for (int mi = 0; mi < 4; ++mi) {
        const size_t rowoff = (size_t)(tok0 + mi * 16) * DFF;
#pragma unroll
        for (int pr = 0; pr < 2; ++pr) {
          const f32x4 g = acc[mi][2 * pr], u = acc[mi][2 * pr + 1];
          const int ffc = ((n0 + wn * 64) >> 1) + pr * 16 + (lane >> 4) * 4;
          uint2 w; w.x = pack2(silu_f(g[0]) * u[0], silu_f(g[1]) * u[1]); w.y = pack2(silu_f(g[2]) * u[2], silu_f(g[3]) * u[3]);
          *(uint2*)(ACT + rowoff + ffc) = w;
        }
      }
    } else if (EPI == EPI_RESID) {
      const float* gv = gate_base + (size_t)cond_of_row(m0) * 9216;
#pragma unroll
      for (int ni = 0; ni < 4; ++ni) {
        const int n = nc0 + ni * 16;
        const float4 gg = *(const float4*)(gv + n);
#pragma unroll
        for (int mi = 0; mi < 4; ++mi) {
          float* xp = p.out + (size_t)(tok0 + mi * 16) * 1024 + n;
          float4 xv = *(const float4*)xp;
          xv.x += coef * gg.x * acc[mi][ni][0]; xv.y += coef * gg.y * acc[mi][ni][1];
          xv.z += coef * gg.z * acc[mi][ni][2]; xv.w += coef * gg.w * acc[mi][ni][3];
          *(float4*)xp = xv;
        }
      }
    } else {
      bf16_t* PR = (bf16_t*)(p.ws + WS_PROJ);
#pragma unroll
      for (int ni = 0; ni < 4; ++ni) {
        const int n = nc0 + ni * 16;
        if (n < PW) {
#pragma unroll
          for (int mi = 0; mi < 4; ++mi) {
            uint2 w; w.x = pack2(acc[mi][ni][0], acc[mi][ni][1]); w.y = pack2(acc[mi][ni][2], acc[mi][ni][3]);
            *(uint2*)(PR + (size_t)(tok0 + mi * 16) * PW + n) = w;
          }
        }
      }
    }
  }
}


namespace pg8 {
#define PG8_LAS __attribute__((address_space(3)))
typedef unsigned short bf16_t;
typedef short bf16x8 __attribute__((ext_vector_type(8)));
typedef float f32x4 __attribute__((ext_vector_type(4)));
typedef unsigned u32x4 __attribute__((ext_vector_type(4)));
constexpr int BM = 256, BK = 64, HALF = 128, HTB = HALF * BK * 2  , STAGE_BYTES = 8 * HTB, NXCD = 8, WGM = 8;

__host__ __device__ __forceinline__ int lds_byte(int r, int c) { const int st = (r >> 4) * 2 + (c >> 5), rr = r & 15, cc = c & 31, ob = rr * 64 + cc * 2; return st * 1024 + (ob ^ (((ob >> 9) & 1) << 5)); }
__host__ __device__ __forceinline__ void stage_rc(int b, int& R, int& C) { const int st = b / 1024, sb = b % 1024, swz = sb ^ (((sb >> 9) & 1) << 5); R = (st >> 1) * 16 + swz / 64; C = (st & 1) * 32 + (swz % 64) / 2; }
__host__ __device__ __forceinline__ int perm32(int rho) { const int n = rho >> 4, i = rho & 15; return 8 * (i >> 2) + 4 * n + (i & 3); }

struct Unit { int pm, pn; };
struct Gemm { const bf16_t* A; const bf16_t* Bt; int M, N, K; };

struct StaticOrder {
    int nM, nN, nwg, G, c;
    __host__ __device__ void init(int M, int N, int G_, int c_) { nM = M / BM; nN = N / BM; nwg = nM * nN; G = G_; c = c_; }
    __host__ __device__ bool next(int i, Unit& u) const {
        const long L = (long)i * G + c; if (L >= nwg) return false;
        int wgid = (int)L; { const int q = nwg / NXCD, r = nwg % NXCD, xcd = wgid % NXCD, off = wgid / NXCD; wgid = (xcd < r ? xcd * (q + 1) : r * (q + 1) + (xcd - r) * q) + off; }
        const int nig = WGM * nN, gid = wgid / nig, fm = gid * WGM, gsz = (nM - fm) < WGM ? (nM - fm) : WGM;
        u.pm = fm + ((wgid % nig) % gsz); u.pn = (wgid % nig) / gsz; return true;
    }
    __device__ __forceinline__ void a_ready(const Unit&) const {}
    __device__ __forceinline__ void done(const Unit&) const {}
};
template <class Epi, class Sched, bool ALIGN_EPI = false, bool SP2 = false>
__device__ __forceinline__ void gemm_phase(PG8_LAS unsigned char* lds, const Gemm g, const Sched& S, const Epi& E) {
    const int tid = rtid(), wid = __builtin_amdgcn_readfirstlane(tid >> 6), lane = tid & 63, wr = wid >> 2, wc = wid & 3, fr = lane & 15, fq = lane >> 4;
    const int K = g.K, nt = K / BK;
    unsigned voffA[2], voffB[2];
#pragma unroll
    for (int i = 0; i < 2; ++i) { int R, C; stage_rc(tid * 16 + i * 8192, R, C); const int Rb = Epi::PERM ? ((R & ~31) + perm32(R & 31)) : R;
        voffA[i] = (unsigned)(R * K + C) * 2u; voffB[i] = (unsigned)(Rb * K + C) * 2u; }
    const size_t kstep = (size_t)(BK * 2);
    const size_t hstep = (size_t)HALF * K * 2;
    const size_t tstep = 2 * hstep;
    const unsigned ldsw = (unsigned)wid * 1024u;
    const int aoff = lds_byte(wr * 64 + fr, fq * 8), boff = lds_byte(wc * 32 + fr, fq * 8);
#define PG8_SA(b, h) (((b) * 2 + (h)) * HTB)
#define PG8_SB(b, h) ((4 + (b) * 2 + (h)) * HTB)
#define PG8_STAGE(bufoff, gbase, voff) do { _Pragma("unroll") for (int _i = 0; _i < 2; ++_i) \
        __builtin_amdgcn_global_load_lds((const unsigned*)((const char*)(gbase) + (voff)[_i]), (PG8_LAS unsigned*)(lds + (bufoff) + ldsw + _i * 8192), 16, 0, 0); } while (0)
#define PG8_LDA(dst, b, h) do { _Pragma("unroll") for (int m = 0; m < 4; ++m) _Pragma("unroll") for (int k = 0; k < 2; ++k) dst[m][k] = *(const PG8_LAS bf16x8*)(lds + PG8_SA(b, h) + aoff + m * 2048 + k * 1024); } while (0)
#define PG8_LDB(dst, b, h) do { _Pragma("unroll") for (int n = 0; n < 2; ++n) _Pragma("unroll") for (int k = 0; k < 2; ++k) dst[n][k] = *(const PG8_LAS bf16x8*)(lds + PG8_SB(b, h) + boff + n * 2048 + k * 1024); } while (0)
#define PG8_MMA(ai, bj, At, Bt) do { __builtin_amdgcn_s_setprio(1); _Pragma("unroll") for (int m = 0; m < 4; ++m) _Pragma("unroll") for (int n = 0; n < 2; ++n) _Pragma("unroll") for (int k = 0; k < 2; ++k) \
        acc[ai][bj][m][n] = __builtin_amdgcn_mfma_f32_16x16x32_bf16(Bt[n][k], At[m][k], acc[ai][bj][m][n], 0, 0, 0); __builtin_amdgcn_s_setprio(0); } while (0)
#define PG8_WAIT_V(n) asm volatile("s_waitcnt vmcnt(" #n ")" ::: "memory")
#define PG8_WAIT_L(n) asm volatile("s_waitcnt lgkmcnt(" #n ")" ::: "memory")
#define PG8_BAR __builtin_amdgcn_s_barrier()
#define PG8_SCHED __builtin_amdgcn_sched_barrier(0)
    Unit cur, nxt; int ui = 0;
    if (!S.next(0, cur)) return;
    f32x4 acc[2][2][4][2];
#pragma unroll
    for (int a = 0; a < 2; ++a)
#pragma unroll
        for (int b = 0; b < 2; ++b)
#pragma unroll
            for (int m = 0; m < 4; ++m)
#pragma unroll
                for (int n = 0; n < 2; ++n) acc[a][b][m][n] = (f32x4){0.f, 0.f, 0.f, 0.f};
    bf16x8 At[4][2], B0[2][2], B1[2][2];
    const char* cA = (const char*)g.A + (size_t)cur.pm * tstep; const char* cB = (const char*)g.Bt + (size_t)cur.pn * tstep;
    S.a_ready(cur);
    if constexpr (SP2) {
        PG8_STAGE(PG8_SB(0, 0), cB, voffB); PG8_STAGE(PG8_SB(0, 1), cB + hstep, voffB); PG8_STAGE(PG8_SA(0, 0), cA, voffA); PG8_STAGE(PG8_SA(0, 1), cA + hstep, voffA);
        if (wr == 1) PG8_BAR;
        PG8_WAIT_V(2); PG8_BAR;
        PG8_STAGE(PG8_SB(1, 0), cB + kstep, voffB); PG8_STAGE(PG8_SA(1, 0), cA + kstep, voffA); PG8_STAGE(PG8_SB(1, 1), cB + hstep + kstep, voffB);
        PG8_WAIT_V(6); PG8_BAR;
    } else {
        PG8_STAGE(PG8_SB(0, 0), cB, voffB); PG8_STAGE(PG8_SA(0, 0), cA, voffA); PG8_STAGE(PG8_SB(0, 1), cB + hstep, voffB); PG8_STAGE(PG8_SA(0, 1), cA + hstep, voffA);
        if (wr == 1) PG8_BAR;
        PG8_WAIT_V(4); PG8_BAR;
        PG8_STAGE(PG8_SB(1, 0), cB + kstep, voffB); PG8_STAGE(PG8_SA(1, 0), cA + kstep, voffA); PG8_STAGE(PG8_SB(1, 1), cB + hstep + kstep, voffB);
        PG8_WAIT_V(6); PG8_BAR;
    }
    for (;;) {
        const bool has_next = S.next(ui + 1, nxt);
        const char* nA = has_next ? (const char*)g.A + (size_t)nxt.pm * tstep : cA; const char* nB = has_next ? (const char*)g.Bt + (size_t)nxt.pn * tstep : cB;
        for (int t = 0; t < nt; t += 2) {
            const bool last = (t == nt - 2);
            const char* a1 = cA + (size_t)(t + 1) * kstep;
            const char* a2 = last ? nA : cA + (size_t)(t + 2) * kstep; const char* b2 = last ? nB : cB + (size_t)(t + 2) * kstep;
            const char* a3 = a2 + kstep; const char* b3 = b2 + kstep;
            if (last && has_next) S.a_ready(nxt);
            if constexpr (SP2) {
            PG8_LDB(B0, 0, 0); PG8_LDB(B1, 0, 1); PG8_SCHED; PG8_LDA(At, 0, 0); PG8_STAGE(PG8_SA(1, 1), a1 + hstep, voffA);
            PG8_WAIT_V(8); PG8_WAIT_L(0); PG8_BAR; PG8_MMA(0, 0, At, B0); PG8_MMA(0, 1, At, B1); PG8_BAR; PG8_SCHED;
            PG8_LDA(At, 0, 1); PG8_STAGE(PG8_SB(0, 0), b2, voffB); PG8_STAGE(PG8_SB(0, 1), b2 + hstep, voffB); PG8_STAGE(PG8_SA(0, 0), a2, voffA);
            PG8_WAIT_V(8); PG8_WAIT_L(0); PG8_BAR; PG8_MMA(1, 0, At, B0); PG8_MMA(1, 1, At, B1); PG8_BAR; PG8_SCHED;
            PG8_LDB(B0, 1, 0); PG8_LDB(B1, 1, 1); PG8_SCHED; PG8_LDA(At, 1, 0); PG8_STAGE(PG8_SA(0, 1), a2 + hstep, voffA);
            PG8_WAIT_V(8); PG8_WAIT_L(0); PG8_BAR; PG8_MMA(0, 0, At, B0); PG8_MMA(0, 1, At, B1); PG8_BAR; PG8_SCHED;
            PG8_LDA(At, 1, 1); PG8_STAGE(PG8_SB(1, 0), b3, voffB); PG8_STAGE(PG8_SB(1, 1), b3 + hstep, voffB); PG8_STAGE(PG8_SA(1, 0), a3, voffA);
            PG8_WAIT_V(8); PG8_WAIT_L(0); PG8_BAR; PG8_MMA(1, 0, At, B0); PG8_MMA(1, 1, At, B1); PG8_BAR; PG8_SCHED;
            } else {
            PG8_LDB(B0, 0, 0); PG8_SCHED; PG8_LDA(At, 0, 0); PG8_STAGE(PG8_SA(1, 1), a1 + hstep, voffA);
            PG8_WAIT_L(8); PG8_BAR; PG8_WAIT_L(0); PG8_MMA(0, 0, At, B0); PG8_BAR; PG8_SCHED;
            PG8_LDB(B1, 0, 1); PG8_STAGE(PG8_SB(0, 0), b2, voffB);
            PG8_BAR; PG8_WAIT_L(0); PG8_MMA(0, 1, At, B1); PG8_BAR;
            PG8_LDA(At, 0, 1); PG8_STAGE(PG8_SA(0, 0), a2, voffA);
            PG8_BAR; PG8_WAIT_L(0); PG8_MMA(1, 0, At, B0); PG8_BAR; PG8_SCHED;
            PG8_STAGE(PG8_SB(0, 1), b2 + hstep, voffB);
            PG8_WAIT_V(6); PG8_BAR; PG8_MMA(1, 1, At, B1); PG8_BAR;
            PG8_LDB(B0, 1, 0); PG8_SCHED; PG8_LDA(At, 1, 0); PG8_STAGE(PG8_SA(0, 1), a2 + hstep, voffA);
            PG8_WAIT_L(8); PG8_BAR; PG8_WAIT_L(0); PG8_MMA(0, 0, At, B0); PG8_BAR; PG8_SCHED;
            PG8_LDB(B1, 1, 1); PG8_STAGE(PG8_SB(1, 0), b3, voffB);
            PG8_BAR; PG8_WAIT_L(0); PG8_MMA(0, 1, At, B1); PG8_BAR;
            PG8_LDA(At, 1, 1); PG8_STAGE(PG8_SA(1, 0), a3, voffA);
            PG8_BAR; PG8_WAIT_L(0); PG8_MMA(1, 0, At, B0); PG8_BAR; PG8_SCHED;
            PG8_STAGE(PG8_SB(1, 1), b3 + hstep, voffB);
            PG8_WAIT_V(6); PG8_BAR; PG8_MMA(1, 1, At, B1); PG8_BAR;
            }
        }
        if constexpr (ALIGN_EPI) { if (wr == 0) PG8_BAR; }
        if constexpr (!Epi::AFTER_DRAIN) { E(acc, cur, wr, wc, fr, fq); S.done(cur); }
        if (!has_next) break;
#pragma unroll
        for (int a = 0; a < 2; ++a)
#pragma unroll
            for (int b = 0; b < 2; ++b)
#pragma unroll
                for (int m = 0; m < 4; ++m)
#pragma unroll
                    for (int n = 0; n < 2; ++n) acc[a][b][m][n] = (f32x4){0.f, 0.f, 0.f, 0.f};
        cur = nxt; cA = nA; cB = nB; ++ui;
        if constexpr (ALIGN_EPI) { if (wr == 1) PG8_BAR; }
    }
    PG8_WAIT_V(0);
    if constexpr (!ALIGN_EPI) { if (wr == 0) PG8_BAR; }
    PG8_BAR;
    if constexpr (Epi::AFTER_DRAIN) { E.fused(acc, cur, wr, wc, fr, fq, lds, wid, lane); S.done(cur); }
#undef PG8_SA
#undef PG8_SB
#undef PG8_STAGE
#undef PG8_LDA
#undef PG8_LDB
#undef PG8_MMA
#undef PG8_WAIT_V
#undef PG8_WAIT_L
#undef PG8_BAR
#undef PG8_SCHED
}
}

DI void wave_rstd(const float* RS, int rowbase  , int lane, float& r0, float& r1) {
  const float* a = RS + (size_t)(rowbase + lane) * 16; const float* b = a + 128 * 16;
  const float4 a0 = *(const float4*)a, a1 = *(const float4*)(a + 4), a2 = *(const float4*)(a + 8), a3 = *(const float4*)(a + 12);
  const float4 b0 = *(const float4*)b, b1 = *(const float4*)(b + 4), b2 = *(const float4*)(b + 8), b3 = *(const float4*)(b + 12);
  const float sa = ((a0.x + a0.y) + (a0.z + a0.w)) + ((a1.x + a1.y) + (a1.z + a1.w)) + ((a2.x + a2.y) + (a2.z + a2.w)) + ((a3.x + a3.y) + (a3.z + a3.w));
  const float sb = ((b0.x + b0.y) + (b0.z + b0.w)) + ((b1.x + b1.y) + (b1.z + b1.w)) + ((b2.x + b2.y) + (b2.z + b2.w)) + ((b3.x + b3.y) + (b3.z + b3.w));
  r0 = rsqrtf(sa * (1.f / 1024.f) + EPSN); r1 = rsqrtf(sb * (1.f / 1024.f) + EPSN);
}
struct EpiSwiglu {
  static constexpr bool PERM = false, AFTER_DRAIN = false;
  bf16_t* ACT; const float* RS; const float* bias  ;
  DI void operator()(const f32x4 (&acc)[2][2][4][2], const pg8::Unit& u, int wr, int wc, int fr, int fq) const {
    const int row0 = u.pm * 256 + wr * 64 + fr, lane = fq * 16 + fr;
    float rs[2]; wave_rstd(RS, u.pm * 256 + wr * 64, lane, rs[0], rs[1]);
    const float* bp = bias + (size_t)cond_of_row(u.pm * 256) * 5632 + u.pn * 256 + wc * 32 + 4 * fq;
    f32x4 bg[2], bu[2];
#pragma unroll
    for (int bj = 0; bj < 2; ++bj) { bg[bj] = *(const f32x4*)(bp + bj * 128); bu[bj] = *(const f32x4*)(bp + bj * 128 + 16); }
#pragma unroll
    for (int ai = 0; ai < 2; ++ai)
#pragma unroll
      for (int m = 0; m < 4; ++m) {
        const float r = __shfl(rs[ai], 16 * m + fr);
        bf16_t* rowp = ACT + (size_t)(row0 + ai * 128 + m * 16) * DFF + ((u.pn * 256 + wc * 32) >> 1) + 4 * fq;
#pragma unroll
        for (int bj = 0; bj < 2; ++bj) {
          const f32x4 g = acc[ai][bj][m][0] * r + bg[bj], v = acc[ai][bj][m][1] * r + bu[bj];
          uint2 w; w.x = pack2(silu_f(g[0]) * v[0], silu_f(g[1]) * v[1]); w.y = pack2(silu_f(g[2]) * v[2], silu_f(g[3]) * v[3]);
          *(uint2*)(rowp + bj * 64) = w;
        }
      }
  }
};
struct EpiResid {
  static constexpr bool PERM = false, AFTER_DRAIN = false;
  float* X; const float* gate_base; float coef;
  bf16_t* H; float* RS; const float* nxt_g  ; const float* nxt_scale  ;
  DI void operator()(const f32x4 (&acc)[2][2][4][2], const pg8::Unit& u, int wr, int wc, int fr, int fq) const {
    const int row0 = u.pm * 256 + wr * 64 + fr, col0 = u.pn * 256 + wc * 32 + 4 * fq;
    const int cond = cond_of_row(u.pm * 256);
    const float* gv = gate_base + (size_t)cond * 9216 + col0;
    const bool has_next = nxt_g != nullptr;
    float ss[2][4];
#pragma unroll
    for (int ai = 0; ai < 2; ++ai)
#pragma unroll
      for (int m = 0; m < 4; ++m) ss[ai][m] = 0.f;
#pragma unroll
    for (int bj = 0; bj < 2; ++bj)
#pragma unroll
      for (int n = 0; n < 2; ++n) {
        const int co = bj * 128 + n * 16;
        const float4 gg = *(const float4*)(gv + co);
        float4 hv = make_float4(0.f, 0.f, 0.f, 0.f);
        if (has_next) {
          const float4 g2 = *(const float4*)(nxt_g + col0 + co), s2 = *(const float4*)(nxt_scale + (size_t)cond * 9216 + col0 + co);
          hv = make_float4(g2.x * (1.f + s2.x), g2.y * (1.f + s2.y), g2.z * (1.f + s2.z), g2.w * (1.f + s2.w));
        }
#pragma unroll
        for (int ai = 0; ai < 2; ++ai)
#pragma unroll
          for (int m = 0; m < 4; ++m) {
            const size_t off = (size_t)(row0 + ai * 128 + m * 16) * 1024 + col0 + co;
            float4 xv = *(const float4*)(X + off);
            const f32x4 a = acc[ai][bj][m][n];
            xv.x += coef * gg.x * a[0]; xv.y += coef * gg.y * a[1]; xv.z += coef * gg.z * a[2]; xv.w += coef * gg.w * a[3];
            *(float4*)(X + off) = xv;
            if (has_next) {
              ss[ai][m] += (xv.x * xv.x + xv.y * xv.y) + (xv.z * xv.z + xv.w * xv.w);
              uint2 w; w.x = pack2(xv.x * hv.x, xv.y * hv.y); w.y = pack2(xv.z * hv.z, xv.w * hv.w);
              *(uint2*)(H + off) = w;
            }
          }
      }
    if (has_next) {
#pragma unroll
      for (int ai = 0; ai < 2; ++ai)
#pragma unroll
        for (int m = 0; m < 4; ++m) {
          float s = ss[ai][m];
          s += __shfl_xor(s, 16); s += __shfl_xor(s, 32);
          if (fq == 0) RS[(size_t)(row0 + ai * 128 + m * 16) * 16 + u.pn * 4 + wc] = s;
        }
    }
  }
};
struct EpiProj {
  static constexpr bool PERM = false, AFTER_DRAIN = false;
  bf16_t* PR; const float* RS; const float* bias  ;
  DI void operator()(const f32x4 (&acc)[2][2][4][2], const pg8::Unit& u, int wr, int wc, int fr, int fq) const {
    const int row0 = u.pm * 256 + wr * 64 + fr, col0 = u.pn * 256 + wc * 32 + 4 * fq, lane = fq * 16 + fr;
    float rs[2]; wave_rstd(RS, u.pm * 256 + wr * 64, lane, rs[0], rs[1]);
    float rr[2][4];
#pragma unroll
    for (int ai = 0; ai < 2; ++ai)
#pragma unroll
      for (int m = 0; m < 4; ++m) rr[ai][m] = __shfl(rs[ai], 16 * m + fr);
    const float* bp = bias + (size_t)cond_of_row(u.pm * 256) * 5632;
#pragma unroll
    for (int bj = 0; bj < 2; ++bj)
#pragma unroll
      for (int n = 0; n < 2; ++n) {
        const int col = col0 + bj * 128 + n * 16;
        if (col < PW) {
          const f32x4 bb = *(const f32x4*)(bp + col);
#pragma unroll
          for (int ai = 0; ai < 2; ++ai)
#pragma unroll
            for (int m = 0; m < 4; ++m) {
              const f32x4 a = acc[ai][bj][m][n] * rr[ai][m] + bb;
              uint2 w; w.x = pack2(a[0], a[1]); w.y = pack2(a[2], a[3]);
              *(uint2*)(PR + (size_t)(row0 + ai * 128 + m * 16) * PW + col) = w;
            }
        }
      }
  }
};
template <class Epi>
DI void gemm8_run(const bf16_t* acts, const bf16_t* wts, int Nw, int K, const Epi& E, char* dsm) {
  pg8::Gemm g; g.A = acts; g.Bt = wts; g.M = NTOK; g.N = Nw; g.K = K;
  pg8::StaticOrder S; S.init(NTOK, Nw, (int)gridDim.x, (int)blockIdx.x);
  pg8::gemm_phase<Epi, pg8::StaticOrder, true, true>((LDSP unsigned char*)dsm, g, S, E);
}

DI void prep_gla_tile(const Params& p, int l, int tt, char* smem) {
  const int tid = otid();
  const bf16_t* PR = (const bf16_t*)(p.ws + WS_PROJ);
  float* GB = (float*)(p.ws + WS_GB); float* ATOT = (float*)(p.ws + WS_ATOT); float* U = (float*)(p.ws + WS_U);
  const int row0 = tt * 64;
  float* bg = (float*)smem;
  bf16_t* ks = (bf16_t*)(smem + 8192);
  bf16_t* vs = (bf16_t*)(smem + 8192 + 16384);
  {
    {
      const int lane = tid & 63, wv = tid >> 6, fr = lane & 15, fq = lane >> 4;
      const bf16_t* hp = (const bf16_t*)(p.ws + WS_H) + (size_t)(row0 + wv * 16 + fr) * 1024 + 8 * fq;
      const bf16_t* wp = (const bf16_t*)(p.ws + WS_WIN) + ((size_t)l * PWR + OFF_BGW + fr) * 1024 + 8 * fq;
      f32x4 c0 = (f32x4){0.f, 0.f, 0.f, 0.f}, c1 = c0;
#pragma unroll 8
      for (int ks = 0; ks < 32; ++ks) {
        const bf16x8 a = *(const bf16x8*)(hp + 32 * ks), b0 = *(const bf16x8*)(wp + 32 * ks), b1 = *(const bf16x8*)(wp + 16 * 1024 + 32 * ks);
        c0 = __builtin_amdgcn_mfma_f32_16x16x32_bf16(a, b0, c0, 0, 0, 0);
        c1 = __builtin_amdgcn_mfma_f32_16x16x32_bf16(a, b1, c1, 0, 0, 0);
      }
      const float* rsp = (const float*)(p.ws + WS_ROWSS) + (size_t)(row0 + wv * 16 + fr) * 16;
      const float4 r0 = *(const float4*)rsp, r1 = *(const float4*)(rsp + 4), r2 = *(const float4*)(rsp + 8), r3 = *(const float4*)(rsp + 12);
      const float rs = rsqrtf((((r0.x + r0.y) + (r0.z + r0.w)) + ((r1.x + r1.y) + (r1.z + r1.w)) + ((r2.x + r2.y) + (r2.z + r2.w)) + ((r3.x + r3.y) + (r3.z + r3.w))) * (1.f / 1024.f) + EPSN);
      const float* bp = (const float*)(p.ws + WS_BIAS) + ((size_t)(l * 3 + 1) * 3 + cond_of_row(row0)) * 5632 + OFF_BGW;
      const float bb0 = bp[fr], bb1 = bp[16 + fr];
#pragma unroll
      for (int r = 0; r < 4; ++r) {
        const float rr = __shfl(rs, 4 * fq + r);
        float* dst = bg + (wv * 16 + 4 * fq + r) * 32;
        dst[fr] = c0[r] * rr + bb0; dst[16 + fr] = c1[r] * rr + bb1;
      }
    }
#pragma unroll
    for (int q = 0; q < 4; ++q) { const int c = tid + 256 * q, row = c >> 4, ch = c & 15; *(uint4*)(ks + row * 128 + 8 * ch) = *(const uint4*)(PR + (size_t)(row0 + row) * PW + OFF_BK + 8 * ch); }
#pragma unroll
    for (int q = 0; q < 8; ++q) { const int c = tid + 256 * q, row = c >> 5, ch = c & 31; *(uint4*)(vs + row * 256 + 8 * ch) = *(const uint4*)(PR + (size_t)(row0 + row) * PW + OFF_BV + 8 * ch); }
  }
  __syncthreads();
  const int s = tid >> 7, k = tid & 127, h = k >> 5, d = k & 31;
  float w[16];
#pragma unroll
  for (int r = 0; r < 16; ++r) w[r] = p.in[18][((size_t)(l * 2 + s) * 16 + r) * 128 + k];
  const float bias = p.in[19][(l * 2 + s) * 128 + k];
  float acc[64];
#pragma unroll
  for (int x = 0; x < 64; ++x) acc[x] = 0.f;
  float run = 0.f;
#pragma unroll 2
  for (int ii = 0; ii < 64; ++ii) {
    const int j = s ? ii : 63 - ii;
    float z = bias;
#pragma unroll
    for (int r = 0; r < 16; ++r) z += bg[j * 32 + s * 16 + r] * w[r];
    const float ls = fminf(z, 0.f) - log1pf(expf(-fabsf(z)));
    GB[(size_t)(row0 + j) * 256 + s * 128 + k] = run;
    const float kd = bf2f(ks[j * 128 + k]) * fast_exp2(run * LOG2E);
    run += ls * (1.f / 16.f);
    const bf16_t* vr = vs + j * 256 + h * 64;
#pragma unroll
    for (int x8 = 0; x8 < 8; ++x8) {
      float vv[8]; unpack8(*(const uint4*)(vr + 8 * x8), vv);
#pragma unroll
      for (int e = 0; e < 8; ++e) acc[8 * x8 + e] += kd * vv[e];
    }
  }
  ATOT[tt * 256 + tid] = expf(run);
  ATOT[192 * 256 + tt * 256 + tid] = run;
  float* u = U + (((size_t)tt * 2 + s) * 4 + h) * 2048 + d * 64;
#pragma unroll
  for (int x4 = 0; x4 < 16; ++x4) *(float4*)(u + 4 * x4) = make_float4(acc[4 * x4], acc[4 * x4 + 1], acc[4 * x4 + 2], acc[4 * x4 + 3]);
  __syncthreads();
}

struct TokRaw { uint4 a; uint2 c0, c1, c2; uint4 av, cv; };
DI void tok_load(const bf16_t* PR, int r, int lane, bool ctx, TokRaw& t) {
  const bf16_t* pr = PR + (size_t)r * PW;
  t.a = *(const uint4*)(pr + (lane >> 3) * 64 + 8 * (lane & 7));
  const bf16_t* src = pr + OFF_CQ + (lane >> 2) * 48 + 12 * (lane & 3);
  t.c0 = *(const uint2*)(src); t.c1 = *(const uint2*)(src + 4); t.c2 = *(const uint2*)(src + 8);
  t.av = make_uint4(0, 0, 0, 0); t.cv = make_uint4(0, 0, 0, 0);
  if (ctx) { if (lane < 16) t.av = *(const uint4*)(pr + OFF_AV + 8 * lane); if (lane < 48) t.cv = *(const uint4*)(pr + OFF_CV + 8 * lane); }
}
DI void prep_token(const Params& p, int l, int r, int lane, const TokRaw& t) {
  bf16_t* QA = (bf16_t*)(p.ws + WS_QA); bf16_t* KA = (bf16_t*)(p.ws + WS_KA);
  bf16_t* QC = (bf16_t*)(p.ws + WS_QC); bf16_t* KC = (bf16_t*)(p.ws + WS_KC);
  const float* rope = (const float*)(p.ws + WS_ROPE);
  const float qsA = 0.125f * LOG2E, qsC = 0.14433756729740643f * LOG2E;
  const bool ctx = r < NCTX;
  const int b = ctx ? (r >> 8) : ((r - NCTX) >> 11);
  const int tq = ctx ? (r & 255) : ((r - NCTX) & 2047);
  const int rowpos = tq >> 6, colpos = tq & 63;
  {
    const int v = lane >> 3, s = lane & 7;
    float x[8]; unpack8(t.a, x);
    float ss = 0.f;
#pragma unroll
    for (int e = 0; e < 8; ++e) ss += x[e] * x[e];
    ss += __shfl_xor(ss, 1); ss += __shfl_xor(ss, 2); ss += __shfl_xor(ss, 4);
    const float rstd = rsqrtf(ss * (1.f / 64.f) + EPSN);
    const float* g = (v < 6 ? p.in[16] : p.in[17]) + l * 64 + 8 * s;
    float y[8];
#pragma unroll
    for (int e = 0; e < 8; ++e) y[e] = x[e] * rstd * g[e];
    if (ctx) {
      if (v >= 6) {
        float* o = p.out + O_AK + ((size_t)(b * 4 + l) * 256 + tq) * 128 + (v - 6) * 64 + 8 * s;
        *(float4*)o = make_float4(y[0], y[1], y[2], y[3]); *(float4*)(o + 4) = make_float4(y[4], y[5], y[6], y[7]);
      }
    } else {
      const int pos = (s < 4) ? rowpos : colpos;
      const float* ct = rope + pos * 16 + (s & 1) * 8; const float* st = rope + 1024 + pos * 16 + (s & 1) * 8;
#pragma unroll
      for (int e = 0; e < 8; ++e) {
        const float yp = __shfl_xor(y[e], 2);
        const float c = ct[e], sn = st[e];
        y[e] = (s & 2) ? (yp * sn + y[e] * c) : (y[e] * c - yp * sn);
      }
    }
    if (v < 6) {
#pragma unroll
      for (int e = 0; e < 8; ++e) y[e] *= qsA;
    }
    uint4 w; w.x = pack2(y[0], y[1]); w.y = pack2(y[2], y[3]); w.z = pack2(y[4], y[5]); w.w = pack2(y[6], y[7]);
    if (v < 6) *(uint4*)(QA + (size_t)r * 384 + v * 64 + 8 * s) = w;
    else *(uint4*)(KA + (size_t)r * 128 + (v - 6) * 64 + 8 * s) = w;
  }
  if (ctx && lane < 16) {
    float x[8]; unpack8(t.av, x);
    float* o = p.out + O_AV + ((size_t)(b * 4 + l) * 256 + tq) * 128 + 8 * lane;
    *(float4*)o = make_float4(x[0], x[1], x[2], x[3]); *(float4*)(o + 4) = make_float4(x[4], x[5], x[6], x[7]);
  }
  {
    const int v = lane >> 2, qd = lane & 3;
    float x[12];
    unpack4(t.c0, x); unpack4(t.c1, x + 4); unpack4(t.c2, x + 8);
    float ss = 0.f;
#pragma unroll
    for (int e = 0; e < 12; ++e) ss += x[e] * x[e];
    ss += __shfl_xor(ss, 1); ss += __shfl_xor(ss, 2);
    const float rstd = rsqrtf(ss * (1.f / 48.f) + EPSN);
    const float* g = (v < 8 ? p.in[21] : p.in[22]) + l * 96 + (v & 1) * 48 + 12 * qd;
    float y[12];
#pragma unroll
    for (int e = 0; e < 12; ++e) y[e] = x[e] * rstd * g[e];
    if (ctx) {
      if (v >= 8) {
        float* o = p.out + O_CK + ((size_t)(b * 4 + l) * 256 + tq) * 384 + (v - 8) * 48 + 12 * qd;
        *(float4*)o = make_float4(y[0], y[1], y[2], y[3]); *(float4*)(o + 4) = make_float4(y[4], y[5], y[6], y[7]);
        *(float4*)(o + 8) = make_float4(y[8], y[9], y[10], y[11]);
      }
    } else {
      const int pos = (qd < 2) ? rowpos : colpos;
      const float* ct = rope + 2048 + pos * 12; const float* st = rope + 2048 + 768 + pos * 12;
#pragma unroll
      for (int e = 0; e < 12; ++e) {
        const float yp = __shfl_xor(y[e], 1);
        const float c = ct[e], sn = st[e];
        y[e] = (qd & 1) ? (yp * sn + y[e] * c) : (y[e] * c - yp * sn);
      }
    }
    if (v < 8) {
#pragma unroll
      for (int e = 0; e < 12; ++e) y[e] *= qsC;
    }
    bf16_t* dst = (v < 8 ? QC : KC) + (size_t)r * 512 + (v & 7) * 64;
    uint2 w0, w1, w2; w0.x = pack2(y[0], y[1]); w0.y = pack2(y[2], y[3]); w1.x = pack2(y[4], y[5]); w1.y = pack2(y[6], y[7]);
    w2.x = pack2(y[8], y[9]); w2.y = pack2(y[10], y[11]);
    *(uint2*)(dst + 12 * qd) = w0; *(uint2*)(dst + 12 * qd + 4) = w1; *(uint2*)(dst + 12 * qd + 8) = w2;
    { unsigned z0; asm volatile("v_mov_b32 %0, 0" : "=v"(z0)); *(uint2*)(dst + 48 + 4 * qd) = make_uint2(z0, z0); }
  }
  if (ctx && lane < 48) {
    float x[8]; unpack8(t.cv, x);
    float* o = p.out + O_CV + ((size_t)(b * 4 + l) * 256 + tq) * 384 + 8 * lane;
    *(float4*)o = make_float4(x[0], x[1], x[2], x[3]); *(float4*)(o + 4) = make_float4(x[4], x[5], x[6], x[7]);
  }
}

DI void prep_phase(const Params& p, int l, char* smem) {
  for (int tt = obid(); tt < 192; tt += vnb()) prep_gla_tile(p, l, tt, smem);
  const int tx = rtid(), lane = tx & 63;
  const int gw = blockIdx.x * 8 + (tx >> 6), nw = gridDim.x * 8;
  const bf16_t* PR = (const bf16_t*)(p.ws + WS_PROJ);
  int r = gw;
  TokRaw cur, nxt;
  if (r < NTOK) tok_load(PR, r, lane, r < NCTX, cur);
#pragma unroll 1
  for (; r < NTOK; r += nw) {
    const int rn = r + nw;
    if (rn < NTOK) tok_load(PR, rn, lane, rn < NCTX, nxt);
    prep_token(p, l, r, lane, cur);
    cur = nxt;
  }
}

typedef unsigned u32x4 __attribute__((ext_vector_type(4)));
struct KVSrc { const bf16_t* k1; const bf16_t* v1; const bf16_t* k2; const bf16_t* v2; int ks1, vs1, ks2, vs2, n1, n2; };
template <int NMAP, int NDT> struct FlashRegs { u32x4 k00, k01, k10, k11, v0, v1, v2; };

template <int NMAP, int NDT>
DI void fl_issue(int kt, const KVSrc& kv, FlashRegs<NMAP, NDT>& R) {
  constexpr int CPR = NDT * 2;
  kt = kt < kv.n1 + kv.n2 ? kt : kv.n1 + kv.n2 - 1;
  const int tid = otid();
  const bf16_t* kb; const bf16_t* vb; int ks, vs;
  if (kt < kv.n1) { kb = kv.k1 + (size_t)kt * 64 * kv.ks1; vb = kv.v1 + (size_t)kt * 64 * kv.vs1; ks = kv.ks1; vs = kv.vs1; }
  else { kb = kv.k2 + (size_t)(kt - kv.n1) * 64 * kv.ks2; vb = kv.v2 + (size_t)(kt - kv.n1) * 64 * kv.vs2; ks = kv.ks2; vs = kv.vs2; }
  R.k00 = *(const u32x4*)(kb + (size_t)(tid >> 3) * ks + (tid & 7) * 8);
  R.k01 = *(const u32x4*)(kb + (size_t)((tid >> 3) + 32) * ks + (tid & 7) * 8);
  if (NMAP == 2) {
    R.k10 = *(const u32x4*)(kb + 64 + (size_t)(tid >> 3) * ks + (tid & 7) * 8);
    R.k11 = *(const u32x4*)(kb + 64 + (size_t)((tid >> 3) + 32) * ks + (tid & 7) * 8);
  } else { R.k10 = R.k00; R.k11 = R.k01; }
  { const int c = tid; R.v0 = *(const u32x4*)(vb + (size_t)(c / CPR) * vs + (c % CPR) * 8); }
  { const int c = tid + 256; R.v1 = *(const u32x4*)(vb + (size_t)(c / CPR) * vs + (c % CPR) * 8); }
  if (NDT == 6) { const int c = tid + 512; R.v2 = *(const u32x4*)(vb + (size_t)(c / CPR) * vs + (c % CPR) * 8); } else R.v2 = R.v1;
}
template <int NMAP, int NDT>
DI void fl_write(char* buf, const FlashRegs<NMAP, NDT>& R) {
  constexpr int CPR = NDT * 2, VSB = NDT * 32 + 32;
  const int tid = otid();
  char* vbuf = buf + NMAP * 8192;
  { const int row = tid >> 3, ch = tid & 7; *(u32x4*)(buf + row * 128 + ((ch ^ (row & 7)) << 4)) = R.k00; }
  { const int row = (tid >> 3) + 32, ch = tid & 7; *(u32x4*)(buf + row * 128 + ((ch ^ (row & 7)) << 4)) = R.k01; }
  if (NMAP == 2) {
    { const int row = tid >> 3, ch = tid & 7; *(u32x4*)(buf + 8192 + row * 128 + ((ch ^ (row & 7)) << 4)) = R.k10; }
    { const int row = (tid >> 3) + 32, ch = tid & 7; *(u32x4*)(buf + 8192 + row * 128 + ((ch ^ (row & 7)) << 4)) = R.k11; }
  }
  { const int c = tid; *(u32x4*)(vbuf + (c / CPR) * VSB + (c % CPR) * 16) = R.v0; }
  { const int c = tid + 256; *(u32x4*)(vbuf + (c / CPR) * VSB + (c % CPR) * 16) = R.v1; }
  if (NDT == 6) { const int c = tid + 512; *(u32x4*)(vbuf + (c / CPR) * VSB + (c % CPR) * 16) = R.v2; }
}
template <int NMAP, int NDT>
DI void fl_compute(const char* buf, const bf16x8 (&qf)[NMAP][2], f32x4 (&oacc)[NMAP][NDT], float (&mrun)[NMAP], float (&lsum)[NMAP], int lane) {
  constexpr int VSB = NDT * 32 + 32;
  const int g = lane >> 4, qq = (lane & 15) >> 2, pp = lane & 3;
  bf16x8 pf[NMAP][2];
#pragma unroll
  for (int m = 0; m < NMAP; ++m) {
    f32x4 sacc[4];
#pragma unroll
    for (int t = 0; t < 4; ++t) sacc[t] = (f32x4){0.f, 0.f, 0.f, 0.f};
#pragma unroll
    for (int ks = 0; ks < 2; ++ks) {
      const int ch = ((ks * 4 + g) ^ (lane & 7)) << 4;
#pragma unroll
      for (int t = 0; t < 4; ++t) {
        const bf16x8 kf = *(const bf16x8*)(buf + m * 8192 + (16 * t + (lane & 15)) * 128 + ch);
        sacc[t] = __builtin_amdgcn_mfma_f32_16x16x32_bf16(kf, qf[m][ks], sacc[t], 0, 0, 0);
      }
    }
    float mx = sacc[0][0];
#pragma unroll
    for (int t = 0; t < 4; ++t)
#pragma unroll
      for (int r = 0; r < 4; ++r) mx = fmaxf(mx, sacc[t][r]);
    mx = fmaxf(mx, __shfl_xor(mx, 16)); mx = fmaxf(mx, __shfl_xor(mx, 32));
    const float mnew = fmaxf(mrun[m], mx);
    const float alpha = fast_exp2(mrun[m] - mnew);
    mrun[m] = mnew;
    float ps = 0.f;
#pragma unroll
    for (int t = 0; t < 4; ++t)
#pragma unroll
      for (int r = 0; r < 4; ++r) { const float pv = fast_exp2(sacc[t][r] - mnew); sacc[t][r] = pv; ps += pv; }
    lsum[m] = lsum[m] * alpha + ps;
#pragma unroll
    for (int d = 0; d < NDT; ++d) oacc[m][d] *= alpha;
#pragma unroll
    for (int ks = 0; ks < 2; ++ks) {
      u32x4 pu;
      pu[0] = pack2(sacc[2 * ks][0], sacc[2 * ks][1]); pu[1] = pack2(sacc[2 * ks][2], sacc[2 * ks][3]);
      pu[2] = pack2(sacc[2 * ks + 1][0], sacc[2 * ks + 1][1]); pu[3] = pack2(sacc[2 * ks + 1][2], sacc[2 * ks + 1][3]);
      pf[m][ks] = __builtin_bit_cast(bf16x8, pu);
    }
  }
  const char* vbuf = buf + NMAP * 8192;
#pragma unroll
  for (int ks = 0; ks < 2; ++ks) {
    const char* vrow = vbuf + (32 * ks + 4 * g + qq) * VSB + pp * 8;
#pragma unroll
    for (int d = 0; d < NDT; ++d) {
      const s16x4 v0 = __builtin_amdgcn_ds_read_tr16_b64_v4i16((LDSP s16x4*)(vrow + d * 32));
      const s16x4 v1 = __builtin_amdgcn_ds_read_tr16_b64_v4i16((LDSP s16x4*)(vrow + 16 * VSB + d * 32));
      const bf16x8 vf = __builtin_shufflevector(v0, v1, 0, 1, 2, 3, 4, 5, 6, 7);
#pragma unroll
      for (int m = 0; m < NMAP; ++m) oacc[m][d] = __builtin_amdgcn_mfma_f32_16x16x32_bf16(vf, pf[m][ks], oacc[m][d], 0, 0, 0);
    }
  }
}

template <int NMAP, int NDT>
DI void flash_run(const bf16_t* __restrict__ qptr, const KVSrc& kv, f32x4 (&oacc)[NMAP][NDT], float (&linv)[NMAP], char* smem) {
  constexpr int BUFB = NMAP * 8192 + 64 * (NDT * 32 + 32);
  const int lane = otid() & 63;
  bf16x8 qf[NMAP][2];
  float mrun[NMAP], lsum[NMAP];
#pragma unroll
  for (int m = 0; m < NMAP; ++m) {
    qf[m][0] = *(const bf16x8*)(qptr + 64 * m); qf[m][1] = *(const bf16x8*)(qptr + 64 * m + 32);
    mrun[m] = -INFINITY; lsum[m] = 0.f;
#pragma unroll
    for (int d = 0; d < NDT; ++d) oacc[m][d] = (f32x4){0.f, 0.f, 0.f, 0.f};
  }
  const int nt = kv.n1 + kv.n2;
  FlashRegs<NMAP, NDT> R0, R1;
  fl_issue<NMAP, NDT>(0, kv, R0);
  fl_issue<NMAP, NDT>(1, kv, R1);
  __syncthreads();
  fl_write<NMAP, NDT>(smem, R0);
  fl_issue<NMAP, NDT>(2, kv, R0);
  __syncthreads();
#pragma unroll 1
  for (int t = 0; t < nt; t += 2) {
    fl_compute<NMAP, NDT>(smem, qf, oacc, mrun, lsum, lane);
    fl_write<NMAP, NDT>(smem + BUFB, R1);
    fl_issue<NMAP, NDT>(t + 3, kv, R1);
    __syncthreads();
    fl_compute<NMAP, NDT>(smem + BUFB, qf, oacc, mrun, lsum, lane);
    fl_write<NMAP, NDT>(smem, R0);
    fl_issue<NMAP, NDT>(t + 4, kv, R0);
    __syncthreads();
  }
#pragma unroll
  for (int m = 0; m < NMAP; ++m) { float l = lsum[m]; l += __shfl_xor(l, 16); l += __shfl_xor(l, 32); linv[m] = 1.f / l; }
}

DI void attn_a_item(const Params& p, int l, bool ctx, int b, int h, int qt, char* smem) {
  const int lane = otid() & 63, wave = otid() >> 6;
  const int seq0 = ctx ? b * 256 : NCTX + b * 2048;
  const int qrow = seq0 + qt * 64 + wave * 16 + (lane & 15);
  const int kvh = h / 3;
  const bf16_t* PR = (const bf16_t*)(p.ws + WS_PROJ);
  KVSrc kv;
  kv.k1 = (const bf16_t*)(p.ws + WS_KA) + (size_t)seq0 * 128 + kvh * 64; kv.ks1 = 128;
  kv.v1 = PR + (size_t)seq0 * PW + OFF_AV + kvh * 64; kv.vs1 = PW;
  kv.n1 = ctx ? 4 : 32; kv.n2 = ctx ? 0 : 8;
  kv.k2 = (const bf16_t*)(p.ws + WS_KAC) + (size_t)((b & 1) * 4 + l) * 512 * 128 + kvh * 64; kv.ks2 = 128;
  kv.v2 = (const bf16_t*)(p.ws + WS_VAC) + (size_t)((b & 1) * 4 + l) * 512 * 128 + kvh * 64; kv.vs2 = 128;
  f32x4 o[1][4]; float linv[1];
  flash_run<1, 4>((const bf16_t*)(p.ws + WS_QA) + (size_t)qrow * 384 + h * 64 + 8 * (lane >> 4), kv, o, linv, smem);
  bf16_t* dst = (bf16_t*)(p.ws + WS_MIX) + (size_t)qrow * 1024 + h * 64 + 4 * (lane >> 4);
  const float li = linv[0];
#pragma unroll
  for (int d = 0; d < 4; ++d) { uint2 w; w.x = pack2(o[0][d][0] * li, o[0][d][1] * li); w.y = pack2(o[0][d][2] * li, o[0][d][3] * li); *(uint2*)(dst + 16 * d) = w; }
}

DI void attn_c_item(const Params& p, int l, bool ctx, int b, int h, int qt, char* smem) {
  const int lane = otid() & 63, wave = otid() >> 6;
  const int seq0 = ctx ? b * 256 : NCTX + b * 2048;
  const int qrow = seq0 + qt * 64 + wave * 16 + (lane & 15);
  const bf16_t* PR = (const bf16_t*)(p.ws + WS_PROJ);
  KVSrc kv;
  kv.ks1 = 512; kv.vs1 = PW; kv.ks2 = 512; kv.vs2 = 384;
  kv.n1 = ctx ? 4 : 32; kv.n2 = ctx ? 0 : 8;
  kv.v1 = PR + (size_t)seq0 * PW + OFF_CV + h * 96;
  kv.v2 = (const bf16_t*)(p.ws + WS_VCC) + (size_t)((b & 1) * 4 + l) * 512 * 384 + h * 96;
  kv.k1 = (const bf16_t*)(p.ws + WS_KC) + (size_t)seq0 * 512 + (h * 2) * 64;
  kv.k2 = (const bf16_t*)(p.ws + WS_KCC) + (size_t)((b & 1) * 4 + l) * 512 * 512 + (h * 2) * 64;
  f32x4 o[2][6]; float linv[2];
  flash_run<2, 6>((const bf16_t*)(p.ws + WS_QC) + (size_t)qrow * 512 + (h * 2) * 64 + 8 * (lane >> 4), kv, o, linv, smem);
  const float lam = ((const float*)(p.ws + WS_MISC))[l];
  const float li0 = linv[0], l1 = linv[1] * lam;
  float ss = 0.f;
#pragma unroll
  for (int d = 0; d < 6; ++d)
#pragma unroll
    for (int r = 0; r < 4; ++r) { const float v = o[0][d][r] * li0 - o[1][d][r] * l1; o[0][d][r] = v; ss += v * v; }
  ss += __shfl_xor(ss, 16); ss += __shfl_xor(ss, 32);
  const float sc = rsqrtf(ss * (1.f / 96.f) + EPSN) * (1.f - p.lam_init[l]);
  const float* g = p.in[24] + l * 96 + 4 * (lane >> 4);
  bf16_t* dst = (bf16_t*)(p.ws + WS_MIX) + (size_t)qrow * 1024 + 640 + h * 96 + 4 * (lane >> 4);
#pragma unroll
  for (int d = 0; d < 6; ++d) {
    const float4 gg = *(const float4*)(g + 16 * d);
    uint2 w; w.x = pack2(o[0][d][0] * sc * gg.x, o[0][d][1] * sc * gg.y); w.y = pack2(o[0][d][2] * sc * gg.z, o[0][d][3] * sc * gg.w);
    *(uint2*)(dst + 16 * d) = w;
  }
}

DI void gla_item(const Params& p, int l, bool ctx, int b, int h, int c, char* smem) {
  const int tid = otid();
  const int seq0 = ctx ? b * 256 : NCTX + b * 2048;
  const int nch = ctx ? 4 : 32;
  const int row0 = seq0 + c * 64, tt0 = seq0 >> 6, tt = tt0 + c;
  const bf16_t* PR = (const bf16_t*)(p.ws + WS_PROJ);
  const float* GB = (const float*)(p.ws + WS_GB); const float* ATOT = (const float*)(p.ws + WS_ATOT); const float* U = (const float*)(p.ws + WS_U);
  float* qd = (float*)smem;
  float* kd = qd + 64 * 36;
  float* vv = kd + 64 * 36;
  float* S = vv + 4096;
  float* sc = S + 2048;
  const int ib = tid >> 4, xb = tid & 15, i0 = ib * 4, x0 = xb * 4;
  float o[4][4];
#pragma unroll
  for (int a = 0; a < 4; ++a)
#pragma unroll
    for (int e = 0; e < 4; ++e) o[a][e] = 0.f;
  for (int s = 0; s < 2; ++s) {
    {
      const int j = tid >> 2, part = tid & 3, kk = h * 32 + part * 8;
      const size_t prow = (size_t)(row0 + j) * PW;
      const uint4 qraw = *(const uint4*)(PR + prow + OFF_BQ + kk), kraw = *(const uint4*)(PR + prow + OFF_BK + kk);
      const float* gbp = GB + (size_t)(row0 + j) * 256 + s * 128 + kk;
      const float* ttp = ATOT + 192 * 256 + tt * 256 + s * 128 + kk;
      const float4 g0 = *(const float4*)gbp, g1 = *(const float4*)(gbp + 4), t0 = *(const float4*)ttp, t1 = *(const float4*)(ttp + 4);
      uint4 vraw0 = make_uint4(0, 0, 0, 0), vraw1 = vraw0;
      if (s == 0) { vraw0 = *(const uint4*)(PR + prow + OFF_BV + h * 64 + part * 16); vraw1 = *(const uint4*)(PR + prow + OFF_BV + h * 64 + part * 16 + 8); }
      float qv[8], kv[8]; unpack8(qraw, qv); unpack8(kraw, kv);
      const float cum[8] = {t0.x - g0.x, t0.y - g0.y, t0.z - g0.z, t0.w - g0.w, t1.x - g1.x, t1.y - g1.y, t1.z - g1.z, t1.w - g1.w};
      float qo[8], ko[8];
#pragma unroll
      for (int e = 0; e < 8; ++e) { qo[e] = qv[e] * 0.17677669529663687f * fast_exp2(cum[e] * LOG2E); ko[e] = kv[e] * fast_exp2(-cum[e] * LOG2E); }
      float* qp = qd + j * 36 + part * 8; float* kp = kd + j * 36 + part * 8;
      *(float4*)qp = make_float4(qo[0], qo[1], qo[2], qo[3]); *(float4*)(qp + 4) = make_float4(qo[4], qo[5], qo[6], qo[7]);
      *(float4*)kp = make_float4(ko[0], ko[1], ko[2], ko[3]); *(float4*)(kp + 4) = make_float4(ko[4], ko[5], ko[6], ko[7]);
      if (s == 0) {
        float x[16]; unpack8(vraw0, x); unpack8(vraw1, x + 8);
        float* vp = vv + j * 64 + part * 16;
#pragma unroll
        for (int e = 0; e < 4; ++e) *(float4*)(vp + 4 * e) = make_float4(x[4 * e], x[4 * e + 1], x[4 * e + 2], x[4 * e + 3]);
      }
    }
    {
      const int d = tid >> 3, v0 = (tid & 7) * 8;
      float S8[8];
      if (ctx) {
#pragma unroll
        for (int e = 0; e < 8; ++e) S8[e] = 0.f;
      } else {
        const float* s0 = p.in[7] + ((((size_t)b * 4 + l) * 2 + s) * 4 + h) * 2048 + d * 64 + v0;
        const float4 a = *(const float4*)s0, bq = *(const float4*)(s0 + 4);
        S8[0] = a.x; S8[1] = a.y; S8[2] = a.z; S8[3] = a.w; S8[4] = bq.x; S8[5] = bq.y; S8[6] = bq.z; S8[7] = bq.w;
      }
      const int nfold = s == 0 ? c : nch - 1 - c;
#pragma unroll 8
      for (int f = 0; f < nfold; ++f) {
        const int t2 = s == 0 ? tt0 + f : tt0 + nch - 1 - f;
        const float a = ATOT[t2 * 256 + s * 128 + h * 32 + d];
        const float* u = U + (((size_t)t2 * 2 + s) * 4 + h) * 2048 + d * 64 + v0;
        const float4 u0 = *(const float4*)u, u1 = *(const float4*)(u + 4);
        S8[0] = a * S8[0] + u0.x; S8[1] = a * S8[1] + u0.y; S8[2] = a * S8[2] + u0.z; S8[3] = a * S8[3] + u0.w;
        S8[4] = a * S8[4] + u1.x; S8[5] = a * S8[5] + u1.y; S8[6] = a * S8[6] + u1.z; S8[7] = a * S8[7] + u1.w;
      }
      *(float4*)(S + d * 64 + v0) = make_float4(S8[0], S8[1], S8[2], S8[3]);
      *(float4*)(S + d * 64 + v0 + 4) = make_float4(S8[4], S8[5], S8[6], S8[7]);
      if (ctx && ((s == 0 && c == nch - 1) || (s == 1 && c == 0))) {
        const float a = ATOT[tt * 256 + s * 128 + h * 32 + d];
        const float* u = U + (((size_t)tt * 2 + s) * 4 + h) * 2048 + d * 64 + v0;
        const float4 u0 = *(const float4*)u, u1 = *(const float4*)(u + 4);
        float* dst = p.out + O_ST + ((((size_t)b * 4 + l) * 2 + s) * 4 + h) * 2048 + d * 64 + v0;
        *(float4*)dst = make_float4(a * S8[0] + u0.x, a * S8[1] + u0.y, a * S8[2] + u0.z, a * S8[3] + u0.w);
        *(float4*)(dst + 4) = make_float4(a * S8[4] + u1.x, a * S8[5] + u1.y, a * S8[6] + u1.z, a * S8[7] + u1.w);
      }
    }
    __syncthreads();
    {
      float a4[4][4];
#pragma unroll
      for (int a = 0; a < 4; ++a)
#pragma unroll
        for (int e = 0; e < 4; ++e) a4[a][e] = 0.f;
#pragma unroll 2
      for (int d4 = 0; d4 < 8; ++d4) {
        float4 q4[4], k4[4];
#pragma unroll
        for (int a = 0; a < 4; ++a) { q4[a] = *(const float4*)(qd + (i0 + a) * 36 + 4 * d4); k4[a] = *(const float4*)(kd + (x0 + a) * 36 + 4 * d4); }
#pragma unroll
        for (int a = 0; a < 4; ++a)
#pragma unroll
          for (int e = 0; e < 4; ++e) a4[a][e] += q4[a].x * k4[e].x + q4[a].y * k4[e].y + q4[a].z * k4[e].z + q4[a].w * k4[e].w;
      }
#pragma unroll
      for (int a = 0; a < 4; ++a) {
        float r4[4];
#pragma unroll
        for (int e = 0; e < 4; ++e) { const int i = i0 + a, j = x0 + e; const bool keep = (s == 0) ? (j <= i) : (j >= i); r4[e] = keep ? a4[a][e] : 0.f; }
        *(float4*)(sc + (i0 + a) * 68 + x0) = make_float4(r4[0], r4[1], r4[2], r4[3]);
      }
    }
    __syncthreads();
    {
#pragma unroll 2
      for (int j = 0; j < 64; j += 4) {
        float4 s4[4], v4[4];
#pragma unroll
        for (int a = 0; a < 4; ++a) { s4[a] = *(const float4*)(sc + (i0 + a) * 68 + j); v4[a] = *(const float4*)(vv + (j + a) * 64 + x0); }
#pragma unroll
        for (int a = 0; a < 4; ++a) {
          o[a][0] += s4[a].x * v4[0].x + s4[a].y * v4[1].x + s4[a].z * v4[2].x + s4[a].w * v4[3].x;
          o[a][1] += s4[a].x * v4[0].y + s4[a].y * v4[1].y + s4[a].z * v4[2].y + s4[a].w * v4[3].y;
          o[a][2] += s4[a].x * v4[0].z + s4[a].y * v4[1].z + s4[a].z * v4[2].z + s4[a].w * v4[3].z;
          o[a][3] += s4[a].x * v4[0].w + s4[a].y * v4[1].w + s4[a].z * v4[2].w + s4[a].w * v4[3].w;
        }
      }
#pragma unroll 2
      for (int d = 0; d < 32; d += 4) {
        float4 q4[4], v4[4];
#pragma unroll
        for (int a = 0; a < 4; ++a) { q4[a] = *(const float4*)(qd + (i0 + a) * 36 + d); v4[a] = *(const float4*)(S + (d + a) * 64 + x0); }
#pragma unroll
        for (int a = 0; a < 4; ++a) {
          o[a][0] += q4[a].x * v4[0].x + q4[a].y * v4[1].x + q4[a].z * v4[2].x + q4[a].w * v4[3].x;
          o[a][1] += q4[a].x * v4[0].y + q4[a].y * v4[1].y + q4[a].z * v4[2].y + q4[a].w * v4[3].y;
          o[a][2] += q4[a].x * v4[0].z + q4[a].y * v4[1].z + q4[a].z * v4[2].z + q4[a].w * v4[3].z;
          o[a][3] += q4[a].x * v4[0].w + q4[a].y * v4[1].w + q4[a].z * v4[2].w + q4[a].w * v4[3].w;
        }
      }
    }
    __syncthreads();
  }
  const float4 gg = *(const float4*)(p.in[20] + l * 64 + x0);
#pragma unroll
  for (int a = 0; a < 4; ++a) {
    float ss = o[a][0] * o[a][0] + o[a][1] * o[a][1] + o[a][2] * o[a][2] + o[a][3] * o[a][3];
    ss += __shfl_xor(ss, 1); ss += __shfl_xor(ss, 2); ss += __shfl_xor(ss, 4); ss += __shfl_xor(ss, 8);
    const float rstd = rsqrtf(ss * (1.f / 64.f) + EPSN);
    const size_t row = row0 + i0 + a;
    float br[4]; unpack4(*(const uint2*)(PR + row * PW + OFF_BR + h * 64 + x0), br);
    uint2 w;
    w.x = pack2(o[a][0] * rstd * gg.x * sigm_silu_acc(br[0]), o[a][1] * rstd * gg.y * sigm_silu_acc(br[1]));
    w.y = pack2(o[a][2] * rstd * gg.z * sigm_silu_acc(br[2]), o[a][3] * rstd * gg.w * sigm_silu_acc(br[3]));
    *(uint2*)((bf16_t*)(p.ws + WS_MIX) + row * 1024 + 384 + h * 64 + x0) = w;
  }
}

DI void mixer_phase(const Params& p, int l, int cidx, char* smem) {
  unsigned* ctr = (unsigned*)(p.ws + WS_MISC + 64) + cidx;
  extern __shared__ __attribute__((aligned(16))) char dsm[];
  LDSP int* sidx = (LDSP int*)(dsm + 131072 + 16);
  constexpr int M_CL = PROBE == 21 ? 2 : 1, M_AL = PROBE == 22 ? 2 : 1, M_GL = PROBE == 23 ? 2 : 1, M_CC = PROBE == 24 ? 2 : 1, M_AC = PROBE == 25 ? 2 : 1, M_GC = PROBE == 26 ? 2 : 1;
  constexpr int N_CL = 256 * M_CL, N_AL = 384 * M_AL, N_GL = 256 * M_GL, N_CC = 512 * M_CC, N_AC = 768 * M_AC, N_GC = 512 * M_GC;
  constexpr int E0 = N_CL, E1 = E0 + N_AL, E2 = E1 + N_GL, E3 = E2 + N_CC, E4 = E3 + N_AC, E5 = E4 + N_GC;
  for (;;) {
    __syncthreads();
    if (threadIdx.x == 0) *sidx = (int)atomicAdd(ctr, 2u);
    __syncthreads();
    const int it = *sidx + ohalf();
    if (it >= E5) break;
    int typ, r; bool ctx;
    if (it < E0) { typ = 0; r = (it) % 256; ctx = false; }
    else if (it < E1) { typ = 1; r = (it - E0) % 384; ctx = false; }
    else if (it < E2) { typ = 2; r = (it - E1) % 256; ctx = false; }
    else if (it < E3) { typ = 0; r = (it - E2) % 512; ctx = true; }
    else if (it < E4) { typ = 1; r = (it - E3) % 768; ctx = true; }
    else { typ = 2; r = (it - E4) % 512; ctx = true; }
    const int sh = ctx ? 2 : 5, nq = 1 << sh;
    const int sub = r & (nq - 1), bh = r >> sh;
    if (typ == 0) attn_c_item(p, l, ctx, bh >> 2, bh & 3, sub, smem);
    else if (typ == 1) attn_a_item(p, l, ctx, bh / 6, bh % 6, sub, smem);
    else gla_item(p, l, ctx, bh >> 2, bh & 3, sub, smem);
  }
}

constexpr int DYN_LDS = 131072 + 64;
typedef const __attribute__((address_space(4))) Params* ParamsK;
DI ParamsK kparams() { ParamsK q = (ParamsK)__builtin_amdgcn_kernarg_segment_ptr(); asm volatile("" : "+s"(q)); return q; }
__global__ void __launch_bounds__(512, 2) fwd_megakernel(Params p_unused) {
  extern __shared__ __attribute__((aligned(16))) char dsm[];
  cg::grid_group grid = cg::this_grid();
  if (gridDim.y == 2) grid.sync();
  const Params& p = *(const Params*)kparams();
  volatile LDSP unsigned* xbw = (volatile LDSP unsigned*)(dsm + 131072);
  if (threadIdx.x == 0) { xbw[0] = 0u; xbw[1] = 0u; xbw[2] = 0u; xbw[3] = 0u; }
  __syncthreads();
  const XcdBarrier xb = xcd_barrier_post((unsigned*)(p.ws + WS_BAR), xbw);
  char* smem = dsm + ohalf() * 65536;
  phase0(p, (float*)smem);
  xcd_barrier(xb);
#pragma unroll 1
  for (int ph = 0; ph < 44; ++ph) {
    const int l = ph / 11, q = ph - l * 11;
    const Params& p = *(const Params*)kparams();
    const float* mod = (const float*)(p.ws + WS_MOD);
    const bf16_t* H = (const bf16_t*)(p.ws + WS_H);
    const bf16_t* ACT = (const bf16_t*)(p.ws + WS_ACT);
    const bf16_t* MIX = (const bf16_t*)(p.ws + WS_MIX);
    const float* modl = mod + (size_t)l * 3 * 9216;
    int nrep = 1;
#if PROBE
    if (PROBE == 1) nrep = (q == 1 || q == 9 || q == 2 || q == 10 || q == 7 || q == 4) ? 2 : 1;
    if (PROBE == 2) nrep = (q == 6) ? 2 : 1;
    if (PROBE == 3) nrep = (q == 5) ? 2 : 1;
    if (PROBE == 4) nrep = (q == 0 || q == 3 || q == 8) ? 2 : 1;
    if (PROBE == 5) nrep = 2;
#endif
#pragma unroll 1
    for (int rep = 0; rep < nrep; ++rep) {
#if PROBE == 5
    if (rep == 1) { xcd_barrier(xb); xcd_barrier(xb); xcd_barrier(xb); continue; }
#endif
    if (q == 3 || q == 8 || (q == 0 && l > 0)) continue;
    const float* RS = (const float*)(p.ws + WS_ROWSS);
    const float* BIAS = (const float*)(p.ws + WS_BIAS);
    if (q == 0) {
      norm0_bias_phase(p);
    } else if (q == 1 || q == 9) {
      const int f = q == 1 ? 0 : 1;
      { EpiSwiglu E; E.ACT = (bf16_t*)(p.ws + WS_ACT); E.RS = RS; E.bias = BIAS + (size_t)(l * 3 + (f ? 2 : 0)) * 3 * 5632;
        gemm8_run(H, (const bf16_t*)(p.ws + WS_WGU) + (size_t)(l * 2 + f) * 5632 * 1024, 5632, 1024, E, dsm); }
    } else if (q == 2 || q == 10 || q == 7) {
      const bf16_t* A; const bf16_t* Bt; int lda, K; const float* gb; float coef; int nl, nsub;
      if (q == 7) { A = MIX; lda = 1024; K = 1024; Bt = (const bf16_t*)(p.ws + WS_WOUT) + (size_t)l * 1024 * 1024; gb = modl + 5 * 1024; coef = 1.0f; nl = l; nsub = 2; }
      else { const int f = q == 2 ? 0 : 1; A = ACT; lda = DFF; K = DFF; Bt = (const bf16_t*)(p.ws + WS_WD) + (size_t)(l * 2 + f) * 1024 * 2816; gb = modl + (f == 0 ? 2 : 8) * 1024; coef = 0.5f;
             nl = f == 0 ? l : l + 1; nsub = f == 0 ? 1 : 0; }
      (void)lda;
      { EpiResid E; E.X = p.out; E.gate_base = gb; E.coef = rep ? 0.f : coef; E.H = (bf16_t*)(p.ws + WS_H); E.RS = (float*)(p.ws + WS_ROWSS);
        E.nxt_g = nl < 4 ? p.in[11] + (nl * 3 + nsub) * 1024 : nullptr; E.nxt_scale = mod + (size_t)(nl < 4 ? nl : 0) * 3 * 9216 + (3 * nsub + 1) * 1024;
        gemm8_run(A, Bt, 1024, K, E, dsm); }
    } else if (q == 4) {
      { EpiProj E; E.PR = (bf16_t*)(p.ws + WS_PROJ); E.RS = RS; E.bias = BIAS + (size_t)(l * 3 + 1) * 3 * 5632;
        gemm8_run(H, (const bf16_t*)(p.ws + WS_WIN) + (size_t)l * PWR * 1024, PWP, 1024, E, dsm); }
    } else if (q == 5) {
      prep_phase(p, l, smem);
    } else {
      mixer_phase(p, l, l + 4 * rep, smem);
    }
    xcd_barrier(xb);
    }
  }
}

extern "C" void kernel_launch(void* const* d_in, const int* in_sizes, int n_in,
                              void* d_out, int out_size, void* d_ws, size_t ws_size,
                              hipStream_t stream) {
  static int grid_blocks = 0;
  if (!grid_blocks) {
    int dev = 0, cus = 0, per_cu = 0;
    (void)hipGetDevice(&dev);
    (void)hipDeviceGetAttribute(&cus, hipDeviceAttributeMultiprocessorCount, dev);
    (void)hipFuncSetAttribute((const void*)fwd_megakernel, hipFuncAttributeMaxDynamicSharedMemorySize, DYN_LDS);
    (void)hipOccupancyMaxActiveBlocksPerMultiprocessor(&per_cu, fwd_megakernel, 512, DYN_LDS);
    if (per_cu < 1) per_cu = 1;
    grid_blocks = cus;
    grid_blocks -= grid_blocks % 8;
  }
  Params p{};
  for (int i = 0; i < 26; ++i) p.in[i] = (const float*)d_in[i];
  p.out = (float*)d_out;
  p.ws = (char*)d_ws;
  for (int i = 0; i < 16; ++i) p.freqA[i] = powf(10000.0f, -(float)i / 16.0f);
  for (int i = 0; i < 12; ++i) p.freqC[i] = powf(10000.0f, -(float)i / 12.0f);
  for (int l = 0; l < 4; ++l) p.lam_init[l] = (float)(0.8 - 0.6 * exp(-0.3 * l));
  (void)hipMemsetAsync((char*)d_ws + WS_BAR, 0, XCD_BAR_WORDS_C * 4, stream);
  void* args[] = {&p};
  hipError_t e = hipLaunchCooperativeKernel((void*)fwd_megakernel, dim3(grid_blocks), dim3(512), args, DYN_LDS, stream);
  if (e != hipSuccess) fprintf(stderr, "cooperative launch failed: %s (grid %d)\n", hipGetErrorString(e), grid_blocks);
}
```

```cpp
#include <hip/hip_runtime.h>
#include <hip/hip_cooperative_groups.h>
#include <cstdio>
#include <cmath>
namespace cg = cooperative_groups;
#ifndef PROBE
#define PROBE 0
#endif

typedef unsigned short bf16_t;
typedef short bf16x8 __attribute__((ext_vector_type(8)));
typedef short s16x4 __attribute__((ext_vector_type(4)));
typedef float f32x4 __attribute__((ext_vector_type(4)));
#define LDSP __attribute__((address_space(3)))
#define DI __device__ __forceinline__

constexpr int DM = 1024, DFF = 2816, NTOK = 12288, NCTX = 8192, PW = 2560, PWP = 2560, PWR = 2592;
constexpr int OFF_AQ = 0, OFF_AK = 384, OFF_AV = 512, OFF_BQ = 640, OFF_BK = 768, OFF_BV = 896,
              OFF_BR = 1152, OFF_CQ = 1408, OFF_CK = 1792, OFF_CV = 2176, OFF_BGW = 2560;
constexpr float EPSN = 1e-6f;
constexpr float LOG2E = 1.4426950408889634f;
constexpr size_t O_YP = 0, O_YS = 8388608, O_AK = 12582912, O_AV = 16777216, O_CK = 20971520, O_CV = 33554432, O_ST = 46137344;

constexpr size_t XCD_BAR_WORDS_C = 3456;
constexpr size_t al256(size_t x) { return (x + 255) & ~(size_t)255; }
constexpr size_t WS_MOD = 0;
constexpr size_t WS_MISC = al256(WS_MOD + 4ull * 3 * 9216 * 4);
constexpr size_t WS_ROPE = WS_MISC + 256;
constexpr size_t WS_WGU = al256(WS_ROPE + (1024 * 2 + 768 * 2) * 4);
constexpr size_t WS_WD = WS_WGU + 8ull * 5632 * 1024 * 2;
constexpr size_t WS_WIN = WS_WD + 8ull * 1024 * 2816 * 2;
constexpr size_t WS_WOUT = WS_WIN + 4ull * PWR * 1024 * 2;
constexpr size_t WS_H = WS_WOUT + 4ull * 1024 * 1024 * 2;
constexpr size_t WS_MIX = WS_H + (size_t)NTOK * 1024 * 2;
constexpr size_t WS_ACT = WS_MIX + (size_t)NTOK * 1024 * 2;
constexpr size_t WS_PROJ = WS_ACT + (size_t)NTOK * DFF * 2;
constexpr size_t WS_QA = WS_PROJ + (size_t)NTOK * PW * 2;
constexpr size_t WS_KA = WS_QA + (size_t)NTOK * 384 * 2;
constexpr size_t WS_QC = WS_KA + (size_t)NTOK * 128 * 2;
constexpr size_t WS_KC = WS_QC + (size_t)NTOK * 512 * 2;
constexpr size_t WS_GB = WS_KC + (size_t)NTOK * 512 * 2;
constexpr size_t WS_ATOT = WS_GB + (size_t)NTOK * 256 * 4;
constexpr size_t WS_U = WS_ATOT + 2 * 192ull * 256 * 4;
constexpr size_t WS_KAC = WS_U + 192ull * 2 * 4 * 2048 * 4;
constexpr size_t WS_VAC = WS_KAC + 2ull * 4 * 512 * 128 * 2;
constexpr size_t WS_KCC = WS_VAC + 2ull * 4 * 512 * 128 * 2;
constexpr size_t WS_VCC = WS_KCC + 2ull * 4 * 512 * 512 * 2;
constexpr size_t WS_BAR = WS_VCC + 2ull * 4 * 512 * 384 * 2;
constexpr size_t WS_ROWSS = al256(WS_BAR + XCD_BAR_WORDS_C * 4);
constexpr size_t WS_BIAS = WS_ROWSS + (size_t)NTOK * 16 * 4;
constexpr size_t WS_END = WS_BIAS + 4ull * 3 * 3 * 5632 * 4;

struct Params {
  const float* in[26];
  float* out;
  char* ws;
  float freqA[16];
  float freqC[12];
  float lam_init[4];
};

DI float bf2f(bf16_t v) { return __uint_as_float(((unsigned)v) << 16); }
DI bf16_t f2bf(float f) { unsigned u = __float_as_uint(f); u += 0x7fffu + ((u >> 16) & 1u); return (bf16_t)(u >> 16); }
typedef float f32x2_t __attribute__((ext_vector_type(2)));
typedef __bf16 bf16x2_t __attribute__((ext_vector_type(2)));
DI unsigned pack2(float lo, float hi) { const f32x2_t v = {lo, hi}; return __builtin_bit_cast(unsigned, __builtin_convertvector(v, bf16x2_t)); }
DI float fast_exp2(float x) { return __builtin_amdgcn_exp2f(x); }
DI float fast_rcp(float x) { return __builtin_amdgcn_rcpf(x); }
DI float silu_f(float g) { return g * fast_rcp(1.f + fast_exp2(-g * LOG2E)); }
DI float sigm_silu_acc(float g) { return g / (1.f + expf(-g)); }
DI void unpack8(uint4 v, float* x) {
  x[0] = __uint_as_float(v.x << 16); x[1] = __uint_as_float(v.x & 0xffff0000u);
  x[2] = __uint_as_float(v.y << 16); x[3] = __uint_as_float(v.y & 0xffff0000u);
  x[4] = __uint_as_float(v.z << 16); x[5] = __uint_as_float(v.z & 0xffff0000u);
  x[6] = __uint_as_float(v.w << 16); x[7] = __uint_as_float(v.w & 0xffff0000u);
}
DI void unpack4(uint2 v, float* x) {
  x[0] = __uint_as_float(v.x << 16); x[1] = __uint_as_float(v.x & 0xffff0000u);
  x[2] = __uint_as_float(v.y << 16); x[3] = __uint_as_float(v.y & 0xffff0000u);
}
DI int otid() { int t = threadIdx.x & 255; asm volatile("" : "+v"(t)); return t; }
DI int ohalf() { return __builtin_amdgcn_readfirstlane((int)(threadIdx.x >> 8)); }
DI int obid() { int b = blockIdx.x * 2 + ohalf(); asm volatile("" : "+s"(b)); return b; }
DI int vnb() { return gridDim.x * 2; }
DI int rtid() { int t = threadIdx.x; asm volatile("" : "+v"(t)); return t; }
DI int cond_of_row(int row) { return row < NCTX ? 0 : 1 + ((row - NCTX) >> 11); }


#define XB_TMO      128
#define XB_XCNT(j)  (256  + 64 * (j))
#define XB_XSUB(j)  (1280 + 64 * (j))
#define XB_XGEN(j)  (2304 + 64 * (j))
#define XB_TOP      3328
#define XB_TOPGEN   3392
#define XCD_BAR_WORDS 3456
#define XB_SPIN_CAP (1u << 22)
DI unsigned xb_ld(unsigned* p) { return __hip_atomic_load(p, __ATOMIC_RELAXED, __HIP_MEMORY_SCOPE_AGENT); }
DI unsigned xb_add(unsigned* p, unsigned v) { return __hip_atomic_fetch_add(p, v, __ATOMIC_RELAXED, __HIP_MEMORY_SCOPE_AGENT); }
DI unsigned xb_xcc_id() { return (unsigned)__builtin_amdgcn_s_getreg((3 << 11) | 20) & 0xFu; }
#define XB_SPIN(cond, bar) do { unsigned _sp = 0; while (cond) { __builtin_amdgcn_s_sleep(1); \
    if ((++_sp & 255u) == 0u) { if (xb_ld(&(bar)[XB_TMO])) break; if (_sp > XB_SPIN_CAP) { atomicAdd(&(bar)[XB_TMO], 1u); break; } } } } while (0)
struct XcdBarrier { unsigned* bar; unsigned x; volatile LDSP unsigned* st; };
DI XcdBarrier xcd_barrier_post(unsigned* bar, volatile LDSP unsigned* st) {
  XcdBarrier b; b.bar = bar; b.x = xb_xcc_id(); b.st = st;
  if (threadIdx.x == 0) (void)xb_add(&bar[XB_XCNT(b.x)], 1u);
  return b;
}
DI void xcd_barrier_complete(unsigned* bar, unsigned x, unsigned& nloc, unsigned& nx) {
  const unsigned G = gridDim.x * gridDim.y * gridDim.z;
  unsigned sum, cnt, mine, sp = 0u;
  for (;;) {
    sum = 0u; cnt = 0u; mine = 0u;
#pragma unroll
    for (unsigned j = 0; j < 16; ++j) { const unsigned c = xb_ld(&bar[XB_XCNT(j)]); sum += c; cnt += (c > 0u) ? 1u : 0u; mine = (j == x) ? c : mine; }
    if (sum == G) break;
    __builtin_amdgcn_s_sleep(1);
    if ((++sp & 255u) == 0u) { if (xb_ld(&bar[XB_TMO])) break; if (sp > XB_SPIN_CAP) { atomicAdd(&bar[XB_TMO], 1u); break; } }
  }
  nloc = mine > 0u ? mine : 1u; nx = cnt > 0u ? cnt : 1u;
}
DI void xcd_barrier(const XcdBarrier& b_) {
  asm volatile("s_waitcnt vmcnt(0)" ::: "memory");
  __syncthreads();
  if (threadIdx.x == 0) {
    XcdBarrier b; b.st = b_.st;
    { unsigned* q = b_.bar; asm volatile("" : "+s"(q)); b.bar = q; }
    { unsigned xx = xb_xcc_id(); asm volatile("" : "+s"(xx)); b.x = xx; }
    unsigned* bar = b.bar;
    __builtin_amdgcn_s_waitcnt(0);
    unsigned nloc = b.st[0], nx = b.st[1];
    if (nloc == 0u) { xcd_barrier_complete(bar, b.x, nloc, nx); b.st[0] = nloc; b.st[1] = nx; }
    const unsigned old = xb_add(&bar[XB_XSUB(b.x)], 1u);
    const unsigned gen = old / nloc;
    if (old + 1u == (gen + 1u) * nloc) {
      __builtin_amdgcn_fence(__ATOMIC_RELEASE, "agent");
      asm volatile("s_waitcnt vmcnt(0)" ::: "memory");
      const unsigned og = xb_add(&bar[XB_TOP], 1u);
      const unsigned tg = og / nx;
      if (og + 1u == (tg + 1u) * nx) xb_add(&bar[XB_TOPGEN], 1u);
      else XB_SPIN(xb_ld(&bar[XB_TOPGEN]) == tg, bar);
      __builtin_amdgcn_fence(__ATOMIC_ACQUIRE, "agent");
      xb_add(&bar[XB_XGEN(b.x)], 1u);
      asm volatile("s_waitcnt vmcnt(0)" ::: "memory");
    } else {
      XB_SPIN(xb_ld(&bar[XB_XGEN(b.x)]) == gen, bar);
      __builtin_amdgcn_fence(__ATOMIC_ACQUIRE, "agent");
      asm volatile("s_waitcnt vmcnt(0)" ::: "memory");
    }
  }
  __syncthreads();
}

DI void transpose_tile(const float* __restrict__ src, int K, int N, bf16_t* __restrict__ dst, int mode, int kt, int nt, float* sm) {
  const int t = otid();
  const int k0 = kt * 64, n0 = nt * 64;
#pragma unroll
  for (int i = 0; i < 4; ++i) {
    const int idx = t + 256 * i, r = idx >> 4, c4 = idx & 15;
    float4 v = make_float4(0.f, 0.f, 0.f, 0.f);
    if (n0 + 4 * c4 < N) v = *(const float4*)(src + (size_t)(k0 + r) * N + n0 + 4 * c4);
    float* d = sm + r * 65 + 4 * c4;
    d[0] = v.x; d[1] = v.y; d[2] = v.z; d[3] = v.w;
  }
  __syncthreads();
#pragma unroll
  for (int i = 0; i < 2; ++i) {
    const int idx = t + 256 * i, nl = idx >> 3, kc = idx & 7;
    const int n = n0 + nl;
    if (n < N) {
      float x[8];
#pragma unroll
      for (int e = 0; e < 8; ++e) x[e] = sm[(8 * kc + e) * 65 + nl];
      uint4 w; w.x = pack2(x[0], x[1]); w.y = pack2(x[2], x[3]); w.z = pack2(x[4], x[5]); w.w = pack2(x[6], x[7]);
      int drow = n;
      if (mode == 1) drow = (n >> 4) * 32 + (n & 15);
      else if (mode == 2) drow = (n >> 4) * 32 + 16 + (n & 15);
      *(uint4*)(dst + (size_t)drow * K + k0 + 8 * kc) = w;
    }
  }
  __syncthreads();
}

DI void adaln_item(const Params& p, int it, float* sm) {
  const int t = otid();
  const int l = it / 72, chunk = it % 72, j0 = chunk * 128;
  float* scond = sm;
  float* red = sm + 3072;
  for (int i = t; i < 3072; i += 256) {
    const int c = i >> 10, k = i & 1023;
    const float v = (c == 0) ? p.in[8][k] : p.in[2][(c - 1) * 1024 + k];
    scond[i] = sigm_silu_acc(v);
  }
  __syncthreads();
  const int cgp = t & 31, kg = t >> 5;
  const float* w = p.in[9] + (size_t)l * 1024 * 9216 + j0 + 4 * cgp;
  float acc[3][4];
#pragma unroll
  for (int c = 0; c < 3; ++c)
#pragma unroll
    for (int e = 0; e < 4; ++e) acc[c][e] = 0.f;
#pragma unroll 8
  for (int kk = 0; kk < 128; ++kk) {
    const int k = kg * 128 + kk;
    const float4 wv = *(const float4*)(w + (size_t)k * 9216);
#pragma unroll
    for (int c = 0; c < 3; ++c) {
      const float s = scond[c * 1024 + k];
      acc[c][0] += s * wv.x; acc[c][1] += s * wv.y; acc[c][2] += s * wv.z; acc[c][3] += s * wv.w;
    }
  }
#pragma unroll
  for (int c = 0; c < 3; ++c)
#pragma unroll
    for (int e = 0; e < 4; ++e) red[(kg * 3 + c) * 128 + 4 * cgp + e] = acc[c][e];
  __syncthreads();
  float* mod = (float*)(p.ws + WS_MOD);
  for (int o = t; o < 384; o += 256) {
    const int c = o >> 7, j = o & 127;
    float s = p.in[10][l * 9216 + j0 + j];
#pragma unroll
    for (int g = 0; g < 8; ++g) s += red[(g * 3 + c) * 128 + j];
    mod[(l * 3 + c) * 9216 + j0 + j] = s;
  }
  __syncthreads();
}

DI void sincos_tab(float pos, float freq, float& cs, float& sn) {
  const double a = (double)pos * (double)freq;
  const double twopi = 6.283185307179586476925286766559;
  const double k = rint(a / twopi);
  const double r = (a - k * twopi) * 0.25;
  const double r2 = r * r;
  double s = r * (1.0 + r2 * (-1.0 / 6 + r2 * (1.0 / 120 + r2 * (-1.0 / 5040 + r2 * (1.0 / 362880 + r2 * (-1.0 / 39916800 + r2 * (1.0 / 6227020800.0)))))));
  double c = 1.0 + r2 * (-0.5 + r2 * (1.0 / 24 + r2 * (-1.0 / 720 + r2 * (1.0 / 40320 + r2 * (-1.0 / 3628800 + r2 * (1.0 / 479001600.0 + r2 * (-1.0 / 87178291200.0)))))));
  double s2 = 2.0 * s * c, c2 = 1.0 - 2.0 * s * s;
  double s4 = 2.0 * s2 * c2, c4 = 1.0 - 2.0 * s2 * s2;
  cs = (float)c4; sn = (float)s4;
}

struct TDesc { const float* src; bf16_t* dst; int K, N, mode, kt, nt; };
DI TDesc tile_desc(const Params& p, int r) {
  TDesc d;
  const int l = r / 5136; r -= l * 5136;
  if (r < 4224) {
    const int f = r / 2112; r -= f * 2112;
    const int which = r / 704; r -= which * 704;
    const int lf = l * 2 + f;
    if (which < 2) { d.src = p.in[which == 0 ? 12 : 13] + (size_t)lf * 1024 * 2816; d.dst = (bf16_t*)(p.ws + WS_WGU) + (size_t)lf * 5632 * 1024; d.K = 1024; d.N = 2816; d.mode = which + 1; d.kt = r / 44; d.nt = r % 44; }
    else { d.src = p.in[14] + (size_t)lf * 2816 * 1024; d.dst = (bf16_t*)(p.ws + WS_WD) + (size_t)lf * 1024 * 2816; d.K = 2816; d.N = 1024; d.mode = 0; d.kt = r / 16; d.nt = r % 16; }
  } else if (r < 4224 + 656) {
    r -= 4224;
    d.src = p.in[15] + (size_t)l * 1024 * PWR; d.dst = (bf16_t*)(p.ws + WS_WIN) + (size_t)l * PWR * 1024; d.K = 1024; d.N = PWR; d.mode = 3; d.kt = r / 41; d.nt = r % 41;
  } else {
    r -= 4224 + 656;
    d.src = p.in[25] + (size_t)l * 1024 * 1024; d.dst = (bf16_t*)(p.ws + WS_WOUT) + (size_t)l * 1024 * 1024; d.K = 1024; d.N = 1024; d.mode = 0; d.kt = r / 16; d.nt = r % 16;
  }
  return d;
}
DI void tile_load(const TDesc& d, int t, f32x4 (&v)[4]) {
  const int k0 = d.kt * 64, n0 = d.nt * 64;
#pragma unroll
  for (int i = 0; i < 4; ++i) {
    const int idx = t + 256 * i, r = idx >> 4, c4 = idx & 15;
    v[i] = (f32x4){0.f, 0.f, 0.f, 0.f};
    if (n0 + 4 * c4 < d.N) v[i] = __builtin_nontemporal_load((const f32x4*)(d.src + (size_t)(k0 + r) * d.N + n0 + 4 * c4));
  }
}
DI void tile_store(const TDesc& d, int t, const f32x4 (&v)[4], float* sm) {
  const int k0 = d.kt * 64, n0 = d.nt * 64;
#pragma unroll
  for (int i = 0; i < 4; ++i) {
    const int idx = t + 256 * i, r = idx >> 4, c4 = idx & 15;
    float* q = sm + r * 65 + 4 * c4;
    q[0] = v[i][0]; q[1] = v[i][1]; q[2] = v[i][2]; q[3] = v[i][3];
  }
  __syncthreads();
#pragma unroll
  for (int i = 0; i < 2; ++i) {
    const int idx = t + 256 * i, nl = idx >> 3, kc = idx & 7;
    const int n = n0 + nl;
    if (n < d.N) {
      float x[8];
#pragma unroll
      for (int e = 0; e < 8; ++e) x[e] = sm[(8 * kc + e) * 65 + nl];
      uint4 w; w.x = pack2(x[0], x[1]); w.y = pack2(x[2], x[3]); w.z = pack2(x[4], x[5]); w.w = pack2(x[6], x[7]);
      int drow = n;
      if (d.mode == 1) drow = (n >> 7) * 256 + (n & 127);
      else if (d.mode == 2) drow = (n >> 7) * 256 + 128 + (n & 127);
      else if (d.mode == 3) drow = n < 1152 ? n : (n < 1184 ? OFF_BGW + (n - 1152) : n - 32);
      *(uint4*)(d.dst + (size_t)drow * d.K + k0 + 8 * kc) = w;
    }
  }
  __syncthreads();
}

DI void phase0(const Params& p, float* sm) {
  const int nb = vnb(), bid = obid(), t = otid();
  if (bid < 288) adaln_item(p, bid, sm);
  {
    const int n_tiles = 4 * 5136;
    int r = bid;
    f32x4 cur[4], nxt[4];
    TDesc dc = tile_desc(p, r < n_tiles ? r : 0);
    if (r < n_tiles) tile_load(dc, t, cur);
#pragma unroll 1
    for (; r < n_tiles; r += nb) {
      const int rn = r + nb;
      TDesc dn = tile_desc(p, rn < n_tiles ? rn : 0);
      if (rn < n_tiles) tile_load(dn, t, nxt);
      tile_store(dc, t, cur, sm);
      dc = dn;
#pragma unroll
      for (int i = 0; i < 4; ++i) cur[i] = nxt[i];
    }
  }
  #define gt ((size_t)(blockIdx.x * 512 + rtid()))
  const size_t gs = (size_t)gridDim.x * 512;
  {
    float4* dst = (float4*)p.out;
    const float4* s0 = (const float4*)p.in[0];
    const float4* s1 = (const float4*)p.in[1];
    const size_t n0 = (size_t)NCTX * 256, n1 = (size_t)NTOK * 256;
    for (size_t i = gt; i < n1; i += gs) dst[i] = (i < n0) ? s0[i] : s1[i - n0];
  }
  {
    bf16_t* kac = (bf16_t*)(p.ws + WS_KAC); bf16_t* vac = (bf16_t*)(p.ws + WS_VAC);
    for (size_t i = gt; i < 524288 / 4; i += gs) {
      const float4 a = ((const float4*)p.in[3])[i], b = ((const float4*)p.in[4])[i];
      uint2 wa, wb; wa.x = pack2(a.x, a.y); wa.y = pack2(a.z, a.w); wb.x = pack2(b.x, b.y); wb.y = pack2(b.z, b.w);
      ((uint2*)kac)[i] = wa; ((uint2*)vac)[i] = wb;
    }
    bf16_t* vcc = (bf16_t*)(p.ws + WS_VCC);
    for (size_t i = gt; i < 1572864 / 4; i += gs) {
      const float4 a = ((const float4*)p.in[6])[i];
      uint2 wa; wa.x = pack2(a.x, a.y); wa.y = pack2(a.z, a.w);
      ((uint2*)vcc)[i] = wa;
    }
    bf16_t* kcc = (bf16_t*)(p.ws + WS_KCC);
    for (size_t i = gt; i < 4096ull * 8 * 16; i += gs) {
      const size_t rv = i >> 4; const int g = (int)(i & 15);
      uint2 w = make_uint2(0, 0);
      if (g < 12) { const float4 a = *(const float4*)(p.in[5] + rv * 48 + 4 * g); w.x = pack2(a.x, a.y); w.y = pack2(a.z, a.w); }
      *(uint2*)(kcc + rv * 64 + 4 * g) = w;
    }
  }
  {
    float* rope = (float*)(p.ws + WS_ROPE);
    for (size_t i = gt; i < 1024 + 768; i += gs) {
      if (i < 1024) { const int pos = (int)i >> 4, f = (int)i & 15; float c, s; sincos_tab((float)pos, p.freqA[f], c, s); rope[i] = c; rope[1024 + i] = s; }
      else { const int j = (int)i - 1024; const int pos = j / 12, f = j % 12; float c, s; sincos_tab((float)pos, p.freqC[f], c, s); rope[2048 + j] = c; rope[2048 + 768 + j] = s; }
    }
    if (gt < 4) {
      const float* lc = p.in[23] + gt * 4 * 48;
      float s1 = 0.f, s2 = 0.f;
      for (int d = 0; d < 48; ++d) { s1 += lc[d] * lc[48 + d]; s2 += lc[96 + d] * lc[144 + d]; }
      ((float*)(p.ws + WS_MISC))[gt] = expf(s1) - expf(s2) + p.lam_init[gt];
      ((unsigned*)(p.ws + WS_MISC + 64))[gt] = 0u; ((unsigned*)(p.ws + WS_MISC + 64))[gt + 4] = 0u;
    }
  }
}
#undef gt

DI void norm0_bias_phase(const Params& p) {
  const int tx = rtid(); const int lane = tx & 63;
  const int gw = blockIdx.x * 8 + (tx >> 6), nw = gridDim.x * 8;
  const float* mod = (const float*)(p.ws + WS_MOD);
  {
    const float* g = p.in[11];
    bf16_t* H = (bf16_t*)(p.ws + WS_H);
    float* RS = (float*)(p.ws + WS_ROWSS);
    for (int row = gw; row < NTOK; row += nw) {
      const float* x = p.out + (size_t)row * 1024;
      float4 v[4]; float ss = 0.f;
#pragma unroll
      for (int c = 0; c < 4; ++c) { v[c] = *(const float4*)(x + c * 256 + lane * 4); ss += v[c].x * v[c].x + v[c].y * v[c].y + v[c].z * v[c].z + v[c].w * v[c].w; }
#pragma unroll
      for (int o = 32; o >= 1; o >>= 1) ss += __shfl_xor(ss, o);
      if (lane < 16) RS[(size_t)row * 16 + lane] = lane == 0 ? ss : 0.f;
      const float* mrow = mod + ((size_t)cond_of_row(row)) * 9216;
#pragma unroll
      for (int c = 0; c < 4; ++c) {
        const int j = c * 256 + lane * 4;
        const float4 gg = *(const float4*)(g + j), sc = *(const float4*)(mrow + 1024 + j);
        uint2 w; w.x = pack2(v[c].x * gg.x * (1.f + sc.x), v[c].y * gg.y * (1.f + sc.y)); w.y = pack2(v[c].z * gg.z * (1.f + sc.z), v[c].w * gg.w * (1.f + sc.w));
        *(uint2*)(H + (size_t)row * 1024 + j) = w;
      }
    }
  }
  {
    float* BIAS = (float*)(p.ws + WS_BIAS);
#pragma unroll 1
    for (int grp = 0; grp < 12; ++grp) {
      const int l = grp / 3, sub = grp - l * 3;
      const int ncol = sub == 1 ? PWR : 5632;
      const bf16_t* Wt = sub == 1 ? (const bf16_t*)(p.ws + WS_WIN) + (size_t)l * PWR * 1024 : (const bf16_t*)(p.ws + WS_WGU) + (size_t)(l * 2 + (sub >> 1)) * 5632 * 1024;
      float sh[3][16];
#pragma unroll
      for (int c = 0; c < 3; ++c) {
        const float* sp = mod + ((size_t)l * 3 + c) * 9216 + (size_t)(3 * sub) * 1024 + lane * 16;
#pragma unroll
        for (int q = 0; q < 4; ++q) { const float4 t = *(const float4*)(sp + 4 * q); sh[c][4 * q] = t.x; sh[c][4 * q + 1] = t.y; sh[c][4 * q + 2] = t.z; sh[c][4 * q + 3] = t.w; }
      }
#pragma unroll 2
      for (int n = gw; n < ncol; n += nw) {
        float w[16]; unpack8(*(const uint4*)(Wt + (size_t)n * 1024 + lane * 16), w); unpack8(*(const uint4*)(Wt + (size_t)n * 1024 + lane * 16 + 8), w + 8);
        float d0 = 0.f, d1 = 0.f, d2 = 0.f;
#pragma unroll
        for (int e = 0; e < 16; ++e) { d0 += sh[0][e] * w[e]; d1 += sh[1][e] * w[e]; d2 += sh[2][e] * w[e]; }
#pragma unroll
        for (int o = 32; o >= 1; o >>= 1) { d0 += __shfl_xor(d0, o); d1 += __shfl_xor(d1, o); d2 += __shfl_xor(d2, o); }
        if (lane < 3) BIAS[((size_t)grp * 3 + lane) * 5632 + n] = lane == 0 ? d0 : (lane == 1 ? d1 : d2);
      }
    }
  }
}

enum { EPI_SWIGLU = 0, EPI_RESID = 1, EPI_PROJ = 2 };

template <int EPI>
DI void gemm_phase(const Params& p, const bf16_t* __restrict__ A, int lda, const bf16_t* __restrict__ Bt, int K, int NT,
                   const float* __restrict__ gate_base  , float coef, char* smem) {
  const int tid = otid(), lane = tid & 63, wave = tid >> 6, wm = wave >> 1, wn = wave & 1;
  const int nb = vnb(), xcd = obid() & 7, slot = obid() >> 3, slots = nb >> 3;
  const int per_x = 12 * NT;
  const int nk = K >> 6;
  char* As = smem;
  char* Bs = smem + 32768;
  for (int q = slot; q < per_x; q += slots) {
    const int grp = q / (4 * NT), r = q - grp * 4 * NT, nt = r >> 2, mtl = r & 3, mt = (grp * 4 + mtl) * 8 + xcd;
    const int m0 = mt * 128, n0 = nt * 128;
    f32x4 acc[4][4];
#pragma unroll
    for (int i = 0; i < 4; ++i)
#pragma unroll
      for (int j = 0; j < 4; ++j) acc[i][j] = (f32x4){0.f, 0.f, 0.f, 0.f};
    const bf16_t* Ag = A + (size_t)(m0 + (tid >> 3)) * lda + (tid & 7) * 8;
    const bf16_t* Bg = Bt + (size_t)(n0 + (tid >> 3)) * K + (tid & 7) * 8;
    const int lrow = tid >> 3, lch = tid & 7;
    uint4 ra[4], rb[4];
#pragma unroll
    for (int i = 0; i < 4; ++i) { ra[i] = *(const uint4*)(Ag + (size_t)(32 * i) * lda); rb[i] = *(const uint4*)(Bg + (size_t)(32 * i) * K); }
#pragma unroll
    for (int i = 0; i < 4; ++i) {
      const int row = lrow + 32 * i; const int off = row * 128 + ((lch ^ (row & 7)) << 4);
      *(uint4*)(As + off) = ra[i]; *(uint4*)(Bs + off) = rb[i];
    }
    __syncthreads();
    for (int kt = 0; kt < nk; ++kt) {
      const int cur = kt & 1;
      if (kt + 1 < nk) {
        const int k0 = (kt + 1) * 64;
#pragma unroll
        for (int i = 0; i < 4; ++i) { ra[i] = *(const uint4*)(Ag + (size_t)(32 * i) * lda + k0); rb[i] = *(const uint4*)(Bg + (size_t)(32 * i) * K + k0); }
      }
      const char* as = As + cur * 16384; const char* bs = Bs + cur * 16384;
#pragma unroll
      for (int ks = 0; ks < 2; ++ks) {
        bf16x8 ax[4], bw[4];
        const int ch = ((ks * 4 + (lane >> 4)) ^ (lane & 7)) << 4;
#pragma unroll
        for (int i = 0; i < 4; ++i) {
          ax[i] = *(const bf16x8*)(as + (wm * 64 + i * 16 + (lane & 15)) * 128 + ch);
          bw[i] = *(const bf16x8*)(bs + (wn * 64 + i * 16 + (lane & 15)) * 128 + ch);
        }
#pragma unroll
        for (int mi = 0; mi < 4; ++mi)
#pragma unroll
          for (int ni = 0; ni < 4; ++ni) acc[mi][ni] = __builtin_amdgcn_mfma_f32_16x16x32_bf16(bw[ni], ax[mi], acc[mi][ni], 0, 0, 0);
      }
      if (kt + 1 < nk) {
        const int nxt = cur ^ 1;
#pragma unroll
        for (int i = 0; i < 4; ++i) {
          const int row = lrow + 32 * i; const int off = nxt * 16384 + row * 128 + ((lch ^ (row & 7)) << 4);
          *(uint4*)(As + off) = ra[i]; *(uint4*)(Bs + off) = rb[i];
        }
      }
      __syncthreads();
    }
    const int tok0 = m0 + wm * 64 + (lane & 15);
    const int nc0 = n0 + wn * 64 + (lane >> 4) * 4;
    if (EPI == EPI_SWIGLU) {
      bf16_t* ACT = (bf16_t*)(p.ws + WS_ACT);
#pragma unroll
      for (int mi = 0; mi < 4; ++mi) {
        const size_t rowoff = (size_t)(tok0 + mi * 16) * DFF;
#pragma unroll
        for (int pr = 0; pr < 2; ++pr) {
          const f32x4 g = acc[mi][2 * pr], u = acc[mi][2 * pr + 1];
          const int ffc = ((n0 + wn * 64) >> 1) + pr * 16 + (lane >> 4) * 4;
          uint2 w; w.x = pack2(silu_f(g[0]) * u[0], silu_f(g[1]) * u[1]); w.y = pack2(silu_f(g[2]) * u[2], silu_f(g[3]) * u[3]);
          *(uint2*)(ACT + rowoff + ffc) = w;
        }
      }
    } else if (EPI == EPI_RESID) {
      const float* gv = gate_base + (size_t)cond_of_row(m0) * 9216;
#pragma unroll
      for (int ni = 0; ni < 4; ++ni) {
        const int n = nc0 + ni * 16;
        const float4 gg = *(const float4*)(gv + n);
#pragma unroll
        for (int mi = 0; mi < 4; ++mi) {
          float* xp = p.out + (size_t)(tok0 + mi * 16) * 1024 + n;
          float4 xv = *(const float4*)xp;
          xv.x += coef * gg.x * acc[mi][ni][0]; xv.y += coef * gg.y * acc[mi][ni][1];
          xv.z += coef * gg.z * acc[mi][ni][2]; xv.w += coef * gg.w * acc[mi][ni][3];
          *(float4*)xp = xv;
        }
      }
    } else {
      bf16_t* PR = (bf16_t*)(p.ws + WS_PROJ);
#pragma unroll
      for (int ni = 0; ni < 4; ++ni) {
        const int n = nc0 + ni * 16;
        if (n < PW) {
#pragma unroll
          for (int mi = 0; mi < 4; ++mi) {
            uint2 w; w.x = pack2(acc[mi][ni][0], acc[mi][ni][1]); w.y = pack2(acc[mi][ni][2], acc[mi][ni][3]);
            *(uint2*)(PR + (size_t)(tok0 + mi * 16) * PW + n) = w;
          }
        }
      }
    }
  }
}


namespace pg8 {
#define PG8_LAS __attribute__((address_space(3)))
typedef unsigned short bf16_t;
typedef short bf16x8 __attribute__((ext_vector_type(8)));
typedef float f32x4 __attribute__((ext_vector_type(4)));
typedef unsigned u32x4 __attribute__((ext_vector_type(4)));
constexpr int BM = 256, BK = 64, HALF = 128, HTB = HALF * BK * 2  , STAGE_BYTES = 8 * HTB, NXCD = 8, WGM = 8;

__host__ __device__ __forceinline__ int lds_byte(int r, int c) { const int st = (r >> 4) * 2 + (c >> 5), rr = r & 15, cc = c & 31, ob = rr * 64 + cc * 2; return st * 1024 + (ob ^ (((ob >> 9) & 1) << 5)); }
__host__ __device__ __forceinline__ void stage_rc(int b, int& R, int& C) { const int st = b / 1024, sb = b % 1024, swz = sb ^ (((sb >> 9) & 1) << 5); R = (st >> 1) * 16 + swz / 64; C = (st & 1) * 32 + (swz % 64) / 2; }
__host__ __device__ __forceinline__ int perm32(int rho) { const int n = rho >> 4, i = rho & 15; return 8 * (i >> 2) + 4 * n + (i & 3); }

struct Unit { int pm, pn; };
struct Gemm { const bf16_t* A; const bf16_t* Bt; int M, N, K; };

struct StaticOrder {
    int nM, nN, nwg, G, c;
    __host__ __device__ void init(int M, int N, int G_, int c_) { nM = M / BM; nN = N / BM; nwg = nM * nN; G = G_; c = c_; }
    __host__ __device__ bool next(int i, Unit& u) const {
        const long L = (long)i * G + c; if (L >= nwg) return false;
        int wgid = (int)L; { const int q = nwg / NXCD, r = nwg % NXCD, xcd = wgid % NXCD, off = wgid / NXCD; wgid = (xcd < r ? xcd * (q + 1) : r * (q + 1) + (xcd - r) * q) + off; }
        const int nig = WGM * nN, gid = wgid / nig, fm = gid * WGM, gsz = (nM - fm) < WGM ? (nM - fm) : WGM;
        u.pm = fm + ((wgid % nig) % gsz); u.pn = (wgid % nig) / gsz; return true;
    }
    __device__ __forceinline__ void a_ready(const Unit&) const {}
    __device__ __forceinline__ void done(const Unit&) const {}
};
template <class Epi, class Sched, bool ALIGN_EPI = false, bool SP2 = false>
__device__ __forceinline__ void gemm_phase(PG8_LAS unsigned char* lds, const Gemm g, const Sched& S, const Epi& E) {
    const int tid = rtid(), wid = __builtin_amdgcn_readfirstlane(tid >> 6), lane = tid & 63, wr = wid >> 2, wc = wid & 3, fr = lane & 15, fq = lane >> 4;
    const int K = g.K, nt = K / BK;
    unsigned voffA[2], voffB[2];
#pragma unroll
    for (int i = 0; i < 2; ++i) { int R, C; stage_rc(tid * 16 + i * 8192, R, C); const int Rb = Epi::PERM ? ((R & ~31) + perm32(R & 31)) : R;
        voffA[i] = (unsigned)(R * K + C) * 2u; voffB[i] = (unsigned)(Rb * K + C) * 2u; }
    const size_t kstep = (size_t)(BK * 2);
    const size_t hstep = (size_t)HALF * K * 2;
    const size_t tstep = 2 * hstep;
    const unsigned ldsw = (unsigned)wid * 1024u;
    const int aoff = lds_byte(wr * 64 + fr, fq * 8), boff = lds_byte(wc * 32 + fr, fq * 8);
#define PG8_SA(b, h) (((b) * 2 + (h)) * HTB)
#define PG8_SB(b, h) ((4 + (b) * 2 + (h)) * HTB)
#define PG8_STAGE(bufoff, gbase, voff) do { _Pragma("unroll") for (int _i = 0; _i < 2; ++_i) \
        __builtin_amdgcn_global_load_lds((const unsigned*)((const char*)(gbase) + (voff)[_i]), (PG8_LAS unsigned*)(lds + (bufoff) + ldsw + _i * 8192), 16, 0, 0); } while (0)
#define PG8_LDA(dst, b, h) do { _Pragma("unroll") for (int m = 0; m < 4; ++m) _Pragma("unroll") for (int k = 0; k < 2; ++k) dst[m][k] = *(const PG8_LAS bf16x8*)(lds + PG8_SA(b, h) + aoff + m * 2048 + k * 1024); } while (0)
#define PG8_LDB(dst, b, h) do { _Pragma("unroll") for (int n = 0; n < 2; ++n) _Pragma("unroll") for (int k = 0; k < 2; ++k) dst[n][k] = *(const PG8_LAS bf16x8*)(lds + PG8_SB(b, h) + boff + n * 2048 + k * 1024); } while (0)
#define PG8_MMA(ai, bj, At, Bt) do { __builtin_amdgcn_s_setprio(1); _Pragma("unroll") for (int m = 0; m < 4; ++m) _Pragma("unroll") for (int n = 0; n < 2; ++n) _Pragma("unroll") for (int k = 0; k < 2; ++k) \
        acc[ai][bj][m][n] = __builtin_amdgcn_mfma_f32_16x16x32_bf16(Bt[n][k], At[m][k], acc[ai][bj][m][n], 0, 0, 0); __builtin_amdgcn_s_setprio(0); } while (0)
#define PG8_WAIT_V(n) asm volatile("s_waitcnt vmcnt(" #n ")" ::: "memory")
#define PG8_WAIT_L(n) asm volatile("s_waitcnt lgkmcnt(" #n ")" ::: "memory")
#define PG8_BAR __builtin_amdgcn_s_barrier()
#define PG8_SCHED __builtin_amdgcn_sched_barrier(0)
    Unit cur, nxt; int ui = 0;
    if (!S.next(0, cur)) return;
    f32x4 acc[2][2][4][2];
#pragma unroll
    for (int a = 0; a < 2; ++a)
#pragma unroll
        for (int b = 0; b < 2; ++b)
#pragma unroll
            for (int m = 0; m < 4; ++m)
#pragma unroll
                for (int n = 0; n < 2; ++n) acc[a][b][m][n] = (f32x4){0.f, 0.f, 0.f, 0.f};
    bf16x8 At[4][2], B0[2][2], B1[2][2];
    const char* cA = (const char*)g.A + (size_t)cur.pm * tstep; const char* cB = (const char*)g.Bt + (size_t)cur.pn * tstep;
    S.a_ready(cur);
    if constexpr (SP2) {
        PG8_STAGE(PG8_SB(0, 0), cB, voffB); PG8_STAGE(PG8_SB(0, 1), cB + hstep, voffB); PG8_STAGE(PG8_SA(0, 0), cA, voffA); PG8_STAGE(PG8_SA(0, 1), cA + hstep, voffA);
        if (wr == 1) PG8_BAR;
        PG8_WAIT_V(2); PG8_BAR;
        PG8_STAGE(PG8_SB(1, 0), cB + kstep, voffB); PG8_STAGE(PG8_SA(1, 0), cA + kstep, voffA); PG8_STAGE(PG8_SB(1, 1), cB + hstep + kstep, voffB);
        PG8_WAIT_V(6); PG8_BAR;
    } else {
        PG8_STAGE(PG8_SB(0, 0), cB, voffB); PG8_STAGE(PG8_SA(0, 0), cA, voffA); PG8_STAGE(PG8_SB(0, 1), cB + hstep, voffB); PG8_STAGE(PG8_SA(0, 1), cA + hstep, voffA);
        if (wr == 1) PG8_BAR;
        PG8_WAIT_V(4); PG8_BAR;
        PG8_STAGE(PG8_SB(1, 0), cB + kstep, voffB); PG8_STAGE(PG8_SA(1, 0), cA + kstep, voffA); PG8_STAGE(PG8_SB(1, 1), cB + hstep + kstep, voffB);
        PG8_WAIT_V(6); PG8_BAR;
    }
    for (;;) {
        const bool has_next = S.next(ui + 1, nxt);
        const char* nA = has_next ? (const char*)g.A + (size_t)nxt.pm * tstep : cA; const char* nB = has_next ? (const char*)g.Bt + (size_t)nxt.pn * tstep : cB;
        for (int t = 0; t < nt; t += 2) {
            const bool last = (t == nt - 2);
            const char* a1 = cA + (size_t)(t + 1) * kstep;
            const char* a2 = last ? nA : cA + (size_t)(t + 2) * kstep; const char* b2 = last ? nB : cB + (size_t)(t + 2) * kstep;
            const char* a3 = a2 + kstep; const char* b3 = b2 + kstep;
            if (last && has_next) S.a_ready(nxt);
            if constexpr (SP2) {
            PG8_LDB(B0, 0, 0); PG8_LDB(B1, 0, 1); PG8_SCHED; PG8_LDA(At, 0, 0); PG8_STAGE(PG8_SA(1, 1), a1 + hstep, voffA);
            PG8_WAIT_V(8); PG8_WAIT_L(0); PG8_BAR; PG8_MMA(0, 0, At, B0); PG8_MMA(0, 1, At, B1); PG8_BAR; PG8_SCHED;
            PG8_LDA(At, 0, 1); PG8_STAGE(PG8_SB(0, 0), b2, voffB); PG8_STAGE(PG8_SB(0, 1), b2 + hstep, voffB); PG8_STAGE(PG8_SA(0, 0), a2, voffA);
            PG8_WAIT_V(8); PG8_WAIT_L(0); PG8_BAR; PG8_MMA(1, 0, At, B0); PG8_MMA(1, 1, At, B1); PG8_BAR; PG8_SCHED;
            PG8_LDB(B0, 1, 0); PG8_LDB(B1, 1, 1); PG8_SCHED; PG8_LDA(At, 1, 0); PG8_STAGE(PG8_SA(0, 1), a2 + hstep, voffA);
            PG8_WAIT_V(8); PG8_WAIT_L(0); PG8_BAR; PG8_MMA(0, 0, At, B0); PG8_MMA(0, 1, At, B1); PG8_BAR; PG8_SCHED;
            PG8_LDA(At, 1, 1); PG8_STAGE(PG8_SB(1, 0), b3, voffB); PG8_STAGE(PG8_SB(1, 1), b3 + hstep, voffB); PG8_STAGE(PG8_SA(1, 0), a3, voffA);
            PG8_WAIT_V(8); PG8_WAIT_L(0); PG8_BAR; PG8_MMA(1, 0, At, B0); PG8_MMA(1, 1, At, B1); PG8_BAR; PG8_SCHED;
            } else {
            PG8_LDB(B0, 0, 0); PG8_SCHED; PG8_LDA(At, 0, 0); PG8_STAGE(PG8_SA(1, 1), a1 + hstep, voffA);
            PG8_WAIT_L(8); PG8_BAR; PG8_WAIT_L(0); PG8_MMA(0, 0, At, B0); PG8_BAR; PG8_SCHED;
            PG8_LDB(B1, 0, 1); PG8_STAGE(PG8_SB(0, 0), b2, voffB);
            PG8_BAR; PG8_WAIT_L(0); PG8_MMA(0, 1, At, B1); PG8_BAR;
            PG8_LDA(At, 0, 1); PG8_STAGE(PG8_SA(0, 0), a2, voffA);
            PG8_BAR; PG8_WAIT_L(0); PG8_MMA(1, 0, At, B0); PG8_BAR; PG8_SCHED;
            PG8_STAGE(PG8_SB(0, 1), b2 + hstep, voffB);
            PG8_WAIT_V(6); PG8_BAR; PG8_MMA(1, 1, At, B1); PG8_BAR;
            PG8_LDB(B0, 1, 0); PG8_SCHED; PG8_LDA(At, 1, 0); PG8_STAGE(PG8_SA(0, 1), a2 + hstep, voffA);
            PG8_WAIT_L(8); PG8_BAR; PG8_WAIT_L(0); PG8_MMA(0, 0, At, B0); PG8_BAR; PG8_SCHED;
            PG8_LDB(B1, 1, 1); PG8_STAGE(PG8_SB(1, 0), b3, voffB);
            PG8_BAR; PG8_WAIT_L(0); PG8_MMA(0, 1, At, B1); PG8_BAR;
            PG8_LDA(At, 1, 1); PG8_STAGE(PG8_SA(1, 0), a3, voffA);
            PG8_BAR; PG8_WAIT_L(0); PG8_MMA(1, 0, At, B0); PG8_BAR; PG8_SCHED;
            PG8_STAGE(PG8_SB(1, 1), b3 + hstep, voffB);
            PG8_WAIT_V(6); PG8_BAR; PG8_MMA(1, 1, At, B1); PG8_BAR;
            }
        }
        if constexpr (ALIGN_EPI) { if (wr == 0) PG8_BAR; }
        if constexpr (!Epi::AFTER_DRAIN) { E(acc, cur, wr, wc, fr, fq); S.done(cur); }
        if (!has_next) break;
#pragma unroll
        for (int a = 0; a < 2; ++a)
#pragma unroll
            for (int b = 0; b < 2; ++b)
#pragma unroll
                for (int m = 0; m < 4; ++m)
#pragma unroll
                    for (int n = 0; n < 2; ++n) acc[a][b][m][n] = (f32x4){0.f, 0.f, 0.f, 0.f};
        cur = nxt; cA = nA; cB = nB; ++ui;
        if constexpr (ALIGN_EPI) { if (wr == 1) PG8_BAR; }
    }
    PG8_WAIT_V(0);
    if constexpr (!ALIGN_EPI) { if (wr == 0) PG8_BAR; }
    PG8_BAR;
    if constexpr (Epi::AFTER_DRAIN) { E.fused(acc, cur, wr, wc, fr, fq, lds, wid, lane); S.done(cur); }
#undef PG8_SA
#undef PG8_SB
#undef PG8_STAGE
#undef PG8_LDA
#undef PG8_LDB
#undef PG8_MMA
#undef PG8_WAIT_V
#undef PG8_WAIT_L
#undef PG8_BAR
#undef PG8_SCHED
}
}

DI void wave_rstd(const float* RS, int rowbase  , int lane, float& r0, float& r1) {
  const float* a = RS + (size_t)(rowbase + lane) * 16; const float* b = a + 128 * 16;
  const float4 a0 = *(const float4*)a, a1 = *(const float4*)(a + 4), a2 = *(const float4*)(a + 8), a3 = *(const float4*)(a + 12);
  const float4 b0 = *(const float4*)b, b1 = *(const float4*)(b + 4), b2 = *(const float4*)(b + 8), b3 = *(const float4*)(b + 12);
  const float sa = ((a0.x + a0.y) + (a0.z + a0.w)) + ((a1.x + a1.y) + (a1.z + a1.w)) + ((a2.x + a2.y) + (a2.z + a2.w)) + ((a3.x + a3.y) + (a3.z + a3.w));
  const float sb = ((b0.x + b0.y) + (b0.z + b0.w)) + ((b1.x + b1.y) + (b1.z + b1.w)) + ((b2.x + b2.y) + (b2.z + b2.w)) + ((b3.x + b3.y) + (b3.z + b3.w));
  r0 = rsqrtf(sa * (1.f / 1024.f) + EPSN); r1 = rsqrtf(sb * (1.f / 1024.f) + EPSN);
}
struct EpiSwiglu {
  static constexpr bool PERM = true, AFTER_DRAIN = false;
  bf16_t* ACT; const float* RS; const float* bias  ;
  DI void operator()(const f32x4 (&acc)[2][2][4][2], const pg8::Unit& u, int wr, int wc, int fr, int fq) const {
    const int row0 = u.pm * 256 + wr * 64 + fr, lane = fq * 16 + fr;
    float rs[2]; wave_rstd(RS, u.pm * 256 + wr * 64, lane, rs[0], rs[1]);
    const float* bp = bias + (size_t)cond_of_row(u.pm * 256) * 5632 + u.pn * 256 + wc * 32 + 8 * fq;
    const f32x4 bg0 = *(const f32x4*)(bp), bg1 = *(const f32x4*)(bp + 4), bu0 = *(const f32x4*)(bp + 128), bu1 = *(const f32x4*)(bp + 132);
#pragma unroll
    for (int ai = 0; ai < 2; ++ai)
#pragma unroll
      for (int m = 0; m < 4; ++m) {
        const float r = __shfl(rs[ai], 16 * m + fr);
        const f32x4 g0 = acc[ai][0][m][0] * r + bg0, g1 = acc[ai][0][m][1] * r + bg1, v0 = acc[ai][1][m][0] * r + bu0, v1 = acc[ai][1][m][1] * r + bu1;
        uint4 w;
        w.x = pack2(silu_f(g0[0]) * v0[0], silu_f(g0[1]) * v0[1]); w.y = pack2(silu_f(g0[2]) * v0[2], silu_f(g0[3]) * v0[3]);
        w.z = pack2(silu_f(g1[0]) * v1[0], silu_f(g1[1]) * v1[1]); w.w = pack2(silu_f(g1[2]) * v1[2], silu_f(g1[3]) * v1[3]);
        *(uint4*)(ACT + (size_t)(row0 + ai * 128 + m * 16) * DFF + u.pn * 128 + wc * 32 + 8 * fq) = w;
      }
  }
};
struct EpiResid {
  static constexpr bool PERM = true, AFTER_DRAIN = false;
  float* X; const float* gate_base; float coef;
  bf16_t* H; float* RS; const float* nxt_g  ; const float* nxt_scale  ;
  DI void operator()(const f32x4 (&acc)[2][2][4][2], const pg8::Unit& u, int wr, int wc, int fr, int fq) const {
    const int row0 = u.pm * 256 + wr * 64 + fr, col0 = u.pn * 256 + wc * 32 + 8 * fq;
    const int cond = cond_of_row(u.pm * 256);
    const float* gv = gate_base + (size_t)cond * 9216 + col0;
    const bool has_next = nxt_g != nullptr;
    float ss[2][4];
#pragma unroll
    for (int ai = 0; ai < 2; ++ai)
#pragma unroll
      for (int m = 0; m < 4; ++m) ss[ai][m] = 0.f;
#pragma unroll
    for (int bj = 0; bj < 2; ++bj) {
      const int co = bj * 128;
      const float4 gg0 = *(const float4*)(gv + co), gg1 = *(const float4*)(gv + co + 4);
      float4 hv0 = make_float4(0.f, 0.f, 0.f, 0.f), hv1 = hv0;
      if (has_next) {
        const float* gp = nxt_g + col0 + co; const float* sp = nxt_scale + (size_t)cond * 9216 + col0 + co;
        const float4 g20 = *(const float4*)gp, g21 = *(const float4*)(gp + 4), s20 = *(const float4*)sp, s21 = *(const float4*)(sp + 4);
        hv0 = make_float4(g20.x * (1.f + s20.x), g20.y * (1.f + s20.y), g20.z * (1.f + s20.z), g20.w * (1.f + s20.w));
        hv1 = make_float4(g21.x * (1.f + s21.x), g21.y * (1.f + s21.y), g21.z * (1.f + s21.z), g21.w * (1.f + s21.w));
      }
#pragma unroll
      for (int ai = 0; ai < 2; ++ai)
#pragma unroll
        for (int m = 0; m < 4; ++m) {
          const size_t off = (size_t)(row0 + ai * 128 + m * 16) * 1024 + col0 + co;
          float4 x0 = *(const float4*)(X + off), x1 = *(const float4*)(X + off + 4);
          const f32x4 a0 = acc[ai][bj][m][0], a1 = acc[ai][bj][m][1];
          x0.x += coef * gg0.x * a0[0]; x0.y += coef * gg0.y * a0[1]; x0.z += coef * gg0.z * a0[2]; x0.w += coef * gg0.w * a0[3];
          x1.x += coef * gg1.x * a1[0]; x1.y += coef * gg1.y * a1[1]; x1.z += coef * gg1.z * a1[2]; x1.w += coef * gg1.w * a1[3];
          *(float4*)(X + off) = x0; *(float4*)(X + off + 4) = x1;
          if (has_next) {
            ss[ai][m] += ((x0.x * x0.x + x0.y * x0.y) + (x0.z * x0.z + x0.w * x0.w)) + ((x1.x * x1.x + x1.y * x1.y) + (x1.z * x1.z + x1.w * x1.w));
            uint4 w; w.x = pack2(x0.x * hv0.x, x0.y * hv0.y); w.y = pack2(x0.z * hv0.z, x0.w * hv0.w); w.z = pack2(x1.x * hv1.x, x1.y * hv1.y); w.w = pack2(x1.z * hv1.z, x1.w * hv1.w);
            *(uint4*)(H + off) = w;
          }
        }
    }
    if (has_next) {
#pragma unroll
      for (int ai = 0; ai < 2; ++ai)
#pragma unroll
        for (int m = 0; m < 4; ++m) {
          float s = ss[ai][m];
          s += __shfl_xor(s, 16); s += __shfl_xor(s, 32);
          if (fq == 0) RS[(size_t)(row0 + ai * 128 + m * 16) * 16 + u.pn * 4 + wc] = s;
        }
    }
  }
};
struct EpiProj {
  static constexpr bool PERM = true, AFTER_DRAIN = false;
  bf16_t* PR; const float* RS; const float* bias  ;
  DI void operator()(const f32x4 (&acc)[2][2][4][2], const pg8::Unit& u, int wr, int wc, int fr, int fq) const {
    const int row0 = u.pm * 256 + wr * 64 + fr, col0 = u.pn * 256 + wc * 32 + 8 * fq, lane = fq * 16 + fr;
    float rs[2]; wave_rstd(RS, u.pm * 256 + wr * 64, lane, rs[0], rs[1]);
    float rr[2][4];
#pragma unroll
    for (int ai = 0; ai < 2; ++ai)
#pragma unroll
      for (int m = 0; m < 4; ++m) rr[ai][m] = __shfl(rs[ai], 16 * m + fr);
    const float* bp = bias + (size_t)cond_of_row(u.pm * 256) * 5632;
#pragma unroll
    for (int bj = 0; bj < 2; ++bj) {
      const int col = col0 + bj * 128;
      if (col < PW) {
        const f32x4 b0 = *(const f32x4*)(bp + col), b1 = *(const f32x4*)(bp + col + 4);
#pragma unroll
        for (int ai = 0; ai < 2; ++ai)
#pragma unroll
          for (int m = 0; m < 4; ++m) {
            const f32x4 a0 = acc[ai][bj][m][0] * rr[ai][m] + b0, a1 = acc[ai][bj][m][1] * rr[ai][m] + b1;
            uint4 w; w.x = pack2(a0[0], a0[1]); w.y = pack2(a0[2], a0[3]); w.z = pack2(a1[0], a1[1]); w.w = pack2(a1[2], a1[3]);
            *(uint4*)(PR + (size_t)(row0 + ai * 128 + m * 16) * PW + col) = w;
          }
      }
    }
  }
};
template <class Epi>
DI void gemm8_run(const bf16_t* acts, const bf16_t* wts, int Nw, int K, const Epi& E, char* dsm) {
  pg8::Gemm g; g.A = acts; g.Bt = wts; g.M = NTOK; g.N = Nw; g.K = K;
  pg8::StaticOrder S; S.init(NTOK, Nw, (int)gridDim.x, (int)blockIdx.x);
  pg8::gemm_phase<Epi, pg8::StaticOrder, true, true>((LDSP unsigned char*)dsm, g, S, E);
}

DI void prep_gla_tile(const Params& p, int l, int tt, char* smem) {
  const int tid = otid();
  const bf16_t* PR = (const bf16_t*)(p.ws + WS_PROJ);
  float* GB = (float*)(p.ws + WS_GB); float* ATOT = (float*)(p.ws + WS_ATOT); float* U = (float*)(p.ws + WS_U);
  const int row0 = tt * 64;
  float* bg = (float*)smem;
  bf16_t* ks = (bf16_t*)(smem + 8192);
  bf16_t* vs = (bf16_t*)(smem + 8192 + 16384);
  {
    {
      const int lane = tid & 63, wv = tid >> 6, fr = lane & 15, fq = lane >> 4;
      const bf16_t* hp = (const bf16_t*)(p.ws + WS_H) + (size_t)(row0 + wv * 16 + fr) * 1024 + 8 * fq;
      const bf16_t* wp = (const bf16_t*)(p.ws + WS_WIN) + ((size_t)l * PWR + OFF_BGW + fr) * 1024 + 8 * fq;
      f32x4 c0 = (f32x4){0.f, 0.f, 0.f, 0.f}, c1 = c0;
#pragma unroll 8
      for (int ks = 0; ks < 32; ++ks) {
        const bf16x8 a = *(const bf16x8*)(hp + 32 * ks), b0 = *(const bf16x8*)(wp + 32 * ks), b1 = *(const bf16x8*)(wp + 16 * 1024 + 32 * ks);
        c0 = __builtin_amdgcn_mfma_f32_16x16x32_bf16(a, b0, c0, 0, 0, 0);
        c1 = __builtin_amdgcn_mfma_f32_16x16x32_bf16(a, b1, c1, 0, 0, 0);
      }
      const float* rsp = (const float*)(p.ws + WS_ROWSS) + (size_t)(row0 + wv * 16 + fr) * 16;
      const float4 r0 = *(const float4*)rsp, r1 = *(const float4*)(rsp + 4), r2 = *(const float4*)(rsp + 8), r3 = *(const float4*)(rsp + 12);
      const float rs = rsqrtf((((r0.x + r0.y) + (r0.z + r0.w)) + ((r1.x + r1.y) + (r1.z + r1.w)) + ((r2.x + r2.y) + (r2.z + r2.w)) + ((r3.x + r3.y) + (r3.z + r3.w))) * (1.f / 1024.f) + EPSN);
      const float* bp = (const float*)(p.ws + WS_BIAS) + ((size_t)(l * 3 + 1) * 3 + cond_of_row(row0)) * 5632 + OFF_BGW;
      const float bb0 = bp[fr], bb1 = bp[16 + fr];
#pragma unroll
      for (int r = 0; r < 4; ++r) {
        const float rr = __shfl(rs, 4 * fq + r);
        float* dst = bg + (wv * 16 + 4 * fq + r) * 32;
        dst[fr] = c0[r] * rr + bb0; dst[16 + fr] = c1[r] * rr + bb1;
      }
    }
#pragma unroll
    for (int q = 0; q < 4; ++q) { const int c = tid + 256 * q, row = c >> 4, ch = c & 15; *(uint4*)(ks + row * 128 + 8 * ch) = *(const uint4*)(PR + (size_t)(row0 + row) * PW + OFF_BK + 8 * ch); }
#pragma unroll
    for (int q = 0; q < 8; ++q) { const int c = tid + 256 * q, row = c >> 5, ch = c & 31; *(uint4*)(vs + row * 256 + 8 * ch) = *(const uint4*)(PR + (size_t)(row0 + row) * PW + OFF_BV + 8 * ch); }
  }
  __syncthreads();
  const int s = tid >> 7, k = tid & 127, h = k >> 5, d = k & 31;
  float w[16];
#pragma unroll
  for (int r = 0; r < 16; ++r) w[r] = p.in[18][((size_t)(l * 2 + s) * 16 + r) * 128 + k];
  const float bias = p.in[19][(l * 2 + s) * 128 + k];
  float acc[64];
#pragma unroll
  for (int x = 0; x < 64; ++x) acc[x] = 0.f;
  float run = 0.f;
#pragma unroll 2
  for (int ii = 0; ii < 64; ++ii) {
    const int j = s ? ii : 63 - ii;
    float z = bias;
#pragma unroll
    for (int r = 0; r < 16; ++r) z += bg[j * 32 + s * 16 + r] * w[r];
    const float ls = fminf(z, 0.f) - log1pf(expf(-fabsf(z)));
    GB[(size_t)(row0 + j) * 256 + s * 128 + k] = run;
    const float kd = bf2f(ks[j * 128 + k]) * fast_exp2(run * LOG2E);
    run += ls * (1.f / 16.f);
    const bf16_t* vr = vs + j * 256 + h * 64;
#pragma unroll
    for (int x8 = 0; x8 < 8; ++x8) {
      float vv[8]; unpack8(*(const uint4*)(vr + 8 * x8), vv);
#pragma unroll
      for (int e = 0; e < 8; ++e) acc[8 * x8 + e] += kd * vv[e];
    }
  }
  ATOT[tt * 256 + tid] = expf(run);
  ATOT[192 * 256 + tt * 256 + tid] = run;
  float* u = U + (((size_t)tt * 2 + s) * 4 + h) * 2048 + d * 64;
#pragma unroll
  for (int x4 = 0; x4 < 16; ++x4) *(float4*)(u + 4 * x4) = make_float4(acc[4 * x4], acc[4 * x4 + 1], acc[4 * x4 + 2], acc[4 * x4 + 3]);
  __syncthreads();
}

struct TokRaw { uint4 a; uint2 c0, c1, c2; uint4 av, cv; };
DI void tok_load(const bf16_t* PR, int r, int lane, bool ctx, TokRaw& t) {
  const bf16_t* pr = PR + (size_t)r * PW;
  t.a = *(const uint4*)(pr + (lane >> 3) * 64 + 8 * (lane & 7));
  const bf16_t* src = pr + OFF_CQ + (lane >> 2) * 48 + 12 * (lane & 3);
  t.c0 = *(const uint2*)(src); t.c1 = *(const uint2*)(src + 4); t.c2 = *(const uint2*)(src + 8);
  t.av = make_uint4(0, 0, 0, 0); t.cv = make_uint4(0, 0, 0, 0);
  if (ctx) { if (lane < 16) t.av = *(const uint4*)(pr + OFF_AV + 8 * lane); if (lane < 48) t.cv = *(const uint4*)(pr + OFF_CV + 8 * lane); }
}
DI void prep_token(const Params& p, int l, int r, int lane, const TokRaw& t) {
  bf16_t* QA = (bf16_t*)(p.ws + WS_QA); bf16_t* KA = (bf16_t*)(p.ws + WS_KA);
  bf16_t* QC = (bf16_t*)(p.ws + WS_QC); bf16_t* KC = (bf16_t*)(p.ws + WS_KC);
  const float* rope = (const float*)(p.ws + WS_ROPE);
  const float qsA = 0.125f * LOG2E, qsC = 0.14433756729740643f * LOG2E;
  const bool ctx = r < NCTX;
  const int b = ctx ? (r >> 8) : ((r - NCTX) >> 11);
  const int tq = ctx ? (r & 255) : ((r - NCTX) & 2047);
  const int rowpos = tq >> 6, colpos = tq & 63;
  {
    const int v = lane >> 3, s = lane & 7;
    float x[8]; unpack8(t.a, x);
    float ss = 0.f;
#pragma unroll
    for (int e = 0; e < 8; ++e) ss += x[e] * x[e];
    ss += __shfl_xor(ss, 1); ss += __shfl_xor(ss, 2); ss += __shfl_xor(ss, 4);
    const float rstd = rsqrtf(ss * (1.f / 64.f) + EPSN);
    const float* g = (v < 6 ? p.in[16] : p.in[17]) + l * 64 + 8 * s;
    float y[8];
#pragma unroll
    for (int e = 0; e < 8; ++e) y[e] = x[e] * rstd * g[e];
    if (ctx) {
      if (v >= 6) {
        float* o = p.out + O_AK + ((size_t)(b * 4 + l) * 256 + tq) * 128 + (v - 6) * 64 + 8 * s;
        *(float4*)o = make_float4(y[0], y[1], y[2], y[3]); *(float4*)(o + 4) = make_float4(y[4], y[5], y[6], y[7]);
      }
    } else {
      const int pos = (s < 4) ? rowpos : colpos;
      const float* ct = rope + pos * 16 + (s & 1) * 8; const float* st = rope + 1024 + pos * 16 + (s & 1) * 8;
#pragma unroll
      for (int e = 0; e < 8; ++e) {
        const float yp = __shfl_xor(y[e], 2);
        const float c = ct[e], sn = st[e];
        y[e] = (s & 2) ? (yp * sn + y[e] * c) : (y[e] * c - yp * sn);
      }
    }
    if (v < 6) {
#pragma unroll
      for (int e = 0; e < 8; ++e) y[e] *= qsA;
    }
    uint4 w; w.x = pack2(y[0], y[1]); w.y = pack2(y[2], y[3]); w.z = pack2(y[4], y[5]); w.w = pack2(y[6], y[7]);
    if (v < 6) *(uint4*)(QA + (size_t)r * 384 + v * 64 + 8 * s) = w;
    else *(uint4*)(KA + (size_t)r * 128 + (v - 6) * 64 + 8 * s) = w;
  }
  if (ctx && lane < 16) {
    float x[8]; unpack8(t.av, x);
    float* o = p.out + O_AV + ((size_t)(b * 4 + l) * 256 + tq) * 128 + 8 * lane;
    *(float4*)o = make_float4(x[0], x[1], x[2], x[3]); *(float4*)(o + 4) = make_float4(x[4], x[5], x[6], x[7]);
  }
  {
    const int v = lane >> 2, qd = lane & 3;
    float x[12];
    unpack4(t.c0, x); unpack4(t.c1, x + 4); unpack4(t.c2, x + 8);
    float ss = 0.f;
#pragma unroll
    for (int e = 0; e < 12; ++e) ss += x[e] * x[e];
    ss += __shfl_xor(ss, 1); ss += __shfl_xor(ss, 2);
    const float rstd = rsqrtf(ss * (1.f / 48.f) + EPSN);
    const float* g = (v < 8 ? p.in[21] : p.in[22]) + l * 96 + (v & 1) * 48 + 12 * qd;
    float y[12];
#pragma unroll
    for (int e = 0; e < 12; ++e) y[e] = x[e] * rstd * g[e];
    if (ctx) {
      if (v >= 8) {
        float* o = p.out + O_CK + ((size_t)(b * 4 + l) * 256 + tq) * 384 + (v - 8) * 48 + 12 * qd;
        *(float4*)o = make_float4(y[0], y[1], y[2], y[3]); *(float4*)(o + 4) = make_float4(y[4], y[5], y[6], y[7]);
        *(float4*)(o + 8) = make_float4(y[8], y[9], y[10], y[11]);
      }
    } else {
      const int pos = (qd < 2) ? rowpos : colpos;
      const float* ct = rope + 2048 + pos * 12; const float* st = rope + 2048 + 768 + pos * 12;
#pragma unroll
      for (int e = 0; e < 12; ++e) {
        const float yp = __shfl_xor(y[e], 1);
        const float c = ct[e], sn = st[e];
        y[e] = (qd & 1) ? (yp * sn + y[e] * c) : (y[e] * c - yp * sn);
      }
    }
    if (v < 8) {
#pragma unroll
      for (int e = 0; e < 12; ++e) y[e] *= qsC;
    }
    bf16_t* dst = (v < 8 ? QC : KC) + (size_t)r * 512 + (v & 7) * 64;
    uint2 w0, w1, w2; w0.x = pack2(y[0], y[1]); w0.y = pack2(y[2], y[3]); w1.x = pack2(y[4], y[5]); w1.y = pack2(y[6], y[7]);
    w2.x = pack2(y[8], y[9]); w2.y = pack2(y[10], y[11]);
    *(uint2*)(dst + 12 * qd) = w0; *(uint2*)(dst + 12 * qd + 4) = w1; *(uint2*)(dst + 12 * qd + 8) = w2;
    { unsigned z0; asm volatile("v_mov_b32 %0, 0" : "=v"(z0)); *(uint2*)(dst + 48 + 4 * qd) = make_uint2(z0, z0); }
  }
  if (ctx && lane < 48) {
    float x[8]; unpack8(t.cv, x);
    float* o = p.out + O_CV + ((size_t)(b * 4 + l) * 256 + tq) * 384 + 8 * lane;
    *(float4*)o = make_float4(x[0], x[1], x[2], x[3]); *(float4*)(o + 4) = make_float4(x[4], x[5], x[6], x[7]);
  }
}

DI void prep_phase(const Params& p, int l, char* smem) {
  for (int tt = obid(); tt < 192; tt += vnb()) prep_gla_tile(p, l, tt, smem);
  const int tx = rtid(), lane = tx & 63;
  const int gw = blockIdx.x * 8 + (tx >> 6), nw = gridDim.x * 8;
  const bf16_t* PR = (const bf16_t*)(p.ws + WS_PROJ);
  int r = gw;
  TokRaw cur, nxt;
  if (r < NTOK) tok_load(PR, r, lane, r < NCTX, cur);
#pragma unroll 1
  for (; r < NTOK; r += nw) {
    const int rn = r + nw;
    if (rn < NTOK) tok_load(PR, rn, lane, rn < NCTX, nxt);
    prep_token(p, l, r, lane, cur);
    cur = nxt;
  }
}

typedef unsigned u32x4 __attribute__((ext_vector_type(4)));
struct KVSrc { const bf16_t* k1; const bf16_t* v1; const bf16_t* k2; const bf16_t* v2; int ks1, vs1, ks2, vs2, n1, n2; };
template <int NMAP, int NDT> struct FlashRegs { u32x4 k00, k01, k10, k11, v0, v1, v2; };

template <int NMAP, int NDT>
DI void fl_issue(int kt, const KVSrc& kv, FlashRegs<NMAP, NDT>& R) {
  constexpr int CPR = NDT * 2;
  kt = kt < kv.n1 + kv.n2 ? kt : kv.n1 + kv.n2 - 1;
  const int tid = otid();
  const bf16_t* kb; const bf16_t* vb; int ks, vs;
  if (kt < kv.n1) { kb = kv.k1 + (size_t)kt * 64 * kv.ks1; vb = kv.v1 + (size_t)kt * 64 * kv.vs1; ks = kv.ks1; vs = kv.vs1; }
  else { kb = kv.k2 + (size_t)(kt - kv.n1) * 64 * kv.ks2; vb = kv.v2 + (size_t)(kt - kv.n1) * 64 * kv.vs2; ks = kv.ks2; vs = kv.vs2; }
  R.k00 = *(const u32x4*)(kb + (size_t)(tid >> 3) * ks + (tid & 7) * 8);
  R.k01 = *(const u32x4*)(kb + (size_t)((tid >> 3) + 32) * ks + (tid & 7) * 8);
  if (NMAP == 2) {
    R.k10 = *(const u32x4*)(kb + 64 + (size_t)(tid >> 3) * ks + (tid & 7) * 8);
    R.k11 = *(const u32x4*)(kb + 64 + (size_t)((tid >> 3) + 32) * ks + (tid & 7) * 8);
  } else { R.k10 = R.k00; R.k11 = R.k01; }
  { const int c = tid; R.v0 = *(const u32x4*)(vb + (size_t)(c / CPR) * vs + (c % CPR) * 8); }
  { const int c = tid + 256; R.v1 = *(const u32x4*)(vb + (size_t)(c / CPR) * vs + (c % CPR) * 8); }
  if (NDT == 6) { const int c = tid + 512; R.v2 = *(const u32x4*)(vb + (size_t)(c / CPR) * vs + (c % CPR) * 8); } else R.v2 = R.v1;
}
template <int NMAP, int NDT>
DI void fl_write(char* buf, const FlashRegs<NMAP, NDT>& R) {
  constexpr int CPR = NDT * 2, VSB = NDT * 32 + 32;
  const int tid = otid();
  char* vbuf = buf + NMAP * 8192;
  { const int row = tid >> 3, ch = tid & 7; *(u32x4*)(buf + row * 128 + ((ch ^ (row & 7)) << 4)) = R.k00; }
  { const int row = (tid >> 3) + 32, ch = tid & 7; *(u32x4*)(buf + row * 128 + ((ch ^ (row & 7)) << 4)) = R.k01; }
  if (NMAP == 2) {
    { const int row = tid >> 3, ch = tid & 7; *(u32x4*)(buf + 8192 + row * 128 + ((ch ^ (row & 7)) << 4)) = R.k10; }
    { const int row = (tid >> 3) + 32, ch = tid & 7; *(u32x4*)(buf + 8192 + row * 128 + ((ch ^ (row & 7)) << 4)) = R.k11; }
  }
  { const int c = tid; *(u32x4*)(vbuf + (c / CPR) * VSB + (c % CPR) * 16) = R.v0; }
  { const int c = tid + 256; *(u32x4*)(vbuf + (c / CPR) * VSB + (c % CPR) * 16) = R.v1; }
  if (NDT == 6) { const int c = tid + 512; *(u32x4*)(vbuf + (c / CPR) * VSB + (c % CPR) * 16) = R.v2; }
}
template <int NMAP, int NDT>
DI void fl_compute(const char* buf, const bf16x8 (&qf)[NMAP][2], f32x4 (&oacc)[NMAP][NDT], float (&mrun)[NMAP], float (&lsum)[NMAP], int lane) {
  constexpr int VSB = NDT * 32 + 32;
  const int g = lane >> 4, qq = (lane & 15) >> 2, pp = lane & 3;
  bf16x8 pf[NMAP][2];
#pragma unroll
  for (int m = 0; m < NMAP; ++m) {
    f32x4 sacc[4];
#pragma unroll
    for (int t = 0; t < 4; ++t) sacc[t] = (f32x4){0.f, 0.f, 0.f, 0.f};
#pragma unroll
    for (int ks = 0; ks < 2; ++ks) {
      const int ch = ((ks * 4 + g) ^ (lane & 7)) << 4;
#pragma unroll
      for (int t = 0; t < 4; ++t) {
        const bf16x8 kf = *(const bf16x8*)(buf + m * 8192 + (16 * t + (lane & 15)) * 128 + ch);
        sacc[t] = __builtin_amdgcn_mfma_f32_16x16x32_bf16(kf, qf[m][ks], sacc[t], 0, 0, 0);
      }
    }
    float mx = sacc[0][0];
#pragma unroll
    for (int t = 0; t < 4; ++t)
#pragma unroll
      for (int r = 0; r < 4; ++r) mx = fmaxf(mx, sacc[t][r]);
    mx = fmaxf(mx, __shfl_xor(mx, 16)); mx = fmaxf(mx, __shfl_xor(mx, 32));
    const float mnew = fmaxf(mrun[m], mx);
    const float alpha = fast_exp2(mrun[m] - mnew);
    mrun[m] = mnew;
    float ps = 0.f;
#pragma unroll
    for (int t = 0; t < 4; ++t)
#pragma unroll
      for (int r = 0; r < 4; ++r) { const float pv = fast_exp2(sacc[t][r] - mnew); sacc[t][r] = pv; ps += pv; }
    lsum[m] = lsum[m] * alpha + ps;
#pragma unroll
    for (int d = 0; d < NDT; ++d) oacc[m][d] *= alpha;
#pragma unroll
    for (int ks = 0; ks < 2; ++ks) {
      u32x4 pu;
      pu[0] = pack2(sacc[2 * ks][0], sacc[2 * ks][1]); pu[1] = pack2(sacc[2 * ks][2], sacc[2 * ks][3]);
      pu[2] = pack2(sacc[2 * ks + 1][0], sacc[2 * ks + 1][1]); pu[3] = pack2(sacc[2 * ks + 1][2], sacc[2 * ks + 1][3]);
      pf[m][ks] = __builtin_bit_cast(bf16x8, pu);
    }
  }
  const char* vbuf = buf + NMAP * 8192;
#pragma unroll
  for (int ks = 0; ks < 2; ++ks) {
    const char* vrow = vbuf + (32 * ks + 4 * g + qq) * VSB + pp * 8;
#pragma unroll
    for (int d = 0; d < NDT; ++d) {
      const s16x4 v0 = __builtin_amdgcn_ds_read_tr16_b64_v4i16((LDSP s16x4*)(vrow + d * 32));
      const s16x4 v1 = __builtin_amdgcn_ds_read_tr16_b64_v4i16((LDSP s16x4*)(vrow + 16 * VSB + d * 32));
      const bf16x8 vf = __builtin_shufflevector(v0, v1, 0, 1, 2, 3, 4, 5, 6, 7);
#pragma unroll
      for (int m = 0; m < NMAP; ++m) oacc[m][d] = __builtin_amdgcn_mfma_f32_16x16x32_bf16(vf, pf[m][ks], oacc[m][d], 0, 0, 0);
    }
  }
}

template <int NMAP, int NDT>
DI void flash_run(const bf16_t* __restrict__ qptr, const KVSrc& kv, f32x4 (&oacc)[NMAP][NDT], float (&linv)[NMAP], char* smem) {
  constexpr int BUFB = NMAP * 8192 + 64 * (NDT * 32 + 32);
  const int lane = otid() & 63;
  bf16x8 qf[NMAP][2];
  float mrun[NMAP], lsum[NMAP];
#pragma unroll
  for (int m = 0; m < NMAP; ++m) {
    qf[m][0] = *(const bf16x8*)(qptr + 64 * m); qf[m][1] = *(const bf16x8*)(qptr + 64 * m + 32);
    mrun[m] = -INFINITY; lsum[m] = 0.f;
#pragma unroll
    for (int d = 0; d < NDT; ++d) oacc[m][d] = (f32x4){0.f, 0.f, 0.f, 0.f};
  }
  const int nt = kv.n1 + kv.n2;
  FlashRegs<NMAP, NDT> R0, R1;
  fl_issue<NMAP, NDT>(0, kv, R0);
  fl_issue<NMAP, NDT>(1, kv, R1);
  __syncthreads();
  fl_write<NMAP, NDT>(smem, R0);
  fl_issue<NMAP, NDT>(2, kv, R0);
  __syncthreads();
#pragma unroll 1
  for (int t = 0; t < nt; t += 2) {
    fl_compute<NMAP, NDT>(smem, qf, oacc, mrun, lsum, lane);
    fl_write<NMAP, NDT>(smem + BUFB, R1);
    fl_issue<NMAP, NDT>(t + 3, kv, R1);
    __syncthreads();
    fl_compute<NMAP, NDT>(smem + BUFB, qf, oacc, mrun, lsum, lane);
    fl_write<NMAP, NDT>(smem, R0);
    fl_issue<NMAP, NDT>(t + 4, kv, R0);
    __syncthreads();
  }
#pragma unroll
  for (int m = 0; m < NMAP; ++m) { float l = lsum[m]; l += __shfl_xor(l, 16); l += __shfl_xor(l, 32); linv[m] = 1.f / l; }
}

DI void attn_a_item(const Params& p, int l, bool ctx, int b, int h, int qt, char* smem) {
  const int lane = otid() & 63, wave = otid() >> 6;
  const int seq0 = ctx ? b * 256 : NCTX + b * 2048;
  const int qrow = seq0 + qt * 64 + wave * 16 + (lane & 15);
  const int kvh = h / 3;
  const bf16_t* PR = (const bf16_t*)(p.ws + WS_PROJ);
  KVSrc kv;
  kv.k1 = (const bf16_t*)(p.ws + WS_KA) + (size_t)seq0 * 128 + kvh * 64; kv.ks1 = 128;
  kv.v1 = PR + (size_t)seq0 * PW + OFF_AV + kvh * 64; kv.vs1 = PW;
  kv.n1 = ctx ? 4 : 32; kv.n2 = ctx ? 0 : 8;
  kv.k2 = (const bf16_t*)(p.ws + WS_KAC) + (size_t)((b & 1) * 4 + l) * 512 * 128 + kvh * 64; kv.ks2 = 128;
  kv.v2 = (const bf16_t*)(p.ws + WS_VAC) + (size_t)((b & 1) * 4 + l) * 512 * 128 + kvh * 64; kv.vs2 = 128;
  f32x4 o[1][4]; float linv[1];
  flash_run<1, 4>((const bf16_t*)(p.ws + WS_QA) + (size_t)qrow * 384 + h * 64 + 8 * (lane >> 4), kv, o, linv, smem);
  bf16_t* dst = (bf16_t*)(p.ws + WS_MIX) + (size_t)qrow * 1024 + h * 64 + 4 * (lane >> 4);
  const float li = linv[0];
#pragma unroll
  for (int d = 0; d < 4; ++d) { uint2 w; w.x = pack2(o[0][d][0] * li, o[0][d][1] * li); w.y = pack2(o[0][d][2] * li, o[0][d][3] * li); *(uint2*)(dst + 16 * d) = w; }
}

DI void attn_c_item(const Params& p, int l, bool ctx, int b, int h, int qt, char* smem) {
  const int lane = otid() & 63, wave = otid() >> 6;
  const int seq0 = ctx ? b * 256 : NCTX + b * 2048;
  const int qrow = seq0 + qt * 64 + wave * 16 + (lane & 15);
  const bf16_t* PR = (const bf16_t*)(p.ws + WS_PROJ);
  KVSrc kv;
  kv.ks1 = 512; kv.vs1 = PW; kv.ks2 = 512; kv.vs2 = 384;
  kv.n1 = ctx ? 4 : 32; kv.n2 = ctx ? 0 : 8;
  kv.v1 = PR + (size_t)seq0 * PW + OFF_CV + h * 96;
  kv.v2 = (const bf16_t*)(p.ws + WS_VCC) + (size_t)((b & 1) * 4 + l) * 512 * 384 + h * 96;
  kv.k1 = (const bf16_t*)(p.ws + WS_KC) + (size_t)seq0 * 512 + (h * 2) * 64;
  kv.k2 = (const bf16_t*)(p.ws + WS_KCC) + (size_t)((b & 1) * 4 + l) * 512 * 512 + (h * 2) * 64;
  f32x4 o[2][6]; float linv[2];
  flash_run<2, 6>((const bf16_t*)(p.ws + WS_QC) + (size_t)qrow * 512 + (h * 2) * 64 + 8 * (lane >> 4), kv, o, linv, smem);
  const float lam = ((const float*)(p.ws + WS_MISC))[l];
  const float li0 = linv[0], l1 = linv[1] * lam;
  float ss = 0.f;
#pragma unroll
  for (int d = 0; d < 6; ++d)
#pragma unroll
    for (int r = 0; r < 4; ++r) { const float v = o[0][d][r] * li0 - o[1][d][r] * l1; o[0][d][r] = v; ss += v * v; }
  ss += __shfl_xor(ss, 16); ss += __shfl_xor(ss, 32);
  const float sc = rsqrtf(ss * (1.f / 96.f) + EPSN) * (1.f - p.lam_init[l]);
  const float* g = p.in[24] + l * 96 + 4 * (lane >> 4);
  bf16_t* dst = (bf16_t*)(p.ws + WS_MIX) + (size_t)qrow * 1024 + 640 + h * 96 + 4 * (lane >> 4);
#pragma unroll
  for (int d = 0; d < 6; ++d) {
    const float4 gg = *(const float4*)(g + 16 * d);
    uint2 w; w.x = pack2(o[0][d][0] * sc * gg.x, o[0][d][1] * sc * gg.y); w.y = pack2(o[0][d][2] * sc * gg.z, o[0][d][3] * sc * gg.w);
    *(uint2*)(dst + 16 * d) = w;
  }
}

DI void gla_item(const Params& p, int l, bool ctx, int b, int h, int c, char* smem) {
  const int tid = otid();
  const int seq0 = ctx ? b * 256 : NCTX + b * 2048;
  const int nch = ctx ? 4 : 32;
  const int row0 = seq0 + c * 64, tt0 = seq0 >> 6, tt = tt0 + c;
  const bf16_t* PR = (const bf16_t*)(p.ws + WS_PROJ);
  const float* GB = (const float*)(p.ws + WS_GB); const float* ATOT = (const float*)(p.ws + WS_ATOT); const float* U = (const float*)(p.ws + WS_U);
  float* qd = (float*)smem;
  float* kd = qd + 64 * 36;
  float* vv = kd + 64 * 36;
  float* S = vv + 4096;
  float* sc = S + 2048;
  const int ib = tid >> 4, xb = tid & 15, i0 = ib * 4, x0 = xb * 4;
  float o[4][4];
#pragma unroll
  for (int a = 0; a < 4; ++a)
#pragma unroll
    for (int e = 0; e < 4; ++e) o[a][e] = 0.f;
  for (int s = 0; s < 2; ++s) {
    {
      const int j = tid >> 2, part = tid & 3, kk = h * 32 + part * 8;
      const size_t prow = (size_t)(row0 + j) * PW;
      const uint4 qraw = *(const uint4*)(PR + prow + OFF_BQ + kk), kraw = *(const uint4*)(PR + prow + OFF_BK + kk);
      const float* gbp = GB + (size_t)(row0 + j) * 256 + s * 128 + kk;
      const float* ttp = ATOT + 192 * 256 + tt * 256 + s * 128 + kk;
      const float4 g0 = *(const float4*)gbp, g1 = *(const float4*)(gbp + 4), t0 = *(const float4*)ttp, t1 = *(const float4*)(ttp + 4);
      uint4 vraw0 = make_uint4(0, 0, 0, 0), vraw1 = vraw0;
      if (s == 0) { vraw0 = *(const uint4*)(PR + prow + OFF_BV + h * 64 + part * 16); vraw1 = *(const uint4*)(PR + prow + OFF_BV + h * 64 + part * 16 + 8); }
      float qv[8], kv[8]; unpack8(qraw, qv); unpack8(kraw, kv);
      const float cum[8] = {t0.x - g0.x, t0.y - g0.y, t0.z - g0.z, t0.w - g0.w, t1.x - g1.x, t1.y - g1.y, t1.z - g1.z, t1.w - g1.w};
      float qo[8], ko[8];
#pragma unroll
      for (int e = 0; e < 8; ++e) { qo[e] = qv[e] * 0.17677669529663687f * fast_exp2(cum[e] * LOG2E); ko[e] = kv[e] * fast_exp2(-cum[e] * LOG2E); }
      float* qp = qd + j * 36 + part * 8; float* kp = kd + j * 36 + part * 8;
      *(float4*)qp = make_float4(qo[0], qo[1], qo[2], qo[3]); *(float4*)(qp + 4) = make_float4(qo[4], qo[5], qo[6], qo[7]);
      *(float4*)kp = make_float4(ko[0], ko[1], ko[2], ko[3]); *(float4*)(kp + 4) = make_float4(ko[4], ko[5], ko[6], ko[7]);
      if (s == 0) {
        float x[16]; unpack8(vraw0, x); unpack8(vraw1, x + 8);
        float* vp = vv + j * 64 + part * 16;
#pragma unroll
        for (int e = 0; e < 4; ++e) *(float4*)(vp + 4 * e) = make_float4(x[4 * e], x[4 * e + 1], x[4 * e + 2], x[4 * e + 3]);
      }
    }
    {
      const int d = tid >> 3, v0 = (tid & 7) * 8;
      float S8[8];
      if (ctx) {
#pragma unroll
        for (int e = 0; e < 8; ++e) S8[e] = 0.f;
      } else {
        const float* s0 = p.in[7] + ((((size_t)b * 4 + l) * 2 + s) * 4 + h) * 2048 + d * 64 + v0;
        const float4 a = *(const float4*)s0, bq = *(const float4*)(s0 + 4);
        S8[0] = a.x; S8[1] = a.y; S8[2] = a.z; S8[3] = a.w; S8[4] = bq.x; S8[5] = bq.y; S8[6] = bq.z; S8[7] = bq.w;
      }
      const int nfold = s == 0 ? c : nch - 1 - c;
#pragma unroll 8
      for (int f = 0; f < nfold; ++f) {
        const int t2 = s == 0 ? tt0 + f : tt0 + nch - 1 - f;
        const float a = ATOT[t2 * 256 + s * 128 + h * 32 + d];
        const float* u = U + (((size_t)t2 * 2 + s) * 4 + h) * 2048 + d * 64 + v0;
        const float4 u0 = *(const float4*)u, u1 = *(const float4*)(u + 4);
        S8[0] = a * S8[0] + u0.x; S8[1] = a * S8[1] + u0.y; S8[2] = a * S8[2] + u0.z; S8[3] = a * S8[3] + u0.w;
        S8[4] = a * S8[4] + u1.x; S8[5] = a * S8[5] + u1.y; S8[6] = a * S8[6] + u1.z; S8[7] = a * S8[7] + u1.w;
      }
      *(float4*)(S + d * 64 + v0) = make_float4(S8[0], S8[1], S8[2], S8[3]);
      *(float4*)(S + d * 64 + v0 + 4) = make_float4(S8[4], S8[5], S8[6], S8[7]);
      if (ctx && ((s == 0 && c == nch - 1) || (s == 1 && c == 0))) {
        const float a = ATOT[tt * 256 + s * 128 + h * 32 + d];
        const float* u = U + (((size_t)tt * 2 + s) * 4 + h) * 2048 + d * 64 + v0;
        const float4 u0 = *(const float4*)u, u1 = *(const float4*)(u + 4);
        float* dst = p.out + O_ST + ((((size_t)b * 4 + l) * 2 + s) * 4 + h) * 2048 + d * 64 + v0;
        *(float4*)dst = make_float4(a * S8[0] + u0.x, a * S8[1] + u0.y, a * S8[2] + u0.z, a * S8[3] + u0.w);
        *(float4*)(dst + 4) = make_float4(a * S8[4] + u1.x, a * S8[5] + u1.y, a * S8[6] + u1.z, a * S8[7] + u1.w);
      }
    }
    __syncthreads();
    {
      float a4[4][4];
#pragma unroll
      for (int a = 0; a < 4; ++a)
#pragma unroll
        for (int e = 0; e < 4; ++e) a4[a][e] = 0.f;
#pragma unroll 2
      for (int d4 = 0; d4 < 8; ++d4) {
        float4 q4[4], k4[4];
#pragma unroll
        for (int a = 0; a < 4; ++a) { q4[a] = *(const float4*)(qd + (i0 + a) * 36 + 4 * d4); k4[a] = *(const float4*)(kd + (x0 + a) * 36 + 4 * d4); }
#pragma unroll
        for (int a = 0; a < 4; ++a)
#pragma unroll
          for (int e = 0; e < 4; ++e) a4[a][e] += q4[a].x * k4[e].x + q4[a].y * k4[e].y + q4[a].z * k4[e].z + q4[a].w * k4[e].w;
      }
#pragma unroll
      for (int a = 0; a < 4; ++a) {
        float r4[4];
#pragma unroll
        for (int e = 0; e < 4; ++e) { const int i = i0 + a, j = x0 + e; const bool keep = (s == 0) ? (j <= i) : (j >= i); r4[e] = keep ? a4[a][e] : 0.f; }
        *(float4*)(sc + (i0 + a) * 68 + x0) = make_float4(r4[0], r4[1], r4[2], r4[3]);
      }
    }
    __syncthreads();
    {
#pragma unroll 2
      for (int j = 0; j < 64; j += 4) {
        float4 s4[4], v4[4];
#pragma unroll
        for (int a = 0; a < 4; ++a) { s4[a] = *(const float4*)(sc + (i0 + a) * 68 + j); v4[a] = *(const float4*)(vv + (j + a) * 64 + x0); }
#pragma unroll
        for (int a = 0; a < 4; ++a) {
          o[a][0] += s4[a].x * v4[0].x + s4[a].y * v4[1].x + s4[a].z * v4[2].x + s4[a].w * v4[3].x;
          o[a][1] += s4[a].x * v4[0].y + s4[a].y * v4[1].y + s4[a].z * v4[2].y + s4[a].w * v4[3].y;
          o[a][2] += s4[a].x * v4[0].z + s4[a].y * v4[1].z + s4[a].z * v4[2].z + s4[a].w * v4[3].z;
          o[a][3] += s4[a].x * v4[0].w + s4[a].y * v4[1].w + s4[a].z * v4[2].w + s4[a].w * v4[3].w;
        }
      }
#pragma unroll 2
      for (int d = 0; d < 32; d += 4) {
        float4 q4[4], v4[4];
#pragma unroll
        for (int a = 0; a < 4; ++a) { q4[a] = *(const float4*)(qd + (i0 + a) * 36 + d); v4[a] = *(const float4*)(S + (d + a) * 64 + x0); }
#pragma unroll
        for (int a = 0; a < 4; ++a) {
          o[a][0] += q4[a].x * v4[0].x + q4[a].y * v4[1].x + q4[a].z * v4[2].x + q4[a].w * v4[3].x;
          o[a][1] += q4[a].x * v4[0].y + q4[a].y * v4[1].y + q4[a].z * v4[2].y + q4[a].w * v4[3].y;
          o[a][2] += q4[a].x * v4[0].z + q4[a].y * v4[1].z + q4[a].z * v4[2].z + q4[a].w * v4[3].z;
          o[a][3] += q4[a].x * v4[0].w + q4[a].y * v4[1].w + q4[a].z * v4[2].w + q4[a].w * v4[3].w;
        }
      }
    }
    __syncthreads();
  }
  const float4 gg = *(const float4*)(p.in[20] + l * 64 + x0);
#pragma unroll
  for (int a = 0; a < 4; ++a) {
    float ss = o[a][0] * o[a][0] + o[a][1] * o[a][1] + o[a][2] * o[a][2] + o[a][3] * o[a][3];
    ss += __shfl_xor(ss, 1); ss += __shfl_xor(ss, 2); ss += __shfl_xor(ss, 4); ss += __shfl_xor(ss, 8);
    const float rstd = rsqrtf(ss * (1.f / 64.f) + EPSN);
    const size_t row = row0 + i0 + a;
    float br[4]; unpack4(*(const uint2*)(PR + row * PW + OFF_BR + h * 64 + x0), br);
    uint2 w;
    w.x = pack2(o[a][0] * rstd * gg.x * sigm_silu_acc(br[0]), o[a][1] * rstd * gg.y * sigm_silu_acc(br[1]));
    w.y = pack2(o[a][2] * rstd * gg.z * sigm_silu_acc(br[2]), o[a][3] * rstd * gg.w * sigm_silu_acc(br[3]));
    *(uint2*)((bf16_t*)(p.ws + WS_MIX) + row * 1024 + 384 + h * 64 + x0) = w;
  }
}

DI void mixer_phase(const Params& p, int l, int cidx, char* smem) {
  unsigned* ctr = (unsigned*)(p.ws + WS_MISC + 64) + cidx;
  extern __shared__ __attribute__((aligned(16))) char dsm[];
  LDSP int* sidx = (LDSP int*)(dsm + 131072 + 16);
  constexpr int M_CL = PROBE == 21 ? 2 : 1, M_AL = PROBE == 22 ? 2 : 1, M_GL = PROBE == 23 ? 2 : 1, M_CC = PROBE == 24 ? 2 : 1, M_AC = PROBE == 25 ? 2 : 1, M_GC = PROBE == 26 ? 2 : 1;
  constexpr int N_CL = 256 * M_CL, N_AL = 384 * M_AL, N_GL = 256 * M_GL, N_CC = 512 * M_CC, N_AC = 768 * M_AC, N_GC = 512 * M_GC;
  constexpr int E0 = N_CL, E1 = E0 + N_AL, E2 = E1 + N_GL, E3 = E2 + N_CC, E4 = E3 + N_AC, E5 = E4 + N_GC;
  for (;;) {
    __syncthreads();
    if (threadIdx.x == 0) *sidx = (int)atomicAdd(ctr, 2u);
    __syncthreads();
    const int it = *sidx + ohalf();
    if (it >= E5) break;
    int typ, r; bool ctx;
    if (it < E0) { typ = 0; r = (it) % 256; ctx = false; }
    else if (it < E1) { typ = 1; r = (it - E0) % 384; ctx = false; }
    else if (it < E2) { typ = 2; r = (it - E1) % 256; ctx = false; }
    else if (it < E3) { typ = 0; r = (it - E2) % 512; ctx = true; }
    else if (it < E4) { typ = 1; r = (it - E3) % 768; ctx = true; }
    else { typ = 2; r = (it - E4) % 512; ctx = true; }
    const int sh = ctx ? 2 : 5, nq = 1 << sh;
    const int sub = r & (nq - 1), bh = r >> sh;
    if (typ == 0) attn_c_item(p, l, ctx, bh >> 2, bh & 3, sub, smem);
    else if (typ == 1) attn_a_item(p, l, ctx, bh / 6, bh % 6, sub, smem);
    else gla_item(p, l, ctx, bh >> 2, bh & 3, sub, smem);
  }
}

constexpr int DYN_LDS = 131072 + 64;
typedef const __attribute__((address_space(4))) Params* ParamsK;
DI ParamsK kparams() { ParamsK q = (ParamsK)__builtin_amdgcn_kernarg_segment_ptr(); asm volatile("" : "+s"(q)); return q; }
__global__ void __launch_bounds__(512, 2) fwd_megakernel(Params p_unused) {
  extern __shared__ __attribute__((aligned(16))) char dsm[];
  cg::grid_group grid = cg::this_grid();
  if (gridDim.y == 2) grid.sync();
  const Params& p = *(const Params*)kparams();
  volatile LDSP unsigned* xbw = (volatile LDSP unsigned*)(dsm + 131072);
  if (threadIdx.x == 0) { xbw[0] = 0u; xbw[1] = 0u; xbw[2] = 0u; xbw[3] = 0u; }
  __syncthreads();
  const XcdBarrier xb = xcd_barrier_post((unsigned*)(p.ws + WS_BAR), xbw);
  char* smem = dsm + ohalf() * 65536;
  phase0(p, (float*)smem);
  xcd_barrier(xb);
#pragma unroll 1
  for (int ph = 0; ph < 44; ++ph) {
    const int l = ph / 11, q = ph - l * 11;
    const Params& p = *(const Params*)kparams();
    const float* mod = (const float*)(p.ws + WS_MOD);
    const bf16_t* H = (const bf16_t*)(p.ws + WS_H);
    const bf16_t* ACT = (const bf16_t*)(p.ws + WS_ACT);
    const bf16_t* MIX = (const bf16_t*)(p.ws + WS_MIX);
    const float* modl = mod + (size_t)l * 3 * 9216;
    int nrep = 1;
#if PROBE
    if (PROBE == 1) nrep = (q == 1 || q == 9 || q == 2 || q == 10 || q == 7 || q == 4) ? 2 : 1;
    if (PROBE == 2) nrep = (q == 6) ? 2 : 1;
    if (PROBE == 3) nrep = (q == 5) ? 2 : 1;
    if (PROBE == 4) nrep = (q == 0 || q == 3 || q == 8) ? 2 : 1;
    if (PROBE == 5) nrep = 2;
#endif
#pragma unroll 1
    for (int rep = 0; rep < nrep; ++rep) {
#if PROBE == 5
    if (rep == 1) { xcd_barrier(xb); xcd_barrier(xb); xcd_barrier(xb); continue; }
#endif
    if (q == 3 || q == 8 || (q == 0 && l > 0)) continue;
    const float* RS = (const float*)(p.ws + WS_ROWSS);
    const float* BIAS = (const float*)(p.ws + WS_BIAS);
    if (q == 0) {
      norm0_bias_phase(p);
    } else if (q == 1 || q == 9) {
      const int f = q == 1 ? 0 : 1;
      { EpiSwiglu E; E.ACT = (bf16_t*)(p.ws + WS_ACT); E.RS = RS; E.bias = BIAS + (size_t)(l * 3 + (f ? 2 : 0)) * 3 * 5632;
        gemm8_run(H, (const bf16_t*)(p.ws + WS_WGU) + (size_t)(l * 2 + f) * 5632 * 1024, 5632, 1024, E, dsm); }
    } else if (q == 2 || q == 10 || q == 7) {
      const bf16_t* A; const bf16_t* Bt; int lda, K; const float* gb; float coef; int nl, nsub;
      if (q == 7) { A = MIX; lda = 1024; K = 1024; Bt = (const bf16_t*)(p.ws + WS_WOUT) + (size_t)l * 1024 * 1024; gb = modl + 5 * 1024; coef = 1.0f; nl = l; nsub = 2; }
      else { const int f = q == 2 ? 0 : 1; A = ACT; lda = DFF; K = DFF; Bt = (const bf16_t*)(p.ws + WS_WD) + (size_t)(l * 2 + f) * 1024 * 2816; gb = modl + (f == 0 ? 2 : 8) * 1024; coef = 0.5f;
             nl = f == 0 ? l : l + 1; nsub = f == 0 ? 1 : 0; }
      (void)lda;
      { EpiResid E; E.X = p.out; E.gate_base = gb; E.coef = rep ? 0.f : coef; E.H = (bf16_t*)(p.ws + WS_H); E.RS = (float*)(p.ws + WS_ROWSS);
        E.nxt_g = nl < 4 ? p.in[11] + (nl * 3 + nsub) * 1024 : nullptr; E.nxt_scale = mod + (size_t)(nl < 4 ? nl : 0) * 3 * 9216 + (3 * nsub + 1) * 1024;
        gemm8_run(A, Bt, 1024, K, E, dsm); }
    } else if (q == 4) {
      { EpiProj E; E.PR = (bf16_t*)(p.ws + WS_PROJ); E.RS = RS; E.bias = BIAS + (size_t)(l * 3 + 1) * 3 * 5632;
        gemm8_run(H, (const bf16_t*)(p.ws + WS_WIN) + (size_t)l * PWR * 1024, PWP, 1024, E, dsm); }
    } else if (q == 5) {
      prep_phase(p, l, smem);
    } else {
      mixer_phase(p, l, l + 4 * rep, smem);
    }
    xcd_barrier(xb);
    }
  }
}

extern "C" void kernel_launch(void* const* d_in, const int* in_sizes, int n_in,
                              void* d_out, int out_size, void* d_ws, size_t ws_size,
                              hipStream_t stream) {
  static int grid_blocks = 0;
  if (!grid_blocks) {
    int dev = 0, cus = 0, per_cu = 0;
    (void)hipGetDevice(&dev);
    (void)hipDeviceGetAttribute(&cus, hipDeviceAttributeMultiprocessorCount, dev);
    (void)hipFuncSetAttribute((const void*)fwd_megakernel, hipFuncAttributeMaxDynamicSharedMemorySize, DYN_LDS);
    (void)hipOccupancyMaxActiveBlocksPerMultiprocessor(&per_cu, fwd_megakernel, 512, DYN_LDS);
    if (per_cu < 1) per_cu = 1;
    grid_blocks = cus;
    grid_blocks -= grid_blocks % 8;
  }
  Params p{};
  for (int i = 0; i < 26; ++i) p.in[i] = (const float*)d_in[i];
  p.out = (float*)d_out;
  p.ws = (char*)d_ws;
  for (int i = 0; i < 16; ++i) p.freqA[i] = powf(10000.0f, -(float)i / 16.0f);
  for (int i = 0; i < 12; ++i) p.freqC[i] = powf(10000.0f, -(float)i / 12.0f);
  for (int l = 0; l < 4; ++l) p.lam_init[l] = (float)(0.8 - 0.6 * exp(-0.3 * l));
  (void)hipMemsetAsync((char*)d_ws + WS_BAR, 0, XCD_BAR_WORDS_C * 4, stream);
  void* args[] = {&p};
  hipError_t e = hipLaunchCooperativeKernel((void*)fwd_megakernel, dim3(grid_blocks), dim3(512), args, DYN_LDS, stream);
  if (e != hipSuccess) fprintf(stderr, "cooperative launch failed: %s (grid %d)\n", hipGetErrorString(e), grid_blocks);
}
```

```cpp
#include <hip/hip_runtime.h>
#include <hip/hip_cooperative_groups.h>
#include <cstdio>
#include <cmath>
namespace cg = cooperative_groups;
#ifndef PROBE
#define PROBE 0
#endif

typedef unsigned short bf16_t;
typedef short bf16x8 __attribute__((ext_vector_type(8)));
typedef short s16x4 __attribute__((ext_vector_type(4)));
typedef float f32x4 __attribute__((ext_vector_type(4)));
#define LDSP __attribute__((address_space(3)))
#define DI __device__ __forceinline__

constexpr int DM = 1024, DFF = 2816, NTOK = 12288, NCTX = 8192, PW = 2560, PWP = 2560, PWR = 2592;
constexpr int OFF_AQ = 0, OFF_AK = 384, OFF_AV = 512, OFF_BQ = 640, OFF_BK = 768, OFF_BV = 896,
              OFF_BR = 1152, OFF_CQ = 1408, OFF_CK = 1792, OFF_CV = 2176, OFF_BGW = 2560;
constexpr float EPSN = 1e-6f;
constexpr float LOG2E = 1.4426950408889634f;
constexpr size_t O_YP = 0, O_YS = 8388608, O_AK = 12582912, O_AV = 16777216, O_CK = 20971520, O_CV = 33554432, O_ST = 46137344;

constexpr size_t XCD_BAR_WORDS_C = 3456;
constexpr size_t al256(size_t x) { return (x + 255) & ~(size_t)255; }
constexpr size_t WS_MOD = 0;
constexpr size_t WS_MISC = al256(WS_MOD + 4ull * 3 * 9216 * 4);
constexpr size_t WS_ROPE = WS_MISC + 256;
constexpr size_t WS_WGU = al256(WS_ROPE + (1024 * 2 + 768 * 2) * 4);
constexpr size_t WS_WD = WS_WGU + 8ull * 5632 * 1024 * 2;
constexpr size_t WS_WIN = WS_WD + 8ull * 1024 * 2816 * 2;
constexpr size_t WS_WOUT = WS_WIN + 4ull * PWR * 1024 * 2;
constexpr size_t WS_H = WS_WOUT + 4ull * 1024 * 1024 * 2;
constexpr size_t WS_MIX = WS_H + (size_t)NTOK * 1024 * 2;
constexpr size_t WS_ACT = WS_MIX + (size_t)NTOK * 1024 * 2;
constexpr size_t WS_PROJ = WS_ACT + (size_t)NTOK * DFF * 2;
constexpr size_t WS_QA = WS_PROJ + (size_t)NTOK * PW * 2;
constexpr size_t WS_KA = WS_QA + (size_t)NTOK * 384 * 2;
constexpr size_t WS_QC = WS_KA + (size_t)NTOK * 128 * 2;
constexpr size_t WS_KC = WS_QC + (size_t)NTOK * 512 * 2;
constexpr size_t WS_GB = WS_KC + (size_t)NTOK * 512 * 2;
constexpr size_t WS_ATOT = WS_GB + (size_t)NTOK * 256 * 4;
constexpr size_t WS_U = WS_ATOT + 2 * 192ull * 256 * 4;
constexpr size_t WS_KAC = WS_U + 192ull * 2 * 4 * 2048 * 4;
constexpr size_t WS_VAC = WS_KAC + 2ull * 4 * 512 * 128 * 2;
constexpr size_t WS_KCC = WS_VAC + 2ull * 4 * 512 * 128 * 2;
constexpr size_t WS_VCC = WS_KCC + 2ull * 4 * 512 * 512 * 2;
constexpr size_t WS_BAR = WS_VCC + 2ull * 4 * 512 * 384 * 2;
constexpr size_t WS_ROWSS = al256(WS_BAR + XCD_BAR_WORDS_C * 4);
constexpr size_t WS_BIAS = WS_ROWSS + (size_t)NTOK * 16 * 4;
constexpr size_t WS_END = WS_BIAS + 4ull * 3 * 3 * 5632 * 4;

struct Params {
  const float* in[26];
  float* out;
  char* ws;
  float freqA[16];
  float freqC[12];
  float lam_init[4];
};

DI float bf2f(bf16_t v) { return __uint_as_float(((unsigned)v) << 16); }
DI bf16_t f2bf(float f) { unsigned u = __float_as_uint(f); u += 0x7fffu + ((u >> 16) & 1u); return (bf16_t)(u >> 16); }
typedef float f32x2_t __attribute__((ext_vector_type(2)));
typedef __bf16 bf16x2_t __attribute__((ext_vector_type(2)));
DI unsigned pack2(float lo, float hi) { const f32x2_t v = {lo, hi}; return __builtin_bit_cast(unsigned, __builtin_convertvector(v, bf16x2_t)); }
DI float fast_exp2(float x) { return __builtin_amdgcn_exp2f(x); }
DI float fast_rcp(float x) { return __builtin_amdgcn_rcpf(x); }
DI float silu_f(float g) { return g * fast_rcp(1.f + fast_exp2(-g * LOG2E)); }
DI float sigm_silu_acc(float g) { return g / (1.f + expf(-g)); }
DI void unpack8(uint4 v, float* x) {
  x[0] = __uint_as_float(v.x << 16); x[1] = __uint_as_float(v.x & 0xffff0000u);
  x[2] = __uint_as_float(v.y << 16); x[3] = __uint_as_float(v.y & 0xffff0000u);
  x[4] = __uint_as_float(v.z << 16); x[5] = __uint_as_float(v.z & 0xffff0000u);
  x[6] = __uint_as_float(v.w << 16); x[7] = __uint_as_float(v.w & 0xffff0000u);
}
DI void unpack4(uint2 v, float* x) {
  x[0] = __uint_as_float(v.x << 16); x[1] = __uint_as_float(v.x & 0xffff0000u);
  x[2] = __uint_as_float(v.y << 16); x[3] = __uint_as_float(v.y & 0xffff0000u);
}
DI int otid() { int t = threadIdx.x & 255; asm volatile("" : "+v"(t)); return t; }
DI int ohalf() { return __builtin_amdgcn_readfirstlane((int)(threadIdx.x >> 8)); }
DI int obid() { int b = blockIdx.x * 2 + ohalf(); asm volatile("" : "+s"(b)); return b; }
DI int vnb() { return gridDim.x * 2; }
DI int rtid() { int t = threadIdx.x; asm volatile("" : "+v"(t)); return t; }
DI int cond_of_row(int row) { return row < NCTX ? 0 : 1 + ((row - NCTX) >> 11); }


#define XB_TMO      128
#define XB_XCNT(j)  (256  + 64 * (j))
#define XB_XSUB(j)  (1280 + 64 * (j))
#define XB_XGEN(j)  (2304 + 64 * (j))
#define XB_TOP      3328
#define XB_TOPGEN   3392
#define XCD_BAR_WORDS 3456
#define XB_SPIN_CAP (1u << 22)
DI unsigned xb_ld(unsigned* p) { return __hip_atomic_load(p, __ATOMIC_RELAXED, __HIP_MEMORY_SCOPE_AGENT); }
DI unsigned xb_add(unsigned* p, unsigned v) { return __hip_atomic_fetch_add(p, v, __ATOMIC_RELAXED, __HIP_MEMORY_SCOPE_AGENT); }
DI unsigned xb_xcc_id() { return (unsigned)__builtin_amdgcn_s_getreg((3 << 11) | 20) & 0xFu; }
#define XB_SPIN(cond, bar) do { unsigned _sp = 0; while (cond) { __builtin_amdgcn_s_sleep(1); \
    if ((++_sp & 255u) == 0u) { if (xb_ld(&(bar)[XB_TMO])) break; if (_sp > XB_SPIN_CAP) { atomicAdd(&(bar)[XB_TMO], 1u); break; } } } } while (0)
struct XcdBarrier { unsigned* bar; unsigned x; volatile LDSP unsigned* st; };
DI XcdBarrier xcd_barrier_post(unsigned* bar, volatile LDSP unsigned* st) {
  XcdBarrier b; b.bar = bar; b.x = xb_xcc_id(); b.st = st;
  if (threadIdx.x == 0) (void)xb_add(&bar[XB_XCNT(b.x)], 1u);
  return b;
}
DI void xcd_barrier_complete(unsigned* bar, unsigned x, unsigned& nloc, unsigned& nx) {
  const unsigned G = gridDim.x * gridDim.y * gridDim.z;
  unsigned sum, cnt, mine, sp = 0u;
  for (;;) {
    sum = 0u; cnt = 0u; mine = 0u;
#pragma unroll
    for (unsigned j = 0; j < 16; ++j) { const unsigned c = xb_ld(&bar[XB_XCNT(j)]); sum += c; cnt += (c > 0u) ? 1u : 0u; mine = (j == x) ? c : mine; }
    if (sum == G) break;
    __builtin_amdgcn_s_sleep(1);
    if ((++sp & 255u) == 0u) { if (xb_ld(&bar[XB_TMO])) break; if (sp > XB_SPIN_CAP) { atomicAdd(&bar[XB_TMO], 1u); break; } }
  }
  nloc = mine > 0u ? mine : 1u; nx = cnt > 0u ? cnt : 1u;
}
DI void xcd_barrier(const XcdBarrier& b_) {
  asm volatile("s_waitcnt vmcnt(0)" ::: "memory");
  __syncthreads();
  if (threadIdx.x == 0) {
    XcdBarrier b; b.st = b_.st;
    { unsigned* q = b_.bar; asm volatile("" : "+s"(q)); b.bar = q; }
    { unsigned xx = xb_xcc_id(); asm volatile("" : "+s"(xx)); b.x = xx; }
    unsigned* bar = b.bar;
    __builtin_amdgcn_s_waitcnt(0);
    unsigned nloc = b.st[0], nx = b.st[1];
    if (nloc == 0u) { xcd_barrier_complete(bar, b.x, nloc, nx); b.st[0] = nloc; b.st[1] = nx; }
    const unsigned old = xb_add(&bar[XB_XSUB(b.x)], 1u);
    const unsigned gen = old / nloc;
    if (old + 1u == (gen + 1u) * nloc) {
      __builtin_amdgcn_fence(__ATOMIC_RELEASE, "agent");
      asm volatile("s_waitcnt vmcnt(0)" ::: "memory");
      const unsigned og = xb_add(&bar[XB_TOP], 1u);
      const unsigned tg = og / nx;
      if (og + 1u == (tg + 1u) * nx) xb_add(&bar[XB_TOPGEN], 1u);
      else XB_SPIN(xb_ld(&bar[XB_TOPGEN]) == tg, bar);
      __builtin_amdgcn_fence(__ATOMIC_ACQUIRE, "agent");
      xb_add(&bar[XB_XGEN(b.x)], 1u);
      asm volatile("s_waitcnt vmcnt(0)" ::: "memory");
    } else {
      XB_SPIN(xb_ld(&bar[XB_XGEN(b.x)]) == gen, bar);
      __builtin_amdgcn_fence(__ATOMIC_ACQUIRE, "agent");
      asm volatile("s_waitcnt vmcnt(0)" ::: "memory");
    }
  }
  __syncthreads();
}

DI void transpose_tile(const float* __restrict__ src, int K, int N, bf16_t* __restrict__ dst, int mode, int kt, int nt, float* sm) {
  const int t = otid();
  const int k0 = kt * 64, n0 = nt * 64;
#pragma unroll
  for (int i = 0; i < 4; ++i) {
    const int idx = t + 256 * i, r = idx >> 4, c4 = idx & 15;
    float4 v = make_float4(0.f, 0.f, 0.f, 0.f);
    if (n0 + 4 * c4 < N) v = *(const float4*)(src + (size_t)(k0 + r) * N + n0 + 4 * c4);
    float* d = sm + r * 65 + 4 * c4;
    d[0] = v.x; d[1] = v.y; d[2] = v.z; d[3] = v.w;
  }
  __syncthreads();
#pragma unroll
  for (int i = 0; i < 2; ++i) {
    const int idx = t + 256 * i, nl = idx >> 3, kc = idx & 7;
    const int n = n0 + nl;
    if (n < N) {
      float x[8];
#pragma unroll
      for (int e = 0; e < 8; ++e) x[e] = sm[(8 * kc + e) * 65 + nl];
      uint4 w; w.x = pack2(x[0], x[1]); w.y = pack2(x[2], x[3]); w.z = pack2(x[4], x[5]); w.w = pack2(x[6], x[7]);
      int drow = n;
      if (mode == 1) drow = (n >> 4) * 32 + (n & 15);
      else if (mode == 2) drow = (n >> 4) * 32 + 16 + (n & 15);
      *(uint4*)(dst + (size_t)drow * K + k0 + 8 * kc) = w;
    }
  }
  __syncthreads();
}

DI void adaln_item(const Params& p, int it, float* sm) {
  const int t = otid();
  const int l = it / 72, chunk = it % 72, j0 = chunk * 128;
  float* scond = sm;
  float* red = sm + 3072;
  for (int i = t; i < 3072; i += 256) {
    const int c = i >> 10, k = i & 1023;
    const float v = (c == 0) ? p.in[8][k] : p.in[2][(c - 1) * 1024 + k];
    scond[i] = sigm_silu_acc(v);
  }
  __syncthreads();
  const int cgp = t & 31, kg = t >> 5;
  const float* w = p.in[9] + (size_t)l * 1024 * 9216 + j0 + 4 * cgp;
  float acc[3][4];
#pragma unroll
  for (int c = 0; c < 3; ++c)
#pragma unroll
    for (int e = 0; e < 4; ++e) acc[c][e] = 0.f;
#pragma unroll 8
  for (int kk = 0; kk < 128; ++kk) {
    const int k = kg * 128 + kk;
    const float4 wv = *(const float4*)(w + (size_t)k * 9216);
#pragma unroll
    for (int c = 0; c < 3; ++c) {
      const float s = scond[c * 1024 + k];
      acc[c][0] += s * wv.x; acc[c][1] += s * wv.y; acc[c][2] += s * wv.z; acc[c][3] += s * wv.w;
    }
  }
#pragma unroll
  for (int c = 0; c < 3; ++c)
#pragma unroll
    for (int e = 0; e < 4; ++e) red[(kg * 3 + c) * 128 + 4 * cgp + e] = acc[c][e];
  __syncthreads();
  float* mod = (float*)(p.ws + WS_MOD);
  for (int o = t; o < 384; o += 256) {
    const int c = o >> 7, j = o & 127;
    float s = p.in[10][l * 9216 + j0 + j];
#pragma unroll
    for (int g = 0; g < 8; ++g) s += red[(g * 3 + c) * 128 + j];
    mod[(l * 3 + c) * 9216 + j0 + j] = s;
  }
  __syncthreads();
}

DI void sincos_tab(float pos, float freq, float& cs, float& sn) {
  const double a = (double)pos * (double)freq;
  const double twopi = 6.283185307179586476925286766559;
  const double k = rint(a / twopi);
  const double r = (a - k * twopi) * 0.25;
  const double r2 = r * r;
  double s = r * (1.0 + r2 * (-1.0 / 6 + r2 * (1.0 / 120 + r2 * (-1.0 / 5040 + r2 * (1.0 / 362880 + r2 * (-1.0 / 39916800 + r2 * (1.0 / 6227020800.0)))))));
  double c = 1.0 + r2 * (-0.5 + r2 * (1.0 / 24 + r2 * (-1.0 / 720 + r2 * (1.0 / 40320 + r2 * (-1.0 / 3628800 + r2 * (1.0 / 479001600.0 + r2 * (-1.0 / 87178291200.0)))))));
  double s2 = 2.0 * s * c, c2 = 1.0 - 2.0 * s * s;
  double s4 = 2.0 * s2 * c2, c4 = 1.0 - 2.0 * s2 * s2;
  cs = (float)c4; sn = (float)s4;
}

struct TDesc { const float* src; bf16_t* dst; int K, N, mode, kt, nt; };
DI TDesc tile_desc(const Params& p, int r) {
  TDesc d;
  const int l = r / 5136; r -= l * 5136;
  if (r < 4224) {
    const int f = r / 2112; r -= f * 2112;
    const int which = r / 704; r -= which * 704;
    const int lf = l * 2 + f;
    if (which < 2) { d.src = p.in[which == 0 ? 12 : 13] + (size_t)lf * 1024 * 2816; d.dst = (bf16_t*)(p.ws + WS_WGU) + (size_t)lf * 5632 * 1024; d.K = 1024; d.N = 2816; d.mode = which + 1; d.kt = r / 44; d.nt = r % 44; }
    else { d.src = p.in[14] + (size_t)lf * 2816 * 1024; d.dst = (bf16_t*)(p.ws + WS_WD) + (size_t)lf * 1024 * 2816; d.K = 2816; d.N = 1024; d.mode = 0; d.kt = r / 16; d.nt = r % 16; }
  } else if (r < 4224 + 656) {
    r -= 4224;
    d.src = p.in[15] + (size_t)l * 1024 * PWR; d.dst = (bf16_t*)(p.ws + WS_WIN) + (size_t)l * PWR * 1024; d.K = 1024; d.N = PWR; d.mode = 3; d.kt = r / 41; d.nt = r % 41;
  } else {
    r -= 4224 + 656;
    d.src = p.in[25] + (size_t)l * 1024 * 1024; d.dst = (bf16_t*)(p.ws + WS_WOUT) + (size_t)l * 1024 * 1024; d.K = 1024; d.N = 1024; d.mode = 0; d.kt = r / 16; d.nt = r % 16;
  }
  return d;
}
DI void tile_load(const TDesc& d, int t, f32x4 (&v)[4]) {
  const int k0 = d.kt * 64, n0 = d.nt * 64;
#pragma unroll
  for (int i = 0; i < 4; ++i) {
    const int idx = t + 256 * i, r = idx >> 4, c4 = idx & 15;
    v[i] = (f32x4){0.f, 0.f, 0.f, 0.f};
    if (n0 + 4 * c4 < d.N) v[i] = __builtin_nontemporal_load((const f32x4*)(d.src + (size_t)(k0 + r) * d.N + n0 + 4 * c4));
  }
}
DI void tile_store(const TDesc& d, int t, const f32x4 (&v)[4], float* sm) {
  const int k0 = d.kt * 64, n0 = d.nt * 64;
#pragma unroll
  for (int i = 0; i < 4; ++i) {
    const int idx = t + 256 * i, r = idx >> 4, c4 = idx & 15;
    float* q = sm + r * 65 + 4 * c4;
    q[0] = v[i][0]; q[1] = v[i][1]; q[2] = v[i][2]; q[3] = v[i][3];
  }
  __syncthreads();
#pragma unroll
  for (int i = 0; i < 2; ++i) {
    const int idx = t + 256 * i, nl = idx >> 3, kc = idx & 7;
    const int n = n0 + nl;
    if (n < d.N) {
      float x[8];
#pragma unroll
      for (int e = 0; e < 8; ++e) x[e] = sm[(8 * kc + e) * 65 + nl];
      uint4 w; w.x = pack2(x[0], x[1]); w.y = pack2(x[2], x[3]); w.z = pack2(x[4], x[5]); w.w = pack2(x[6], x[7]);
      int drow = n;
      if (d.mode == 1) drow = (n >> 7) * 256 + (n & 127);
      else if (d.mode == 2) drow = (n >> 7) * 256 + 128 + (n & 127);
      else if (d.mode == 3) drow = n < 1152 ? n : (n < 1184 ? OFF_BGW + (n - 1152) : n - 32);
      *(uint4*)(d.dst + (size_t)drow * d.K + k0 + 8 * kc) = w;
    }
  }
  __syncthreads();
}

DI void convert_slice(const Params& p, int layer, int t_begin, int t_end, int first_blk, float* sm) {
  const int t = otid();
  const int nworkers = (gridDim.x - first_blk) * 2, w = (blockIdx.x - first_blk) * 2 + ohalf();
  int r = t_begin + w;
  f32x4 cur[4], nxt[4];
  TDesc dc = tile_desc(p, layer * 5136 + (r < t_end ? r : t_begin));
  if (r < t_end) tile_load(dc, t, cur);
#pragma unroll 1
  for (; r < t_end; r += nworkers) {
    const int rn = r + nworkers;
    TDesc dn = tile_desc(p, layer * 5136 + (rn < t_end ? rn : t_begin));
    if (rn < t_end) tile_load(dn, t, nxt);
    tile_store(dc, t, cur, sm);
    dc = dn;
#pragma unroll
    for (int i = 0; i < 4; ++i) cur[i] = nxt[i];
  }
}
DI void bias_from_f32(const Params& p, int layer, char* dsm) {
  const int tx = rtid(), lane = tx & 63, kc = tx >> 6;
  float* shl = (float*)dsm;
  float* red = shl + 3072;
  const float* mod = (const float*)(p.ws + WS_MOD);
  float* BIAS = (float*)(p.ws + WS_BIAS);
  const int nidle = gridDim.x - 192, me = blockIdx.x - 192;
#pragma unroll 1
  for (int task = me; task < 55; task += nidle) {
    const int mi = task / 11, ch = task - mi * 11;
    const int sub = mi < 2 ? 0 : (mi == 2 ? 1 : 2);
    const int N = mi == 2 ? PWR : 2816;
    const float* W = mi == 2 ? p.in[15] + (size_t)layer * 1024 * PWR
                             : p.in[(mi == 0 || mi == 3) ? 12 : 13] + (size_t)(layer * 2 + (mi < 2 ? 0 : 1)) * 1024 * 2816;
    __syncthreads();
    for (int i = tx; i < 3072; i += 512) { const int c = i >> 10, k = i & 1023; shl[i] = mod[((size_t)layer * 3 + c) * 9216 + (size_t)(3 * sub) * 1024 + k]; }
    __syncthreads();
    const int n = ch * 256 + lane * 4;
    f32x4 a0 = (f32x4){0.f, 0.f, 0.f, 0.f}, a1 = a0, a2 = a0;
    if (n < N) {
      const float* wp = W + (size_t)(kc * 128) * N + n;
#pragma unroll 8
      for (int i = 0; i < 128; ++i) {
        const f32x4 wv = *(const f32x4*)(wp + (size_t)i * N);
        const int k = kc * 128 + i;
        a0 += wv * shl[k]; a1 += wv * shl[1024 + k]; a2 += wv * shl[2048 + k];
      }
    }
    *(f32x4*)(red + (kc * 3 + 0) * 256 + lane * 4) = a0; *(f32x4*)(red + (kc * 3 + 1) * 256 + lane * 4) = a1; *(f32x4*)(red + (kc * 3 + 2) * 256 + lane * 4) = a2;
    __syncthreads();
    for (int o = tx; o < 768; o += 512) {
      const int c = o >> 8, j = o & 255, nn = ch * 256 + j;
      float s = 0.f;
#pragma unroll
      for (int g = 0; g < 8; ++g) s += red[(g * 3 + c) * 256 + j];
      if (nn < N) {
        int col;
        if (mi == 2) col = nn < 1152 ? nn : (nn < 1184 ? OFF_BGW + (nn - 1152) : nn - 32);
        else col = (nn >> 7) * 256 + (nn & 127) + ((mi == 1 || mi == 4) ? 128 : 0);
        BIAS[((size_t)(layer * 3 + sub) * 3 + c) * 5632 + col] = s;
      }
    }
  }
  __syncthreads();
}

DI void phase0(const Params& p, float* sm) {
  const int nb = vnb(), bid = obid(), t = otid();
#if PROBE == 6
  for (int prep_ = 0; prep_ < 2; ++prep_) {
#endif
  if (bid < 288) adaln_item(p, bid, sm);
  {
    const int n_tiles = 5136 + 3 * 2448;
    auto gid = [](int q) { return q < 5136 ? q : ((q - 5136) / 2448 + 1) * 5136 + 2688 + (q - 5136) % 2448; };
    int r, stride, lim;
    if (nb == 512) { if (bid < 288) { r = bid; stride = 288; lim = 5760; } else { r = 5760 + (bid - 288); stride = 224; lim = n_tiles; } }
    else { r = bid; stride = nb; lim = n_tiles; }
    f32x4 cur[4], nxt[4];
    TDesc dc = tile_desc(p, gid(r < lim ? r : 0));
    if (r < lim) tile_load(dc, t, cur);
#pragma unroll 1
    for (; r < lim; r += stride) {
      const int rn = r + stride;
      TDesc dn = tile_desc(p, gid(rn < lim ? rn : 0));
      if (rn < lim) tile_load(dn, t, nxt);
      tile_store(dc, t, cur, sm);
      dc = dn;
#pragma unroll
      for (int i = 0; i < 4; ++i) cur[i] = nxt[i];
    }
  }
#if PROBE == 6
  }
#endif
  #define gt ((size_t)(blockIdx.x * 512 + rtid()))
  const size_t gs = (size_t)gridDim.x * 512;
  {
    float4* dst = (float4*)p.out;
    const float4* s0 = (const float4*)p.in[0];
    const float4* s1 = (const float4*)p.in[1];
    const size_t n0 = (size_t)NCTX * 256, n1 = (size_t)NTOK * 256;
    for (size_t i = gt; i < n1; i += gs) dst[i] = (i < n0) ? s0[i] : s1[i - n0];
  }
  {
    bf16_t* kac = (bf16_t*)(p.ws + WS_KAC); bf16_t* vac = (bf16_t*)(p.ws + WS_VAC);
    for (size_t i = gt; i < 524288 / 4; i += gs) {
      const float4 a = ((const float4*)p.in[3])[i], b = ((const float4*)p.in[4])[i];
      uint2 wa, wb; wa.x = pack2(a.x, a.y); wa.y = pack2(a.z, a.w); wb.x = pack2(b.x, b.y); wb.y = pack2(b.z, b.w);
      ((uint2*)kac)[i] = wa; ((uint2*)vac)[i] = wb;
    }
    bf16_t* vcc = (bf16_t*)(p.ws + WS_VCC);
    for (size_t i = gt; i < 1572864 / 4; i += gs) {
      const float4 a = ((const float4*)p.in[6])[i];
      uint2 wa; wa.x = pack2(a.x, a.y); wa.y = pack2(a.z, a.w);
      ((uint2*)vcc)[i] = wa;
    }
    bf16_t* kcc = (bf16_t*)(p.ws + WS_KCC);
    for (size_t i = gt; i < 4096ull * 8 * 16; i += gs) {
      const size_t rv = i >> 4; const int g = (int)(i & 15);
      uint2 w = make_uint2(0, 0);
      if (g < 12) { const float4 a = *(const float4*)(p.in[5] + rv * 48 + 4 * g); w.x = pack2(a.x, a.y); w.y = pack2(a.z, a.w); }
      *(uint2*)(kcc + rv * 64 + 4 * g) = w;
    }
  }
  {
    float* rope = (float*)(p.ws + WS_ROPE);
    for (size_t i = gt; i < 1024 + 768; i += gs) {
      if (i < 1024) { const int pos = (int)i >> 4, f = (int)i & 15; float c, s; sincos_tab((float)pos, p.freqA[f], c, s); rope[i] = c; rope[1024 + i] = s; }
      else { const int j = (int)i - 1024; const int pos = j / 12, f = j % 12; float c, s; sincos_tab((float)pos, p.freqC[f], c, s); rope[2048 + j] = c; rope[2048 + 768 + j] = s; }
    }
    if (gt < 4) {
      const float* lc = p.in[23] + gt * 4 * 48;
      float s1 = 0.f, s2 = 0.f;
      for (int d = 0; d < 48; ++d) { s1 += lc[d] * lc[48 + d]; s2 += lc[96 + d] * lc[144 + d]; }
      ((float*)(p.ws + WS_MISC))[gt] = expf(s1) - expf(s2) + p.lam_init[gt];
      ((unsigned*)(p.ws + WS_MISC + 64))[gt] = 0u; ((unsigned*)(p.ws + WS_MISC + 64))[gt + 4] = 0u;
    }
  }
}
#undef gt

DI void norm0_bias_phase(const Params& p) {
  const int tx = rtid(); const int lane = tx & 63;
  const int gw = blockIdx.x * 8 + (tx >> 6), nw = gridDim.x * 8;
  const float* mod = (const float*)(p.ws + WS_MOD);
  {
    const float* g = p.in[11];
    bf16_t* H = (bf16_t*)(p.ws + WS_H);
    float* RS = (float*)(p.ws + WS_ROWSS);
    for (int row = gw; row < NTOK; row += nw) {
      const float* x = p.out + (size_t)row * 1024;
      float4 v[4]; float ss = 0.f;
#pragma unroll
      for (int c = 0; c < 4; ++c) { v[c] = *(const float4*)(x + c * 256 + lane * 4); ss += v[c].x * v[c].x + v[c].y * v[c].y + v[c].z * v[c].z + v[c].w * v[c].w; }
#pragma unroll
      for (int o = 32; o >= 1; o >>= 1) ss += __shfl_xor(ss, o);
      if (lane < 16) RS[(size_t)row * 16 + lane] = lane == 0 ? ss : 0.f;
      const float* mrow = mod + ((size_t)cond_of_row(row)) * 9216;
#pragma unroll
      for (int c = 0; c < 4; ++c) {
        const int j = c * 256 + lane * 4;
        const float4 gg = *(const float4*)(g + j), sc = *(const float4*)(mrow + 1024 + j);
        uint2 w; w.x = pack2(v[c].x * gg.x * (1.f + sc.x), v[c].y * gg.y * (1.f + sc.y)); w.y = pack2(v[c].z * gg.z * (1.f + sc.z), v[c].w * gg.w * (1.f + sc.w));
        *(uint2*)(H + (size_t)row * 1024 + j) = w;
      }
    }
  }
  {
    float* BIAS = (float*)(p.ws + WS_BIAS);
#pragma unroll 1
    for (int grp = 0; grp < 3; ++grp) {
      const int l = grp / 3, sub = grp - l * 3;
      const int ncol = sub == 1 ? PWR : 5632;
      const bf16_t* Wt = sub == 1 ? (const bf16_t*)(p.ws + WS_WIN) + (size_t)l * PWR * 1024 : (const bf16_t*)(p.ws + WS_WGU) + (size_t)(l * 2 + (sub >> 1)) * 5632 * 1024;
      float sh[3][16];
#pragma unroll
      for (int c = 0; c < 3; ++c) {
        const float* sp = mod + ((size_t)l * 3 + c) * 9216 + (size_t)(3 * sub) * 1024 + lane * 16;
#pragma unroll
        for (int q = 0; q < 4; ++q) { const float4 t = *(const float4*)(sp + 4 * q); sh[c][4 * q] = t.x; sh[c][4 * q + 1] = t.y; sh[c][4 * q + 2] = t.z; sh[c][4 * q + 3] = t.w; }
      }
#pragma unroll 2
      for (int n = gw; n < ncol; n += nw) {
        float w[16]; unpack8(*(const uint4*)(Wt + (size_t)n * 1024 + lane * 16), w); unpack8(*(const uint4*)(Wt + (size_t)n * 1024 + lane * 16 + 8), w + 8);
        float d0 = 0.f, d1 = 0.f, d2 = 0.f;
#pragma unroll
        for (int e = 0; e < 16; ++e) { d0 += sh[0][e] * w[e]; d1 += sh[1][e] * w[e]; d2 += sh[2][e] * w[e]; }
#pragma unroll
        for (int o = 32; o >= 1; o >>= 1) { d0 += __shfl_xor(d0, o); d1 += __shfl_xor(d1, o); d2 += __shfl_xor(d2, o); }
        if (lane < 3) BIAS[((size_t)grp * 3 + lane) * 5632 + n] = lane == 0 ? d0 : (lane == 1 ? d1 : d2);
      }
    }
  }
}

enum { EPI_SWIGLU = 0, EPI_RESID = 1, EPI_PROJ = 2 };

template <int EPI>
DI void gemm_phase(const Params& p, const bf16_t* __restrict__ A, int lda, const bf16_t* __restrict__ Bt, int K, int NT,
                   const float* __restrict__ gate_base  , float coef, char* smem) {
  const int tid = otid(), lane = tid & 63, wave = tid >> 6, wm = wave >> 1, wn = wave & 1;
  const int nb = vnb(), xcd = obid() & 7, slot = obid() >> 3, slots = nb >> 3;
  const int per_x = 12 * NT;
  const int nk = K >> 6;
  char* As = smem;
  char* Bs = smem + 32768;
  for (int q = slot; q < per_x; q += slots) {
    const int grp = q / (4 * NT), r = q - grp * 4 * NT, nt = r >> 2, mtl = r & 3, mt = (grp * 4 + mtl) * 8 + xcd;
    const int m0 = mt * 128, n0 = nt * 128;
    f32x4 acc[4][4];
#pragma unroll
    for (int i = 0; i < 4; ++i)
#pragma unroll
      for (int j = 0; j < 4; ++j) acc[i][j] = (f32x4){0.f, 0.f, 0.f, 0.f};
    const bf16_t* Ag = A + (size_t)(m0 + (tid >> 3)) * lda + (tid & 7) * 8;
    const bf16_t* Bg = Bt + (size_t)(n0 + (tid >> 3)) * K + (tid & 7) * 8;
    const int lrow = tid >> 3, lch = tid & 7;
    uint4 ra[4], rb[4];
#pragma unroll
    for (int i = 0; i < 4; ++i) { ra[i] = *(const uint4*)(Ag + (size_t)(32 * i) * lda); rb[i] = *(const uint4*)(Bg + (size_t)(32 * i) * K); }
#pragma unroll
    for (int i = 0; i < 4; ++i) {
      const int row = lrow + 32 * i; const int off = row * 128 + ((lch ^ (row & 7)) << 4);
      *(uint4*)(As + off) = ra[i]; *(uint4*)(Bs + off) = rb[i];
    }
    __syncthreads();
    for (int kt = 0; kt < nk; ++kt) {
      const int cur = kt & 1;
      if (kt + 1 < nk) {
        const int k0 = (kt + 1) * 64;
#pragma unroll
        for (int i = 0; i < 4; ++i) { ra[i] = *(const uint4*)(Ag + (size_t)(32 * i) * lda + k0); rb[i] = *(const uint4*)(Bg + (size_t)(32 * i) * K + k0); }
      }
      const char* as = As + cur * 16384; const char* bs = Bs + cur * 16384;
#pragma unroll
      for (int ks = 0; ks < 2; ++ks) {
        bf16x8 ax[4], bw[4];
        const int ch = ((ks * 4 + (lane >> 4)) ^ (lane & 7)) << 4;
#pragma unroll
        for (int i = 0; i < 4; ++i) {
          ax[i] = *(const bf16x8*)(as + (wm * 64 + i * 16 + (lane & 15)) * 128 + ch);
          bw[i] = *(const bf16x8*)(bs + (wn * 64 + i * 16 + (lane & 15)) * 128 + ch);
        }
#pragma unroll
        for (int mi = 0; mi < 4; ++mi)
#pragma unroll
          for (int ni = 0; ni < 4; ++ni) acc[mi][ni] = __builtin_amdgcn_mfma_f32_16x16x32_bf16(bw[ni], ax[mi], acc[mi][ni], 0, 0, 0);
      }
      if (kt + 1 < nk) {
        const int nxt = cur ^ 1;
#pragma unroll
        for (int i = 0; i < 4; ++i) {
          const int row = lrow + 32 * i; const int off = nxt * 16384 + row * 128 + ((lch ^ (row & 7)) << 4);
          *(uint4*)(As + off) = ra[i]; *(uint4*)(Bs + off) = rb[i];
        }
      }
      __syncthreads();
    }
    const int tok0 = m0 + wm * 64 + (lane & 15);
    const int nc0 = n0 + wn * 64 + (lane >> 4) * 4;
    if (EPI == EPI_SWIGLU) {
      bf16_t* ACT = (bf16_t*)(p.ws + WS_ACT);
#pragma unroll
      for (int mi = 0; mi < 4; ++mi) {
        const size_t rowoff = (size_t)(tok0 + mi * 16) * DFF;
#pragma unroll
        for (int pr = 0; pr < 2; ++pr) {
          const f32x4 g = acc[mi][2 * pr], u = acc[mi][2 * pr + 1];
          const int ffc = ((n0 + wn * 64) >> 1) + pr * 16 + (lane >> 4) * 4;
          uint2 w; w.x = pack2(silu_f(g[0]) * u[0], silu_f(g[1]) * u[1]); w.y = pack2(silu_f(g[2]) * u[2], silu_f(g[3]) * u[3]);
          *(uint2*)(ACT + rowoff + ffc) = w;
        }
      }
    } else if (EPI == EPI_RESID) {
      const float* gv = gate_base + (size_t)cond_of_row(m0) * 9216;
#pragma unroll
      for (int ni = 0; ni < 4; ++ni) {
        const int n = nc0 + ni * 16;
        const float4 gg = *(const float4*)(gv + n);
#pragma unroll
        for (int mi = 0; mi < 4; ++mi) {
          float* xp = p.out + (size_t)(tok0 + mi * 16) * 1024 + n;
          float4 xv = *(const float4*)xp;
          xv.x += coef * gg.x * acc[mi][ni][0]; xv.y += coef * gg.y * acc[mi][ni][1];
          xv.z += coef * gg.z * acc[mi][ni][2]; xv.w += coef * gg.w * acc[mi][ni][3];
          *(float4*)xp = xv;
        }
      }
    } else {
      bf16_t* PR = (bf16_t*)(p.ws + WS_PROJ);
#pragma unroll
      for (int ni = 0; ni < 4; ++ni) {
        const int n = nc0 + ni * 16;
        if (n < PW) {
#pragma unroll
          for (int mi = 0; mi < 4; ++mi) {
            uint2 w; w.x = pack2(acc[mi][ni][0], acc[mi][ni][1]); w.y = pack2(acc[mi][ni][2], acc[mi][ni][3]);
            *(uint2*)(PR + (size_t)(tok0 + mi * 16) * PW + n) = w;
          }
        }
      }
    }
  }
}


namespace pg8 {
#define PG8_LAS __attribute__((address_space(3)))
typedef unsigned short bf16_t;
typedef short bf16x8 __attribute__((ext_vector_type(8)));
typedef float f32x4 __attribute__((ext_vector_type(4)));
typedef unsigned u32x4 __attribute__((ext_vector_type(4)));
constexpr int BM = 256, BK = 64, HALF = 128, HTB = HALF * BK * 2  , STAGE_BYTES = 8 * HTB, NXCD = 8, WGM = 8;

__host__ __device__ __forceinline__ int lds_byte(int r, int c) { const int st = (r >> 4) * 2 + (c >> 5), rr = r & 15, cc = c & 31, ob = rr * 64 + cc * 2; return st * 1024 + (ob ^ (((ob >> 9) & 1) << 5)); }
__host__ __device__ __forceinline__ void stage_rc(int b, int& R, int& C) { const int st = b / 1024, sb = b % 1024, swz = sb ^ (((sb >> 9) & 1) << 5); R = (st >> 1) * 16 + swz / 64; C = (st & 1) * 32 + (swz % 64) / 2; }
__host__ __device__ __forceinline__ int perm32(int rho) { const int n = rho >> 4, i = rho & 15; return 8 * (i >> 2) + 4 * n + (i & 3); }

struct Unit { int pm, pn; };
struct Gemm { const bf16_t* A; const bf16_t* Bt; int M, N, K; };

struct StaticOrder {
    int nM, nN, nwg, G, c;
    __host__ __device__ void init(int M, int N, int G_, int c_) { nM = M / BM; nN = N / BM; nwg = nM * nN; G = G_; c = c_; }
    __host__ __device__ bool next(int i, Unit& u) const {
        const long L = (long)i * G + c; if (L >= nwg) return false;
        int wgid = (int)L; { const int q = nwg / NXCD, r = nwg % NXCD, xcd = wgid % NXCD, off = wgid / NXCD; wgid = (xcd < r ? xcd * (q + 1) : r * (q + 1) + (xcd - r) * q) + off; }
        const int nig = WGM * nN, gid = wgid / nig, fm = gid * WGM, gsz = (nM - fm) < WGM ? (nM - fm) : WGM;
        u.pm = fm + ((wgid % nig) % gsz); u.pn = (wgid % nig) / gsz; return true;
    }
    __device__ __forceinline__ void a_ready(const Unit&) const {}
    __device__ __forceinline__ void done(const Unit&) const {}
};
template <class Epi, class Sched, bool ALIGN_EPI = false, bool SP2 = false>
__device__ __forceinline__ void gemm_phase(PG8_LAS unsigned char* lds, const Gemm g, const Sched& S, const Epi& E) {
    const int tid = rtid(), wid = __builtin_amdgcn_readfirstlane(tid >> 6), lane = tid & 63, wr = wid >> 2, wc = wid & 3, fr = lane & 15, fq = lane >> 4;
    const int K = g.K, nt = K / BK;
    unsigned voffA[2], voffB[2];
#pragma unroll
    for (int i = 0; i < 2; ++i) { int R, C; stage_rc(tid * 16 + i * 8192, R, C); const int Rb = Epi::PERM ? ((R & ~31) + perm32(R & 31)) : R;
        voffA[i] = (unsigned)(R * K + C) * 2u; voffB[i] = (unsigned)(Rb * K + C) * 2u; }
    const size_t kstep = (size_t)(BK * 2);
    const size_t hstep = (size_t)HALF * K * 2;
    const size_t tstep = 2 * hstep;
    const unsigned ldsw = (unsigned)wid * 1024u;
    const int aoff = lds_byte(wr * 64 + fr, fq * 8), boff = lds_byte(wc * 32 + fr, fq * 8);
#define PG8_SA(b, h) (((b) * 2 + (h)) * HTB)
#define PG8_SB(b, h) ((4 + (b) * 2 + (h)) * HTB)
#define PG8_STAGE(bufoff, gbase, voff) do { _Pragma("unroll") for (int _i = 0; _i < 2; ++_i) \
        __builtin_amdgcn_global_load_lds((const unsigned*)((const char*)(gbase) + (voff)[_i]), (PG8_LAS unsigned*)(lds + (bufoff) + ldsw + _i * 8192), 16, 0, 0); } while (0)
#define PG8_LDA(dst, b, h) do { _Pragma("unroll") for (int m = 0; m < 4; ++m) _Pragma("unroll") for (int k = 0; k < 2; ++k) dst[m][k] = *(const PG8_LAS bf16x8*)(lds + PG8_SA(b, h) + aoff + m * 2048 + k * 1024); } while (0)
#define PG8_LDB(dst, b, h) do { _Pragma("unroll") for (int n = 0; n < 2; ++n) _Pragma("unroll") for (int k = 0; k < 2; ++k) dst[n][k] = *(const PG8_LAS bf16x8*)(lds + PG8_SB(b, h) + boff + n * 2048 + k * 1024); } while (0)
#define PG8_MMA(ai, bj, At, Bt) do { __builtin_amdgcn_s_setprio(1); _Pragma("unroll") for (int m = 0; m < 4; ++m) _Pragma("unroll") for (int n = 0; n < 2; ++n) _Pragma("unroll") for (int k = 0; k < 2; ++k) \
        acc[ai][bj][m][n] = __builtin_amdgcn_mfma_f32_16x16x32_bf16(Bt[n][k], At[m][k], acc[ai][bj][m][n], 0, 0, 0); __builtin_amdgcn_s_setprio(0); } while (0)
#define PG8_WAIT_V(n) asm volatile("s_waitcnt vmcnt(" #n ")" ::: "memory")
#define PG8_WAIT_L(n) asm volatile("s_waitcnt lgkmcnt(" #n ")" ::: "memory")
#define PG8_BAR __builtin_amdgcn_s_barrier()
#define PG8_SCHED __builtin_amdgcn_sched_barrier(0)
    Unit cur, nxt; int ui = 0;
    if (!S.next(0, cur)) return;
    f32x4 acc[2][2][4][2];
#pragma unroll
    for (int a = 0; a < 2; ++a)
#pragma unroll
        for (int b = 0; b < 2; ++b)
#pragma unroll
            for (int m = 0; m < 4; ++m)
#pragma unroll
                for (int n = 0; n < 2; ++n) acc[a][b][m][n] = (f32x4){0.f, 0.f, 0.f, 0.f};
    bf16x8 At[4][2], B0[2][2], B1[2][2];
    const char* cA = (const char*)g.A + (size_t)cur.pm * tstep; const char* cB = (const char*)g.Bt + (size_t)cur.pn * tstep;
    S.a_ready(cur);
    if constexpr (SP2) {
        PG8_STAGE(PG8_SB(0, 0), cB, voffB); PG8_STAGE(PG8_SB(0, 1), cB + hstep, voffB); PG8_STAGE(PG8_SA(0, 0), cA, voffA); PG8_STAGE(PG8_SA(0, 1), cA + hstep, voffA);
        if (wr == 1) PG8_BAR;
        PG8_WAIT_V(2); PG8_BAR;
        PG8_STAGE(PG8_SB(1, 0), cB + kstep, voffB); PG8_STAGE(PG8_SA(1, 0), cA + kstep, voffA); PG8_STAGE(PG8_SB(1, 1), cB + hstep + kstep, voffB);
        PG8_WAIT_V(6); PG8_BAR;
    } else {
        PG8_STAGE(PG8_SB(0, 0), cB, voffB); PG8_STAGE(PG8_SA(0, 0), cA, voffA); PG8_STAGE(PG8_SB(0, 1), cB + hstep, voffB); PG8_STAGE(PG8_SA(0, 1), cA + hstep, voffA);
        if (wr == 1) PG8_BAR;
        PG8_WAIT_V(4); PG8_BAR;
        PG8_STAGE(PG8_SB(1, 0), cB + kstep, voffB); PG8_STAGE(PG8_SA(1, 0), cA + kstep, voffA); PG8_STAGE(PG8_SB(1, 1), cB + hstep + kstep, voffB);
        PG8_WAIT_V(6); PG8_BAR;
    }
    for (;;) {
        const bool has_next = S.next(ui + 1, nxt);
        const char* nA = has_next ? (const char*)g.A + (size_t)nxt.pm * tstep : cA; const char* nB = has_next ? (const char*)g.Bt + (size_t)nxt.pn * tstep : cB;
        for (int t = 0; t < nt; t += 2) {
            const bool last = (t == nt - 2);
            const char* a1 = cA + (size_t)(t + 1) * kstep;
            const char* a2 = last ? nA : cA + (size_t)(t + 2) * kstep; const char* b2 = last ? nB : cB + (size_t)(t + 2) * kstep;
            const char* a3 = a2 + kstep; const char* b3 = b2 + kstep;
            if (last && has_next) S.a_ready(nxt);
            if constexpr (SP2) {
            PG8_LDB(B0, 0, 0); PG8_LDB(B1, 0, 1); PG8_SCHED; PG8_LDA(At, 0, 0); PG8_STAGE(PG8_SA(1, 1), a1 + hstep, voffA);
            PG8_WAIT_V(8); PG8_WAIT_L(0); PG8_BAR; PG8_MMA(0, 0, At, B0); PG8_MMA(0, 1, At, B1); PG8_BAR; PG8_SCHED;
            PG8_LDA(At, 0, 1); PG8_STAGE(PG8_SB(0, 0), b2, voffB); PG8_STAGE(PG8_SB(0, 1), b2 + hstep, voffB); PG8_STAGE(PG8_SA(0, 0), a2, voffA);
            PG8_WAIT_V(8); PG8_WAIT_L(0); PG8_BAR; PG8_MMA(1, 0, At, B0); PG8_MMA(1, 1, At, B1); PG8_BAR; PG8_SCHED;
            PG8_LDB(B0, 1, 0); PG8_LDB(B1, 1, 1); PG8_SCHED; PG8_LDA(At, 1, 0); PG8_STAGE(PG8_SA(0, 1), a2 + hstep, voffA);
            PG8_WAIT_V(8); PG8_WAIT_L(0); PG8_BAR; PG8_MMA(0, 0, At, B0); PG8_MMA(0, 1, At, B1); PG8_BAR; PG8_SCHED;
            PG8_LDA(At, 1, 1); PG8_STAGE(PG8_SB(1, 0), b3, voffB); PG8_STAGE(PG8_SB(1, 1), b3 + hstep, voffB); PG8_STAGE(PG8_SA(1, 0), a3, voffA);
            PG8_WAIT_V(8); PG8_WAIT_L(0); PG8_BAR; PG8_MMA(1, 0, At, B0); PG8_MMA(1, 1, At, B1); PG8_BAR; PG8_SCHED;
            } else {
            PG8_LDB(B0, 0, 0); PG8_SCHED; PG8_LDA(At, 0, 0); PG8_STAGE(PG8_SA(1, 1), a1 + hstep, voffA);
            PG8_WAIT_L(8); PG8_BAR; PG8_WAIT_L(0); PG8_MMA(0, 0, At, B0); PG8_BAR; PG8_SCHED;
            PG8_LDB(B1, 0, 1); PG8_STAGE(PG8_SB(0, 0), b2, voffB);
            PG8_BAR; PG8_WAIT_L(0); PG8_MMA(0, 1, At, B1); PG8_BAR;
            PG8_LDA(At, 0, 1); PG8_STAGE(PG8_SA(0, 0), a2, voffA);
            PG8_BAR; PG8_WAIT_L(0); PG8_MMA(1, 0, At, B0); PG8_BAR; PG8_SCHED;
            PG8_STAGE(PG8_SB(0, 1), b2 + hstep, voffB);
            PG8_WAIT_V(6); PG8_BAR; PG8_MMA(1, 1, At, B1); PG8_BAR;
            PG8_LDB(B0, 1, 0); PG8_SCHED; PG8_LDA(At, 1, 0); PG8_STAGE(PG8_SA(0, 1), a2 + hstep, voffA);
            PG8_WAIT_L(8); PG8_BAR; PG8_WAIT_L(0); PG8_MMA(0, 0, At, B0); PG8_BAR; PG8_SCHED;
            PG8_LDB(B1, 1, 1); PG8_STAGE(PG8_SB(1, 0), b3, voffB);
            PG8_BAR; PG8_WAIT_L(0); PG8_MMA(0, 1, At, B1); PG8_BAR;
            PG8_LDA(At, 1, 1); PG8_STAGE(PG8_SA(1, 0), a3, voffA);
            PG8_BAR; PG8_WAIT_L(0); PG8_MMA(1, 0, At, B0); PG8_BAR; PG8_SCHED;
            PG8_STAGE(PG8_SB(1, 1), b3 + hstep, voffB);
            PG8_WAIT_V(6); PG8_BAR; PG8_MMA(1, 1, At, B1); PG8_BAR;
            }
        }
        if constexpr (ALIGN_EPI) { if (wr == 0) PG8_BAR; }
        if constexpr (!Epi::AFTER_DRAIN) { E(acc, cur, wr, wc, fr, fq); S.done(cur); }
        if (!has_next) break;
#pragma unroll
        for (int a = 0; a < 2; ++a)
#pragma unroll
            for (int b = 0; b < 2; ++b)
#pragma unroll
                for (int m = 0; m < 4; ++m)
#pragma unroll
                    for (int n = 0; n < 2; ++n) acc[a][b][m][n] = (f32x4){0.f, 0.f, 0.f, 0.f};
        cur = nxt; cA = nA; cB = nB; ++ui;
        if constexpr (ALIGN_EPI) { if (wr == 1) PG8_BAR; }
    }
    PG8_WAIT_V(0);
    if constexpr (!ALIGN_EPI) { if (wr == 0) PG8_BAR; }
    PG8_BAR;
    if constexpr (Epi::AFTER_DRAIN) { E.fused(acc, cur, wr, wc, fr, fq, lds, wid, lane); S.done(cur); }
#undef PG8_SA
#undef PG8_SB
#undef PG8_STAGE
#undef PG8_LDA
#undef PG8_LDB
#undef PG8_MMA
#undef PG8_WAIT_V
#undef PG8_WAIT_L
#undef PG8_BAR
#undef PG8_SCHED
}
}

DI void wave_rstd(const float* RS, int rowbase  , int lane, float& r0, float& r1) {
  const float* a = RS + (size_t)(rowbase + lane) * 16; const float* b = a + 128 * 16;
  const float4 a0 = *(const float4*)a, a1 = *(const float4*)(a + 4), a2 = *(const float4*)(a + 8), a3 = *(const float4*)(a + 12);
  const float4 b0 = *(const float4*)b, b1 = *(const float4*)(b + 4), b2 = *(const float4*)(b + 8), b3 = *(const float4*)(b + 12);
  const float sa = ((a0.x + a0.y) + (a0.z + a0.w)) + ((a1.x + a1.y) + (a1.z + a1.w)) + ((a2.x + a2.y) + (a2.z + a2.w)) + ((a3.x + a3.y) + (a3.z + a3.w));
  const float sb = ((b0.x + b0.y) + (b0.z + b0.w)) + ((b1.x + b1.y) + (b1.z + b1.w)) + ((b2.x + b2.y) + (b2.z + b2.w)) + ((b3.x + b3.y) + (b3.z + b3.w));
  r0 = rsqrtf(sa * (1.f / 1024.f) + EPSN); r1 = rsqrtf(sb * (1.f / 1024.f) + EPSN);
}
struct EpiSwiglu {
  static constexpr bool PERM = true, AFTER_DRAIN = false;
  bf16_t* ACT; const float* RS; const float* bias  ;
  DI void operator()(const f32x4 (&acc)[2][2][4][2], const pg8::Unit& u, int wr, int wc, int fr, int fq) const {
    const int row0 = u.pm * 256 + wr * 64 + fr, lane = fq * 16 + fr;
    float rs[2]; wave_rstd(RS, u.pm * 256 + wr * 64, lane, rs[0], rs[1]);
    const float* bp = bias + (size_t)cond_of_row(u.pm * 256) * 5632 + u.pn * 256 + wc * 32 + 8 * fq;
    const f32x4 bg0 = *(const f32x4*)(bp), bg1 = *(const f32x4*)(bp + 4), bu0 = *(const f32x4*)(bp + 128), bu1 = *(const f32x4*)(bp + 132);
#pragma unroll
    for (int ai = 0; ai < 2; ++ai)
#pragma unroll
      for (int m = 0; m < 4; ++m) {
        const float r = __shfl(rs[ai], 16 * m + fr);
        const f32x4 g0 = acc[ai][0][m][0] * r + bg0, g1 = acc[ai][0][m][1] * r + bg1, v0 = acc[ai][1][m][0] * r + bu0, v1 = acc[ai][1][m][1] * r + bu1;
        uint4 w;
        w.x = pack2(silu_f(g0[0]) * v0[0], silu_f(g0[1]) * v0[1]); w.y = pack2(silu_f(g0[2]) * v0[2], silu_f(g0[3]) * v0[3]);
        w.z = pack2(silu_f(g1[0]) * v1[0], silu_f(g1[1]) * v1[1]); w.w = pack2(silu_f(g1[2]) * v1[2], silu_f(g1[3]) * v1[3]);
        *(uint4*)(ACT + (size_t)(row0 + ai * 128 + m * 16) * DFF + u.pn * 128 + wc * 32 + 8 * fq) = w;
      }
  }
};
struct EpiResid {
  static constexpr bool PERM = true, AFTER_DRAIN = false;
  float* X; const float* gate_base; float coef;
  bf16_t* H; float* RS; const float* nxt_g  ; const float* nxt_scale  ;
  DI void operator()(const f32x4 (&acc)[2][2][4][2], const pg8::Unit& u, int wr, int wc, int fr, int fq) const {
    const int row0 = u.pm * 256 + wr * 64 + fr, col0 = u.pn * 256 + wc * 32 + 8 * fq;
    const int cond = cond_of_row(u.pm * 256);
    const float* gv = gate_base + (size_t)cond * 9216 + col0;
    const bool has_next = nxt_g != nullptr;
    float ss[2][4];
#pragma unroll
    for (int ai = 0; ai < 2; ++ai)
#pragma unroll
      for (int m = 0; m < 4; ++m) ss[ai][m] = 0.f;
#pragma unroll
    for (int bj = 0; bj < 2; ++bj) {
      const int co = bj * 128;
      const float4 gg0 = *(const float4*)(gv + co), gg1 = *(const float4*)(gv + co + 4);
      float4 hv0 = make_float4(0.f, 0.f, 0.f, 0.f), hv1 = hv0;
      if (has_next) {
        const float* gp = nxt_g + col0 + co; const float* sp = nxt_scale + (size_t)cond * 9216 + col0 + co;
        const float4 g20 = *(const float4*)gp, g21 = *(const float4*)(gp + 4), s20 = *(const float4*)sp, s21 = *(const float4*)(sp + 4);
        hv0 = make_float4(g20.x * (1.f + s20.x), g20.y * (1.f + s20.y), g20.z * (1.f + s20.z), g20.w * (1.f + s20.w));
        hv1 = make_float4(g21.x * (1.f + s21.x), g21.y * (1.f + s21.y), g21.z * (1.f + s21.z), g21.w * (1.f + s21.w));
      }
#pragma unroll
      for (int ai = 0; ai < 2; ++ai)
#pragma unroll
        for (int m = 0; m < 4; ++m) {
          const size_t off = (size_t)(row0 + ai * 128 + m * 16) * 1024 + col0 + co;
          float4 x0 = *(const float4*)(X + off), x1 = *(const float4*)(X + off + 4);
          const f32x4 a0 = acc[ai][bj][m][0], a1 = acc[ai][bj][m][1];
          x0.x += coef * gg0.x * a0[0]; x0.y += coef * gg0.y * a0[1]; x0.z += coef * gg0.z * a0[2]; x0.w += coef * gg0.w * a0[3];
          x1.x += coef * gg1.x * a1[0]; x1.y += coef * gg1.y * a1[1]; x1.z += coef * gg1.z * a1[2]; x1.w += coef * gg1.w * a1[3];
          *(float4*)(X + off) = x0; *(float4*)(X + off + 4) = x1;
          if (has_next) {
            ss[ai][m] += ((x0.x * x0.x + x0.y * x0.y) + (x0.z * x0.z + x0.w * x0.w)) + ((x1.x * x1.x + x1.y * x1.y) + (x1.z * x1.z + x1.w * x1.w));
            uint4 w; w.x = pack2(x0.x * hv0.x, x0.y * hv0.y); w.y = pack2(x0.z * hv0.z, x0.w * hv0.w); w.z = pack2(x1.x * hv1.x, x1.y * hv1.y); w.w = pack2(x1.z * hv1.z, x1.w * hv1.w);
            *(uint4*)(H + off) = w;
          }
        }
    }
    if (has_next) {
#pragma unroll
      for (int ai = 0; ai < 2; ++ai)
#pragma unroll
        for (int m = 0; m < 4; ++m) {
          float s = ss[ai][m];
          s += __shfl_xor(s, 16); s += __shfl_xor(s, 32);
          if (fq == 0) RS[(size_t)(row0 + ai * 128 + m * 16) * 16 + u.pn * 4 + wc] = s;
        }
    }
  }
};
struct EpiProj {
  static constexpr bool PERM = true, AFTER_DRAIN = false;
  bf16_t* PR; const float* RS; const float* bias  ;
  DI void operator()(const f32x4 (&acc)[2][2][4][2], const pg8::Unit& u, int wr, int wc, int fr, int fq) const {
    const int row0 = u.pm * 256 + wr * 64 + fr, col0 = u.pn * 256 + wc * 32 + 8 * fq, lane = fq * 16 + fr;
    float rs[2]; wave_rstd(RS, u.pm * 256 + wr * 64, lane, rs[0], rs[1]);
    float rr[2][4];
#pragma unroll
    for (int ai = 0; ai < 2; ++ai)
#pragma unroll
      for (int m = 0; m < 4; ++m) rr[ai][m] = __shfl(rs[ai], 16 * m + fr);
    const float* bp = bias + (size_t)cond_of_row(u.pm * 256) * 5632;
#pragma unroll
    for (int bj = 0; bj < 2; ++bj) {
      const int col = col0 + bj * 128;
      if (col < PW) {
        const f32x4 b0 = *(const f32x4*)(bp + col), b1 = *(const f32x4*)(bp + col + 4);
#pragma unroll
        for (int ai = 0; ai < 2; ++ai)
#pragma unroll
          for (int m = 0; m < 4; ++m) {
            const f32x4 a0 = acc[ai][bj][m][0] * rr[ai][m] + b0, a1 = acc[ai][bj][m][1] * rr[ai][m] + b1;
            uint4 w; w.x = pack2(a0[0], a0[1]); w.y = pack2(a0[2], a0[3]); w.z = pack2(a1[0], a1[1]); w.w = pack2(a1[2], a1[3]);
            *(uint4*)(PR + (size_t)(row0 + ai * 128 + m * 16) * PW + col) = w;
          }
      }
    }
  }
};
template <class Epi>
DI void gemm8_run(const bf16_t* acts, const bf16_t* wts, int Nw, int K, const Epi& E, char* dsm) {
  pg8::Gemm g; g.A = acts; g.Bt = wts; g.M = NTOK; g.N = Nw; g.K = K;
  pg8::StaticOrder S; S.init(NTOK, Nw, (int)gridDim.x, (int)blockIdx.x);
  pg8::gemm_phase<Epi, pg8::StaticOrder, true, true>((LDSP unsigned char*)dsm, g, S, E);
}

DI void prep_gla_tile(const Params& p, int l, int tt, char* smem) {
  const int tid = otid();
  const bf16_t* PR = (const bf16_t*)(p.ws + WS_PROJ);
  float* GB = (float*)(p.ws + WS_GB); float* ATOT = (float*)(p.ws + WS_ATOT); float* U = (float*)(p.ws + WS_U);
  const int row0 = tt * 64;
  float* bg = (float*)smem;
  bf16_t* ks = (bf16_t*)(smem + 8192);
  bf16_t* vs = (bf16_t*)(smem + 8192 + 16384);
  {
    {
      const int lane = tid & 63, wv = tid >> 6, fr = lane & 15, fq = lane >> 4;
      const bf16_t* hp = (const bf16_t*)(p.ws + WS_H) + (size_t)(row0 + wv * 16 + fr) * 1024 + 8 * fq;
      const bf16_t* wp = (const bf16_t*)(p.ws + WS_WIN) + ((size_t)l * PWR + OFF_BGW + fr) * 1024 + 8 * fq;
      f32x4 c0 = (f32x4){0.f, 0.f, 0.f, 0.f}, c1 = c0;
#pragma unroll 8
      for (int ks = 0; ks < 32; ++ks) {
        const bf16x8 a = *(const bf16x8*)(hp + 32 * ks), b0 = *(const bf16x8*)(wp + 32 * ks), b1 = *(const bf16x8*)(wp + 16 * 1024 + 32 * ks);
        c0 = __builtin_amdgcn_mfma_f32_16x16x32_bf16(a, b0, c0, 0, 0, 0);
        c1 = __builtin_amdgcn_mfma_f32_16x16x32_bf16(a, b1, c1, 0, 0, 0);
      }
      const float* rsp = (const float*)(p.ws + WS_ROWSS) + (size_t)(row0 + wv * 16 + fr) * 16;
      const float4 r0 = *(const float4*)rsp, r1 = *(const float4*)(rsp + 4), r2 = *(const float4*)(rsp + 8), r3 = *(const float4*)(rsp + 12);
      const float rs = rsqrtf((((r0.x + r0.y) + (r0.z + r0.w)) + ((r1.x + r1.y) + (r1.z + r1.w)) + ((r2.x + r2.y) + (r2.z + r2.w)) + ((r3.x + r3.y) + (r3.z + r3.w))) * (1.f / 1024.f) + EPSN);
      const float* bp = (const float*)(p.ws + WS_BIAS) + ((size_t)(l * 3 + 1) * 3 + cond_of_row(row0)) * 5632 + OFF_BGW;
      const float bb0 = bp[fr], bb1 = bp[16 + fr];
#pragma unroll
      for (int r = 0; r < 4; ++r) {
        const float rr = __shfl(rs, 4 * fq + r);
        float* dst = bg + (wv * 16 + 4 * fq + r) * 32;
        dst[fr] = c0[r] * rr + bb0; dst[16 + fr] = c1[r] * rr + bb1;
      }
    }
#pragma unroll
    for (int q = 0; q < 4; ++q) { const int c = tid + 256 * q, row = c >> 4, ch = c & 15; *(uint4*)(ks + row * 128 + 8 * ch) = *(const uint4*)(PR + (size_t)(row0 + row) * PW + OFF_BK + 8 * ch); }
#pragma unroll
    for (int q = 0; q < 8; ++q) { const int c = tid + 256 * q, row = c >> 5, ch = c & 31; *(uint4*)(vs + row * 256 + 8 * ch) = *(const uint4*)(PR + (size_t)(row0 + row) * PW + OFF_BV + 8 * ch); }
  }
  __syncthreads();
  const int s = tid >> 7, k = tid & 127, h = k >> 5, d = k & 31;
  float w[16];
#pragma unroll
  for (int r = 0; r < 16; ++r) w[r] = p.in[18][((size_t)(l * 2 + s) * 16 + r) * 128 + k];
  const float bias = p.in[19][(l * 2 + s) * 128 + k];
  float acc[64];
#pragma unroll
  for (int x = 0; x < 64; ++x) acc[x] = 0.f;
  float run = 0.f;
#pragma unroll 2
  for (int ii = 0; ii < 64; ++ii) {
    const int j = s ? ii : 63 - ii;
    float z = bias;
#pragma unroll
    for (int r = 0; r < 16; ++r) z += bg[j * 32 + s * 16 + r] * w[r];
    const float ls = fminf(z, 0.f) - log1pf(expf(-fabsf(z)));
    GB[(size_t)(row0 + j) * 256 + s * 128 + k] = run;
    const float kd = bf2f(ks[j * 128 + k]) * fast_exp2(run * LOG2E);
    run += ls * (1.f / 16.f);
    const bf16_t* vr = vs + j * 256 + h * 64;
#pragma unroll
    for (int x8 = 0; x8 < 8; ++x8) {
      float vv[8]; unpack8(*(const uint4*)(vr + 8 * x8), vv);
#pragma unroll
      for (int e = 0; e < 8; ++e) acc[8 * x8 + e] += kd * vv[e];
    }
  }
  ATOT[tt * 256 + tid] = expf(run);
  ATOT[192 * 256 + tt * 256 + tid] = run;
  float* u = U + (((size_t)tt * 2 + s) * 4 + h) * 2048 + d * 64;
#pragma unroll
  for (int x4 = 0; x4 < 16; ++x4) *(float4*)(u + 4 * x4) = make_float4(acc[4 * x4], acc[4 * x4 + 1], acc[4 * x4 + 2], acc[4 * x4 + 3]);
  __syncthreads();
}

struct TokRaw { uint4 a; uint2 c0, c1, c2; uint4 av, cv; };
DI void tok_load(const bf16_t* PR, int r, int lane, bool ctx, TokRaw& t) {
  const bf16_t* pr = PR + (size_t)r * PW;
  t.a = *(const uint4*)(pr + (lane >> 3) * 64 + 8 * (lane & 7));
  const bf16_t* src = pr + OFF_CQ + (lane >> 2) * 48 + 12 * (lane & 3);
  t.c0 = *(const uint2*)(src); t.c1 = *(const uint2*)(src + 4); t.c2 = *(const uint2*)(src + 8);
  t.av = make_uint4(0, 0, 0, 0); t.cv = make_uint4(0, 0, 0, 0);
  if (ctx) { if (lane < 16) t.av = *(const uint4*)(pr + OFF_AV + 8 * lane); if (lane < 48) t.cv = *(const uint4*)(pr + OFF_CV + 8 * lane); }
}
DI void prep_token(const Params& p, int l, int r, int lane, const TokRaw& t) {
  bf16_t* QA = (bf16_t*)(p.ws + WS_QA); bf16_t* KA = (bf16_t*)(p.ws + WS_KA);
  bf16_t* QC = (bf16_t*)(p.ws + WS_QC); bf16_t* KC = (bf16_t*)(p.ws + WS_KC);
  const float* rope = (const float*)(p.ws + WS_ROPE);
  const float qsA = 0.125f * LOG2E, qsC = 0.14433756729740643f * LOG2E;
  const bool ctx = r < NCTX;
  const int b = ctx ? (r >> 8) : ((r - NCTX) >> 11);
  const int tq = ctx ? (r & 255) : ((r - NCTX) & 2047);
  const int rowpos = tq >> 6, colpos = tq & 63;
  {
    const int v = lane >> 3, s = lane & 7;
    float x[8]; unpack8(t.a, x);
    float ss = 0.f;
#pragma unroll
    for (int e = 0; e < 8; ++e) ss += x[e] * x[e];
    ss += __shfl_xor(ss, 1); ss += __shfl_xor(ss, 2); ss += __shfl_xor(ss, 4);
    const float rstd = rsqrtf(ss * (1.f / 64.f) + EPSN);
    const float* g = (v < 6 ? p.in[16] : p.in[17]) + l * 64 + 8 * s;
    float y[8];
#pragma unroll
    for (int e = 0; e < 8; ++e) y[e] = x[e] * rstd * g[e];
    if (ctx) {
      if (v >= 6) {
        float* o = p.out + O_AK + ((size_t)(b * 4 + l) * 256 + tq) * 128 + (v - 6) * 64 + 8 * s;
        *(float4*)o = make_float4(y[0], y[1], y[2], y[3]); *(float4*)(o + 4) = make_float4(y[4], y[5], y[6], y[7]);
      }
    } else {
      const int pos = (s < 4) ? rowpos : colpos;
      const float* ct = rope + pos * 16 + (s & 1) * 8; const float* st = rope + 1024 + pos * 16 + (s & 1) * 8;
#pragma unroll
      for (int e = 0; e < 8; ++e) {
        const float yp = __shfl_xor(y[e], 2);
        const float c = ct[e], sn = st[e];
        y[e] = (s & 2) ? (yp * sn + y[e] * c) : (y[e] * c - yp * sn);
      }
    }
    if (v < 6) {
#pragma unroll
      for (int e = 0; e < 8; ++e) y[e] *= qsA;
    }
    uint4 w; w.x = pack2(y[0], y[1]); w.y = pack2(y[2], y[3]); w.z = pack2(y[4], y[5]); w.w = pack2(y[6], y[7]);
    if (v < 6) *(uint4*)(QA + (size_t)r * 384 + v * 64 + 8 * s) = w;
    else *(uint4*)(KA + (size_t)r * 128 + (v - 6) * 64 + 8 * s) = w;
  }
  if (ctx && lane < 16) {
    float x[8]; unpack8(t.av, x);
    float* o = p.out + O_AV + ((size_t)(b * 4 + l) * 256 + tq) * 128 + 8 * lane;
    *(float4*)o = make_float4(x[0], x[1], x[2], x[3]); *(float4*)(o + 4) = make_float4(x[4], x[5], x[6], x[7]);
  }
  {
    const int v = lane >> 2, qd = lane & 3;
    float x[12];
    unpack4(t.c0, x); unpack4(t.c1, x + 4); unpack4(t.c2, x + 8);
    float ss = 0.f;
#pragma unroll
    for (int e = 0; e < 12; ++e) ss += x[e] * x[e];
    ss += __shfl_xor(ss, 1); ss += __shfl_xor(ss, 2);
    const float rstd = rsqrtf(ss * (1.f / 48.f) + EPSN);
    const float* g = (v < 8 ? p.in[21] : p.in[22]) + l * 96 + (v & 1) * 48 + 12 * qd;
    float y[12];
#pragma unroll
    for (int e = 0; e < 12; ++e) y[e] = x[e] * rstd * g[e];
    if (ctx) {
      if (v >= 8) {
        float* o = p.out + O_CK + ((size_t)(b * 4 + l) * 256 + tq) * 384 + (v - 8) * 48 + 12 * qd;
        *(float4*)o = make_float4(y[0], y[1], y[2], y[3]); *(float4*)(o + 4) = make_float4(y[4], y[5], y[6], y[7]);
        *(float4*)(o + 8) = make_float4(y[8], y[9], y[10], y[11]);
      }
    } else {
      const int pos = (qd < 2) ? rowpos : colpos;
      const float* ct = rope + 2048 + pos * 12; const float* st = rope + 2048 + 768 + pos * 12;
#pragma unroll
      for (int e = 0; e < 12; ++e) {
        const float yp = __shfl_xor(y[e], 1);
        const float c = ct[e], sn = st[e];
        y[e] = (qd & 1) ? (yp * sn + y[e] * c) : (y[e] * c - yp * sn);
      }
    }
    if (v < 8) {
#pragma unroll
      for (int e = 0; e < 12; ++e) y[e] *= qsC;
    }
    bf16_t* dst = (v < 8 ? QC : KC) + (size_t)r * 512 + (v & 7) * 64;
    uint2 w0, w1, w2; w0.x = pack2(y[0], y[1]); w0.y = pack2(y[2], y[3]); w1.x = pack2(y[4], y[5]); w1.y = pack2(y[6], y[7]);
    w2.x = pack2(y[8], y[9]); w2.y = pack2(y[10], y[11]);
    *(uint2*)(dst + 12 * qd) = w0; *(uint2*)(dst + 12 * qd + 4) = w1; *(uint2*)(dst + 12 * qd + 8) = w2;
    { unsigned z0; asm volatile("v_mov_b32 %0, 0" : "=v"(z0)); *(uint2*)(dst + 48 + 4 * qd) = make_uint2(z0, z0); }
  }
  if (ctx && lane < 48) {
    float x[8]; unpack8(t.cv, x);
    float* o = p.out + O_CV + ((size_t)(b * 4 + l) * 256 + tq) * 384 + 8 * lane;
    *(float4*)o = make_float4(x[0], x[1], x[2], x[3]); *(float4*)(o + 4) = make_float4(x[4], x[5], x[6], x[7]);
  }
}

DI void prep_phase(const Params& p, int l, char* smem) {
  int bx = blockIdx.x, gx = gridDim.x; asm volatile("" : "+s"(bx), "+s"(gx));
  if (gx > 96 && bx < 96) { prep_gla_tile(p, l, obid(), smem); return; }
  if (gx <= 96) for (int tt = obid(); tt < 192; tt += vnb()) prep_gla_tile(p, l, tt, smem);
  const int tx = rtid(), lane = tx & 63;
  const int fb = gx > 96 ? 96 : 0;
  const int gw = (bx - fb) * 8 + (tx >> 6), nw = (gx - fb) * 8;
  const bf16_t* PR = (const bf16_t*)(p.ws + WS_PROJ);
  int r = gw;
  TokRaw cur, nxt;
  if (r < NTOK) tok_load(PR, r, lane, r < NCTX, cur);
#pragma unroll 1
  for (; r < NTOK; r += nw) {
    const int rn = r + nw;
    if (rn < NTOK) tok_load(PR, rn, lane, rn < NCTX, nxt);
    prep_token(p, l, r, lane, cur);
    cur = nxt;
  }
}

typedef unsigned u32x4 __attribute__((ext_vector_type(4)));
struct KVSrc { const bf16_t* k1; const bf16_t* v1; const bf16_t* k2; const bf16_t* v2; int ks1, vs1, ks2, vs2, n1, n2; };
template <int NMAP, int NDT> struct FlashRegs { u32x4 k00, k01, k10, k11, v0, v1, v2; };

template <int NMAP, int NDT>
DI void fl_issue(int kt, const KVSrc& kv, FlashRegs<NMAP, NDT>& R) {
  constexpr int CPR = NDT * 2;
  kt = kt < kv.n1 + kv.n2 ? kt : kv.n1 + kv.n2 - 1;
  const int tid = otid();
  const bf16_t* kb; const bf16_t* vb; int ks, vs;
  if (kt < kv.n1) { kb = kv.k1 + (size_t)kt * 64 * kv.ks1; vb = kv.v1 + (size_t)kt * 64 * kv.vs1; ks = kv.ks1; vs = kv.vs1; }
  else { kb = kv.k2 + (size_t)(kt - kv.n1) * 64 * kv.ks2; vb = kv.v2 + (size_t)(kt - kv.n1) * 64 * kv.vs2; ks = kv.ks2; vs = kv.vs2; }
  R.k00 = *(const u32x4*)(kb + (size_t)(tid >> 3) * ks + (tid & 7) * 8);
  R.k01 = *(const u32x4*)(kb + (size_t)((tid >> 3) + 32) * ks + (tid & 7) * 8);
  if (NMAP == 2) {
    R.k10 = *(const u32x4*)(kb + 64 + (size_t)(tid >> 3) * ks + (tid & 7) * 8);
    R.k11 = *(const u32x4*)(kb + 64 + (size_t)((tid >> 3) + 32) * ks + (tid & 7) * 8);
  } else { R.k10 = R.k00; R.k11 = R.k01; }
  { const int c = tid; R.v0 = *(const u32x4*)(vb + (size_t)(c / CPR) * vs + (c % CPR) * 8); }
  { const int c = tid + 256; R.v1 = *(const u32x4*)(vb + (size_t)(c / CPR) * vs + (c % CPR) * 8); }
  if (NDT == 6) { const int c = tid + 512; R.v2 = *(const u32x4*)(vb + (size_t)(c / CPR) * vs + (c % CPR) * 8); } else R.v2 = R.v1;
}
template <int NMAP, int NDT>
DI void fl_write(char* buf, const FlashRegs<NMAP, NDT>& R) {
  constexpr int CPR = NDT * 2, VSB = NDT * 32 + 32;
  const int tid = otid();
  char* vbuf = buf + NMAP * 8192;
  { const int row = tid >> 3, ch = tid & 7; *(u32x4*)(buf + row * 128 + ((ch ^ (row & 7)) << 4)) = R.k00; }
  { const int row = (tid >> 3) + 32, ch = tid & 7; *(u32x4*)(buf + row * 128 + ((ch ^ (row & 7)) << 4)) = R.k01; }
  if (NMAP == 2) {
    { const int row = tid >> 3, ch = tid & 7; *(u32x4*)(buf + 8192 + row * 128 + ((ch ^ (row & 7)) << 4)) = R.k10; }
    { const int row = (tid >> 3) + 32, ch = tid & 7; *(u32x4*)(buf + 8192 + row * 128 + ((ch ^ (row & 7)) << 4)) = R.k11; }
  }
  { const int c = tid; *(u32x4*)(vbuf + (c / CPR) * VSB + (c % CPR) * 16) = R.v0; }
  { const int c = tid + 256; *(u32x4*)(vbuf + (c / CPR) * VSB + (c % CPR) * 16) = R.v1; }
  if (NDT == 6) { const int c = tid + 512; *(u32x4*)(vbuf + (c / CPR) * VSB + (c % CPR) * 16) = R.v2; }
}
template <int NMAP, int NDT>
DI void fl_compute(const char* buf, const bf16x8 (&qf)[NMAP][2], f32x4 (&oacc)[NMAP][NDT], float (&mrun)[NMAP], float (&lsum)[NMAP], int lane) {
  constexpr int VSB = NDT * 32 + 32;
  const int g = lane >> 4, qq = (lane & 15) >> 2, pp = lane & 3;
  bf16x8 pf[NMAP][2];
#pragma unroll
  for (int m = 0; m < NMAP; ++m) {
    f32x4 sacc[4];
#pragma unroll
    for (int t = 0; t < 4; ++t) sacc[t] = (f32x4){0.f, 0.f, 0.f, 0.f};
#pragma unroll
    for (int ks = 0; ks < 2; ++ks) {
      const int ch = ((ks * 4 + g) ^ (lane & 7)) << 4;
#pragma unroll
      for (int t = 0; t < 4; ++t) {
        const bf16x8 kf = *(const bf16x8*)(buf + m * 8192 + (16 * t + (lane & 15)) * 128 + ch);
        sacc[t] = __builtin_amdgcn_mfma_f32_16x16x32_bf16(kf, qf[m][ks], sacc[t], 0, 0, 0);
      }
    }
    float mx = sacc[0][0];
#pragma unroll
    for (int t = 0; t < 4; ++t)
#pragma unroll
      for (int r = 0; r < 4; ++r) mx = fmaxf(mx, sacc[t][r]);
    mx = fmaxf(mx, __shfl_xor(mx, 16)); mx = fmaxf(mx, __shfl_xor(mx, 32));
    const float mnew = fmaxf(mrun[m], mx);
    const float alpha = fast_exp2(mrun[m] - mnew);
    mrun[m] = mnew;
    float ps = 0.f;
#pragma unroll
    for (int t = 0; t < 4; ++t)
#pragma unroll
      for (int r = 0; r < 4; ++r) { const float pv = fast_exp2(sacc[t][r] - mnew); sacc[t][r] = pv; ps += pv; }
    lsum[m] = lsum[m] * alpha + ps;
#pragma unroll
    for (int d = 0; d < NDT; ++d) oacc[m][d] *= alpha;
#pragma unroll
    for (int ks = 0; ks < 2; ++ks) {
      u32x4 pu;
      pu[0] = pack2(sacc[2 * ks][0], sacc[2 * ks][1]); pu[1] = pack2(sacc[2 * ks][2], sacc[2 * ks][3]);
      pu[2] = pack2(sacc[2 * ks + 1][0], sacc[2 * ks + 1][1]); pu[3] = pack2(sacc[2 * ks + 1][2], sacc[2 * ks + 1][3]);
      pf[m][ks] = __builtin_bit_cast(bf16x8, pu);
    }
  }
  const char* vbuf = buf + NMAP * 8192;
#pragma unroll
  for (int ks = 0; ks < 2; ++ks) {
    const char* vrow = vbuf + (32 * ks + 4 * g + qq) * VSB + pp * 8;
#pragma unroll
    for (int d = 0; d < NDT; ++d) {
      const s16x4 v0 = __builtin_amdgcn_ds_read_tr16_b64_v4i16((LDSP s16x4*)(vrow + d * 32));
      const s16x4 v1 = __builtin_amdgcn_ds_read_tr16_b64_v4i16((LDSP s16x4*)(vrow + 16 * VSB + d * 32));
      const bf16x8 vf = __builtin_shufflevector(v0, v1, 0, 1, 2, 3, 4, 5, 6, 7);
#pragma unroll
      for (int m = 0; m < NMAP; ++m) oacc[m][d] = __builtin_amdgcn_mfma_f32_16x16x32_bf16(vf, pf[m][ks], oacc[m][d], 0, 0, 0);
    }
  }
}

template <int NMAP, int NDT>
DI void flash_run(const bf16_t* __restrict__ qptr, const KVSrc& kv, f32x4 (&oacc)[NMAP][NDT], float (&linv)[NMAP], char* smem) {
  constexpr int BUFB = NMAP * 8192 + 64 * (NDT * 32 + 32);
  const int lane = otid() & 63;
  bf16x8 qf[NMAP][2];
  float mrun[NMAP], lsum[NMAP];
#pragma unroll
  for (int m = 0; m < NMAP; ++m) {
    qf[m][0] = *(const bf16x8*)(qptr + 64 * m); qf[m][1] = *(const bf16x8*)(qptr + 64 * m + 32);
    mrun[m] = -INFINITY; lsum[m] = 0.f;
#pragma unroll
    for (int d = 0; d < NDT; ++d) oacc[m][d] = (f32x4){0.f, 0.f, 0.f, 0.f};
  }
  const int nt = kv.n1 + kv.n2;
  FlashRegs<NMAP, NDT> R0, R1;
  fl_issue<NMAP, NDT>(0, kv, R0);
  fl_issue<NMAP, NDT>(1, kv, R1);
  __syncthreads();
  fl_write<NMAP, NDT>(smem, R0);
  fl_issue<NMAP, NDT>(2, kv, R0);
  __syncthreads();
#pragma unroll 1
  for (int t = 0; t < nt; t += 2) {
    fl_compute<NMAP, NDT>(smem, qf, oacc, mrun, lsum, lane);
    fl_write<NMAP, NDT>(smem + BUFB, R1);
    fl_issue<NMAP, NDT>(t + 3, kv, R1);
    __syncthreads();
    fl_compute<NMAP, NDT>(smem + BUFB, qf, oacc, mrun, lsum, lane);
    fl_write<NMAP, NDT>(smem, R0);
    fl_issue<NMAP, NDT>(t + 4, kv, R0);
    __syncthreads();
  }
#pragma unroll
  for (int m = 0; m < NMAP; ++m) { float l = lsum[m]; l += __shfl_xor(l, 16); l += __shfl_xor(l, 32); linv[m] = 1.f / l; }
}

DI void attn_a_item(const Params& p, int l, bool ctx, int b, int h, int qt, char* smem) {
  const int lane = otid() & 63, wave = otid() >> 6;
  const int seq0 = ctx ? b * 256 : NCTX + b * 2048;
  const int qrow = seq0 + qt * 64 + wave * 16 + (lane & 15);
  const int kvh = h / 3;
  const bf16_t* PR = (const bf16_t*)(p.ws + WS_PROJ);
  KVSrc kv;
  kv.k1 = (const bf16_t*)(p.ws + WS_KA) + (size_t)seq0 * 128 + kvh * 64; kv.ks1 = 128;
  kv.v1 = PR + (size_t)seq0 * PW + OFF_AV + kvh * 64; kv.vs1 = PW;
  kv.n1 = ctx ? 4 : 32; kv.n2 = ctx ? 0 : 8;
  kv.k2 = (const bf16_t*)(p.ws + WS_KAC) + (size_t)((b & 1) * 4 + l) * 512 * 128 + kvh * 64; kv.ks2 = 128;
  kv.v2 = (const bf16_t*)(p.ws + WS_VAC) + (size_t)((b & 1) * 4 + l) * 512 * 128 + kvh * 64; kv.vs2 = 128;
  f32x4 o[1][4]; float linv[1];
  flash_run<1, 4>((const bf16_t*)(p.ws + WS_QA) + (size_t)qrow * 384 + h * 64 + 8 * (lane >> 4), kv, o, linv, smem);
  bf16_t* dst = (bf16_t*)(p.ws + WS_MIX) + (size_t)qrow * 1024 + h * 64 + 4 * (lane >> 4);
  const float li = linv[0];
#pragma unroll
  for (int d = 0; d < 4; ++d) { uint2 w; w.x = pack2(o[0][d][0] * li, o[0][d][1] * li); w.y = pack2(o[0][d][2] * li, o[0][d][3] * li); *(uint2*)(dst + 16 * d) = w; }
}

DI void attn_c_item(const Params& p, int l, bool ctx, int b, int h, int qt, char* smem) {
  const int lane = otid() & 63, wave = otid() >> 6;
  const int seq0 = ctx ? b * 256 : NCTX + b * 2048;
  const int qrow = seq0 + qt * 64 + wave * 16 + (lane & 15);
  const bf16_t* PR = (const bf16_t*)(p.ws + WS_PROJ);
  KVSrc kv;
  kv.ks1 = 512; kv.vs1 = PW; kv.ks2 = 512; kv.vs2 = 384;
  kv.n1 = ctx ? 4 : 32; kv.n2 = ctx ? 0 : 8;
  kv.v1 = PR + (size_t)seq0 * PW + OFF_CV + h * 96;
  kv.v2 = (const bf16_t*)(p.ws + WS_VCC) + (size_t)((b & 1) * 4 + l) * 512 * 384 + h * 96;
  kv.k1 = (const bf16_t*)(p.ws + WS_KC) + (size_t)seq0 * 512 + (h * 2) * 64;
  kv.k2 = (const bf16_t*)(p.ws + WS_KCC) + (size_t)((b & 1) * 4 + l) * 512 * 512 + (h * 2) * 64;
  f32x4 o[2][6]; float linv[2];
  flash_run<2, 6>((const bf16_t*)(p.ws + WS_QC) + (size_t)qrow * 512 + (h * 2) * 64 + 8 * (lane >> 4), kv, o, linv, smem);
  const float lam = ((const float*)(p.ws + WS_MISC))[l];
  const float li0 = linv[0], l1 = linv[1] * lam;
  float ss = 0.f;
#pragma unroll
  for (int d = 0; d < 6; ++d)
#pragma unroll
    for (int r = 0; r < 4; ++r) { const float v = o[0][d][r] * li0 - o[1][d][r] * l1; o[0][d][r] = v; ss += v * v; }
  ss += __shfl_xor(ss, 16); ss += __shfl_xor(ss, 32);
  const float sc = rsqrtf(ss * (1.f / 96.f) + EPSN) * (1.f - p.lam_init[l]);
  const float* g = p.in[24] + l * 96 + 4 * (lane >> 4);
  bf16_t* dst = (bf16_t*)(p.ws + WS_MIX) + (size_t)qrow * 1024 + 640 + h * 96 + 4 * (lane >> 4);
#pragma unroll
  for (int d = 0; d < 6; ++d) {
    const float4 gg = *(const float4*)(g + 16 * d);
    uint2 w; w.x = pack2(o[0][d][0] * sc * gg.x, o[0][d][1] * sc * gg.y); w.y = pack2(o[0][d][2] * sc * gg.z, o[0][d][3] * sc * gg.w);
    *(uint2*)(dst + 16 * d) = w;
  }
}

DI void gla_item(const Params& p, int l, bool ctx, int b, int h, int c, char* smem) {
  const int tid = otid();
  const int seq0 = ctx ? b * 256 : NCTX + b * 2048;
  const int nch = ctx ? 4 : 32;
  const int row0 = seq0 + c * 64, tt0 = seq0 >> 6, tt = tt0 + c;
  const bf16_t* PR = (const bf16_t*)(p.ws + WS_PROJ);
  const float* GB = (const float*)(p.ws + WS_GB); const float* ATOT = (const float*)(p.ws + WS_ATOT); const float* U = (const float*)(p.ws + WS_U);
  float* qd = (float*)smem;
  float* kd = qd + 64 * 36;
  float* vv = kd + 64 * 36;
  float* S = vv + 4096;
  float* sc = S + 2048;
  const int ib = tid >> 4, xb = tid & 15, i0 = ib * 4, x0 = xb * 4;
  float o[4][4];
#pragma unroll
  for (int a = 0; a < 4; ++a)
#pragma unroll
    for (int e = 0; e < 4; ++e) o[a][e] = 0.f;
  for (int s = 0; s < 2; ++s) {
    {
      const int j = tid >> 2, part = tid & 3, kk = h * 32 + part * 8;
      const size_t prow = (size_t)(row0 + j) * PW;
      const uint4 qraw = *(const uint4*)(PR + prow + OFF_BQ + kk), kraw = *(const uint4*)(PR + prow + OFF_BK + kk);
      const float* gbp = GB + (size_t)(row0 + j) * 256 + s * 128 + kk;
      const float* ttp = ATOT + 192 * 256 + tt * 256 + s * 128 + kk;
      const float4 g0 = *(const float4*)gbp, g1 = *(const float4*)(gbp + 4), t0 = *(const float4*)ttp, t1 = *(const float4*)(ttp + 4);
      uint4 vraw0 = make_uint4(0, 0, 0, 0), vraw1 = vraw0;
      if (s == 0) { vraw0 = *(const uint4*)(PR + prow + OFF_BV + h * 64 + part * 16); vraw1 = *(const uint4*)(PR + prow + OFF_BV + h * 64 + part * 16 + 8); }
      float qv[8], kv[8]; unpack8(qraw, qv); unpack8(kraw, kv);
      const float cum[8] = {t0.x - g0.x, t0.y - g0.y, t0.z - g0.z, t0.w - g0.w, t1.x - g1.x, t1.y - g1.y, t1.z - g1.z, t1.w - g1.w};
      float qo[8], ko[8];
#pragma unroll
      for (int e = 0; e < 8; ++e) { qo[e] = qv[e] * 0.17677669529663687f * fast_exp2(cum[e] * LOG2E); ko[e] = kv[e] * fast_exp2(-cum[e] * LOG2E); }
      float* qp = qd + j * 36 + part * 8; float* kp = kd + j * 36 + part * 8;
      *(float4*)qp = make_float4(qo[0], qo[1], qo[2], qo[3]); *(float4*)(qp + 4) = make_float4(qo[4], qo[5], qo[6], qo[7]);
      *(float4*)kp = make_float4(ko[0], ko[1], ko[2], ko[3]); *(float4*)(kp + 4) = make_float4(ko[4], ko[5], ko[6], ko[7]);
      if (s == 0) {
        float x[16]; unpack8(vraw0, x); unpack8(vraw1, x + 8);
        float* vp = vv + j * 64 + part * 16;
#pragma unroll
        for (int e = 0; e < 4; ++e) *(float4*)(vp + 4 * e) = make_float4(x[4 * e], x[4 * e + 1], x[4 * e + 2], x[4 * e + 3]);
      }
    }
    {
      const int d = tid >> 3, v0 = (tid & 7) * 8;
      float S8[8];
      if (ctx) {
#pragma unroll
        for (int e = 0; e < 8; ++e) S8[e] = 0.f;
      } else {
        const float* s0 = p.in[7] + ((((size_t)b * 4 + l) * 2 + s) * 4 + h) * 2048 + d * 64 + v0;
        const float4 a = *(const float4*)s0, bq = *(const float4*)(s0 + 4);
        S8[0] = a.x; S8[1] = a.y; S8[2] = a.z; S8[3] = a.w; S8[4] = bq.x; S8[5] = bq.y; S8[6] = bq.z; S8[7] = bq.w;
      }
      const int nfold = s == 0 ? c : nch - 1 - c;
#pragma unroll 8
      for (int f = 0; f < nfold; ++f) {
        const int t2 = s == 0 ? tt0 + f : tt0 + nch - 1 - f;
        const float a = ATOT[t2 * 256 + s * 128 + h * 32 + d];
        const float* u = U + (((size_t)t2 * 2 + s) * 4 + h) * 2048 + d * 64 + v0;
        const float4 u0 = *(const float4*)u, u1 = *(const float4*)(u + 4);
        S8[0] = a * S8[0] + u0.x; S8[1] = a * S8[1] + u0.y; S8[2] = a * S8[2] + u0.z; S8[3] = a * S8[3] + u0.w;
        S8[4] = a * S8[4] + u1.x; S8[5] = a * S8[5] + u1.y; S8[6] = a * S8[6] + u1.z; S8[7] = a * S8[7] + u1.w;
      }
      *(float4*)(S + d * 64 + v0) = make_float4(S8[0], S8[1], S8[2], S8[3]);
      *(float4*)(S + d * 64 + v0 + 4) = make_float4(S8[4], S8[5], S8[6], S8[7]);
      if (ctx && ((s == 0 && c == nch - 1) || (s == 1 && c == 0))) {
        const float a = ATOT[tt * 256 + s * 128 + h * 32 + d];
        const float* u = U + (((size_t)tt * 2 + s) * 4 + h) * 2048 + d * 64 + v0;
        const float4 u0 = *(const float4*)u, u1 = *(const float4*)(u + 4);
        float* dst = p.out + O_ST + ((((size_t)b * 4 + l) * 2 + s) * 4 + h) * 2048 + d * 64 + v0;
        *(float4*)dst = make_float4(a * S8[0] + u0.x, a * S8[1] + u0.y, a * S8[2] + u0.z, a * S8[3] + u0.w);
        *(float4*)(dst + 4) = make_float4(a * S8[4] + u1.x, a * S8[5] + u1.y, a * S8[6] + u1.z, a * S8[7] + u1.w);
      }
    }
    __syncthreads();
    {
      float a4[4][4];
#pragma unroll
      for (int a = 0; a < 4; ++a)
#pragma unroll
        for (int e = 0; e < 4; ++e) a4[a][e] = 0.f;
#pragma unroll 2
      for (int d4 = 0; d4 < 8; ++d4) {
        float4 q4[4], k4[4];
#pragma unroll
        for (int a = 0; a < 4; ++a) { q4[a] = *(const float4*)(qd + (i0 + a) * 36 + 4 * d4); k4[a] = *(const float4*)(kd + (x0 + a) * 36 + 4 * d4); }
#pragma unroll
        for (int a = 0; a < 4; ++a)
#pragma unroll
          for (int e = 0; e < 4; ++e) a4[a][e] += q4[a].x * k4[e].x + q4[a].y * k4[e].y + q4[a].z * k4[e].z + q4[a].w * k4[e].w;
      }
#pragma unroll
      for (int a = 0; a < 4; ++a) {
        float r4[4];
#pragma unroll
        for (int e = 0; e < 4; ++e) { const int i = i0 + a, j = x0 + e; const bool keep = (s == 0) ? (j <= i) : (j >= i); r4[e] = keep ? a4[a][e] : 0.f; }
        *(float4*)(sc + (i0 + a) * 68 + x0) = make_float4(r4[0], r4[1], r4[2], r4[3]);
      }
    }
    __syncthreads();
    {
#pragma unroll 2
      for (int j = 0; j < 64; j += 4) {
        float4 s4[4], v4[4];
#pragma unroll
        for (int a = 0; a < 4; ++a) { s4[a] = *(const float4*)(sc + (i0 + a) * 68 + j); v4[a] = *(const float4*)(vv + (j + a) * 64 + x0); }
#pragma unroll
        for (int a = 0; a < 4; ++a) {
          o[a][0] += s4[a].x * v4[0].x + s4[a].y * v4[1].x + s4[a].z * v4[2].x + s4[a].w * v4[3].x;
          o[a][1] += s4[a].x * v4[0].y + s4[a].y * v4[1].y + s4[a].z * v4[2].y + s4[a].w * v4[3].y;
          o[a][2] += s4[a].x * v4[0].z + s4[a].y * v4[1].z + s4[a].z * v4[2].z + s4[a].w * v4[3].z;
          o[a][3] += s4[a].x * v4[0].w + s4[a].y * v4[1].w + s4[a].z * v4[2].w + s4[a].w * v4[3].w;
        }
      }
#pragma unroll 2
      for (int d = 0; d < 32; d += 4) {
        float4 q4[4], v4[4];
#pragma unroll
        for (int a = 0; a < 4; ++a) { q4[a] = *(const float4*)(qd + (i0 + a) * 36 + d); v4[a] = *(const float4*)(S + (d + a) * 64 + x0); }
#pragma unroll
        for (int a = 0; a < 4; ++a) {
          o[a][0] += q4[a].x * v4[0].x + q4[a].y * v4[1].x + q4[a].z * v4[2].x + q4[a].w * v4[3].x;
          o[a][1] += q4[a].x * v4[0].y + q4[a].y * v4[1].y + q4[a].z * v4[2].y + q4[a].w * v4[3].y;
          o[a][2] += q4[a].x * v4[0].z + q4[a].y * v4[1].z + q4[a].z * v4[2].z + q4[a].w * v4[3].z;
          o[a][3] += q4[a].x * v4[0].w + q4[a].y * v4[1].w + q4[a].z * v4[2].w + q4[a].w * v4[3].w;
        }
      }
    }
    __syncthreads();
  }
  const float4 gg = *(const float4*)(p.in[20] + l * 64 + x0);
#pragma unroll
  for (int a = 0; a < 4; ++a) {
    float ss = o[a][0] * o[a][0] + o[a][1] * o[a][1] + o[a][2] * o[a][2] + o[a][3] * o[a][3];
    ss += __shfl_xor(ss, 1); ss += __shfl_xor(ss, 2); ss += __shfl_xor(ss, 4); ss += __shfl_xor(ss, 8);
    const float rstd = rsqrtf(ss * (1.f / 64.f) + EPSN);
    const size_t row = row0 + i0 + a;
    float br[4]; unpack4(*(const uint2*)(PR + row * PW + OFF_BR + h * 64 + x0), br);
    uint2 w;
    w.x = pack2(o[a][0] * rstd * gg.x * sigm_silu_acc(br[0]), o[a][1] * rstd * gg.y * sigm_silu_acc(br[1]));
    w.y = pack2(o[a][2] * rstd * gg.z * sigm_silu_acc(br[2]), o[a][3] * rstd * gg.w * sigm_silu_acc(br[3]));
    *(uint2*)((bf16_t*)(p.ws + WS_MIX) + row * 1024 + 384 + h * 64 + x0) = w;
  }
}

DI void mixer_phase(const Params& p, int l, int cidx, char* smem) {
  unsigned* ctr = (unsigned*)(p.ws + WS_MISC + 64) + cidx;
  extern __shared__ __attribute__((aligned(16))) char dsm[];
  LDSP int* sidx = (LDSP int*)(dsm + 131072 + 16);
  constexpr int M_CL = PROBE == 21 ? 2 : 1, M_AL = PROBE == 22 ? 2 : 1, M_GL = PROBE == 23 ? 2 : 1, M_CC = PROBE == 24 ? 2 : 1, M_AC = PROBE == 25 ? 2 : 1, M_GC = PROBE == 26 ? 2 : 1;
  constexpr int N_CL = 256 * M_CL, N_AL = 384 * M_AL, N_GL = 256 * M_GL, N_CC = 512 * M_CC, N_AC = 768 * M_AC, N_GC = 512 * M_GC;
  constexpr int E0 = N_CL, E1 = E0 + N_AL, E2 = E1 + N_GL, E3 = E2 + N_CC, E4 = E3 + N_AC, E5 = E4 + N_GC;
  for (;;) {
    __syncthreads();
    if (threadIdx.x == 0) *sidx = (int)atomicAdd(ctr, 2u);
    __syncthreads();
    const int it = *sidx + ohalf();
    if (it >= E5) break;
    int typ, r; bool ctx;
    if (it < E0) { typ = 0; r = (it) % 256; ctx = false; }
    else if (it < E1) { typ = 1; r = (it - E0) % 384; ctx = false; }
    else if (it < E2) { typ = 2; r = (it - E1) % 256; ctx = false; }
    else if (it < E3) { typ = 0; r = (it - E2) % 512; ctx = true; }
    else if (it < E4) { typ = 1; r = (it - E3) % 768; ctx = true; }
    else { typ = 2; r = (it - E4) % 512; ctx = true; }
    const int sh = ctx ? 2 : 5, nq = 1 << sh;
    const int sub = r & (nq - 1), bh = r >> sh;
    if (typ == 0) attn_c_item(p, l, ctx, bh >> 2, bh & 3, sub, smem);
    else if (typ == 1) attn_a_item(p, l, ctx, bh / 6, bh % 6, sub, smem);
    else gla_item(p, l, ctx, bh >> 2, bh & 3, sub, smem);
  }
}

constexpr int DYN_LDS = 131072 + 64;
typedef const __attribute__((address_space(4))) Params* ParamsK;
DI ParamsK kparams() { ParamsK q = (ParamsK)__builtin_amdgcn_kernarg_segment_ptr(); asm volatile("" : "+s"(q)); return q; }
__global__ void __launch_bounds__(512, 2) fwd_megakernel(Params p_unused) {
  extern __shared__ __attribute__((aligned(16))) char dsm[];
  cg::grid_group grid = cg::this_grid();
  if (gridDim.y == 2) grid.sync();
  const Params& p = *(const Params*)kparams();
  volatile LDSP unsigned* xbw = (volatile LDSP unsigned*)(dsm + 131072);
  if (threadIdx.x == 0) { xbw[0] = 0u; xbw[1] = 0u; xbw[2] = 0u; xbw[3] = 0u; }
  __syncthreads();
  const XcdBarrier xb = xcd_barrier_post((unsigned*)(p.ws + WS_BAR), xbw);
  char* smem = dsm + ohalf() * 65536;
  phase0(p, (float*)smem);
  xcd_barrier(xb);
#pragma unroll 1
  for (int ph = 0; ph < 44; ++ph) {
    const int l = ph / 11, q = ph - l * 11;
    const Params& p = *(const Params*)kparams();
    const float* mod = (const float*)(p.ws + WS_MOD);
    const bf16_t* H = (const bf16_t*)(p.ws + WS_H);
    const bf16_t* ACT = (const bf16_t*)(p.ws + WS_ACT);
    const bf16_t* MIX = (const bf16_t*)(p.ws + WS_MIX);
    const float* modl = mod + (size_t)l * 3 * 9216;
    int nrep = 1;
#if PROBE
    if (PROBE == 1) nrep = (q == 1 || q == 9 || q == 2 || q == 10 || q == 7 || q == 4) ? 2 : 1;
    if (PROBE == 2) nrep = (q == 6) ? 2 : 1;
    if (PROBE == 3) nrep = (q == 5) ? 2 : 1;
    if (PROBE == 4) nrep = (q == 0 || q == 3 || q == 8) ? 2 : 1;
    if (PROBE == 5) nrep = 2;
#endif
#pragma unroll 1
    for (int rep = 0; rep < nrep; ++rep) {
#if PROBE == 5
    if (rep == 1) { xcd_barrier(xb); xcd_barrier(xb); xcd_barrier(xb); continue; }
#endif
    if (q == 3 || q == 8 || (q == 0 && l > 0)) continue;
    const float* RS = (const float*)(p.ws + WS_ROWSS);
    const float* BIAS = (const float*)(p.ws + WS_BIAS);
    if (q == 0) {
      norm0_bias_phase(p);
    } else if (q == 1 || q == 9) {
      const int f = q == 1 ? 0 : 1;
      { EpiSwiglu E; E.ACT = (bf16_t*)(p.ws + WS_ACT); E.RS = RS; E.bias = BIAS + (size_t)(l * 3 + (f ? 2 : 0)) * 3 * 5632;
        gemm8_run(H, (const bf16_t*)(p.ws + WS_WGU) + (size_t)(l * 2 + f) * 5632 * 1024, 5632, 1024, E, dsm); }
      if (l < 3 && rep == 0 && blockIdx.x >= 32) convert_slice(p, l + 1, f * 1344, f * 1344 + 1344, 32, (float*)smem);
    } else if (q == 2 || q == 10 || q == 7) {
      const bf16_t* A; const bf16_t* Bt; int lda, K; const float* gb; float coef; int nl, nsub;
      if (q == 7) { A = MIX; lda = 1024; K = 1024; Bt = (const bf16_t*)(p.ws + WS_WOUT) + (size_t)l * 1024 * 1024; gb = modl + 5 * 1024; coef = 1.0f; nl = l; nsub = 2; }
      else { const int f = q == 2 ? 0 : 1; A = ACT; lda = DFF; K = DFF; Bt = (const bf16_t*)(p.ws + WS_WD) + (size_t)(l * 2 + f) * 1024 * 2816; gb = modl + (f == 0 ? 2 : 8) * 1024; coef = 0.5f;
             nl = f == 0 ? l : l + 1; nsub = f == 0 ? 1 : 0; }
      (void)lda;
      if (l < 3 && rep == 0 && q == 10 && blockIdx.x >= 192) bias_from_f32(p, l + 1, dsm);
      { EpiResid E; E.X = p.out; E.gate_base = gb; E.coef = rep ? 0.f : coef; E.H = (bf16_t*)(p.ws + WS_H); E.RS = (float*)(p.ws + WS_ROWSS);
        E.nxt_g = nl < 4 ? p.in[11] + (nl * 3 + nsub) * 1024 : nullptr; E.nxt_scale = mod + (size_t)(nl < 4 ? nl : 0) * 3 * 9216 + (3 * nsub + 1) * 1024;
        gemm8_run(A, Bt, 1024, K, E, dsm); }
    } else if (q == 4) {
      { EpiProj E; E.PR = (bf16_t*)(p.ws + WS_PROJ); E.RS = RS; E.bias = BIAS + (size_t)(l * 3 + 1) * 3 * 5632;
        gemm8_run(H, (const bf16_t*)(p.ws + WS_WIN) + (size_t)l * PWR * 1024, PWP, 1024, E, dsm); }
    } else if (q == 5) {
      prep_phase(p, l, smem);
    } else {
      mixer_phase(p, l, l + 4 * rep, smem);
    }
    xcd_barrier(xb);
    }
  }
}

extern "C" void kernel_launch(void* const* d_in, const int* in_sizes, int n_in,
                              void* d_out, int out_size, void* d_ws, size_t ws_size,
                              hipStream_t stream) {
  static int grid_blocks = 0;
  if (!grid_blocks) {
    int dev = 0, cus = 0, per_cu = 0;
    (void)hipGetDevice(&dev);
    (void)hipDeviceGetAttribute(&cus, hipDeviceAttributeMultiprocessorCount, dev);
    (void)hipFuncSetAttribute((const void*)fwd_megakernel, hipFuncAttributeMaxDynamicSharedMemorySize, DYN_LDS);
    (void)hipOccupancyMaxActiveBlocksPerMultiprocessor(&per_cu, fwd_megakernel, 512, DYN_LDS);
    if (per_cu < 1) per_cu = 1;
    grid_blocks = cus;
    grid_blocks -= grid_blocks % 8;
  }
  Params p{};
  for (int i = 0; i < 26; ++i) p.in[i] = (const float*)d_in[i];
  p.out = (float*)d_out;
  p.ws = (char*)d_ws;
  for (int i = 0; i < 16; ++i) p.freqA[i] = powf(10000.0f, -(float)i / 16.0f);
  for (int i = 0; i < 12; ++i) p.freqC[i] = powf(10000.0f, -(float)i / 12.0f);
  for (int l = 0; l < 4; ++l) p.lam_init[l] = (float)(0.8 - 0.6 * exp(-0.3 * l));
  (void)hipMemsetAsync((char*)d_ws + WS_BAR, 0, XCD_BAR_WORDS_C * 4, stream);
  void* args[] = {&p};
  hipError_t e = hipLaunchCooperativeKernel((void*)fwd_megakernel, dim3(grid_blocks), dim3(512), args, DYN_LDS, stream);
  if (e != hipSuccess) fprintf(stderr, "cooperative launch failed: %s (grid %d)\n", hipGetErrorString(e), grid_blocks);
}
```

```cpp
#include <hip/hip_runtime.h>
#include <hip/hip_cooperative_groups.h>
#include <cstdio>
#include <cmath>
namespace cg = cooperative_groups;
#ifndef PROBE
#define PROBE 0
#endif

typedef unsigned short bf16_t;
typedef short bf16x8 __attribute__((ext_vector_type(8)));
typedef short s16x4 __attribute__((ext_vector_type(4)));
typedef float f32x4 __attribute__((ext_vector_type(4)));
#define LDSP __attribute__((address_space(3)))
#define DI __device__ __forceinline__

constexpr int DM = 1024, DFF = 2816, NTOK = 12288, NCTX = 8192, PW = 2560, PWP = 2560, PWR = 2592;
constexpr int OFF_AQ = 0, OFF_AK = 384, OFF_AV = 512, OFF_BQ = 640, OFF_BK = 768, OFF_BV = 896,
              OFF_BR = 1152, OFF_CQ = 1408, OFF_CK = 1792, OFF_CV = 2176, OFF_BGW = 2560;
constexpr float EPSN = 1e-6f;
constexpr float LOG2E = 1.4426950408889634f;
constexpr size_t O_YP = 0, O_YS = 8388608, O_AK = 12582912, O_AV = 16777216, O_CK = 20971520, O_CV = 33554432, O_ST = 46137344;

constexpr size_t XCD_BAR_WORDS_C = 3456;
constexpr size_t al256(size_t x) { return (x + 255) & ~(size_t)255; }
constexpr size_t WS_MOD = 0;
constexpr size_t WS_MISC = al256(WS_MOD + 4ull * 3 * 9216 * 4);
constexpr size_t WS_ROPE = WS_MISC + 256;
constexpr size_t WS_WGU = al256(WS_ROPE + (1024 * 2 + 768 * 2) * 4);
constexpr size_t WS_WD = WS_WGU + 8ull * 5632 * 1024 * 2;
constexpr size_t WS_WIN = WS_WD + 8ull * 1024 * 2816 * 2;
constexpr size_t WS_WOUT = WS_WIN + 4ull * PWR * 1024 * 2;
constexpr size_t WS_H = WS_WOUT + 4ull * 1024 * 1024 * 2;
constexpr size_t WS_MIX = WS_H + (size_t)NTOK * 1024 * 2;
constexpr size_t WS_ACT = WS_MIX + (size_t)NTOK * 1024 * 2;
constexpr size_t WS_PROJ = WS_ACT + (size_t)NTOK * DFF * 2;
constexpr size_t WS_QA = WS_PROJ + (size_t)NTOK * PW * 2;
constexpr size_t WS_KA = WS_QA + (size_t)NTOK * 384 * 2;
constexpr size_t WS_QC = WS_KA + (size_t)NTOK * 128 * 2;
constexpr size_t WS_KC = WS_QC + (size_t)NTOK * 512 * 2;
constexpr size_t WS_GB = WS_KC + (size_t)NTOK * 512 * 2;
constexpr size_t WS_ATOT = WS_GB + (size_t)NTOK * 256 * 4;
constexpr size_t WS_U = WS_ATOT + 2 * 192ull * 256 * 4;
constexpr size_t WS_KAC = WS_U + 192ull * 2 * 4 * 2048 * 4;
constexpr size_t WS_VAC = WS_KAC + 2ull * 4 * 512 * 128 * 2;
constexpr size_t WS_KCC = WS_VAC + 2ull * 4 * 512 * 128 * 2;
constexpr size_t WS_VCC = WS_KCC + 2ull * 4 * 512 * 512 * 2;
constexpr size_t WS_BAR = WS_VCC + 2ull * 4 * 512 * 384 * 2;
constexpr size_t WS_ROWSS = al256(WS_BAR + XCD_BAR_WORDS_C * 4);
constexpr size_t WS_BIAS = WS_ROWSS + (size_t)NTOK * 16 * 4;
constexpr size_t WS_END = WS_BIAS + 4ull * 3 * 3 * 5632 * 4;

struct Params {
  const float* in[26];
  float* out;
  char* ws;
  float freqA[16];
  float freqC[12];
  float lam_init[4];
};

DI float bf2f(bf16_t v) { return __uint_as_float(((unsigned)v) << 16); }
DI bf16_t f2bf(float f) { unsigned u = __float_as_uint(f); u += 0x7fffu + ((u >> 16) & 1u); return (bf16_t)(u >> 16); }
typedef float f32x2_t __attribute__((ext_vector_type(2)));
typedef __bf16 bf16x2_t __attribute__((ext_vector_type(2)));
DI unsigned pack2(float lo, float hi) { const f32x2_t v = {lo, hi}; return __builtin_bit_cast(unsigned, __builtin_convertvector(v, bf16x2_t)); }
DI float fast_exp2(float x) { return __builtin_amdgcn_exp2f(x); }
DI float fast_rcp(float x) { return __builtin_amdgcn_rcpf(x); }
DI float silu_f(float g) { return g * fast_rcp(1.f + fast_exp2(-g * LOG2E)); }
DI float sigm_silu_acc(float g) { return g / (1.f + expf(-g)); }
DI void unpack8(uint4 v, float* x) {
  x[0] = __uint_as_float(v.x << 16); x[1] = __uint_as_float(v.x & 0xffff0000u);
  x[2] = __uint_as_float(v.y << 16); x[3] = __uint_as_float(v.y & 0xffff0000u);
  x[4] = __uint_as_float(v.z << 16); x[5] = __uint_as_float(v.z & 0xffff0000u);
  x[6] = __uint_as_float(v.w << 16); x[7] = __uint_as_float(v.w & 0xffff0000u);
}
DI void unpack4(uint2 v, float* x) {
  x[0] = __uint_as_float(v.x << 16); x[1] = __uint_as_float(v.x & 0xffff0000u);
  x[2] = __uint_as_float(v.y << 16); x[3] = __uint_as_float(v.y & 0xffff0000u);
}
DI int otid() { int t = threadIdx.x & 255; asm volatile("" : "+v"(t)); return t; }
DI int ohalf() { return __builtin_amdgcn_readfirstlane((int)(threadIdx.x >> 8)); }
DI int obid() { int b = blockIdx.x * 2 + ohalf(); asm volatile("" : "+s"(b)); return b; }
DI int vnb() { return gridDim.x * 2; }
DI int rtid() { int t = threadIdx.x; asm volatile("" : "+v"(t)); return t; }
DI int cond_of_row(int row) { return row < NCTX ? 0 : 1 + ((row - NCTX) >> 11); }


#define XB_TMO      128
#define XB_XCNT(j)  (256  + 64 * (j))
#define XB_XSUB(j)  (1280 + 64 * (j))
#define XB_XGEN(j)  (2304 + 64 * (j))
#define XB_TOP      3328
#define XB_TOPGEN   3392
#define XCD_BAR_WORDS 3456
#define XB_SPIN_CAP (1u << 22)
DI unsigned xb_ld(unsigned* p) { return __hip_atomic_load(p, __ATOMIC_RELAXED, __HIP_MEMORY_SCOPE_AGENT); }
DI unsigned xb_add(unsigned* p, unsigned v) { return __hip_atomic_fetch_add(p, v, __ATOMIC_RELAXED, __HIP_MEMORY_SCOPE_AGENT); }
DI unsigned xb_xcc_id() { return (unsigned)__builtin_amdgcn_s_getreg((3 << 11) | 20) & 0xFu; }
#define XB_SPIN(cond, bar) do { unsigned _sp = 0; while (cond) { __builtin_amdgcn_s_sleep(1); \
    if ((++_sp & 255u) == 0u) { if (xb_ld(&(bar)[XB_TMO])) break; if (_sp > XB_SPIN_CAP) { atomicAdd(&(bar)[XB_TMO], 1u); break; } } } } while (0)
struct XcdBarrier { unsigned* bar; unsigned x; volatile LDSP unsigned* st; };
DI XcdBarrier xcd_barrier_post(unsigned* bar, volatile LDSP unsigned* st) {
  XcdBarrier b; b.bar = bar; b.x = xb_xcc_id(); b.st = st;
  if (threadIdx.x == 0) (void)xb_add(&bar[XB_XCNT(b.x)], 1u);
  return b;
}
DI void xcd_barrier_complete(unsigned* bar, unsigned x, unsigned& nloc, unsigned& nx) {
  const unsigned G = gridDim.x * gridDim.y * gridDim.z;
  unsigned sum, cnt, mine, sp = 0u;
  for (;;) {
    sum = 0u; cnt = 0u; mine = 0u;
#pragma unroll
    for (unsigned j = 0; j < 16; ++j) { const unsigned c = xb_ld(&bar[XB_XCNT(j)]); sum += c; cnt += (c > 0u) ? 1u : 0u; mine = (j == x) ? c : mine; }
    if (sum == G) break;
    __builtin_amdgcn_s_sleep(1);
    if ((++sp & 255u) == 0u) { if (xb_ld(&bar[XB_TMO])) break; if (sp > XB_SPIN_CAP) { atomicAdd(&bar[XB_TMO], 1u); break; } }
  }
  nloc = mine > 0u ? mine : 1u; nx = cnt > 0u ? cnt : 1u;
}
DI void xcd_barrier(const XcdBarrier& b_) {
  asm volatile("s_waitcnt vmcnt(0)" ::: "memory");
  __syncthreads();
  if (threadIdx.x == 0) {
    XcdBarrier b; b.st = b_.st;
    { unsigned* q = b_.bar; asm volatile("" : "+s"(q)); b.bar = q; }
    { unsigned xx = xb_xcc_id(); asm volatile("" : "+s"(xx)); b.x = xx; }
    unsigned* bar = b.bar;
    __builtin_amdgcn_s_waitcnt(0);
    unsigned nloc = b.st[0], nx = b.st[1];
    if (nloc == 0u) { xcd_barrier_complete(bar, b.x, nloc, nx); b.st[0] = nloc; b.st[1] = nx; }
    const unsigned old = xb_add(&bar[XB_XSUB(b.x)], 1u);
    const unsigned gen = old / nloc;
    if (old + 1u == (gen + 1u) * nloc) {
      __builtin_amdgcn_fence(__ATOMIC_RELEASE, "agent");
      asm volatile("s_waitcnt vmcnt(0)" ::: "memory");
      const unsigned og = xb_add(&bar[XB_TOP], 1u);
      const unsigned tg = og / nx;
      if (og + 1u == (tg + 1u) * nx) xb_add(&bar[XB_TOPGEN], 1u);
      else XB_SPIN(xb_ld(&bar[XB_TOPGEN]) == tg, bar);
      __builtin_amdgcn_fence(__ATOMIC_ACQUIRE, "agent");
      xb_add(&bar[XB_XGEN(b.x)], 1u);
      asm volatile("s_waitcnt vmcnt(0)" ::: "memory");
    } else {
      XB_SPIN(xb_ld(&bar[XB_XGEN(b.x)]) == gen, bar);
      __builtin_amdgcn_fence(__ATOMIC_ACQUIRE, "agent");
      asm volatile("s_waitcnt vmcnt(0)" ::: "memory");
    }
  }
  __syncthreads();
}

DI void transpose_tile(const float* __restrict__ src, int K, int N, bf16_t* __restrict__ dst, int mode, int kt, int nt, float* sm) {
  const int t = otid();
  const int k0 = kt * 64, n0 = nt * 64;
#pragma unroll
  for (int i = 0; i < 4; ++i) {
    const int idx = t + 256 * i, r = idx >> 4, c4 = idx & 15;
    float4 v = make_float4(0.f, 0.f, 0.f, 0.f);
    if (n0 + 4 * c4 < N) v = *(const float4*)(src + (size_t)(k0 + r) * N + n0 + 4 * c4);
    float* d = sm + r * 65 + 4 * c4;
    d[0] = v.x; d[1] = v.y; d[2] = v.z; d[3] = v.w;
  }
  __syncthreads();
#pragma unroll
  for (int i = 0; i < 2; ++i) {
    const int idx = t + 256 * i, nl = idx >> 3, kc = idx & 7;
    const int n = n0 + nl;
    if (n < N) {
      float x[8];
#pragma unroll
      for (int e = 0; e < 8; ++e) x[e] = sm[(8 * kc + e) * 65 + nl];
      uint4 w; w.x = pack2(x[0], x[1]); w.y = pack2(x[2], x[3]); w.z = pack2(x[4], x[5]); w.w = pack2(x[6], x[7]);
      int drow = n;
      if (mode == 1) drow = (n >> 4) * 32 + (n & 15);
      else if (mode == 2) drow = (n >> 4) * 32 + 16 + (n & 15);
      *(uint4*)(dst + (size_t)drow * K + k0 + 8 * kc) = w;
    }
  }
  __syncthreads();
}

DI void adaln_item(const Params& p, int it, float* sm) {
  const int t = otid();
  const int l = it / 72, chunk = it % 72, j0 = chunk * 128;
  float* scond = sm;
  float* red = sm + 3072;
  for (int i = t; i < 3072; i += 256) {
    const int c = i >> 10, k = i & 1023;
    const float v = (c == 0) ? p.in[8][k] : p.in[2][(c - 1) * 1024 + k];
    scond[i] = sigm_silu_acc(v);
  }
  __syncthreads();
  const int cgp = t & 31, kg = t >> 5;
  const float* w = p.in[9] + (size_t)l * 1024 * 9216 + j0 + 4 * cgp;
  float acc[3][4];
#pragma unroll
  for (int c = 0; c < 3; ++c)
#pragma unroll
    for (int e = 0; e < 4; ++e) acc[c][e] = 0.f;
#pragma unroll 8
  for (int kk = 0; kk < 128; ++kk) {
    const int k = kg * 128 + kk;
    const float4 wv = *(const float4*)(w + (size_t)k * 9216);
#pragma unroll
    for (int c = 0; c < 3; ++c) {
      const float s = scond[c * 1024 + k];
      acc[c][0] += s * wv.x; acc[c][1] += s * wv.y; acc[c][2] += s * wv.z; acc[c][3] += s * wv.w;
    }
  }
#pragma unroll
  for (int c = 0; c < 3; ++c)
#pragma unroll
    for (int e = 0; e < 4; ++e) red[(kg * 3 + c) * 128 + 4 * cgp + e] = acc[c][e];
  __syncthreads();
  float* mod = (float*)(p.ws + WS_MOD);
  for (int o = t; o < 384; o += 256) {
    const int c = o >> 7, j = o & 127;
    float s = p.in[10][l * 9216 + j0 + j];
#pragma unroll
    for (int g = 0; g < 8; ++g) s += red[(g * 3 + c) * 128 + j];
    mod[(l * 3 + c) * 9216 + j0 + j] = s;
  }
  __syncthreads();
}

DI void sincos_tab(float pos, float freq, float& cs, float& sn) {
  const double a = (double)pos * (double)freq;
  const double twopi = 6.283185307179586476925286766559;
  const double k = rint(a / twopi);
  const double r = (a - k * twopi) * 0.25;
  const double r2 = r * r;
  double s = r * (1.0 + r2 * (-1.0 / 6 + r2 * (1.0 / 120 + r2 * (-1.0 / 5040 + r2 * (1.0 / 362880 + r2 * (-1.0 / 39916800 + r2 * (1.0 / 6227020800.0)))))));
  double c = 1.0 + r2 * (-0.5 + r2 * (1.0 / 24 + r2 * (-1.0 / 720 + r2 * (1.0 / 40320 + r2 * (-1.0 / 3628800 + r2 * (1.0 / 479001600.0 + r2 * (-1.0 / 87178291200.0)))))));
  double s2 = 2.0 * s * c, c2 = 1.0 - 2.0 * s * s;
  double s4 = 2.0 * s2 * c2, c4 = 1.0 - 2.0 * s2 * s2;
  cs = (float)c4; sn = (float)s4;
}

struct TDesc { const float* src; bf16_t* dst; int K, N, mode, kt, nt; };
DI TDesc tile_desc(const Params& p, int r) {
  TDesc d;
  const int l = r / 5136; r -= l * 5136;
  if (r < 4224) {
    const int f = r / 2112; r -= f * 2112;
    const int which = r / 704; r -= which * 704;
    const int lf = l * 2 + f;
    if (which < 2) { d.src = p.in[which == 0 ? 12 : 13] + (size_t)lf * 1024 * 2816; d.dst = (bf16_t*)(p.ws + WS_WGU) + (size_t)lf * 5632 * 1024; d.K = 1024; d.N = 2816; d.mode = which + 1; d.kt = r / 44; d.nt = r % 44; }
    else { d.src = p.in[14] + (size_t)lf * 2816 * 1024; d.dst = (bf16_t*)(p.ws + WS_WD) + (size_t)lf * 1024 * 2816; d.K = 2816; d.N = 1024; d.mode = 0; d.kt = r / 16; d.nt = r % 16; }
  } else if (r < 4224 + 656) {
    r -= 4224;
    d.src = p.in[15] + (size_t)l * 1024 * PWR; d.dst = (bf16_t*)(p.ws + WS_WIN) + (size_t)l * PWR * 1024; d.K = 1024; d.N = PWR; d.mode = 3; d.kt = r / 41; d.nt = r % 41;
  } else {
    r -= 4224 + 656;
    d.src = p.in[25] + (size_t)l * 1024 * 1024; d.dst = (bf16_t*)(p.ws + WS_WOUT) + (size_t)l * 1024 * 1024; d.K = 1024; d.N = 1024; d.mode = 0; d.kt = r / 16; d.nt = r % 16;
  }
  return d;
}
DI void tile_load(const TDesc& d, int t, f32x4 (&v)[4]) {
  const int k0 = d.kt * 64, n0 = d.nt * 64;
#pragma unroll
  for (int i = 0; i < 4; ++i) {
    const int idx = t + 256 * i, r = idx >> 4, c4 = idx & 15;
    v[i] = (f32x4){0.f, 0.f, 0.f, 0.f};
    if (n0 + 4 * c4 < d.N) v[i] = __builtin_nontemporal_load((const f32x4*)(d.src + (size_t)(k0 + r) * d.N + n0 + 4 * c4));
  }
}
DI void tile_store(const TDesc& d, int t, const f32x4 (&v)[4], float* sm) {
  const int k0 = d.kt * 64, n0 = d.nt * 64;
#pragma unroll
  for (int i = 0; i < 4; ++i) {
    const int idx = t + 256 * i, r = idx >> 4, c4 = idx & 15;
    float* q = sm + r * 65 + 4 * c4;
    q[0] = v[i][0]; q[1] = v[i][1]; q[2] = v[i][2]; q[3] = v[i][3];
  }
  __syncthreads();
#pragma unroll
  for (int i = 0; i < 2; ++i) {
    const int idx = t + 256 * i, nl = idx >> 3, kc = idx & 7;
    const int n = n0 + nl;
    if (n < d.N) {
      float x[8];
#pragma unroll
      for (int e = 0; e < 8; ++e) x[e] = sm[(8 * kc + e) * 65 + nl];
      uint4 w; w.x = pack2(x[0], x[1]); w.y = pack2(x[2], x[3]); w.z = pack2(x[4], x[5]); w.w = pack2(x[6], x[7]);
      int drow = n;
      if (d.mode == 1) drow = (n >> 7) * 256 + (n & 127);
      else if (d.mode == 2) drow = (n >> 7) * 256 + 128 + (n & 127);
      else if (d.mode == 3) drow = n < 1152 ? n : (n < 1184 ? OFF_BGW + (n - 1152) : n - 32);
      *(uint4*)(d.dst + (size_t)drow * d.K + k0 + 8 * kc) = w;
    }
  }
  __syncthreads();
}

DI void convert_slice(const Params& p, int layer, int t_begin, int t_end, int first_blk, float* sm) {
  const int t = otid();
  const int nworkers = (gridDim.x - first_blk) * 2, w = (blockIdx.x - first_blk) * 2 + ohalf();
  int r = t_begin + w;
  f32x4 cur[4], nxt[4];
  TDesc dc = tile_desc(p, layer * 5136 + (r < t_end ? r : t_begin));
  if (r < t_end) tile_load(dc, t, cur);
#pragma unroll 1
  for (; r < t_end; r += nworkers) {
    const int rn = r + nworkers;
    TDesc dn = tile_desc(p, layer * 5136 + (rn < t_end ? rn : t_begin));
    if (rn < t_end) tile_load(dn, t, nxt);
    tile_store(dc, t, cur, sm);
    dc = dn;
#pragma unroll
    for (int i = 0; i < 4; ++i) cur[i] = nxt[i];
  }
}
DI void bias_from_f32(const Params& p, int layer, char* dsm) {
  const int tx = rtid(), lane = tx & 63, kc = tx >> 6;
  float* shl = (float*)dsm;
  float* red = shl + 3072;
  const float* mod = (const float*)(p.ws + WS_MOD);
  float* BIAS = (float*)(p.ws + WS_BIAS);
  const int nidle = gridDim.x - 192, me = blockIdx.x - 192;
#pragma unroll 1
  for (int task = me; task < 55; task += nidle) {
    const int mi = task / 11, ch = task - mi * 11;
    const int sub = mi < 2 ? 0 : (mi == 2 ? 1 : 2);
    const int N = mi == 2 ? PWR : 2816;
    const float* W = mi == 2 ? p.in[15] + (size_t)layer * 1024 * PWR
                             : p.in[(mi == 0 || mi == 3) ? 12 : 13] + (size_t)(layer * 2 + (mi < 2 ? 0 : 1)) * 1024 * 2816;
    __syncthreads();
    for (int i = tx; i < 3072; i += 512) { const int c = i >> 10, k = i & 1023; shl[i] = mod[((size_t)layer * 3 + c) * 9216 + (size_t)(3 * sub) * 1024 + k]; }
    __syncthreads();
    const int n = ch * 256 + lane * 4;
    f32x4 a0 = (f32x4){0.f, 0.f, 0.f, 0.f}, a1 = a0, a2 = a0;
    if (n < N) {
      const float* wp = W + (size_t)(kc * 128) * N + n;
#pragma unroll 8
      for (int i = 0; i < 128; ++i) {
        const f32x4 wv = *(const f32x4*)(wp + (size_t)i * N);
        const int k = kc * 128 + i;
        a0 += wv * shl[k]; a1 += wv * shl[1024 + k]; a2 += wv * shl[2048 + k];
      }
    }
    *(f32x4*)(red + (kc * 3 + 0) * 256 + lane * 4) = a0; *(f32x4*)(red + (kc * 3 + 1) * 256 + lane * 4) = a1; *(f32x4*)(red + (kc * 3 + 2) * 256 + lane * 4) = a2;
    __syncthreads();
    for (int o = tx; o < 768; o += 512) {
      const int c = o >> 8, j = o & 255, nn = ch * 256 + j;
      float s = 0.f;
#pragma unroll
      for (int g = 0; g < 8; ++g) s += red[(g * 3 + c) * 256 + j];
      if (nn < N) {
        int col;
        if (mi == 2) col = nn < 1152 ? nn : (nn < 1184 ? OFF_BGW + (nn - 1152) : nn - 32);
        else col = (nn >> 7) * 256 + (nn & 127) + ((mi == 1 || mi == 4) ? 128 : 0);
        BIAS[((size_t)(layer * 3 + sub) * 3 + c) * 5632 + col] = s;
      }
    }
  }
  __syncthreads();
}

DI void phase0(const Params& p, float* sm) {
  const int nb = vnb(), bid = obid(), t = otid();
#if PROBE == 6
  for (int prep_ = 0; prep_ < 2; ++prep_) {
#endif
  if (bid < 288) adaln_item(p, bid, sm);
  {
    const int n_tiles = 5136 + 3 * 2448;
    auto gid = [](int q) { return q < 5136 ? q : ((q - 5136) / 2448 + 1) * 5136 + 2688 + (q - 5136) % 2448; };
    int r, stride, lim;
    if (nb == 512) { if (bid < 288) { r = bid; stride = 288; lim = 5760; } else { r = 5760 + (bid - 288); stride = 224; lim = n_tiles; } }
    else { r = bid; stride = nb; lim = n_tiles; }
    f32x4 cur[4], nxt[4];
    TDesc dc = tile_desc(p, gid(r < lim ? r : 0));
    if (r < lim) tile_load(dc, t, cur);
#pragma unroll 1
    for (; r < lim; r += stride) {
      const int rn = r + stride;
      TDesc dn = tile_desc(p, gid(rn < lim ? rn : 0));
      if (rn < lim) tile_load(dn, t, nxt);
      tile_store(dc, t, cur, sm);
      dc = dn;
#pragma unroll
      for (int i = 0; i < 4; ++i) cur[i] = nxt[i];
    }
  }
#if PROBE == 6
  }
#endif
  #define gt ((size_t)(blockIdx.x * 512 + rtid()))
  const size_t gs = (size_t)gridDim.x * 512;
  {
    float4* dst = (float4*)p.out;
    const float4* s0 = (const float4*)p.in[0];
    const float4* s1 = (const float4*)p.in[1];
    const size_t n0 = (size_t)NCTX * 256, n1 = (size_t)NTOK * 256;
    for (size_t i = gt; i < n1; i += gs) dst[i] = (i < n0) ? s0[i] : s1[i - n0];
  }
  {
    bf16_t* kac = (bf16_t*)(p.ws + WS_KAC); bf16_t* vac = (bf16_t*)(p.ws + WS_VAC);
    for (size_t i = gt; i < 524288 / 4; i += gs) {
      const float4 a = ((const float4*)p.in[3])[i], b = ((const float4*)p.in[4])[i];
      uint2 wa, wb; wa.x = pack2(a.x, a.y); wa.y = pack2(a.z, a.w); wb.x = pack2(b.x, b.y); wb.y = pack2(b.z, b.w);
      ((uint2*)kac)[i] = wa; ((uint2*)vac)[i] = wb;
    }
    bf16_t* vcc = (bf16_t*)(p.ws + WS_VCC);
    for (size_t i = gt; i < 1572864 / 4; i += gs) {
      const float4 a = ((const float4*)p.in[6])[i];
      uint2 wa; wa.x = pack2(a.x, a.y); wa.y = pack2(a.z, a.w);
      ((uint2*)vcc)[i] = wa;
    }
    bf16_t* kcc = (bf16_t*)(p.ws + WS_KCC);
    for (size_t i = gt; i < 4096ull * 8 * 16; i += gs) {
      const size_t rv = i >> 4; const int g = (int)(i & 15);
      uint2 w = make_uint2(0, 0);
      if (g < 12) { const float4 a = *(const float4*)(p.in[5] + rv * 48 + 4 * g); w.x = pack2(a.x, a.y); w.y = pack2(a.z, a.w); }
      *(uint2*)(kcc + rv * 64 + 4 * g) = w;
    }
  }
  {
    float* rope = (float*)(p.ws + WS_ROPE);
    for (size_t i = gt; i < 1024 + 768; i += gs) {
      if (i < 1024) { const int pos = (int)i >> 4, f = (int)i & 15; float c, s; sincos_tab((float)pos, p.freqA[f], c, s); rope[i] = c; rope[1024 + i] = s; }
      else { const int j = (int)i - 1024; const int pos = j / 12, f = j % 12; float c, s; sincos_tab((float)pos, p.freqC[f], c, s); rope[2048 + j] = c; rope[2048 + 768 + j] = s; }
    }
    if (gt < 4) {
      const float* lc = p.in[23] + gt * 4 * 48;
      float s1 = 0.f, s2 = 0.f;
      for (int d = 0; d < 48; ++d) { s1 += lc[d] * lc[48 + d]; s2 += lc[96 + d] * lc[144 + d]; }
      ((float*)(p.ws + WS_MISC))[gt] = expf(s1) - expf(s2) + p.lam_init[gt];
      ((unsigned*)(p.ws + WS_MISC + 64))[gt] = 0u; ((unsigned*)(p.ws + WS_MISC + 64))[gt + 4] = 0u;
    }
  }
}
#undef gt

DI void norm0_bias_phase(const Params& p) {
  const int tx = rtid(); const int lane = tx & 63;
  const int gw = blockIdx.x * 8 + (tx >> 6), nw = gridDim.x * 8;
  const float* mod = (const float*)(p.ws + WS_MOD);
  {
    const float* g = p.in[11];
    bf16_t* H = (bf16_t*)(p.ws + WS_H);
    float* RS = (float*)(p.ws + WS_ROWSS);
    for (int row = gw; row < NTOK; row += nw) {
      const float* x = p.out + (size_t)row * 1024;
      float4 v[4]; float ss = 0.f;
#pragma unroll
      for (int c = 0; c < 4; ++c) { v[c] = *(const float4*)(x + c * 256 + lane * 4); ss += v[c].x * v[c].x + v[c].y * v[c].y + v[c].z * v[c].z + v[c].w * v[c].w; }
#pragma unroll
      for (int o = 32; o >= 1; o >>= 1) ss += __shfl_xor(ss, o);
      if (lane < 16) RS[(size_t)row * 16 + lane] = lane == 0 ? ss : 0.f;
      const float* mrow = mod + ((size_t)cond_of_row(row)) * 9216;
#pragma unroll
      for (int c = 0; c < 4; ++c) {
        const int j = c * 256 + lane * 4;
        const float4 gg = *(const float4*)(g + j), sc = *(const float4*)(mrow + 1024 + j);
        uint2 w; w.x = pack2(v[c].x * gg.x * (1.f + sc.x), v[c].y * gg.y * (1.f + sc.y)); w.y = pack2(v[c].z * gg.z * (1.f + sc.z), v[c].w * gg.w * (1.f + sc.w));
        *(uint2*)(H + (size_t)row * 1024 + j) = w;
      }
    }
  }
  {
    float* BIAS = (float*)(p.ws + WS_BIAS);
#pragma unroll 1
    for (int grp = 0; grp < 3; ++grp) {
      const int l = grp / 3, sub = grp - l * 3;
      const int ncol = sub == 1 ? PWR : 5632;
      const bf16_t* Wt = sub == 1 ? (const bf16_t*)(p.ws + WS_WIN) + (size_t)l * PWR * 1024 : (const bf16_t*)(p.ws + WS_WGU) + (size_t)(l * 2 + (sub >> 1)) * 5632 * 1024;
      float sh[3][16];
#pragma unroll
      for (int c = 0; c < 3; ++c) {
        const float* sp = mod + ((size_t)l * 3 + c) * 9216 + (size_t)(3 * sub) * 1024 + lane * 16;
#pragma unroll
        for (int q = 0; q < 4; ++q) { const float4 t = *(const float4*)(sp + 4 * q); sh[c][4 * q] = t.x; sh[c][4 * q + 1] = t.y; sh[c][4 * q + 2] = t.z; sh[c][4 * q + 3] = t.w; }
      }
#pragma unroll 2
      for (int n = gw; n < ncol; n += nw) {
        float w[16]; unpack8(*(const uint4*)(Wt + (size_t)n * 1024 + lane * 16), w); unpack8(*(const uint4*)(Wt + (size_t)n * 1024 + lane * 16 + 8), w + 8);
        float d0 = 0.f, d1 = 0.f, d2 = 0.f;
#pragma unroll
        for (int e = 0; e < 16; ++e) { d0 += sh[0][e] * w[e]; d1 += sh[1][e] * w[e]; d2 += sh[2][e] * w[e]; }
#pragma unroll
        for (int o = 32; o >= 1; o >>= 1) { d0 += __shfl_xor(d0, o); d1 += __shfl_xor(d1, o); d2 += __shfl_xor(d2, o); }
        if (lane < 3) BIAS[((size_t)grp * 3 + lane) * 5632 + n] = lane == 0 ? d0 : (lane == 1 ? d1 : d2);
      }
    }
  }
}

enum { EPI_SWIGLU = 0, EPI_RESID = 1, EPI_PROJ = 2 };

template <int EPI>
DI void gemm_phase(const Params& p, const bf16_t* __restrict__ A, int lda, const bf16_t* __restrict__ Bt, int K, int NT,
                   const float* __restrict__ gate_base  , float coef, char* smem) {
  const int tid = otid(), lane = tid & 63, wave = tid >> 6, wm = wave >> 1, wn = wave & 1;
  const int nb = vnb(), xcd = obid() & 7, slot = obid() >> 3, slots = nb >> 3;
  const int per_x = 12 * NT;
  const int nk = K >> 6;
  char* As = smem;
  char* Bs = smem + 32768;
  for (int q = slot; q < per_x; q += slots) {
    const int grp = q / (4 * NT), r = q - grp * 4 * NT, nt = r >> 2, mtl = r & 3, mt = (grp * 4 + mtl) * 8 + xcd;
    const int m0 = mt * 128, n0 = nt * 128;
    f32x4 acc[4][4];
#pragma unroll
    for (int i = 0; i < 4; ++i)
#pragma unroll
      for (int j = 0; j < 4; ++j) acc[i][j] = (f32x4){0.f, 0.f, 0.f, 0.f};
    const bf16_t* Ag = A + (size_t)(m0 + (tid >> 3)) * lda + (tid & 7) * 8;
    const bf16_t* Bg = Bt + (size_t)(n0 + (tid >> 3)) * K + (tid & 7) * 8;
    const int lrow = tid >> 3, lch = tid & 7;
    uint4 ra[4], rb[4];
#pragma unroll
    for (int i = 0; i < 4; ++i) { ra[i] = *(const uint4*)(Ag + (size_t)(32 * i) * lda); rb[i] = *(const uint4*)(Bg + (size_t)(32 * i) * K); }
#pragma unroll
    for (int i = 0; i < 4; ++i) {
      const int row = lrow + 32 * i; const int off = row * 128 + ((lch ^ (row & 7)) << 4);
      *(uint4*)(As + off) = ra[i]; *(uint4*)(Bs + off) = rb[i];
    }
    __syncthreads();
    for (int kt = 0; kt < nk; ++kt) {
      const int cur = kt & 1;
      if (kt + 1 < nk) {
        const int k0 = (kt + 1) * 64;
#pragma unroll
        for (int i = 0; i < 4; ++i) { ra[i] = *(const uint4*)(Ag + (size_t)(32 * i) * lda + k0); rb[i] = *(const uint4*)(Bg + (size_t)(32 * i) * K + k0); }
      }
      const char* as = As + cur * 16384; const char* bs = Bs + cur * 16384;
#pragma unroll
      for (int ks = 0; ks < 2; ++ks) {
        bf16x8 ax[4], bw[4];
        const int ch = ((ks * 4 + (lane >> 4)) ^ (lane & 7)) << 4;
#pragma unroll
        for (int i = 0; i < 4; ++i) {
          ax[i] = *(const bf16x8*)(as + (wm * 64 + i * 16 + (lane & 15)) * 128 + ch);
          bw[i] = *(const bf16x8*)(bs + (wn * 64 + i * 16 + (lane & 15)) * 128 + ch);
        }
#pragma unroll
        for (int mi = 0; mi < 4; ++mi)
#pragma unroll
          for (int ni = 0; ni < 4; ++ni) acc[mi][ni] = __builtin_amdgcn_mfma_f32_16x16x32_bf16(bw[ni], ax[mi], acc[mi][ni], 0, 0, 0);
      }
      if (kt + 1 < nk) {
        const int nxt = cur ^ 1;
#pragma unroll
        for (int i = 0; i < 4; ++i) {
          const int row = lrow + 32 * i; const int off = nxt * 16384 + row * 128 + ((lch ^ (row & 7)) << 4);
          *(uint4*)(As + off) = ra[i]; *(uint4*)(Bs + off) = rb[i];
        }
      }
      __syncthreads();
    }
    const int tok0 = m0 + wm * 64 + (lane & 15);
    const int nc0 = n0 + wn * 64 + (lane >> 4) * 4;
    if (EPI == EPI_SWIGLU) {
      bf16_t* ACT = (bf16_t*)(p.ws + WS_ACT);
#pragma unroll
      for (int mi = 0; mi < 4; ++mi) {
        const size_t rowoff = (size_t)(tok0 + mi * 16) * DFF;
#pragma unroll
        for (int pr = 0; pr < 2; ++pr) {
          const f32x4 g = acc[mi][2 * pr], u = acc[mi][2 * pr + 1];
          const int ffc = ((n0 + wn * 64) >> 1) + pr * 16 + (lane >> 4) * 4;
          uint2 w; w.x = pack2(silu_f(g[0]) * u[0], silu_f(g[1]) * u[1]); w.y = pack2(silu_f(g[2]) * u[2], silu_f(g[3]) * u[3]);
          *(uint2*)(ACT + rowoff + ffc) = w;
        }
      }
    } else if (EPI == EPI_RESID) {
      const float* gv = gate_base + (size_t)cond_of_row(m0) * 9216;
#pragma unroll
      for (int ni = 0; ni < 4; ++ni) {
        const int n = nc0 + ni * 16;
        const float4 gg = *(const float4*)(gv + n);
#pragma unroll
        for (int mi = 0; mi < 4; ++mi) {
          float* xp = p.out + (size_t)(tok0 + mi * 16) * 1024 + n;
          float4 xv = *(const float4*)xp;
          xv.x += coef * gg.x * acc[mi][ni][0]; xv.y += coef * gg.y * acc[mi][ni][1];
          xv.z += coef * gg.z * acc[mi][ni][2]; xv.w += coef * gg.w * acc[mi][ni][3];
          *(float4*)xp = xv;
        }
      }
    } else {
      bf16_t* PR = (bf16_t*)(p.ws + WS_PROJ);
#pragma unroll
      for (int ni = 0; ni < 4; ++ni) {
        const int n = nc0 + ni * 16;
        if (n < PW) {
#pragma unroll
          for (int mi = 0; mi < 4; ++mi) {
            uint2 w; w.x = pack2(acc[mi][ni][0], acc[mi][ni][1]); w.y = pack2(acc[mi][ni][2], acc[mi][ni][3]);
            *(uint2*)(PR + (size_t)(tok0 + mi * 16) * PW + n) = w;
          }
        }
      }
    }
  }
}


namespace pg8 {
#define PG8_LAS __attribute__((address_space(3)))
typedef unsigned short bf16_t;
typedef short bf16x8 __attribute__((ext_vector_type(8)));
typedef float f32x4 __attribute__((ext_vector_type(4)));
typedef unsigned u32x4 __attribute__((ext_vector_type(4)));
constexpr int BM = 256, BK = 64, HALF = 128, HTB = HALF * BK * 2  , STAGE_BYTES = 8 * HTB, NXCD = 8, WGM = 8;

__host__ __device__ __forceinline__ int lds_byte(int r, int c) { const int st = (r >> 4) * 2 + (c >> 5), rr = r & 15, cc = c & 31, ob = rr * 64 + cc * 2; return st * 1024 + (ob ^ (((ob >> 9) & 1) << 5)); }
__host__ __device__ __forceinline__ void stage_rc(int b, int& R, int& C) { const int st = b / 1024, sb = b % 1024, swz = sb ^ (((sb >> 9) & 1) << 5); R = (st >> 1) * 16 + swz / 64; C = (st & 1) * 32 + (swz % 64) / 2; }
__host__ __device__ __forceinline__ int perm32(int rho) { const int n = rho >> 4, i = rho & 15; return 8 * (i >> 2) + 4 * n + (i & 3); }

struct Unit { int pm, pn; };
struct Gemm { const bf16_t* A; const bf16_t* Bt; int M, N, K; };

struct StaticOrder {
    int nM, nN, nwg, G, c;
    __host__ __device__ void init(int M, int N, int G_, int c_) { nM = M / BM; nN = N / BM; nwg = nM * nN; G = G_; c = c_; }
    __host__ __device__ bool next(int i, Unit& u) const {
        const long L = (long)i * G + c; if (L >= nwg) return false;
        int wgid = (int)L; { const int q = nwg / NXCD, r = nwg % NXCD, xcd = wgid % NXCD, off = wgid / NXCD; wgid = (xcd < r ? xcd * (q + 1) : r * (q + 1) + (xcd - r) * q) + off; }
        const int nig = WGM * nN, gid = wgid / nig, fm = gid * WGM, gsz = (nM - fm) < WGM ? (nM - fm) : WGM;
        u.pm = fm + ((wgid % nig) % gsz); u.pn = (wgid % nig) / gsz; return true;
    }
    __device__ __forceinline__ void a_ready(const Unit&) const {}
    __device__ __forceinline__ void done(const Unit&) const {}
};
template <class Epi, class Sched, bool ALIGN_EPI = false, bool SP2 = false>
__device__ __forceinline__ void gemm_phase(PG8_LAS unsigned char* lds, const Gemm g, const Sched& S, const Epi& E) {
    const int tid = rtid(), wid = __builtin_amdgcn_readfirstlane(tid >> 6), lane = tid & 63, wr = wid >> 2, wc = wid & 3, fr = lane & 15, fq = lane >> 4;
    const int K = g.K, nt = K / BK;
    unsigned voffA[2], voffB[2];
#pragma unroll
    for (int i = 0; i < 2; ++i) { int R, C; stage_rc(tid * 16 + i * 8192, R, C); const int Rb = Epi::PERM ? ((R & ~31) + perm32(R & 31)) : R;
        voffA[i] = (unsigned)(R * K + C) * 2u; voffB[i] = (unsigned)(Rb * K + C) * 2u; }
    const size_t kstep = (size_t)(BK * 2);
    const size_t hstep = (size_t)HALF * K * 2;
    const size_t tstep = 2 * hstep;
    const unsigned ldsw = (unsigned)wid * 1024u;
    const int aoff = lds_byte(wr * 64 + fr, fq * 8), boff = lds_byte(wc * 32 + fr, fq * 8);
#define PG8_SA(b, h) (((b) * 2 + (h)) * HTB)
#define PG8_SB(b, h) ((4 + (b) * 2 + (h)) * HTB)
#define PG8_STAGE(bufoff, gbase, voff) do { _Pragma("unroll") for (int _i = 0; _i < 2; ++_i) \
        __builtin_amdgcn_global_load_lds((const unsigned*)((const char*)(gbase) + (voff)[_i]), (PG8_LAS unsigned*)(lds + (bufoff) + ldsw + _i * 8192), 16, 0, 0); } while (0)
#define PG8_LDA(dst, b, h) do { _Pragma("unroll") for (int m = 0; m < 4; ++m) _Pragma("unroll") for (int k = 0; k < 2; ++k) dst[m][k] = *(const PG8_LAS bf16x8*)(lds + PG8_SA(b, h) + aoff + m * 2048 + k * 1024); } while (0)
#define PG8_LDB(dst, b, h) do { _Pragma("unroll") for (int n = 0; n < 2; ++n) _Pragma("unroll") for (int k = 0; k < 2; ++k) dst[n][k] = *(const PG8_LAS bf16x8*)(lds + PG8_SB(b, h) + boff + n * 2048 + k * 1024); } while (0)
#define PG8_MMA(ai, bj, At, Bt) do { __builtin_amdgcn_s_setprio(1); _Pragma("unroll") for (int m = 0; m < 4; ++m) _Pragma("unroll") for (int n = 0; n < 2; ++n) _Pragma("unroll") for (int k = 0; k < 2; ++k) \
        acc[ai][bj][m][n] = __builtin_amdgcn_mfma_f32_16x16x32_bf16(Bt[n][k], At[m][k], acc[ai][bj][m][n], 0, 0, 0); __builtin_amdgcn_s_setprio(0); } while (0)
#define PG8_WAIT_V(n) asm volatile("s_waitcnt vmcnt(" #n ")" ::: "memory")
#define PG8_WAIT_L(n) asm volatile("s_waitcnt lgkmcnt(" #n ")" ::: "memory")
#define PG8_BAR __builtin_amdgcn_s_barrier()
#define PG8_SCHED __builtin_amdgcn_sched_barrier(0)
    Unit cur, nxt; int ui = 0;
    if (!S.next(0, cur)) return;
    f32x4 acc[2][2][4][2];
#pragma unroll
    for (int a = 0; a < 2; ++a)
#pragma unroll
        for (int b = 0; b < 2; ++b)
#pragma unroll
            for (int m = 0; m < 4; ++m)
#pragma unroll
                for (int n = 0; n < 2; ++n) acc[a][b][m][n] = (f32x4){0.f, 0.f, 0.f, 0.f};
    bf16x8 At[4][2], B0[2][2], B1[2][2];
    const char* cA = (const char*)g.A + (size_t)cur.pm * tstep; const char* cB = (const char*)g.Bt + (size_t)cur.pn * tstep;
    S.a_ready(cur);
    if constexpr (SP2) {
        PG8_STAGE(PG8_SB(0, 0), cB, voffB); PG8_STAGE(PG8_SB(0, 1), cB + hstep, voffB); PG8_STAGE(PG8_SA(0, 0), cA, voffA); PG8_STAGE(PG8_SA(0, 1), cA + hstep, voffA);
        if (wr == 1) PG8_BAR;
        PG8_WAIT_V(2); PG8_BAR;
        PG8_STAGE(PG8_SB(1, 0), cB + kstep, voffB); PG8_STAGE(PG8_SA(1, 0), cA + kstep, voffA); PG8_STAGE(PG8_SB(1, 1), cB + hstep + kstep, voffB);
        PG8_WAIT_V(6); PG8_BAR;
    } else {
        PG8_STAGE(PG8_SB(0, 0), cB, voffB); PG8_STAGE(PG8_SA(0, 0), cA, voffA); PG8_STAGE(PG8_SB(0, 1), cB + hstep, voffB); PG8_STAGE(PG8_SA(0, 1), cA + hstep, voffA);
        if (wr == 1) PG8_BAR;
        PG8_WAIT_V(4); PG8_BAR;
        PG8_STAGE(PG8_SB(1, 0), cB + kstep, voffB); PG8_STAGE(PG8_SA(1, 0), cA + kstep, voffA); PG8_STAGE(PG8_SB(1, 1), cB + hstep + kstep, voffB);
        PG8_WAIT_V(6); PG8_BAR;
    }
    for (;;) {
        const bool has_next = S.next(ui + 1, nxt);
        const char* nA = has_next ? (const char*)g.A + (size_t)nxt.pm * tstep : cA; const char* nB = has_next ? (const char*)g.Bt + (size_t)nxt.pn * tstep : cB;
        for (int t = 0; t < nt; t += 2) {
            const bool last = (t == nt - 2);
            const char* a1 = cA + (size_t)(t + 1) * kstep;
            const char* a2 = last ? nA : cA + (size_t)(t + 2) * kstep; const char* b2 = last ? nB : cB + (size_t)(t + 2) * kstep;
            const char* a3 = a2 + kstep; const char* b3 = b2 + kstep;
            if (last && has_next) S.a_ready(nxt);
            if constexpr (SP2) {
            PG8_LDB(B0, 0, 0); PG8_LDB(B1, 0, 1); PG8_SCHED; PG8_LDA(At, 0, 0); PG8_STAGE(PG8_SA(1, 1), a1 + hstep, voffA);
            PG8_WAIT_V(8); PG8_WAIT_L(0); PG8_BAR; PG8_MMA(0, 0, At, B0); PG8_MMA(0, 1, At, B1); PG8_BAR; PG8_SCHED;
            PG8_LDA(At, 0, 1); PG8_STAGE(PG8_SB(0, 0), b2, voffB); PG8_STAGE(PG8_SB(0, 1), b2 + hstep, voffB); PG8_STAGE(PG8_SA(0, 0), a2, voffA);
            PG8_WAIT_V(8); PG8_WAIT_L(0); PG8_BAR; PG8_MMA(1, 0, At, B0); PG8_MMA(1, 1, At, B1); PG8_BAR; PG8_SCHED;
            PG8_LDB(B0, 1, 0); PG8_LDB(B1, 1, 1); PG8_SCHED; PG8_LDA(At, 1, 0); PG8_STAGE(PG8_SA(0, 1), a2 + hstep, voffA);
            PG8_WAIT_V(8); PG8_WAIT_L(0); PG8_BAR; PG8_MMA(0, 0, At, B0); PG8_MMA(0, 1, At, B1); PG8_BAR; PG8_SCHED;
            PG8_LDA(At, 1, 1); PG8_STAGE(PG8_SB(1, 0), b3, voffB); PG8_STAGE(PG8_SB(1, 1), b3 + hstep, voffB); PG8_STAGE(PG8_SA(1, 0), a3, voffA);
            PG8_WAIT_V(8); PG8_WAIT_L(0); PG8_BAR; PG8_MMA(1, 0, At, B0); PG8_MMA(1, 1, At, B1); PG8_BAR; PG8_SCHED;
            } else {
            PG8_LDB(B0, 0, 0); PG8_SCHED; PG8_LDA(At, 0, 0); PG8_STAGE(PG8_SA(1, 1), a1 + hstep, voffA);
            PG8_WAIT_L(8); PG8_BAR; PG8_WAIT_L(0); PG8_MMA(0, 0, At, B0); PG8_BAR; PG8_SCHED;
            PG8_LDB(B1, 0, 1); PG8_STAGE(PG8_SB(0, 0), b2, voffB);
            PG8_BAR; PG8_WAIT_L(0); PG8_MMA(0, 1, At, B1); PG8_BAR;
            PG8_LDA(At, 0, 1); PG8_STAGE(PG8_SA(0, 0), a2, voffA);
            PG8_BAR; PG8_WAIT_L(0); PG8_MMA(1, 0, At, B0); PG8_BAR; PG8_SCHED;
            PG8_STAGE(PG8_SB(0, 1), b2 + hstep, voffB);
            PG8_WAIT_V(6); PG8_BAR; PG8_MMA(1, 1, At, B1); PG8_BAR;
            PG8_LDB(B0, 1, 0); PG8_SCHED; PG8_LDA(At, 1, 0); PG8_STAGE(PG8_SA(0, 1), a2 + hstep, voffA);
            PG8_WAIT_L(8); PG8_BAR; PG8_WAIT_L(0); PG8_MMA(0, 0, At, B0); PG8_BAR; PG8_SCHED;
            PG8_LDB(B1, 1, 1); PG8_STAGE(PG8_SB(1, 0), b3, voffB);
            PG8_BAR; PG8_WAIT_L(0); PG8_MMA(0, 1, At, B1); PG8_BAR;
            PG8_LDA(At, 1, 1); PG8_STAGE(PG8_SA(1, 0), a3, voffA);
            PG8_BAR; PG8_WAIT_L(0); PG8_MMA(1, 0, At, B0); PG8_BAR; PG8_SCHED;
            PG8_STAGE(PG8_SB(1, 1), b3 + hstep, voffB);
            PG8_WAIT_V(6); PG8_BAR; PG8_MMA(1, 1, At, B1); PG8_BAR;
            }
        }
        if constexpr (ALIGN_EPI) { if (wr == 0) PG8_BAR; }
        if constexpr (!Epi::AFTER_DRAIN) { E(acc, cur, wr, wc, fr, fq); S.done(cur); }
        if (!has_next) break;
#pragma unroll
        for (int a = 0; a < 2; ++a)
#pragma unroll
            for (int b = 0; b < 2; ++b)
#pragma unroll
                for (int m = 0; m < 4; ++m)
#pragma unroll
                    for (int n = 0; n < 2; ++n) acc[a][b][m][n] = (f32x4){0.f, 0.f, 0.f, 0.f};
        cur = nxt; cA = nA; cB = nB; ++ui;
        if constexpr (ALIGN_EPI) { if (wr == 1) PG8_BAR; }
    }
    PG8_WAIT_V(0);
    if constexpr (!ALIGN_EPI) { if (wr == 0) PG8_BAR; }
    PG8_BAR;
    if constexpr (Epi::AFTER_DRAIN) { E.fused(acc, cur, wr, wc, fr, fq, lds, wid, lane); S.done(cur); }
#undef PG8_SA
#undef PG8_SB
#undef PG8_STAGE
#undef PG8_LDA
#undef PG8_LDB
#undef PG8_MMA
#undef PG8_WAIT_V
#undef PG8_WAIT_L
#undef PG8_BAR
#undef PG8_SCHED
}
}

DI void wave_rstd(const float* RS, int rowbase  , int lane, float& r0, float& r1) {
  const float* a = RS + (size_t)(rowbase + lane) * 16; const float* b = a + 128 * 16;
  const float4 a0 = *(const float4*)a, a1 = *(const float4*)(a + 4), a2 = *(const float4*)(a + 8), a3 = *(const float4*)(a + 12);
  const float4 b0 = *(const float4*)b, b1 = *(const float4*)(b + 4), b2 = *(const float4*)(b + 8), b3 = *(const float4*)(b + 12);
  const float sa = ((a0.x + a0.y) + (a0.z + a0.w)) + ((a1.x + a1.y) + (a1.z + a1.w)) + ((a2.x + a2.y) + (a2.z + a2.w)) + ((a3.x + a3.y) + (a3.z + a3.w));
  const float sb = ((b0.x + b0.y) + (b0.z + b0.w)) + ((b1.x + b1.y) + (b1.z + b1.w)) + ((b2.x + b2.y) + (b2.z + b2.w)) + ((b3.x + b3.y) + (b3.z + b3.w));
  r0 = rsqrtf(sa * (1.f / 1024.f) + EPSN); r1 = rsqrtf(sb * (1.f / 1024.f) + EPSN);
}
struct EpiSwiglu {
  static constexpr bool PERM = true, AFTER_DRAIN = false;
  bf16_t* ACT; const float* RS; const float* bias  ;
  DI void operator()(const f32x4 (&acc)[2][2][4][2], const pg8::Unit& u, int wr, int wc, int fr, int fq) const {
    const int row0 = u.pm * 256 + wr * 64 + fr, lane = fq * 16 + fr;
    float rs[2]; wave_rstd(RS, u.pm * 256 + wr * 64, lane, rs[0], rs[1]);
    const float* bp = bias + (size_t)cond_of_row(u.pm * 256) * 5632 + u.pn * 256 + wc * 32 + 8 * fq;
    const f32x4 bg0 = *(const f32x4*)(bp), bg1 = *(const f32x4*)(bp + 4), bu0 = *(const f32x4*)(bp + 128), bu1 = *(const f32x4*)(bp + 132);
#pragma unroll
    for (int ai = 0; ai < 2; ++ai)
#pragma unroll
      for (int m = 0; m < 4; ++m) {
        const float r = __shfl(rs[ai], 16 * m + fr);
        const f32x4 g0 = acc[ai][0][m][0] * r + bg0, g1 = acc[ai][0][m][1] * r + bg1, v0 = acc[ai][1][m][0] * r + bu0, v1 = acc[ai][1][m][1] * r + bu1;
        uint4 w;
        w.x = pack2(silu_f(g0[0]) * v0[0], silu_f(g0[1]) * v0[1]); w.y = pack2(silu_f(g0[2]) * v0[2], silu_f(g0[3]) * v0[3]);
        w.z = pack2(silu_f(g1[0]) * v1[0], silu_f(g1[1]) * v1[1]); w.w = pack2(silu_f(g1[2]) * v1[2], silu_f(g1[3]) * v1[3]);
        *(uint4*)(ACT + (size_t)(row0 + ai * 128 + m * 16) * DFF + u.pn * 128 + wc * 32 + 8 * fq) = w;
      }
  }
};
struct EpiResid {
  static constexpr bool PERM = true, AFTER_DRAIN = false;
  float* X; const float* gate_base; float coef;
  bf16_t* H; float* RS; const float* nxt_g  ; const float* nxt_scale  ;
  DI void operator()(const f32x4 (&acc)[2][2][4][2], const pg8::Unit& u, int wr, int wc, int fr, int fq) const {
    const int row0 = u.pm * 256 + wr * 64 + fr, col0 = u.pn * 256 + wc * 32 + 8 * fq;
    const int cond = cond_of_row(u.pm * 256);
    const float* gv = gate_base + (size_t)cond * 9216 + col0;
    const bool has_next = nxt_g != nullptr;
    float ss[2][4];
#pragma unroll
    for (int ai = 0; ai < 2; ++ai)
#pragma unroll
      for (int m = 0; m < 4; ++m) ss[ai][m] = 0.f;
#pragma unroll
    for (int bj = 0; bj < 2; ++bj) {
      const int co = bj * 128;
      const float4 gg0 = *(const float4*)(gv + co), gg1 = *(const float4*)(gv + co + 4);
      float4 hv0 = make_float4(0.f, 0.f, 0.f, 0.f), hv1 = hv0;
      if (has_next) {
        const float* gp = nxt_g + col0 + co; const float* sp = nxt_scale + (size_t)cond * 9216 + col0 + co;
        const float4 g20 = *(const float4*)gp, g21 = *(const float4*)(gp + 4), s20 = *(const float4*)sp, s21 = *(const float4*)(sp + 4);
        hv0 = make_float4(g20.x * (1.f + s20.x), g20.y * (1.f + s20.y), g20.z * (1.f + s20.z), g20.w * (1.f + s20.w));
        hv1 = make_float4(g21.x * (1.f + s21.x), g21.y * (1.f + s21.y), g21.z * (1.f + s21.z), g21.w * (1.f + s21.w));
      }
#pragma unroll
      for (int ai = 0; ai < 2; ++ai)
#pragma unroll
        for (int m = 0; m < 4; ++m) {
          const size_t off = (size_t)(row0 + ai * 128 + m * 16) * 1024 + col0 + co;
          float4 x0 = *(const float4*)(X + off), x1 = *(const float4*)(X + off + 4);
          const f32x4 a0 = acc[ai][bj][m][0], a1 = acc[ai][bj][m][1];
          x0.x += coef * gg0.x * a0[0]; x0.y += coef * gg0.y * a0[1]; x0.z += coef * gg0.z * a0[2]; x0.w += coef * gg0.w * a0[3];
          x1.x += coef * gg1.x * a1[0]; x1.y += coef * gg1.y * a1[1]; x1.z += coef * gg1.z * a1[2]; x1.w += coef * gg1.w * a1[3];
          *(float4*)(X + off) = x0; *(float4*)(X + off + 4) = x1;
          if (has_next) {
            ss[ai][m] += ((x0.x * x0.x + x0.y * x0.y) + (x0.z * x0.z + x0.w * x0.w)) + ((x1.x * x1.x + x1.y * x1.y) + (x1.z * x1.z + x1.w * x1.w));
            uint4 w; w.x = pack2(x0.x * hv0.x, x0.y * hv0.y); w.y = pack2(x0.z * hv0.z, x0.w * hv0.w); w.z = pack2(x1.x * hv1.x, x1.y * hv1.y); w.w = pack2(x1.z * hv1.z, x1.w * hv1.w);
            *(uint4*)(H + off) = w;
          }
        }
    }
    if (has_next) {
#pragma unroll
      for (int ai = 0; ai < 2; ++ai)
#pragma unroll
        for (int m = 0; m < 4; ++m) {
          float s = ss[ai][m];
          s += __shfl_xor(s, 16); s += __shfl_xor(s, 32);
          if (fq == 0) RS[(size_t)(row0 + ai * 128 + m * 16) * 16 + u.pn * 4 + wc] = s;
        }
    }
  }
};
struct EpiProj {
  static constexpr bool PERM = true, AFTER_DRAIN = false;
  bf16_t* PR; const float* RS; const float* bias  ;
  DI void operator()(const f32x4 (&acc)[2][2][4][2], const pg8::Unit& u, int wr, int wc, int fr, int fq) const {
    const int row0 = u.pm * 256 + wr * 64 + fr, col0 = u.pn * 256 + wc * 32 + 8 * fq, lane = fq * 16 + fr;
    float rs[2]; wave_rstd(RS, u.pm * 256 + wr * 64, lane, rs[0], rs[1]);
    float rr[2][4];
#pragma unroll
    for (int ai = 0; ai < 2; ++ai)
#pragma unroll
      for (int m = 0; m < 4; ++m) rr[ai][m] = __shfl(rs[ai], 16 * m + fr);
    const float* bp = bias + (size_t)cond_of_row(u.pm * 256) * 5632;
#pragma unroll
    for (int bj = 0; bj < 2; ++bj) {
      const int col = col0 + bj * 128;
      if (col < PW) {
        const f32x4 b0 = *(const f32x4*)(bp + col), b1 = *(const f32x4*)(bp + col + 4);
#pragma unroll
        for (int ai = 0; ai < 2; ++ai)
#pragma unroll
          for (int m = 0; m < 4; ++m) {
            const f32x4 a0 = acc[ai][bj][m][0] * rr[ai][m] + b0, a1 = acc[ai][bj][m][1] * rr[ai][m] + b1;
            uint4 w; w.x = pack2(a0[0], a0[1]); w.y = pack2(a0[2], a0[3]); w.z = pack2(a1[0], a1[1]); w.w = pack2(a1[2], a1[3]);
            *(uint4*)(PR + (size_t)(row0 + ai * 128 + m * 16) * PW + col) = w;
          }
      }
    }
  }
};
template <class Epi>
DI void gemm8_run(const bf16_t* acts, const bf16_t* wts, int Nw, int K, const Epi& E, char* dsm) {
  pg8::Gemm g; g.A = acts; g.Bt = wts; g.M = NTOK; g.N = Nw; g.K = K;
  pg8::StaticOrder S; S.init(NTOK, Nw, (int)gridDim.x, (int)blockIdx.x);
  pg8::gemm_phase<Epi, pg8::StaticOrder, true, true>((LDSP unsigned char*)dsm, g, S, E);
}

DI void prep_gla_tile(const Params& p, int l, int tt, char* smem) {
  const int tid = otid();
  const bf16_t* PR = (const bf16_t*)(p.ws + WS_PROJ);
  float* GB = (float*)(p.ws + WS_GB); float* ATOT = (float*)(p.ws + WS_ATOT); float* U = (float*)(p.ws + WS_U);
  const int row0 = tt * 64;
  float* bg = (float*)smem;
  bf16_t* ks = (bf16_t*)(smem + 8192);
  bf16_t* vs = (bf16_t*)(smem + 8192 + 16384);
  {
    {
      const int lane = tid & 63, wv = tid >> 6, fr = lane & 15, fq = lane >> 4;
      const bf16_t* hp = (const bf16_t*)(p.ws + WS_H) + (size_t)(row0 + wv * 16 + fr) * 1024 + 8 * fq;
      const bf16_t* wp = (const bf16_t*)(p.ws + WS_WIN) + ((size_t)l * PWR + OFF_BGW + fr) * 1024 + 8 * fq;
      f32x4 c0 = (f32x4){0.f, 0.f, 0.f, 0.f}, c1 = c0;
#pragma unroll 8
      for (int ks = 0; ks < 32; ++ks) {
        const bf16x8 a = *(const bf16x8*)(hp + 32 * ks), b0 = *(const bf16x8*)(wp + 32 * ks), b1 = *(const bf16x8*)(wp + 16 * 1024 + 32 * ks);
        c0 = __builtin_amdgcn_mfma_f32_16x16x32_bf16(a, b0, c0, 0, 0, 0);
        c1 = __builtin_amdgcn_mfma_f32_16x16x32_bf16(a, b1, c1, 0, 0, 0);
      }
      const float* rsp = (const float*)(p.ws + WS_ROWSS) + (size_t)(row0 + wv * 16 + fr) * 16;
      const float4 r0 = *(const float4*)rsp, r1 = *(const float4*)(rsp + 4), r2 = *(const float4*)(rsp + 8), r3 = *(const float4*)(rsp + 12);
      const float rs = rsqrtf((((r0.x + r0.y) + (r0.z + r0.w)) + ((r1.x + r1.y) + (r1.z + r1.w)) + ((r2.x + r2.y) + (r2.z + r2.w)) + ((r3.x + r3.y) + (r3.z + r3.w))) * (1.f / 1024.f) + EPSN);
      const float* bp = (const float*)(p.ws + WS_BIAS) + ((size_t)(l * 3 + 1) * 3 + cond_of_row(row0)) * 5632 + OFF_BGW;
      const float bb0 = bp[fr], bb1 = bp[16 + fr];
#pragma unroll
      for (int r = 0; r < 4; ++r) {
        const float rr = __shfl(rs, 4 * fq + r);
        float* dst = bg + (wv * 16 + 4 * fq + r) * 32;
        dst[fr] = c0[r] * rr + bb0; dst[16 + fr] = c1[r] * rr + bb1;
      }
    }
#pragma unroll
    for (int q = 0; q < 4; ++q) { const int c = tid + 256 * q, row = c >> 4, ch = c & 15; *(uint4*)(ks + row * 128 + 8 * ch) = *(const uint4*)(PR + (size_t)(row0 + row) * PW + OFF_BK + 8 * ch); }
#pragma unroll
    for (int q = 0; q < 8; ++q) { const int c = tid + 256 * q, row = c >> 5, ch = c & 31; *(uint4*)(vs + row * 256 + 8 * ch) = *(const uint4*)(PR + (size_t)(row0 + row) * PW + OFF_BV + 8 * ch); }
  }
  __syncthreads();
  const int s = tid >> 7, k = tid & 127, h = k >> 5, d = k & 31;
  float w[16];
#pragma unroll
  for (int r = 0; r < 16; ++r) w[r] = p.in[18][((size_t)(l * 2 + s) * 16 + r) * 128 + k];
  const float bias = p.in[19][(l * 2 + s) * 128 + k];
  float acc[64];
#pragma unroll
  for (int x = 0; x < 64; ++x) acc[x] = 0.f;
  float run = 0.f;
#pragma unroll 2
  for (int ii = 0; ii < 64; ++ii) {
    const int j = s ? ii : 63 - ii;
    float z = bias;
#pragma unroll
    for (int r = 0; r < 16; ++r) z += bg[j * 32 + s * 16 + r] * w[r];
    const float ls = fminf(z, 0.f) - log1pf(expf(-fabsf(z)));
    GB[(size_t)(row0 + j) * 256 + s * 128 + k] = run;
    const float kd = bf2f(ks[j * 128 + k]) * fast_exp2(run * LOG2E);
    run += ls * (1.f / 16.f);
    const bf16_t* vr = vs + j * 256 + h * 64;
#pragma unroll
    for (int x8 = 0; x8 < 8; ++x8) {
      float vv[8]; unpack8(*(const uint4*)(vr + 8 * x8), vv);
#pragma unroll
      for (int e = 0; e < 8; ++e) acc[8 * x8 + e] += kd * vv[e];
    }
  }
  ATOT[tt * 256 + tid] = expf(run);
  ATOT[192 * 256 + tt * 256 + tid] = run;
  float* u = U + (((size_t)tt * 2 + s) * 4 + h) * 2048 + d * 64;
#pragma unroll
  for (int x4 = 0; x4 < 16; ++x4) *(float4*)(u + 4 * x4) = make_float4(acc[4 * x4], acc[4 * x4 + 1], acc[4 * x4 + 2], acc[4 * x4 + 3]);
  __syncthreads();
}

struct TokRaw { uint4 a; uint2 c0, c1, c2; uint4 av, cv; };
DI void tok_load(const bf16_t* PR, int r, int lane, bool ctx, TokRaw& t) {
  const bf16_t* pr = PR + (size_t)r * PW;
  t.a = *(const uint4*)(pr + (lane >> 3) * 64 + 8 * (lane & 7));
  const bf16_t* src = pr + OFF_CQ + (lane >> 2) * 48 + 12 * (lane & 3);
  t.c0 = *(const uint2*)(src); t.c1 = *(const uint2*)(src + 4); t.c2 = *(const uint2*)(src + 8);
  t.av = make_uint4(0, 0, 0, 0); t.cv = make_uint4(0, 0, 0, 0);
  if (ctx) { if (lane < 16) t.av = *(const uint4*)(pr + OFF_AV + 8 * lane); if (lane < 48) t.cv = *(const uint4*)(pr + OFF_CV + 8 * lane); }
}
DI void prep_token(const Params& p, int l, int r, int lane, const TokRaw& t) {
  bf16_t* QA = (bf16_t*)(p.ws + WS_QA); bf16_t* KA = (bf16_t*)(p.ws + WS_KA);
  bf16_t* QC = (bf16_t*)(p.ws + WS_QC); bf16_t* KC = (bf16_t*)(p.ws + WS_KC);
  const float* rope = (const float*)(p.ws + WS_ROPE);
  const float qsA = 0.125f * LOG2E, qsC = 0.14433756729740643f * LOG2E;
  const bool ctx = r < NCTX;
  const int b = ctx ? (r >> 8) : ((r - NCTX) >> 11);
  const int tq = ctx ? (r & 255) : ((r - NCTX) & 2047);
  const int rowpos = tq >> 6, colpos = tq & 63;
  {
    const int v = lane >> 3, s = lane & 7;
    float x[8]; unpack8(t.a, x);
    float ss = 0.f;
#pragma unroll
    for (int e = 0; e < 8; ++e) ss += x[e] * x[e];
    ss += __shfl_xor(ss, 1); ss += __shfl_xor(ss, 2); ss += __shfl_xor(ss, 4);
    const float rstd = rsqrtf(ss * (1.f / 64.f) + EPSN);
    const float* g = (v < 6 ? p.in[16] : p.in[17]) + l * 64 + 8 * s;
    float y[8];
#pragma unroll
    for (int e = 0; e < 8; ++e) y[e] = x[e] * rstd * g[e];
    if (ctx) {
      if (v >= 6) {
        float* o = p.out + O_AK + ((size_t)(b * 4 + l) * 256 + tq) * 128 + (v - 6) * 64 + 8 * s;
        *(float4*)o = make_float4(y[0], y[1], y[2], y[3]); *(float4*)(o + 4) = make_float4(y[4], y[5], y[6], y[7]);
      }
    } else {
      const int pos = (s < 4) ? rowpos : colpos;
      const float* ct = rope + pos * 16 + (s & 1) * 8; const float* st = rope + 1024 + pos * 16 + (s & 1) * 8;
#pragma unroll
      for (int e = 0; e < 8; ++e) {
        const float yp = __shfl_xor(y[e], 2);
        const float c = ct[e], sn = st[e];
        y[e] = (s & 2) ? (yp * sn + y[e] * c) : (y[e] * c - yp * sn);
      }
    }
    if (v < 6) {
#pragma unroll
      for (int e = 0; e < 8; ++e) y[e] *= qsA;
    }
    uint4 w; w.x = pack2(y[0], y[1]); w.y = pack2(y[2], y[3]); w.z = pack2(y[4], y[5]); w.w = pack2(y[6], y[7]);
    if (v < 6) *(uint4*)(QA + (size_t)r * 384 + v * 64 + 8 * s) = w;
    else *(uint4*)(KA + (size_t)r * 128 + (v - 6) * 64 + 8 * s) = w;
  }
  if (ctx && lane < 16) {
    float x[8]; unpack8(t.av, x);
    float* o = p.out + O_AV + ((size_t)(b * 4 + l) * 256 + tq) * 128 + 8 * lane;
    *(float4*)o = make_float4(x[0], x[1], x[2], x[3]); *(float4*)(o + 4) = make_float4(x[4], x[5], x[6], x[7]);
  }
  {
    const int v = lane >> 2, qd = lane & 3;
    float x[12];
    unpack4(t.c0, x); unpack4(t.c1, x + 4); unpack4(t.c2, x + 8);
    float ss = 0.f;
#pragma unroll
    for (int e = 0; e < 12; ++e) ss += x[e] * x[e];
    ss += __shfl_xor(ss, 1); ss += __shfl_xor(ss, 2);
    const float rstd = rsqrtf(ss * (1.f / 48.f) + EPSN);
    const float* g = (v < 8 ? p.in[21] : p.in[22]) + l * 96 + (v & 1) * 48 + 12 * qd;
    float y[12];
#pragma unroll
    for (int e = 0; e < 12; ++e) y[e] = x[e] * rstd * g[e];
    if (ctx) {
      if (v >= 8) {
        float* o = p.out + O_CK + ((size_t)(b * 4 + l) * 256 + tq) * 384 + (v - 8) * 48 + 12 * qd;
        *(float4*)o = make_float4(y[0], y[1], y[2], y[3]); *(float4*)(o + 4) = make_float4(y[4], y[5], y[6], y[7]);
        *(float4*)(o + 8) = make_float4(y[8], y[9], y[10], y[11]);
      }
    } else {
      const int pos = (qd < 2) ? rowpos : colpos;
      const float* ct = rope + 2048 + pos * 12; const float* st = rope + 2048 + 768 + pos * 12;
#pragma unroll
      for (int e = 0; e < 12; ++e) {
        const float yp = __shfl_xor(y[e], 1);
        const float c = ct[e], sn = st[e];
        y[e] = (qd & 1) ? (yp * sn + y[e] * c) : (y[e] * c - yp * sn);
      }
    }
    if (v < 8) {
#pragma unroll
      for (int e = 0; e < 12; ++e) y[e] *= qsC;
    }
    bf16_t* dst = (v < 8 ? QC : KC) + (size_t)r * 512 + (v & 7) * 64;
    uint2 w0, w1, w2; w0.x = pack2(y[0], y[1]); w0.y = pack2(y[2], y[3]); w1.x = pack2(y[4], y[5]); w1.y = pack2(y[6], y[7]);
    w2.x = pack2(y[8], y[9]); w2.y = pack2(y[10], y[11]);
    *(uint2*)(dst + 12 * qd) = w0; *(uint2*)(dst + 12 * qd + 4) = w1; *(uint2*)(dst + 12 * qd + 8) = w2;
    { unsigned z0; asm volatile("v_mov_b32 %0, 0" : "=v"(z0)); *(uint2*)(dst + 48 + 4 * qd) = make_uint2(z0, z0); }
  }
  if (ctx && lane < 48) {
    float x[8]; unpack8(t.cv, x);
    float* o = p.out + O_CV + ((size_t)(b * 4 + l) * 256 + tq) * 384 + 8 * lane;
    *(float4*)o = make_float4(x[0], x[1], x[2], x[3]); *(float4*)(o + 4) = make_float4(x[4], x[5], x[6], x[7]);
  }
}

DI void prep_phase(const Params& p, int l, char* smem) {
  int bx = blockIdx.x, gx = gridDim.x; asm volatile("" : "+s"(bx), "+s"(gx));
  if (gx > 96 && bx < 96) { prep_gla_tile(p, l, obid(), smem); return; }
  if (gx <= 96) for (int tt = obid(); tt < 192; tt += vnb()) prep_gla_tile(p, l, tt, smem);
  const int tx = rtid(), lane = tx & 63;
  const int fb = gx > 96 ? 96 : 0;
  const int gw = (bx - fb) * 8 + (tx >> 6), nw = (gx - fb) * 8;
  const bf16_t* PR = (const bf16_t*)(p.ws + WS_PROJ);
  int r = gw;
  TokRaw cur, nxt;
  if (r < NTOK) tok_load(PR, r, lane, r < NCTX, cur);
#pragma unroll 1
  for (; r < NTOK; r += nw) {
    const int rn = r + nw;
    if (rn < NTOK) tok_load(PR, rn, lane, rn < NCTX, nxt);
    prep_token(p, l, r, lane, cur);
    cur = nxt;
  }
}

typedef unsigned u32x4 __attribute__((ext_vector_type(4)));
struct KVSrc { const bf16_t* k1; const bf16_t* v1; const bf16_t* k2; const bf16_t* v2; int ks1, vs1, ks2, vs2, n1, n2; };
template <int NMAP, int NDT> struct FlashRegs { u32x4 k00, k01, k10, k11, v0, v1, v2; };

template <int NMAP, int NDT>
DI void fl_issue(int kt, const KVSrc& kv, FlashRegs<NMAP, NDT>& R) {
  constexpr int CPR = NDT * 2;
  kt = kt < kv.n1 + kv.n2 ? kt : kv.n1 + kv.n2 - 1;
  const int tid = otid();
  const bf16_t* kb; const bf16_t* vb; int ks, vs;
  if (kt < kv.n1) { kb = kv.k1 + (size_t)kt * 64 * kv.ks1; vb = kv.v1 + (size_t)kt * 64 * kv.vs1; ks = kv.ks1; vs = kv.vs1; }
  else { kb = kv.k2 + (size_t)(kt - kv.n1) * 64 * kv.ks2; vb = kv.v2 + (size_t)(kt - kv.n1) * 64 * kv.vs2; ks = kv.ks2; vs = kv.vs2; }
  R.k00 = *(const u32x4*)(kb + (size_t)(tid >> 3) * ks + (tid & 7) * 8);
  R.k01 = *(const u32x4*)(kb + (size_t)((tid >> 3) + 32) * ks + (tid & 7) * 8);
  if (NMAP == 2) {
    R.k10 = *(const u32x4*)(kb + 64 + (size_t)(tid >> 3) * ks + (tid & 7) * 8);
    R.k11 = *(const u32x4*)(kb + 64 + (size_t)((tid >> 3) + 32) * ks + (tid & 7) * 8);
  } else { R.k10 = R.k00; R.k11 = R.k01; }
  { const int c = tid; R.v0 = *(const u32x4*)(vb + (size_t)(c / CPR) * vs + (c % CPR) * 8); }
  { const int c = tid + 256; R.v1 = *(const u32x4*)(vb + (size_t)(c / CPR) * vs + (c % CPR) * 8); }
  if (NDT == 6) { const int c = tid + 512; R.v2 = *(const u32x4*)(vb + (size_t)(c / CPR) * vs + (c % CPR) * 8); } else R.v2 = R.v1;
}
template <int NMAP, int NDT>
DI void fl_write(char* buf, const FlashRegs<NMAP, NDT>& R) {
  constexpr int CPR = NDT * 2, VSB = NDT * 32 + 32;
  const int tid = otid();
  char* vbuf = buf + NMAP * 8192;
  { const int row = tid >> 3, ch = tid & 7; *(u32x4*)(buf + row * 128 + ((ch ^ (row & 7)) << 4)) = R.k00; }
  { const int row = (tid >> 3) + 32, ch = tid & 7; *(u32x4*)(buf + row * 128 + ((ch ^ (row & 7)) << 4)) = R.k01; }
  if (NMAP == 2) {
    { const int row = tid >> 3, ch = tid & 7; *(u32x4*)(buf + 8192 + row * 128 + ((ch ^ (row & 7)) << 4)) = R.k10; }
    { const int row = (tid >> 3) + 32, ch = tid & 7; *(u32x4*)(buf + 8192 + row * 128 + ((ch ^ (row & 7)) << 4)) = R.k11; }
  }
  { const int c = tid; *(u32x4*)(vbuf + (c / CPR) * VSB + (c % CPR) * 16) = R.v0; }
  { const int c = tid + 256; *(u32x4*)(vbuf + (c / CPR) * VSB + (c % CPR) * 16) = R.v1; }
  if (NDT == 6) { const int c = tid + 512; *(u32x4*)(vbuf + (c / CPR) * VSB + (c % CPR) * 16) = R.v2; }
}
template <int NMAP, int NDT>
DI void fl_compute(const char* buf, const bf16x8 (&qf)[NMAP][2], f32x4 (&oacc)[NMAP][NDT], float (&mrun)[NMAP], float (&lsum)[NMAP], int lane) {
  constexpr int VSB = NDT * 32 + 32;
  const int g = lane >> 4, qq = (lane & 15) >> 2, pp = lane & 3;
  bf16x8 pf[NMAP][2];
#pragma unroll
  for (int m = 0; m < NMAP; ++m) {
    f32x4 sacc[4];
#pragma unroll
    for (int t = 0; t < 4; ++t) sacc[t] = (f32x4){0.f, 0.f, 0.f, 0.f};
#pragma unroll
    for (int ks = 0; ks < 2; ++ks) {
      const int ch = ((ks * 4 + g) ^ (lane & 7)) << 4;
#pragma unroll
      for (int t = 0; t < 4; ++t) {
        const bf16x8 kf = *(const bf16x8*)(buf + m * 8192 + (16 * t + (lane & 15)) * 128 + ch);
        sacc[t] = __builtin_amdgcn_mfma_f32_16x16x32_bf16(kf, qf[m][ks], sacc[t], 0, 0, 0);
      }
    }
    float mx = sacc[0][0];
#pragma unroll
    for (int t = 0; t < 4; ++t)
#pragma unroll
      for (int r = 0; r < 4; ++r) mx = fmaxf(mx, sacc[t][r]);
    mx = fmaxf(mx, __shfl_xor(mx, 16)); mx = fmaxf(mx, __shfl_xor(mx, 32));
    const float mnew = fmaxf(mrun[m], mx);
    const float alpha = fast_exp2(mrun[m] - mnew);
    mrun[m] = mnew;
    float ps = 0.f;
#pragma unroll
    for (int t = 0; t < 4; ++t)
#pragma unroll
      for (int r = 0; r < 4; ++r) { const float pv = fast_exp2(sacc[t][r] - mnew); sacc[t][r] = pv; ps += pv; }
    lsum[m] = lsum[m] * alpha + ps;
#pragma unroll
    for (int d = 0; d < NDT; ++d) oacc[m][d] *= alpha;
#pragma unroll
    for (int ks = 0; ks < 2; ++ks) {
      u32x4 pu;
      pu[0] = pack2(sacc[2 * ks][0], sacc[2 * ks][1]); pu[1] = pack2(sacc[2 * ks][2], sacc[2 * ks][3]);
      pu[2] = pack2(sacc[2 * ks + 1][0], sacc[2 * ks + 1][1]); pu[3] = pack2(sacc[2 * ks + 1][2], sacc[2 * ks + 1][3]);
      pf[m][ks] = __builtin_bit_cast(bf16x8, pu);
    }
  }
  const char* vbuf = buf + NMAP * 8192;
#pragma unroll
  for (int ks = 0; ks < 2; ++ks) {
    const char* vrow = vbuf + (32 * ks + 4 * g + qq) * VSB + pp * 8;
#pragma unroll
    for (int d = 0; d < NDT; ++d) {
      const s16x4 v0 = __builtin_amdgcn_ds_read_tr16_b64_v4i16((LDSP s16x4*)(vrow + d * 32));
      const s16x4 v1 = __builtin_amdgcn_ds_read_tr16_b64_v4i16((LDSP s16x4*)(vrow + 16 * VSB + d * 32));
      const bf16x8 vf = __builtin_shufflevector(v0, v1, 0, 1, 2, 3, 4, 5, 6, 7);
#pragma unroll
      for (int m = 0; m < NMAP; ++m) oacc[m][d] = __builtin_amdgcn_mfma_f32_16x16x32_bf16(vf, pf[m][ks], oacc[m][d], 0, 0, 0);
    }
  }
}

template <int NMAP, int NDT>
DI void flash_run(const bf16_t* __restrict__ qptr, const KVSrc& kv, f32x4 (&oacc)[NMAP][NDT], float (&linv)[NMAP], char* smem) {
  constexpr int BUFB = NMAP * 8192 + 64 * (NDT * 32 + 32);
  const int lane = otid() & 63;
  bf16x8 qf[NMAP][2];
  float mrun[NMAP], lsum[NMAP];
#pragma unroll
  for (int m = 0; m < NMAP; ++m) {
    qf[m][0] = *(const bf16x8*)(qptr + 64 * m); qf[m][1] = *(const bf16x8*)(qptr + 64 * m + 32);
    mrun[m] = -INFINITY; lsum[m] = 0.f;
#pragma unroll
    for (int d = 0; d < NDT; ++d) oacc[m][d] = (f32x4){0.f, 0.f, 0.f, 0.f};
  }
  const int nt = kv.n1 + kv.n2;
  FlashRegs<NMAP, NDT> R0, R1;
  fl_issue<NMAP, NDT>(0, kv, R0);
  fl_issue<NMAP, NDT>(1, kv, R1);
  __syncthreads();
  fl_write<NMAP, NDT>(smem, R0);
  fl_issue<NMAP, NDT>(2, kv, R0);
  __syncthreads();
#pragma unroll 1
  for (int t = 0; t < nt; t += 2) {
    fl_compute<NMAP, NDT>(smem, qf, oacc, mrun, lsum, lane);
    fl_write<NMAP, NDT>(smem + BUFB, R1);
    fl_issue<NMAP, NDT>(t + 3, kv, R1);
    __syncthreads();
    fl_compute<NMAP, NDT>(smem + BUFB, qf, oacc, mrun, lsum, lane);
    fl_write<NMAP, NDT>(smem, R0);
    fl_issue<NMAP, NDT>(t + 4, kv, R0);
    __syncthreads();
  }
#pragma unroll
  for (int m = 0; m < NMAP; ++m) { float l = lsum[m]; l += __shfl_xor(l, 16); l += __shfl_xor(l, 32); linv[m] = 1.f / l; }
}

DI void attn_a_item(const Params& p, int l, bool ctx, int b, int h, int qt, char* smem) {
  const int lane = otid() & 63, wave = otid() >> 6;
  const int seq0 = ctx ? b * 256 : NCTX + b * 2048;
  const int qrow = seq0 + qt * 64 + wave * 16 + (lane & 15);
  const int kvh = h / 3;
  const bf16_t* PR = (const bf16_t*)(p.ws + WS_PROJ);
  KVSrc kv;
  kv.k1 = (const bf16_t*)(p.ws + WS_KA) + (size_t)seq0 * 128 + kvh * 64; kv.ks1 = 128;
  kv.v1 = PR + (size_t)seq0 * PW + OFF_AV + kvh * 64; kv.vs1 = PW;
  kv.n1 = ctx ? 4 : 32; kv.n2 = ctx ? 0 : 8;
  kv.k2 = (const bf16_t*)(p.ws + WS_KAC) + (size_t)((b & 1) * 4 + l) * 512 * 128 + kvh * 64; kv.ks2 = 128;
  kv.v2 = (const bf16_t*)(p.ws + WS_VAC) + (size_t)((b & 1) * 4 + l) * 512 * 128 + kvh * 64; kv.vs2 = 128;
  f32x4 o[1][4]; float linv[1];
  flash_run<1, 4>((const bf16_t*)(p.ws + WS_QA) + (size_t)qrow * 384 + h * 64 + 8 * (lane >> 4), kv, o, linv, smem);
  bf16_t* dst = (bf16_t*)(p.ws + WS_MIX) + (size_t)qrow * 1024 + h * 64 + 4 * (lane >> 4);
  const float li = linv[0];
#pragma unroll
  for (int d = 0; d < 4; ++d) { uint2 w; w.x = pack2(o[0][d][0] * li, o[0][d][1] * li); w.y = pack2(o[0][d][2] * li, o[0][d][3] * li); *(uint2*)(dst + 16 * d) = w; }
}

DI void attn_c_item(const Params& p, int l, bool ctx, int b, int h, int qt, char* smem) {
  const int lane = otid() & 63, wave = otid() >> 6;
  const int seq0 = ctx ? b * 256 : NCTX + b * 2048;
  const int qrow = seq0 + qt * 64 + wave * 16 + (lane & 15);
  const bf16_t* PR = (const bf16_t*)(p.ws + WS_PROJ);
  KVSrc kv;
  kv.ks1 = 512; kv.vs1 = PW; kv.ks2 = 512; kv.vs2 = 384;
  kv.n1 = ctx ? 4 : 32; kv.n2 = ctx ? 0 : 8;
  kv.v1 = PR + (size_t)seq0 * PW + OFF_CV + h * 96;
  kv.v2 = (const bf16_t*)(p.ws + WS_VCC) + (size_t)((b & 1) * 4 + l) * 512 * 384 + h * 96;
  kv.k1 = (const bf16_t*)(p.ws + WS_KC) + (size_t)seq0 * 512 + (h * 2) * 64;
  kv.k2 = (const bf16_t*)(p.ws + WS_KCC) + (size_t)((b & 1) * 4 + l) * 512 * 512 + (h * 2) * 64;
  f32x4 o[2][6]; float linv[2];
  flash_run<2, 6>((const bf16_t*)(p.ws + WS_QC) + (size_t)qrow * 512 + (h * 2) * 64 + 8 * (lane >> 4), kv, o, linv, smem);
  const float lam = ((const float*)(p.ws + WS_MISC))[l];
  const float li0 = linv[0], l1 = linv[1] * lam;
  float ss = 0.f;
#pragma unroll
  for (int d = 0; d < 6; ++d)
#pragma unroll
    for (int r = 0; r < 4; ++r) { const float v = o[0][d][r] * li0 - o[1][d][r] * l1; o[0][d][r] = v; ss += v * v; }
  ss += __shfl_xor(ss, 16); ss += __shfl_xor(ss, 32);
  const float sc = rsqrtf(ss * (1.f / 96.f) + EPSN) * (1.f - p.lam_init[l]);
  const float* g = p.in[24] + l * 96 + 4 * (lane >> 4);
  bf16_t* dst = (bf16_t*)(p.ws + WS_MIX) + (size_t)qrow * 1024 + 640 + h * 96 + 4 * (lane >> 4);
#pragma unroll
  for (int d = 0; d < 6; ++d) {
    const float4 gg = *(const float4*)(g + 16 * d);
    uint2 w; w.x = pack2(o[0][d][0] * sc * gg.x, o[0][d][1] * sc * gg.y); w.y = pack2(o[0][d][2] * sc * gg.z, o[0][d][3] * sc * gg.w);
    *(uint2*)(dst + 16 * d) = w;
  }
}

DI void gla_item(const Params& p, int l, bool ctx, int b, int h, int c, char* smem) {
  const int tid = otid();
  const int seq0 = ctx ? b * 256 : NCTX + b * 2048;
  const int nch = ctx ? 4 : 32;
  const int row0 = seq0 + c * 64, tt0 = seq0 >> 6, tt = tt0 + c;
  const bf16_t* PR = (const bf16_t*)(p.ws + WS_PROJ);
  const float* GB = (const float*)(p.ws + WS_GB); const float* ATOT = (const float*)(p.ws + WS_ATOT); const float* U = (const float*)(p.ws + WS_U);
  float* qd = (float*)smem;
  float* kd = qd + 64 * 36;
  float* vv = kd + 64 * 36;
  float* S = vv + 4096;
  float* sc = S + 2048;
  const int ib = tid >> 4, xb = tid & 15, i0 = ib * 4, x0 = xb * 4;
  float o[4][4];
#pragma unroll
  for (int a = 0; a < 4; ++a)
#pragma unroll
    for (int e = 0; e < 4; ++e) o[a][e] = 0.f;
  for (int s = 0; s < 2; ++s) {
    {
      const int j = tid >> 2, part = tid & 3, kk = h * 32 + part * 8;
      const size_t prow = (size_t)(row0 + j) * PW;
      const uint4 qraw = *(const uint4*)(PR + prow + OFF_BQ + kk), kraw = *(const uint4*)(PR + prow + OFF_BK + kk);
      const float* gbp = GB + (size_t)(row0 + j) * 256 + s * 128 + kk;
      const float* ttp = ATOT + 192 * 256 + tt * 256 + s * 128 + kk;
      const float4 g0 = *(const float4*)gbp, g1 = *(const float4*)(gbp + 4), t0 = *(const float4*)ttp, t1 = *(const float4*)(ttp + 4);
      uint4 vraw0 = make_uint4(0, 0, 0, 0), vraw1 = vraw0;
      if (s == 0) { vraw0 = *(const uint4*)(PR + prow + OFF_BV + h * 64 + part * 16); vraw1 = *(const uint4*)(PR + prow + OFF_BV + h * 64 + part * 16 + 8); }
      float qv[8], kv[8]; unpack8(qraw, qv); unpack8(kraw, kv);
      const float cum[8] = {t0.x - g0.x, t0.y - g0.y, t0.z - g0.z, t0.w - g0.w, t1.x - g1.x, t1.y - g1.y, t1.z - g1.z, t1.w - g1.w};
      float qo[8], ko[8];
#pragma unroll
      for (int e = 0; e < 8; ++e) { qo[e] = qv[e] * 0.17677669529663687f * fast_exp2(cum[e] * LOG2E); ko[e] = kv[e] * fast_exp2(-cum[e] * LOG2E); }
      float* qp = qd + j * 36 + part * 8; float* kp = kd + j * 36 + part * 8;
      *(float4*)qp = make_float4(qo[0], qo[1], qo[2], qo[3]); *(float4*)(qp + 4) = make_float4(qo[4], qo[5], qo[6], qo[7]);
      *(float4*)kp = make_float4(ko[0], ko[1], ko[2], ko[3]); *(float4*)(kp + 4) = make_float4(ko[4], ko[5], ko[6], ko[7]);
      if (s == 0) {
        float x[16]; unpack8(vraw0, x); unpack8(vraw1, x + 8);
        float* vp = vv + j * 64 + part * 16;
#pragma unroll
        for (int e = 0; e < 4; ++e) *(float4*)(vp + 4 * e) = make_float4(x[4 * e], x[4 * e + 1], x[4 * e + 2], x[4 * e + 3]);
      }
    }
    {
      const int d = tid >> 3, v0 = (tid & 7) * 8;
      float S8[8];
      if (ctx) {
#pragma unroll
        for (int e = 0; e < 8; ++e) S8[e] = 0.f;
      } else {
        const float* s0 = p.in[7] + ((((size_t)b * 4 + l) * 2 + s) * 4 + h) * 2048 + d * 64 + v0;
        const float4 a = *(const float4*)s0, bq = *(const float4*)(s0 + 4);
        S8[0] = a.x; S8[1] = a.y; S8[2] = a.z; S8[3] = a.w; S8[4] = bq.x; S8[5] = bq.y; S8[6] = bq.z; S8[7] = bq.w;
      }
      const int nfold = s == 0 ? c : nch - 1 - c;
#pragma unroll 8
      for (int f = 0; f < nfold; ++f) {
        const int t2 = s == 0 ? tt0 + f : tt0 + nch - 1 - f;
        const float a = ATOT[t2 * 256 + s * 128 + h * 32 + d];
        const float* u = U + (((size_t)t2 * 2 + s) * 4 + h) * 2048 + d * 64 + v0;
        const float4 u0 = *(const float4*)u, u1 = *(const float4*)(u + 4);
        S8[0] = a * S8[0] + u0.x; S8[1] = a * S8[1] + u0.y; S8[2] = a * S8[2] + u0.z; S8[3] = a * S8[3] + u0.w;
        S8[4] = a * S8[4] + u1.x; S8[5] = a * S8[5] + u1.y; S8[6] = a * S8[6] + u1.z; S8[7] = a * S8[7] + u1.w;
      }
      *(float4*)(S + d * 64 + v0) = make_float4(S8[0], S8[1], S8[2], S8[3]);
      *(float4*)(S + d * 64 + v0 + 4) = make_float4(S8[4], S8[5], S8[6], S8[7]);
      if (ctx && ((s == 0 && c == nch - 1) || (s == 1 && c == 0))) {
        const float a = ATOT[tt * 256 + s * 128 + h * 32 + d];
        const float* u = U + (((size_t)tt * 2 + s) * 4 + h) * 2048 + d * 64 + v0;
        const float4 u0 = *(const float4*)u, u1 = *(const float4*)(u + 4);
        float* dst = p.out + O_ST + ((((size_t)b * 4 + l) * 2 + s) * 4 + h) * 2048 + d * 64 + v0;
        *(float4*)dst = make_float4(a * S8[0] + u0.x, a * S8[1] + u0.y, a * S8[2] + u0.z, a * S8[3] + u0.w);
        *(float4*)(dst + 4) = make_float4(a * S8[4] + u1.x, a * S8[5] + u1.y, a * S8[6] + u1.z, a * S8[7] + u1.w);
      }
    }
    __syncthreads();
    {
      float a4[4][4];
#pragma unroll
      for (int a = 0; a < 4; ++a)
#pragma unroll
        for (int e = 0; e < 4; ++e) a4[a][e] = 0.f;
#pragma unroll 2
      for (int d4 = 0; d4 < 8; ++d4) {
        float4 q4[4], k4[4];
#pragma unroll
        for (int a = 0; a < 4; ++a) { q4[a] = *(const float4*)(qd + (i0 + a) * 36 + 4 * d4); k4[a] = *(const float4*)(kd + (x0 + a) * 36 + 4 * d4); }
#pragma unroll
        for (int a = 0; a < 4; ++a)
#pragma unroll
          for (int e = 0; e < 4; ++e) a4[a][e] += q4[a].x * k4[e].x + q4[a].y * k4[e].y + q4[a].z * k4[e].z + q4[a].w * k4[e].w;
      }
#pragma unroll
      for (int a = 0; a < 4; ++a) {
        float r4[4];
#pragma unroll
        for (int e = 0; e < 4; ++e) { const int i = i0 + a, j = x0 + e; const bool keep = (s == 0) ? (j <= i) : (j >= i); r4[e] = keep ? a4[a][e] : 0.f; }
        *(float4*)(sc + (i0 + a) * 68 + x0) = make_float4(r4[0], r4[1], r4[2], r4[3]);
      }
    }
    __syncthreads();
    {
#pragma unroll 2
      for (int j = 0; j < 64; j += 4) {
        float4 s4[4], v4[4];
#pragma unroll
        for (int a = 0; a < 4; ++a) { s4[a] = *(const float4*)(sc + (i0 + a) * 68 + j); v4[a] = *(const float4*)(vv + (j + a) * 64 + x0); }
#pragma unroll
        for (int a = 0; a < 4; ++a) {
          o[a][0] += s4[a].x * v4[0].x + s4[a].y * v4[1].x + s4[a].z * v4[2].x + s4[a].w * v4[3].x;
          o[a][1] += s4[a].x * v4[0].y + s4[a].y * v4[1].y + s4[a].z * v4[2].y + s4[a].w * v4[3].y;
          o[a][2] += s4[a].x * v4[0].z + s4[a].y * v4[1].z + s4[a].z * v4[2].z + s4[a].w * v4[3].z;
          o[a][3] += s4[a].x * v4[0].w + s4[a].y * v4[1].w + s4[a].z * v4[2].w + s4[a].w * v4[3].w;
        }
      }
#pragma unroll 2
      for (int d = 0; d < 32; d += 4) {
        float4 q4[4], v4[4];
#pragma unroll
        for (int a = 0; a < 4; ++a) { q4[a] = *(const float4*)(qd + (i0 + a) * 36 + d); v4[a] = *(const float4*)(S + (d + a) * 64 + x0); }
#pragma unroll
        for (int a = 0; a < 4; ++a) {
          o[a][0] += q4[a].x * v4[0].x + q4[a].y * v4[1].x + q4[a].z * v4[2].x + q4[a].w * v4[3].x;
          o[a][1] += q4[a].x * v4[0].y + q4[a].y * v4[1].y + q4[a].z * v4[2].y + q4[a].w * v4[3].y;
          o[a][2] += q4[a].x * v4[0].z + q4[a].y * v4[1].z + q4[a].z * v4[2].z + q4[a].w * v4[3].z;
          o[a][3] += q4[a].x * v4[0].w + q4[a].y * v4[1].w + q4[a].z * v4[2].w + q4[a].w * v4[3].w;
        }
      }
    }
    __syncthreads();
  }
  const float4 gg = *(const float4*)(p.in[20] + l * 64 + x0);
#pragma unroll
  for (int a = 0; a < 4; ++a) {
    float ss = o[a][0] * o[a][0] + o[a][1] * o[a][1] + o[a][2] * o[a][2] + o[a][3] * o[a][3];
    ss += __shfl_xor(ss, 1); ss += __shfl_xor(ss, 2); ss += __shfl_xor(ss, 4); ss += __shfl_xor(ss, 8);
    const float rstd = rsqrtf(ss * (1.f / 64.f) + EPSN);
    const size_t row = row0 + i0 + a;
    float br[4]; unpack4(*(const uint2*)(PR + row * PW + OFF_BR + h * 64 + x0), br);
    uint2 w;
    w.x = pack2(o[a][0] * rstd * gg.x * sigm_silu_acc(br[0]), o[a][1] * rstd * gg.y * sigm_silu_acc(br[1]));
    w.y = pack2(o[a][2] * rstd * gg.z * sigm_silu_acc(br[2]), o[a][3] * rstd * gg.w * sigm_silu_acc(br[3]));
    *(uint2*)((bf16_t*)(p.ws + WS_MIX) + row * 1024 + 384 + h * 64 + x0) = w;
  }
}

DI void gla_item_mfma(const Params& p, int l, bool ctx, int b, int h, int c, char* smem) {
  const int tid = otid(), lane = tid & 63, wave = tid >> 6, g = lane >> 4, fr = lane & 15, qq = fr >> 2, pp = lane & 3;
  const int seq0 = ctx ? b * 256 : NCTX + b * 2048;
  const int nch = ctx ? 4 : 32;
  const int row0 = seq0 + c * 64, tt0 = seq0 >> 6, tt = tt0 + c;
  const bf16_t* PR = (const bf16_t*)(p.ws + WS_PROJ);
  const float* GB = (const float*)(p.ws + WS_GB); const float* ATOT = (const float*)(p.ws + WS_ATOT); const float* U = (const float*)(p.ws + WS_U);
  char* qdb = smem;
  char* kdb = smem + 4096;
  char* vvb = smem + 8192;
  char* Sb = smem + 8192 + 10240;
  f32x4 oacc[4];
#pragma unroll
  for (int vt = 0; vt < 4; ++vt) oacc[vt] = (f32x4){0.f, 0.f, 0.f, 0.f};
#pragma unroll 1
  for (int s = 0; s < 2; ++s) {
    {
      const int j = tid >> 2, part = tid & 3, kk = h * 32 + part * 8;
      const size_t prow = (size_t)(row0 + j) * PW;
      const uint4 qraw = *(const uint4*)(PR + prow + OFF_BQ + kk), kraw = *(const uint4*)(PR + prow + OFF_BK + kk);
      const float* gbp = GB + (size_t)(row0 + j) * 256 + s * 128 + kk;
      const float* ttp = ATOT + 192 * 256 + tt * 256 + s * 128 + kk;
      const float4 g0 = *(const float4*)gbp, g1 = *(const float4*)(gbp + 4), t0 = *(const float4*)ttp, t1 = *(const float4*)(ttp + 4);
      if (s == 0) {
        const uint4 v0 = *(const uint4*)(PR + prow + OFF_BV + h * 64 + part * 16), v1 = *(const uint4*)(PR + prow + OFF_BV + h * 64 + part * 16 + 8);
        *(uint4*)(vvb + j * 160 + part * 32) = v0; *(uint4*)(vvb + j * 160 + part * 32 + 16) = v1;
      }
      float qv[8], kv[8]; unpack8(qraw, qv); unpack8(kraw, kv);
      const float cum[8] = {t0.x - g0.x, t0.y - g0.y, t0.z - g0.z, t0.w - g0.w, t1.x - g1.x, t1.y - g1.y, t1.z - g1.z, t1.w - g1.w};
      float qo[8], ko[8];
#pragma unroll
      for (int e = 0; e < 8; ++e) { qo[e] = qv[e] * 0.17677669529663687f * fast_exp2(cum[e] * LOG2E); ko[e] = kv[e] * fast_exp2(-cum[e] * LOG2E); }
      uint4 qw, kw;
      qw.x = pack2(qo[0], qo[1]); qw.y = pack2(qo[2], qo[3]); qw.z = pack2(qo[4], qo[5]); qw.w = pack2(qo[6], qo[7]);
      kw.x = pack2(ko[0], ko[1]); kw.y = pack2(ko[2], ko[3]); kw.z = pack2(ko[4], ko[5]); kw.w = pack2(ko[6], ko[7]);
      *(uint4*)(qdb + j * 64 + part * 16) = qw; *(uint4*)(kdb + j * 64 + part * 16) = kw;
    }
    {
      const int d = tid >> 3, v0 = (tid & 7) * 8;
      float S8[8];
      if (ctx) {
#pragma unroll
        for (int e = 0; e < 8; ++e) S8[e] = 0.f;
      } else {
        const float* s0 = p.in[7] + ((((size_t)b * 4 + l) * 2 + s) * 4 + h) * 2048 + d * 64 + v0;
        const float4 a = *(const float4*)s0, bq = *(const float4*)(s0 + 4);
        S8[0] = a.x; S8[1] = a.y; S8[2] = a.z; S8[3] = a.w; S8[4] = bq.x; S8[5] = bq.y; S8[6] = bq.z; S8[7] = bq.w;
      }
      const int nfold = s == 0 ? c : nch - 1 - c;
#pragma unroll 8
      for (int f = 0; f < nfold; ++f) {
        const int t2 = s == 0 ? tt0 + f : tt0 + nch - 1 - f;
        const float a = ATOT[t2 * 256 + s * 128 + h * 32 + d];
        const float* u = U + (((size_t)t2 * 2 + s) * 4 + h) * 2048 + d * 64 + v0;
        const float4 u0 = *(const float4*)u, u1 = *(const float4*)(u + 4);
        S8[0] = a * S8[0] + u0.x; S8[1] = a * S8[1] + u0.y; S8[2] = a * S8[2] + u0.z; S8[3] = a * S8[3] + u0.w;
        S8[4] = a * S8[4] + u1.x; S8[5] = a * S8[5] + u1.y; S8[6] = a * S8[6] + u1.z; S8[7] = a * S8[7] + u1.w;
      }
      uint4 sw; sw.x = pack2(S8[0], S8[1]); sw.y = pack2(S8[2], S8[3]); sw.z = pack2(S8[4], S8[5]); sw.w = pack2(S8[6], S8[7]);
      *(uint4*)(Sb + d * 160 + v0 * 2) = sw;
      if (ctx && ((s == 0 && c == nch - 1) || (s == 1 && c == 0))) {
        const float a = ATOT[tt * 256 + s * 128 + h * 32 + d];
        const float* u = U + (((size_t)tt * 2 + s) * 4 + h) * 2048 + d * 64 + v0;
        const float4 u0 = *(const float4*)u, u1 = *(const float4*)(u + 4);
        float* dst = p.out + O_ST + ((((size_t)b * 4 + l) * 2 + s) * 4 + h) * 2048 + d * 64 + v0;
        *(float4*)dst = make_float4(a * S8[0] + u0.x, a * S8[1] + u0.y, a * S8[2] + u0.z, a * S8[3] + u0.w);
        *(float4*)(dst + 4) = make_float4(a * S8[4] + u1.x, a * S8[5] + u1.y, a * S8[6] + u1.z, a * S8[7] + u1.w);
      }
    }
    __syncthreads();
    {
      const int iq = 16 * wave + fr;
      const bf16x8 qf = *(const bf16x8*)(qdb + iq * 64 + g * 16);
      bf16x8 pf[2];
#pragma unroll
      for (int ks = 0; ks < 2; ++ks) {
        u32x4 pu;
#pragma unroll
        for (int hh = 0; hh < 2; ++hh) {
          const int t = 2 * ks + hh;
          const bf16x8 kf = *(const bf16x8*)(kdb + (16 * t + fr) * 64 + g * 16);
          f32x4 sc = __builtin_amdgcn_mfma_f32_16x16x32_bf16(kf, qf, (f32x4){0.f, 0.f, 0.f, 0.f}, 0, 0, 0);
#pragma unroll
          for (int r = 0; r < 4; ++r) { const int j = 16 * t + 4 * g + r; const bool keep = (s == 0) ? (j <= iq) : (j >= iq); sc[r] = keep ? sc[r] : 0.f; }
          pu[2 * hh] = pack2(sc[0], sc[1]); pu[2 * hh + 1] = pack2(sc[2], sc[3]);
        }
        pf[ks] = __builtin_bit_cast(bf16x8, pu);
      }
#pragma unroll
      for (int ks = 0; ks < 2; ++ks) {
        const char* vrow = vvb + (32 * ks + 4 * g + qq) * 160 + pp * 8;
#pragma unroll
        for (int vt = 0; vt < 4; ++vt) {
          const s16x4 v0 = __builtin_amdgcn_ds_read_tr16_b64_v4i16((LDSP s16x4*)(vrow + vt * 32));
          const s16x4 v1 = __builtin_amdgcn_ds_read_tr16_b64_v4i16((LDSP s16x4*)(vrow + 16 * 160 + vt * 32));
          const bf16x8 vf = __builtin_shufflevector(v0, v1, 0, 1, 2, 3, 4, 5, 6, 7);
          oacc[vt] = __builtin_amdgcn_mfma_f32_16x16x32_bf16(vf, pf[ks], oacc[vt], 0, 0, 0);
        }
      }
      {
        const s16x4 qa = *(const s16x4*)(qdb + iq * 64 + (4 * g) * 2), qb = *(const s16x4*)(qdb + iq * 64 + (16 + 4 * g) * 2);
        const bf16x8 qp = __builtin_shufflevector(qa, qb, 0, 1, 2, 3, 4, 5, 6, 7);
        const char* srow = Sb + (4 * g + qq) * 160 + pp * 8;
#pragma unroll
        for (int vt = 0; vt < 4; ++vt) {
          const s16x4 s0 = __builtin_amdgcn_ds_read_tr16_b64_v4i16((LDSP s16x4*)(srow + vt * 32));
          const s16x4 s1 = __builtin_amdgcn_ds_read_tr16_b64_v4i16((LDSP s16x4*)(srow + 16 * 160 + vt * 32));
          const bf16x8 sf = __builtin_shufflevector(s0, s1, 0, 1, 2, 3, 4, 5, 6, 7);
          oacc[vt] = __builtin_amdgcn_mfma_f32_16x16x32_bf16(sf, qp, oacc[vt], 0, 0, 0);
        }
      }
    }
    __syncthreads();
  }
  float ss = 0.f;
#pragma unroll
  for (int vt = 0; vt < 4; ++vt)
#pragma unroll
    for (int r = 0; r < 4; ++r) ss += oacc[vt][r] * oacc[vt][r];
  ss += __shfl_xor(ss, 16); ss += __shfl_xor(ss, 32);
  const float rstd = rsqrtf(ss * (1.f / 64.f) + EPSN);
  const size_t row = row0 + 16 * wave + fr;
#pragma unroll
  for (int vt = 0; vt < 4; ++vt) {
    const int v = 16 * vt + 4 * g;
    const float4 gg = *(const float4*)(p.in[20] + l * 64 + v);
    float br[4]; unpack4(*(const uint2*)(PR + row * PW + OFF_BR + h * 64 + v), br);
    uint2 w;
    w.x = pack2(oacc[vt][0] * rstd * gg.x * sigm_silu_acc(br[0]), oacc[vt][1] * rstd * gg.y * sigm_silu_acc(br[1]));
    w.y = pack2(oacc[vt][2] * rstd * gg.z * sigm_silu_acc(br[2]), oacc[vt][3] * rstd * gg.w * sigm_silu_acc(br[3]));
    *(uint2*)((bf16_t*)(p.ws + WS_MIX) + row * 1024 + 384 + h * 64 + v) = w;
  }
}

DI void mixer_phase(const Params& p, int l, int cidx, char* smem) {
  unsigned* ctr = (unsigned*)(p.ws + WS_MISC + 64) + cidx;
  extern __shared__ __attribute__((aligned(16))) char dsm[];
  LDSP int* sidx = (LDSP int*)(dsm + 131072 + 16);
  constexpr int M_CL = PROBE == 21 ? 2 : 1, M_AL = PROBE == 22 ? 2 : 1, M_GL = PROBE == 23 ? 2 : 1, M_CC = PROBE == 24 ? 2 : 1, M_AC = PROBE == 25 ? 2 : 1, M_GC = PROBE == 26 ? 2 : 1;
  constexpr int N_CL = 256 * M_CL, N_AL = 384 * M_AL, N_GL = 256 * M_GL, N_CC = 512 * M_CC, N_AC = 768 * M_AC, N_GC = 512 * M_GC;
  constexpr int E0 = N_CL, E1 = E0 + N_AL, E2 = E1 + N_GL, E3 = E2 + N_CC, E4 = E3 + N_AC, E5 = E4 + N_GC;
  for (;;) {
    __syncthreads();
    if (threadIdx.x == 0) *sidx = (int)atomicAdd(ctr, 2u);
    __syncthreads();
    const int it = *sidx + ohalf();
    if (it >= E5) break;
    int typ, r; bool ctx;
    if (it < E0) { typ = 0; r = (it) % 256; ctx = false; }
    else if (it < E1) { typ = 1; r = (it - E0) % 384; ctx = false; }
    else if (it < E2) { typ = 2; r = (it - E1) % 256; ctx = false; }
    else if (it < E3) { typ = 0; r = (it - E2) % 512; ctx = true; }
    else if (it < E4) { typ = 1; r = (it - E3) % 768; ctx = true; }
    else { typ = 2; r = (it - E4) % 512; ctx = true; }
    const int sh = ctx ? 2 : 5, nq = 1 << sh;
    const int sub = r & (nq - 1), bh = r >> sh;
    if (typ == 0) attn_c_item(p, l, ctx, bh >> 2, bh & 3, sub, smem);
    else if (typ == 1) attn_a_item(p, l, ctx, bh / 6, bh % 6, sub, smem);
    else gla_item_mfma(p, l, ctx, bh >> 2, bh & 3, sub, smem);
  }
}

constexpr int DYN_LDS = 131072 + 64;
typedef const __attribute__((address_space(4))) Params* ParamsK;
DI ParamsK kparams() { ParamsK q = (ParamsK)__builtin_amdgcn_kernarg_segment_ptr(); asm volatile("" : "+s"(q)); return q; }
__global__ void __launch_bounds__(512, 2) fwd_megakernel(Params p_unused) {
  extern __shared__ __attribute__((aligned(16))) char dsm[];
  cg::grid_group grid = cg::this_grid();
  if (gridDim.y == 2) grid.sync();
  const Params& p = *(const Params*)kparams();
  volatile LDSP unsigned* xbw = (volatile LDSP unsigned*)(dsm + 131072);
  if (threadIdx.x == 0) { xbw[0] = 0u; xbw[1] = 0u; xbw[2] = 0u; xbw[3] = 0u; }
  __syncthreads();
  const XcdBarrier xb = xcd_barrier_post((unsigned*)(p.ws + WS_BAR), xbw);
  char* smem = dsm + ohalf() * 65536;
  phase0(p, (float*)smem);
  xcd_barrier(xb);
#pragma unroll 1
  for (int ph = 0; ph < 44; ++ph) {
    const int l = ph / 11, q = ph - l * 11;
    const Params& p = *(const Params*)kparams();
    const float* mod = (const float*)(p.ws + WS_MOD);
    const bf16_t* H = (const bf16_t*)(p.ws + WS_H);
    const bf16_t* ACT = (const bf16_t*)(p.ws + WS_ACT);
    const bf16_t* MIX = (const bf16_t*)(p.ws + WS_MIX);
    const float* modl = mod + (size_t)l * 3 * 9216;
    int nrep = 1;
#if PROBE
    if (PROBE == 1) nrep = (q == 1 || q == 9 || q == 2 || q == 10 || q == 7 || q == 4) ? 2 : 1;
    if (PROBE == 2) nrep = (q == 6) ? 2 : 1;
    if (PROBE == 3) nrep = (q == 5) ? 2 : 1;
    if (PROBE == 4) nrep = (q == 0 || q == 3 || q == 8) ? 2 : 1;
    if (PROBE == 5) nrep = 2;
#endif
#pragma unroll 1
    for (int rep = 0; rep < nrep; ++rep) {
#if PROBE == 5
    if (rep == 1) { xcd_barrier(xb); xcd_barrier(xb); xcd_barrier(xb); continue; }
#endif
    if (q == 3 || q == 8 || (q == 0 && l > 0)) continue;
    const float* RS = (const float*)(p.ws + WS_ROWSS);
    const float* BIAS = (const float*)(p.ws + WS_BIAS);
    if (q == 0) {
      norm0_bias_phase(p);
    } else if (q == 1 || q == 9) {
      const int f = q == 1 ? 0 : 1;
      { EpiSwiglu E; E.ACT = (bf16_t*)(p.ws + WS_ACT); E.RS = RS; E.bias = BIAS + (size_t)(l * 3 + (f ? 2 : 0)) * 3 * 5632;
        gemm8_run(H, (const bf16_t*)(p.ws + WS_WGU) + (size_t)(l * 2 + f) * 5632 * 1024, 5632, 1024, E, dsm); }
      if (l < 3 && rep == 0 && blockIdx.x >= 32) convert_slice(p, l + 1, f * 1344, f * 1344 + 1344, 32, (float*)smem);
    } else if (q == 2 || q == 10 || q == 7) {
      const bf16_t* A; const bf16_t* Bt; int lda, K; const float* gb; float coef; int nl, nsub;
      if (q == 7) { A = MIX; lda = 1024; K = 1024; Bt = (const bf16_t*)(p.ws + WS_WOUT) + (size_t)l * 1024 * 1024; gb = modl + 5 * 1024; coef = 1.0f; nl = l; nsub = 2; }
      else { const int f = q == 2 ? 0 : 1; A = ACT; lda = DFF; K = DFF; Bt = (const bf16_t*)(p.ws + WS_WD) + (size_t)(l * 2 + f) * 1024 * 2816; gb = modl + (f == 0 ? 2 : 8) * 1024; coef = 0.5f;
             nl = f == 0 ? l : l + 1; nsub = f == 0 ? 1 : 0; }
      (void)lda;
      if (l < 3 && rep == 0 && q == 10 && blockIdx.x >= 192) bias_from_f32(p, l + 1, dsm);
      { EpiResid E; E.X = p.out; E.gate_base = gb; E.coef = rep ? 0.f : coef; E.H = (bf16_t*)(p.ws + WS_H); E.RS = (float*)(p.ws + WS_ROWSS);
        E.nxt_g = nl < 4 ? p.in[11] + (nl * 3 + nsub) * 1024 : nullptr; E.nxt_scale = mod + (size_t)(nl < 4 ? nl : 0) * 3 * 9216 + (3 * nsub + 1) * 1024;
        gemm8_run(A, Bt, 1024, K, E, dsm); }
    } else if (q == 4) {
      { EpiProj E; E.PR = (bf16_t*)(p.ws + WS_PROJ); E.RS = RS; E.bias = BIAS + (size_t)(l * 3 + 1) * 3 * 5632;
        gemm8_run(H, (const bf16_t*)(p.ws + WS_WIN) + (size_t)l * PWR * 1024, PWP, 1024, E, dsm); }
    } else if (q == 5) {
      prep_phase(p, l, smem);
    } else {
      mixer_phase(p, l, l + 4 * rep, smem);
    }
    xcd_barrier(xb);
    }
  }
}

extern "C" void kernel_launch(void* const* d_in, const int* in_sizes, int n_in,
                              void* d_out, int out_size, void* d_ws, size_t ws_size,
                              hipStream_t stream) {
  static int grid_blocks = 0;
  if (!grid_blocks) {
    int dev = 0, cus = 0, per_cu = 0;
    (void)hipGetDevice(&dev);
    (void)hipDeviceGetAttribute(&cus, hipDeviceAttributeMultiprocessorCount, dev);
    (void)hipFuncSetAttribute((const void*)fwd_megakernel, hipFuncAttributeMaxDynamicSharedMemorySize, DYN_LDS);
    (void)hipOccupancyMaxActiveBlocksPerMultiprocessor(&per_cu, fwd_megakernel, 512, DYN_LDS);
    if (per_cu < 1) per_cu = 1;
    grid_blocks = cus;
    grid_blocks -= grid_blocks % 8;
  }
  Params p{};
  for (int i = 0; i < 26; ++i) p.in[i] = (const float*)d_in[i];
  p.out = (float*)d_out;
  p.ws = (char*)d_ws;
  for (int i = 0; i < 16; ++i) p.freqA[i] = powf(10000.0f, -(float)i / 16.0f);
  for (int i = 0; i < 12; ++i) p.freqC[i] = powf(10000.0f, -(float)i / 12.0f);
  for (int l = 0; l < 4; ++l) p.lam_init[l] = (float)(0.8 - 0.6 * exp(-0.3 * l));
  (void)hipMemsetAsync((char*)d_ws + WS_BAR, 0, XCD_BAR_WORDS_C * 4, stream);
  void* args[] = {&p};
  hipError_t e = hipLaunchCooperativeKernel((void*)fwd_megakernel, dim3(grid_blocks), dim3(512), args, DYN_LDS, stream);
  if (e != hipSuccess) fprintf(stderr, "cooperative launch failed: %s (grid %d)\n", hipGetErrorString(e), grid_blocks);
}
```

```cpp
#include <hip/hip_runtime.h>
#include <hip/hip_cooperative_groups.h>
#include <cstdio>
#include <cmath>
namespace cg = cooperative_groups;
#ifndef PROBE
#define PROBE 0
#endif

typedef unsigned short bf16_t;
typedef short bf16x8 __attribute__((ext_vector_type(8)));
typedef short s16x4 __attribute__((ext_vector_type(4)));
typedef float f32x4 __attribute__((ext_vector_type(4)));
#define LDSP __attribute__((address_space(3)))
#define DI __device__ __forceinline__

constexpr int DM = 1024, DFF = 2816, NTOK = 12288, NCTX = 8192, PW = 2560, PWP = 2560, PWR = 2592;
constexpr int OFF_AQ = 0, OFF_AK = 384, OFF_AV = 512, OFF_BQ = 640, OFF_BK = 768, OFF_BV = 896,
              OFF_BR = 1152, OFF_CQ = 1408, OFF_CK = 1792, OFF_CV = 2176, OFF_BGW = 2560;
constexpr float EPSN = 1e-6f;
constexpr float LOG2E = 1.4426950408889634f;
constexpr size_t O_YP = 0, O_YS = 8388608, O_AK = 12582912, O_AV = 16777216, O_CK = 20971520, O_CV = 33554432, O_ST = 46137344;

constexpr size_t XCD_BAR_WORDS_C = 3456;
constexpr size_t al256(size_t x) { return (x + 255) & ~(size_t)255; }
constexpr size_t WS_MOD = 0;
constexpr size_t WS_MISC = al256(WS_MOD + 4ull * 3 * 9216 * 4);
constexpr size_t WS_ROPE = WS_MISC + 256;
constexpr size_t WS_WGU = al256(WS_ROPE + (1024 * 2 + 768 * 2) * 4);
constexpr size_t WS_WD = WS_WGU + 8ull * 5632 * 1024 * 2;
constexpr size_t WS_WIN = WS_WD + 8ull * 1024 * 2816 * 2;
constexpr size_t WS_WOUT = WS_WIN + 4ull * PWR * 1024 * 2;
constexpr size_t WS_H = WS_WOUT + 4ull * 1024 * 1024 * 2;
constexpr size_t WS_MIX = WS_H + (size_t)NTOK * 1024 * 2;
constexpr size_t WS_ACT = WS_MIX + (size_t)NTOK * 1024 * 2;
constexpr size_t WS_PROJ = WS_ACT + (size_t)NTOK * DFF * 2;
constexpr size_t WS_QA = WS_PROJ + (size_t)NTOK * PW * 2;
constexpr size_t WS_KA = WS_QA + (size_t)NTOK * 384 * 2;
constexpr size_t WS_QC = WS_KA + (size_t)NTOK * 128 * 2;
constexpr size_t WS_KC = WS_QC + (size_t)NTOK * 512 * 2;
constexpr size_t WS_GB = WS_KC + (size_t)NTOK * 512 * 2;
constexpr size_t WS_ATOT = WS_GB + (size_t)NTOK * 256 * 4;
constexpr size_t WS_U = WS_ATOT + 2 * 192ull * 256 * 4;
constexpr size_t WS_KAC = WS_U + 192ull * 2 * 4 * 2048 * 4;
constexpr size_t WS_VAC = WS_KAC + 2ull * 4 * 512 * 128 * 2;
constexpr size_t WS_KCC = WS_VAC + 2ull * 4 * 512 * 128 * 2;
constexpr size_t WS_VCC = WS_KCC + 2ull * 4 * 512 * 512 * 2;
constexpr size_t WS_BAR = WS_VCC + 2ull * 4 * 512 * 384 * 2;
constexpr size_t WS_ROWSS = al256(WS_BAR + XCD_BAR_WORDS_C * 4);
constexpr size_t WS_BIAS = WS_ROWSS + (size_t)NTOK * 16 * 4;
constexpr size_t WS_END = WS_BIAS + 4ull * 3 * 3 * 5632 * 4;

struct Params {
  const float* in[26];
  float* out;
  char* ws;
  float freqA[16];
  float freqC[12];
  float lam_init[4];
};

DI float bf2f(bf16_t v) { return __uint_as_float(((unsigned)v) << 16); }
DI bf16_t f2bf(float f) { unsigned u = __float_as_uint(f); u += 0x7fffu + ((u >> 16) & 1u); return (bf16_t)(u >> 16); }
typedef float f32x2_t __attribute__((ext_vector_type(2)));
typedef __bf16 bf16x2_t __attribute__((ext_vector_type(2)));
DI unsigned pack2(float lo, float hi) { const f32x2_t v = {lo, hi}; return __builtin_bit_cast(unsigned, __builtin_convertvector(v, bf16x2_t)); }
DI float fast_exp2(float x) { return __builtin_amdgcn_exp2f(x); }
DI float fast_rcp(float x) { return __builtin_amdgcn_rcpf(x); }
DI float silu_f(float g) { return g * fast_rcp(1.f + fast_exp2(-g * LOG2E)); }
DI float sigm_silu_acc(float g) { return g / (1.f + expf(-g)); }
DI void unpack8(uint4 v, float* x) {
  x[0] = __uint_as_float(v.x << 16); x[1] = __uint_as_float(v.x & 0xffff0000u);
  x[2] = __uint_as_float(v.y << 16); x[3] = __uint_as_float(v.y & 0xffff0000u);
  x[4] = __uint_as_float(v.z << 16); x[5] = __uint_as_float(v.z & 0xffff0000u);
  x[6] = __uint_as_float(v.w << 16); x[7] = __uint_as_float(v.w & 0xffff0000u);
}
DI void unpack4(uint2 v, float* x) {
  x[0] = __uint_as_float(v.x << 16); x[1] = __uint_as_float(v.x & 0xffff0000u);
  x[2] = __uint_as_float(v.y << 16); x[3] = __uint_as_float(v.y & 0xffff0000u);
}
DI int otid() { int t = threadIdx.x & 255; asm volatile("" : "+v"(t)); return t; }
DI int ohalf() { return __builtin_amdgcn_readfirstlane((int)(threadIdx.x >> 8)); }
DI int obid() { int b = blockIdx.x * 2 + ohalf(); asm volatile("" : "+s"(b)); return b; }
DI int vnb() { return gridDim.x * 2; }
DI int rtid() { int t = threadIdx.x; asm volatile("" : "+v"(t)); return t; }
DI int cond_of_row(int row) { return row < NCTX ? 0 : 1 + ((row - NCTX) >> 11); }


#define XB_TMO      128
#define XB_XCNT(j)  (256  + 64 * (j))
#define XB_XSUB(j)  (1280 + 64 * (j))
#define XB_XGEN(j)  (2304 + 64 * (j))
#define XB_TOP      3328
#define XB_TOPGEN   3392
#define XCD_BAR_WORDS 3456
#define XB_SPIN_CAP (1u << 22)
DI unsigned xb_ld(unsigned* p) { return __hip_atomic_load(p, __ATOMIC_RELAXED, __HIP_MEMORY_SCOPE_AGENT); }
DI unsigned xb_add(unsigned* p, unsigned v) { return __hip_atomic_fetch_add(p, v, __ATOMIC_RELAXED, __HIP_MEMORY_SCOPE_AGENT); }
DI unsigned xb_xcc_id() { return (unsigned)__builtin_amdgcn_s_getreg((3 << 11) | 20) & 0xFu; }
#define XB_SPIN(cond, bar) do { unsigned _sp = 0; while (cond) { __builtin_amdgcn_s_sleep(1); \
    if ((++_sp & 255u) == 0u) { if (xb_ld(&(bar)[XB_TMO])) break; if (_sp > XB_SPIN_CAP) { atomicAdd(&(bar)[XB_TMO], 1u); break; } } } } while (0)
struct XcdBarrier { unsigned* bar; unsigned x; volatile LDSP unsigned* st; };
DI XcdBarrier xcd_barrier_post(unsigned* bar, volatile LDSP unsigned* st) {
  XcdBarrier b; b.bar = bar; b.x = xb_xcc_id(); b.st = st;
  if (threadIdx.x == 0) (void)xb_add(&bar[XB_XCNT(b.x)], 1u);
  return b;
}
DI void xcd_barrier_complete(unsigned* bar, unsigned x, unsigned& nloc, unsigned& nx) {
  const unsigned G = gridDim.x * gridDim.y * gridDim.z;
  unsigned sum, cnt, mine, sp = 0u;
  for (;;) {
    sum = 0u; cnt = 0u; mine = 0u;
#pragma unroll
    for (unsigned j = 0; j < 16; ++j) { const unsigned c = xb_ld(&bar[XB_XCNT(j)]); sum += c; cnt += (c > 0u) ? 1u : 0u; mine = (j == x) ? c : mine; }
    if (sum == G) break;
    __builtin_amdgcn_s_sleep(1);
    if ((++sp & 255u) == 0u) { if (xb_ld(&bar[XB_TMO])) break; if (sp > XB_SPIN_CAP) { atomicAdd(&bar[XB_TMO], 1u); break; } }
  }
  nloc = mine > 0u ? mine : 1u; nx = cnt > 0u ? cnt : 1u;
}
DI void xcd_barrier(const XcdBarrier& b_) {
  asm volatile("s_waitcnt vmcnt(0)" ::: "memory");
  __syncthreads();
  if (threadIdx.x == 0) {
    XcdBarrier b; b.st = b_.st;
    { unsigned* q = b_.bar; asm volatile("" : "+s"(q)); b.bar = q; }
    { unsigned xx = xb_xcc_id(); asm volatile("" : "+s"(xx)); b.x = xx; }
    unsigned* bar = b.bar;
    __builtin_amdgcn_s_waitcnt(0);
    unsigned nloc = b.st[0], nx = b.st[1];
    if (nloc == 0u) { xcd_barrier_complete(bar, b.x, nloc, nx); b.st[0] = nloc; b.st[1] = nx; }
    const unsigned old = xb_add(&bar[XB_XSUB(b.x)], 1u);
    const unsigned gen = old / nloc;
    if (old + 1u == (gen + 1u) * nloc) {
      __builtin_amdgcn_fence(__ATOMIC_RELEASE, "agent");
      asm volatile("s_waitcnt vmcnt(0)" ::: "memory");
      const unsigned og = xb_add(&bar[XB_TOP], 1u);
      const unsigned tg = og / nx;
      if (og + 1u == (tg + 1u) * nx) xb_add(&bar[XB_TOPGEN], 1u);
      else XB_SPIN(xb_ld(&bar[XB_TOPGEN]) == tg, bar);
      __builtin_amdgcn_fence(__ATOMIC_ACQUIRE, "agent");
      xb_add(&bar[XB_XGEN(b.x)], 1u);
      asm volatile("s_waitcnt vmcnt(0)" ::: "memory");
    } else {
      XB_SPIN(xb_ld(&bar[XB_XGEN(b.x)]) == gen, bar);
      __builtin_amdgcn_fence(__ATOMIC_ACQUIRE, "agent");
      asm volatile("s_waitcnt vmcnt(0)" ::: "memory");
    }
  }
  __syncthreads();
}

DI void transpose_tile(const float* __restrict__ src, int K, int N, bf16_t* __restrict__ dst, int mode, int kt, int nt, float* sm) {
  const int t = otid();
  const int k0 = kt * 64, n0 = nt * 64;
#pragma unroll
  for (int i = 0; i < 4; ++i) {
    const int idx = t + 256 * i, r = idx >> 4, c4 = idx & 15;
    float4 v = make_float4(0.f, 0.f, 0.f, 0.f);
    if (n0 + 4 * c4 < N) v = *(const float4*)(src + (size_t)(k0 + r) * N + n0 + 4 * c4);
    float* d = sm + r * 65 + 4 * c4;
    d[0] = v.x; d[1] = v.y; d[2] = v.z; d[3] = v.w;
  }
  __syncthreads();
#pragma unroll
  for (int i = 0; i < 2; ++i) {
    const int idx = t + 256 * i, nl = idx >> 3, kc = idx & 7;
    const int n = n0 + nl;
    if (n < N) {
      float x[8];
#pragma unroll
      for (int e = 0; e < 8; ++e) x[e] = sm[(8 * kc + e) * 65 + nl];
      uint4 w; w.x = pack2(x[0], x[1]); w.y = pack2(x[2], x[3]); w.z = pack2(x[4], x[5]); w.w = pack2(x[6], x[7]);
      int drow = n;
      if (mode == 1) drow = (n >> 4) * 32 + (n & 15);
      else if (mode == 2) drow = (n >> 4) * 32 + 16 + (n & 15);
      *(uint4*)(dst + (size_t)drow * K + k0 + 8 * kc) = w;
    }
  }
  __syncthreads();
}

DI void adaln_item(const Params& p, int it, float* sm) {
  const int t = otid();
  const int l = it / 72, chunk = it % 72, j0 = chunk * 128;
  float* scond = sm;
  float* red = sm + 3072;
  for (int i = t; i < 3072; i += 256) {
    const int c = i >> 10, k = i & 1023;
    const float v = (c == 0) ? p.in[8][k] : p.in[2][(c - 1) * 1024 + k];
    scond[i] = sigm_silu_acc(v);
  }
  __syncthreads();
  const int cgp = t & 31, kg = t >> 5;
  const float* w = p.in[9] + (size_t)l * 1024 * 9216 + j0 + 4 * cgp;
  float acc[3][4];
#pragma unroll
  for (int c = 0; c < 3; ++c)
#pragma unroll
    for (int e = 0; e < 4; ++e) acc[c][e] = 0.f;
#pragma unroll 8
  for (int kk = 0; kk < 128; ++kk) {
    const int k = kg * 128 + kk;
    const float4 wv = *(const float4*)(w + (size_t)k * 9216);
#pragma unroll
    for (int c = 0; c < 3; ++c) {
      const float s = scond[c * 1024 + k];
      acc[c][0] += s * wv.x; acc[c][1] += s * wv.y; acc[c][2] += s * wv.z; acc[c][3] += s * wv.w;
    }
  }
#pragma unroll
  for (int c = 0; c < 3; ++c)
#pragma unroll
    for (int e = 0; e < 4; ++e) red[(kg * 3 + c) * 128 + 4 * cgp + e] = acc[c][e];
  __syncthreads();
  float* mod = (float*)(p.ws + WS_MOD);
  for (int o = t; o < 384; o += 256) {
    const int c = o >> 7, j = o & 127;
    float s = p.in[10][l * 9216 + j0 + j];
#pragma unroll
    for (int g = 0; g < 8; ++g) s += red[(g * 3 + c) * 128 + j];
    mod[(l * 3 + c) * 9216 + j0 + j] = s;
  }
  __syncthreads();
}

DI void sincos_tab(float pos, float freq, float& cs, float& sn) {
  const double a = (double)pos * (double)freq;
  const double twopi = 6.283185307179586476925286766559;
  const double k = rint(a / twopi);
  const double r = (a - k * twopi) * 0.25;
  const double r2 = r * r;
  double s = r * (1.0 + r2 * (-1.0 / 6 + r2 * (1.0 / 120 + r2 * (-1.0 / 5040 + r2 * (1.0 / 362880 + r2 * (-1.0 / 39916800 + r2 * (1.0 / 6227020800.0)))))));
  double c = 1.0 + r2 * (-0.5 + r2 * (1.0 / 24 + r2 * (-1.0 / 720 + r2 * (1.0 / 40320 + r2 * (-1.0 / 3628800 + r2 * (1.0 / 479001600.0 + r2 * (-1.0 / 87178291200.0)))))));
  double s2 = 2.0 * s * c, c2 = 1.0 - 2.0 * s * s;
  double s4 = 2.0 * s2 * c2, c4 = 1.0 - 2.0 * s2 * s2;
  cs = (float)c4; sn = (float)s4;
}

struct TDesc { const float* src; bf16_t* dst; int K, N, mode, kt, nt; };
DI TDesc tile_desc(const Params& p, int r) {
  TDesc d;
  const int l = r / 5136; r -= l * 5136;
  if (r < 4224) {
    const int f = r / 2112; r -= f * 2112;
    const int which = r / 704; r -= which * 704;
    const int lf = l * 2 + f;
    if (which < 2) { d.src = p.in[which == 0 ? 12 : 13] + (size_t)lf * 1024 * 2816; d.dst = (bf16_t*)(p.ws + WS_WGU) + (size_t)lf * 5632 * 1024; d.K = 1024; d.N = 2816; d.mode = which + 1; d.kt = r / 44; d.nt = r % 44; }
    else { d.src = p.in[14] + (size_t)lf * 2816 * 1024; d.dst = (bf16_t*)(p.ws + WS_WD) + (size_t)lf * 1024 * 2816; d.K = 2816; d.N = 1024; d.mode = 0; d.kt = r / 16; d.nt = r % 16; }
  } else if (r < 4224 + 656) {
    r -= 4224;
    d.src = p.in[15] + (size_t)l * 1024 * PWR; d.dst = (bf16_t*)(p.ws + WS_WIN) + (size_t)l * PWR * 1024; d.K = 1024; d.N = PWR; d.mode = 3; d.kt = r / 41; d.nt = r % 41;
  } else {
    r -= 4224 + 656;
    d.src = p.in[25] + (size_t)l * 1024 * 1024; d.dst = (bf16_t*)(p.ws + WS_WOUT) + (size_t)l * 1024 * 1024; d.K = 1024; d.N = 1024; d.mode = 0; d.kt = r / 16; d.nt = r % 16;
  }
  return d;
}
DI void tile_load(const TDesc& d, int t, f32x4 (&v)[4]) {
  const int k0 = d.kt * 64, n0 = d.nt * 64;
#pragma unroll
  for (int i = 0; i < 4; ++i) {
    const int idx = t + 256 * i, r = idx >> 4, c4 = idx & 15;
    v[i] = (f32x4){0.f, 0.f, 0.f, 0.f};
    if (n0 + 4 * c4 < d.N) v[i] = __builtin_nontemporal_load((const f32x4*)(d.src + (size_t)(k0 + r) * d.N + n0 + 4 * c4));
  }
}
DI void tile_store(const TDesc& d, int t, const f32x4 (&v)[4], float* sm) {
  const int k0 = d.kt * 64, n0 = d.nt * 64;
#pragma unroll
  for (int i = 0; i < 4; ++i) {
    const int idx = t + 256 * i, r = idx >> 4, c4 = idx & 15;
    float* q = sm + r * 65 + 4 * c4;
    q[0] = v[i][0]; q[1] = v[i][1]; q[2] = v[i][2]; q[3] = v[i][3];
  }
  __syncthreads();
#pragma unroll
  for (int i = 0; i < 2; ++i) {
    const int idx = t + 256 * i, nl = idx >> 3, kc = idx & 7;
    const int n = n0 + nl;
    if (n < d.N) {
      float x[8];
#pragma unroll
      for (int e = 0; e < 8; ++e) x[e] = sm[(8 * kc + e) * 65 + nl];
      uint4 w; w.x = pack2(x[0], x[1]); w.y = pack2(x[2], x[3]); w.z = pack2(x[4], x[5]); w.w = pack2(x[6], x[7]);
      int drow = n;
      if (d.mode == 1) drow = (n >> 7) * 256 + (n & 127);
      else if (d.mode == 2) drow = (n >> 7) * 256 + 128 + (n & 127);
      else if (d.mode == 3) drow = n < 1152 ? n : (n < 1184 ? OFF_BGW + (n - 1152) : n - 32);
      *(uint4*)(d.dst + (size_t)drow * d.K + k0 + 8 * kc) = w;
    }
  }
  __syncthreads();
}

DI void convert_slice(const Params& p, int layer, int t_begin, int t_end, int first_blk, float* sm) {
  const int t = otid();
  const int nworkers = (gridDim.x - first_blk) * 2, w = (blockIdx.x - first_blk) * 2 + ohalf();
  int r = t_begin + w;
  f32x4 cur[4], nxt[4];
  TDesc dc = tile_desc(p, layer * 5136 + (r < t_end ? r : t_begin));
  if (r < t_end) tile_load(dc, t, cur);
#pragma unroll 1
  for (; r < t_end; r += nworkers) {
    const int rn = r + nworkers;
    TDesc dn = tile_desc(p, layer * 5136 + (rn < t_end ? rn : t_begin));
    if (rn < t_end) tile_load(dn, t, nxt);
    tile_store(dc, t, cur, sm);
    dc = dn;
#pragma unroll
    for (int i = 0; i < 4; ++i) cur[i] = nxt[i];
  }
}
DI void bias_from_f32(const Params& p, int layer, char* dsm) {
  const int tx = rtid(), lane = tx & 63, kc = tx >> 6;
  float* shl = (float*)dsm;
  float* red = shl + 3072;
  const float* mod = (const float*)(p.ws + WS_MOD);
  float* BIAS = (float*)(p.ws + WS_BIAS);
  const int nidle = gridDim.x - 192, me = blockIdx.x - 192;
#pragma unroll 1
  for (int task = me; task < 55; task += nidle) {
    const int mi = task / 11, ch = task - mi * 11;
    const int sub = mi < 2 ? 0 : (mi == 2 ? 1 : 2);
    const int N = mi == 2 ? PWR : 2816;
    const float* W = mi == 2 ? p.in[15] + (size_t)layer * 1024 * PWR
                             : p.in[(mi == 0 || mi == 3) ? 12 : 13] + (size_t)(layer * 2 + (mi < 2 ? 0 : 1)) * 1024 * 2816;
    __syncthreads();
    for (int i = tx; i < 3072; i += 512) { const int c = i >> 10, k = i & 1023; shl[i] = mod[((size_t)layer * 3 + c) * 9216 + (size_t)(3 * sub) * 1024 + k]; }
    __syncthreads();
    const int n = ch * 256 + lane * 4;
    f32x4 a0 = (f32x4){0.f, 0.f, 0.f, 0.f}, a1 = a0, a2 = a0;
    if (n < N) {
      const float* wp = W + (size_t)(kc * 128) * N + n;
#pragma unroll 8
      for (int i = 0; i < 128; ++i) {
        const f32x4 wv = *(const f32x4*)(wp + (size_t)i * N);
        const int k = kc * 128 + i;
        a0 += wv * shl[k]; a1 += wv * shl[1024 + k]; a2 += wv * shl[2048 + k];
      }
    }
    *(f32x4*)(red + (kc * 3 + 0) * 256 + lane * 4) = a0; *(f32x4*)(red + (kc * 3 + 1) * 256 + lane * 4) = a1; *(f32x4*)(red + (kc * 3 + 2) * 256 + lane * 4) = a2;
    __syncthreads();
    for (int o = tx; o < 768; o += 512) {
      const int c = o >> 8, j = o & 255, nn = ch * 256 + j;
      float s = 0.f;
#pragma unroll
      for (int g = 0; g < 8; ++g) s += red[(g * 3 + c) * 256 + j];
      if (nn < N) {
        int col;
        if (mi == 2) col = nn < 1152 ? nn : (nn < 1184 ? OFF_BGW + (nn - 1152) : nn - 32);
        else col = (nn >> 7) * 256 + (nn & 127) + ((mi == 1 || mi == 4) ? 128 : 0);
        BIAS[((size_t)(layer * 3 + sub) * 3 + c) * 5632 + col] = s;
      }
    }
  }
  __syncthreads();
}

DI void phase0(const Params& p, float* sm) {
  const int nb = vnb(), bid = obid(), t = otid();
#if PROBE == 6
  for (int prep_ = 0; prep_ < 2; ++prep_) {
#endif
  if (bid < 288) adaln_item(p, bid, sm);
  {
    const int n_tiles = 5136 + 3 * 2448;
    auto gid = [](int q) { return q < 5136 ? q : ((q - 5136) / 2448 + 1) * 5136 + 2688 + (q - 5136) % 2448; };
    int r, stride, lim;
    if (nb == 512) { if (bid < 288) { r = bid; stride = 288; lim = 5760; } else { r = 5760 + (bid - 288); stride = 224; lim = n_tiles; } }
    else { r = bid; stride = nb; lim = n_tiles; }
    f32x4 cur[4], nxt[4];
    TDesc dc = tile_desc(p, gid(r < lim ? r : 0));
    if (r < lim) tile_load(dc, t, cur);
#pragma unroll 1
    for (; r < lim; r += stride) {
      const int rn = r + stride;
      TDesc dn = tile_desc(p, gid(rn < lim ? rn : 0));
      if (rn < lim) tile_load(dn, t, nxt);
      tile_store(dc, t, cur, sm);
      dc = dn;
#pragma unroll
      for (int i = 0; i < 4; ++i) cur[i] = nxt[i];
    }
  }
#if PROBE == 6
  }
#endif
  #define gt ((size_t)(blockIdx.x * 512 + rtid()))
  const size_t gs = (size_t)gridDim.x * 512;
  {
    float4* dst = (float4*)p.out;
    const float4* s0 = (const float4*)p.in[0];
    const float4* s1 = (const float4*)p.in[1];
    const size_t n0 = (size_t)NCTX * 256, n1 = (size_t)NTOK * 256;
    for (size_t i = gt; i < n1; i += gs) dst[i] = (i < n0) ? s0[i] : s1[i - n0];
  }
  {
    bf16_t* kac = (bf16_t*)(p.ws + WS_KAC); bf16_t* vac = (bf16_t*)(p.ws + WS_VAC);
    for (size_t i = gt; i < 524288 / 4; i += gs) {
      const float4 a = ((const float4*)p.in[3])[i], b = ((const float4*)p.in[4])[i];
      uint2 wa, wb; wa.x = pack2(a.x, a.y); wa.y = pack2(a.z, a.w); wb.x = pack2(b.x, b.y); wb.y = pack2(b.z, b.w);
      ((uint2*)kac)[i] = wa; ((uint2*)vac)[i] = wb;
    }
    bf16_t* vcc = (bf16_t*)(p.ws + WS_VCC);
    for (size_t i = gt; i < 1572864 / 4; i += gs) {
      const float4 a = ((const float4*)p.in[6])[i];
      uint2 wa; wa.x = pack2(a.x, a.y); wa.y = pack2(a.z, a.w);
      ((uint2*)vcc)[i] = wa;
    }
    bf16_t* kcc = (bf16_t*)(p.ws + WS_KCC);
    for (size_t i = gt; i < 4096ull * 8 * 16; i += gs) {
      const size_t rv = i >> 4; const int g = (int)(i & 15);
      uint2 w = make_uint2(0, 0);
      if (g < 12) { const float4 a = *(const float4*)(p.in[5] + rv * 48 + 4 * g); w.x = pack2(a.x, a.y); w.y = pack2(a.z, a.w); }
      *(uint2*)(kcc + rv * 64 + 4 * g) = w;
    }
  }
  {
    float* rope = (float*)(p.ws + WS_ROPE);
    for (size_t i = gt; i < 1024 + 768; i += gs) {
      if (i < 1024) { const int pos = (int)i >> 4, f = (int)i & 15; float c, s; sincos_tab((float)pos, p.freqA[f], c, s); rope[i] = c; rope[1024 + i] = s; }
      else { const int j = (int)i - 1024; const int pos = j / 12, f = j % 12; float c, s; sincos_tab((float)pos, p.freqC[f], c, s); rope[2048 + j] = c; rope[2048 + 768 + j] = s; }
    }
    if (gt < 4) {
      const float* lc = p.in[23] + gt * 4 * 48;
      float s1 = 0.f, s2 = 0.f;
      for (int d = 0; d < 48; ++d) { s1 += lc[d] * lc[48 + d]; s2 += lc[96 + d] * lc[144 + d]; }
      ((float*)(p.ws + WS_MISC))[gt] = expf(s1) - expf(s2) + p.lam_init[gt];
      ((unsigned*)(p.ws + WS_MISC + 64))[gt] = 0u; ((unsigned*)(p.ws + WS_MISC + 64))[gt + 4] = 0u;
    }
  }
}
#undef gt

DI void norm0_bias_phase(const Params& p) {
  const int tx = rtid(); const int lane = tx & 63;
  const int gw = blockIdx.x * 8 + (tx >> 6), nw = gridDim.x * 8;
  const float* mod = (const float*)(p.ws + WS_MOD);
  {
    const float* g = p.in[11];
    bf16_t* H = (bf16_t*)(p.ws + WS_H);
    float* RS = (float*)(p.ws + WS_ROWSS);
    for (int row = gw; row < NTOK; row += nw) {
      const float* x = p.out + (size_t)row * 1024;
      float4 v[4]; float ss = 0.f;
#pragma unroll
      for (int c = 0; c < 4; ++c) { v[c] = *(const float4*)(x + c * 256 + lane * 4); ss += v[c].x * v[c].x + v[c].y * v[c].y + v[c].z * v[c].z + v[c].w * v[c].w; }
#pragma unroll
      for (int o = 32; o >= 1; o >>= 1) ss += __shfl_xor(ss, o);
      if (lane < 16) RS[(size_t)row * 16 + lane] = lane == 0 ? ss : 0.f;
      const float* mrow = mod + ((size_t)cond_of_row(row)) * 9216;
#pragma unroll
      for (int c = 0; c < 4; ++c) {
        const int j = c * 256 + lane * 4;
        const float4 gg = *(const float4*)(g + j), sc = *(const float4*)(mrow + 1024 + j);
        uint2 w; w.x = pack2(v[c].x * gg.x * (1.f + sc.x), v[c].y * gg.y * (1.f + sc.y)); w.y = pack2(v[c].z * gg.z * (1.f + sc.z), v[c].w * gg.w * (1.f + sc.w));
        *(uint2*)(H + (size_t)row * 1024 + j) = w;
      }
    }
  }
  {
    float* BIAS = (float*)(p.ws + WS_BIAS);
#pragma unroll 1
    for (int grp = 0; grp < 3; ++grp) {
      const int l = grp / 3, sub = grp - l * 3;
      const int ncol = sub == 1 ? PWR : 5632;
      const bf16_t* Wt = sub == 1 ? (const bf16_t*)(p.ws + WS_WIN) + (size_t)l * PWR * 1024 : (const bf16_t*)(p.ws + WS_WGU) + (size_t)(l * 2 + (sub >> 1)) * 5632 * 1024;
      float sh[3][16];
#pragma unroll
      for (int c = 0; c < 3; ++c) {
        const float* sp = mod + ((size_t)l * 3 + c) * 9216 + (size_t)(3 * sub) * 1024 + lane * 16;
#pragma unroll
        for (int q = 0; q < 4; ++q) { const float4 t = *(const float4*)(sp + 4 * q); sh[c][4 * q] = t.x; sh[c][4 * q + 1] = t.y; sh[c][4 * q + 2] = t.z; sh[c][4 * q + 3] = t.w; }
      }
#pragma unroll 2
      for (int n = gw; n < ncol; n += nw) {
        float w[16]; unpack8(*(const uint4*)(Wt + (size_t)n * 1024 + lane * 16), w); unpack8(*(const uint4*)(Wt + (size_t)n * 1024 + lane * 16 + 8), w + 8);
        float d0 = 0.f, d1 = 0.f, d2 = 0.f;
#pragma unroll
        for (int e = 0; e < 16; ++e) { d0 += sh[0][e] * w[e]; d1 += sh[1][e] * w[e]; d2 += sh[2][e] * w[e]; }
#pragma unroll
        for (int o = 32; o >= 1; o >>= 1) { d0 += __shfl_xor(d0, o); d1 += __shfl_xor(d1, o); d2 += __shfl_xor(d2, o); }
        if (lane < 3) BIAS[((size_t)grp * 3 + lane) * 5632 + n] = lane == 0 ? d0 : (lane == 1 ? d1 : d2);
      }
    }
  }
}

enum { EPI_SWIGLU = 0, EPI_RESID = 1, EPI_PROJ = 2 };

template <int EPI>
DI void gemm_phase(const Params& p, const bf16_t* __restrict__ A, int lda, const bf16_t* __restrict__ Bt, int K, int NT,
                   const float* __restrict__ gate_base  , float coef, char* smem) {
  const int tid = otid(), lane = tid & 63, wave = tid >> 6, wm = wave >> 1, wn = wave & 1;
  const int nb = vnb(), xcd = obid() & 7, slot = obid() >> 3, slots = nb >> 3;
  const int per_x = 12 * NT;
  const int nk = K >> 6;
  char* As = smem;
  char* Bs = smem + 32768;
  for (int q = slot; q < per_x; q += slots) {
    const int grp = q / (4 * NT), r = q - grp * 4 * NT, nt = r >> 2, mtl = r & 3, mt = (grp * 4 + mtl) * 8 + xcd;
    const int m0 = mt * 128, n0 = nt * 128;
    f32x4 acc[4][4];
#pragma unroll
    for (int i = 0; i < 4; ++i)
#pragma unroll
      for (int j = 0; j < 4; ++j) acc[i][j] = (f32x4){0.f, 0.f, 0.f, 0.f};
    const bf16_t* Ag = A + (size_t)(m0 + (tid >> 3)) * lda + (tid & 7) * 8;
    const bf16_t* Bg = Bt + (size_t)(n0 + (tid >> 3)) * K + (tid & 7) * 8;
    const int lrow = tid >> 3, lch = tid & 7;
    uint4 ra[4], rb[4];
#pragma unroll
    for (int i = 0; i < 4; ++i) { ra[i] = *(const uint4*)(Ag + (size_t)(32 * i) * lda); rb[i] = *(const uint4*)(Bg + (size_t)(32 * i) * K); }
#pragma unroll
    for (int i = 0; i < 4; ++i) {
      const int row = lrow + 32 * i; const int off = row * 128 + ((lch ^ (row & 7)) << 4);
      *(uint4*)(As + off) = ra[i]; *(uint4*)(Bs + off) = rb[i];
    }
    __syncthreads();
    for (int kt = 0; kt < nk; ++kt) {
      const int cur = kt & 1;
      if (kt + 1 < nk) {
        const int k0 = (kt + 1) * 64;
#pragma unroll
        for (int i = 0; i < 4; ++i) { ra[i] = *(const uint4*)(Ag + (size_t)(32 * i) * lda + k0); rb[i] = *(const uint4*)(Bg + (size_t)(32 * i) * K + k0); }
      }
      const char* as = As + cur * 16384; const char* bs = Bs + cur * 16384;
#pragma unroll
      for (int ks = 0; ks < 2; ++ks) {
        bf16x8 ax[4], bw[4];
        const int ch = ((ks * 4 + (lane >> 4)) ^ (lane & 7)) << 4;
#pragma unroll
        for (int i = 0; i < 4; ++i) {
          ax[i] = *(const bf16x8*)(as + (wm * 64 + i * 16 + (lane & 15)) * 128 + ch);
          bw[i] = *(const bf16x8*)(bs + (wn * 64 + i * 16 + (lane & 15)) * 128 + ch);
        }
#pragma unroll
        for (int mi = 0; mi < 4; ++mi)
#pragma unroll
          for (int ni = 0; ni < 4; ++ni) acc[mi][ni] = __builtin_amdgcn_mfma_f32_16x16x32_bf16(bw[ni], ax[mi], acc[mi][ni], 0, 0, 0);
      }
      if (kt + 1 < nk) {
        const int nxt = cur ^ 1;
#pragma unroll
        for (int i = 0; i < 4; ++i) {
          const int row = lrow + 32 * i; const int off = nxt * 16384 + row * 128 + ((lch ^ (row & 7)) << 4);
          *(uint4*)(As + off) = ra[i]; *(uint4*)(Bs + off) = rb[i];
        }
      }
      __syncthreads();
    }
    const int tok0 = m0 + wm * 64 + (lane & 15);
    const int nc0 = n0 + wn * 64 + (lane >> 4) * 4;
    if (EPI == EPI_SWIGLU) {
      bf16_t* ACT = (bf16_t*)(p.ws + WS_ACT);
#pragma unroll
      for (int mi = 0; mi < 4; ++mi) {
        const size_t rowoff = (size_t)(tok0 + mi * 16) * DFF;
#pragma unroll
        for (int pr = 0; pr < 2; ++pr) {
          const f32x4 g = acc[mi][2 * pr], u = acc[mi][2 * pr + 1];
          const int ffc = ((n0 + wn * 64) >> 1) + pr * 16 + (lane >> 4) * 4;
          uint2 w; w.x = pack2(silu_f(g[0]) * u[0], silu_f(g[1]) * u[1]); w.y = pack2(silu_f(g[2]) * u[2], silu_f(g[3]) * u[3]);
          *(uint2*)(ACT + rowoff + ffc) = w;
        }
      }
    } else if (EPI == EPI_RESID) {
      const float* gv = gate_base + (size_t)cond_of_row(m0) * 9216;
#pragma unroll
      for (int ni = 0; ni < 4; ++ni) {
        const int n = nc0 + ni * 16;
        const float4 gg = *(const float4*)(gv + n);
#pragma unroll
        for (int mi = 0; mi < 4; ++mi) {
          float* xp = p.out + (size_t)(tok0 + mi * 16) * 1024 + n;
          float4 xv = *(const float4*)xp;
          xv.x += coef * gg.x * acc[mi][ni][0]; xv.y += coef * gg.y * acc[mi][ni][1];
          xv.z += coef * gg.z * acc[mi][ni][2]; xv.w += coef * gg.w * acc[mi][ni][3];
          *(float4*)xp = xv;
        }
      }
    } else {
      bf16_t* PR = (bf16_t*)(p.ws + WS_PROJ);
#pragma unroll
      for (int ni = 0; ni < 4; ++ni) {
        const int n = nc0 + ni * 16;
        if (n < PW) {
#pragma unroll
          for (int mi = 0; mi < 4; ++mi) {
            uint2 w; w.x = pack2(acc[mi][ni][0], acc[mi][ni][1]); w.y = pack2(acc[mi][ni][2], acc[mi][ni][3]);
            *(uint2*)(PR + (size_t)(tok0 + mi * 16) * PW + n) = w;
          }
        }
      }
    }
  }
}


namespace pg8 {
#define PG8_LAS __attribute__((address_space(3)))
typedef unsigned short bf16_t;
typedef short bf16x8 __attribute__((ext_vector_type(8)));
typedef float f32x4 __attribute__((ext_vector_type(4)));
typedef unsigned u32x4 __attribute__((ext_vector_type(4)));
constexpr int BM = 256, BK = 64, HALF = 128, HTB = HALF * BK * 2  , STAGE_BYTES = 8 * HTB, NXCD = 8, WGM = 8;

__host__ __device__ __forceinline__ int lds_byte(int r, int c) { const int st = (r >> 4) * 2 + (c >> 5), rr = r & 15, cc = c & 31, ob = rr * 64 + cc * 2; return st * 1024 + (ob ^ (((ob >> 9) & 1) << 5)); }
__host__ __device__ __forceinline__ void stage_rc(int b, int& R, int& C) { const int st = b / 1024, sb = b % 1024, swz = sb ^ (((sb >> 9) & 1) << 5); R = (st >> 1) * 16 + swz / 64; C = (st & 1) * 32 + (swz % 64) / 2; }
__host__ __device__ __forceinline__ int perm32(int rho) { const int n = rho >> 4, i = rho & 15; return 8 * (i >> 2) + 4 * n + (i & 3); }

struct Unit { int pm, pn; };
struct Gemm { const bf16_t* A; const bf16_t* Bt; int M, N, K; };

struct StaticOrder {
    int nM, nN, nwg, G, c;
    __host__ __device__ void init(int M, int N, int G_, int c_) { nM = M / BM; nN = N / BM; nwg = nM * nN; G = G_; c = c_; }
    __host__ __device__ bool next(int i, Unit& u) const {
        const long L = (long)i * G + c; if (L >= nwg) return false;
        int wgid = (int)L; { const int q = nwg / NXCD, r = nwg % NXCD, xcd = wgid % NXCD, off = wgid / NXCD; wgid = (xcd < r ? xcd * (q + 1) : r * (q + 1) + (xcd - r) * q) + off; }
        const int nig = WGM * nN, gid = wgid / nig, fm = gid * WGM, gsz = (nM - fm) < WGM ? (nM - fm) : WGM;
        u.pm = fm + ((wgid % nig) % gsz); u.pn = (wgid % nig) / gsz; return true;
    }
    __device__ __forceinline__ void a_ready(const Unit&) const {}
    __device__ __forceinline__ void done(const Unit&) const {}
};
template <class Epi, class Sched, bool ALIGN_EPI = false, bool SP2 = false>
__device__ __forceinline__ void gemm_phase(PG8_LAS unsigned char* lds, const Gemm g, const Sched& S, const Epi& E) {
    const int tid = rtid(), wid = __builtin_amdgcn_readfirstlane(tid >> 6), lane = tid & 63, wr = wid >> 2, wc = wid & 3, fr = lane & 15, fq = lane >> 4;
    const int K = g.K, nt = K / BK;
    unsigned voffA[2], voffB[2];
#pragma unroll
    for (int i = 0; i < 2; ++i) { int R, C; stage_rc(tid * 16 + i * 8192, R, C); const int Rb = Epi::PERM ? ((R & ~31) + perm32(R & 31)) : R;
        voffA[i] = (unsigned)(R * K + C) * 2u; voffB[i] = (unsigned)(Rb * K + C) * 2u; }
    const size_t kstep = (size_t)(BK * 2);
    const size_t hstep = (size_t)HALF * K * 2;
    const size_t tstep = 2 * hstep;
    const unsigned ldsw = (unsigned)wid * 1024u;
    const int aoff = lds_byte(wr * 64 + fr, fq * 8), boff = lds_byte(wc * 32 + fr, fq * 8);
#define PG8_SA(b, h) (((b) * 2 + (h)) * HTB)
#define PG8_SB(b, h) ((4 + (b) * 2 + (h)) * HTB)
#define PG8_STAGE(bufoff, gbase, voff) do { _Pragma("unroll") for (int _i = 0; _i < 2; ++_i) \
        __builtin_amdgcn_global_load_lds((const unsigned*)((const char*)(gbase) + (voff)[_i]), (PG8_LAS unsigned*)(lds + (bufoff) + ldsw + _i * 8192), 16, 0, 0); } while (0)
#define PG8_LDA(dst, b, h) do { _Pragma("unroll") for (int m = 0; m < 4; ++m) _Pragma("unroll") for (int k = 0; k < 2; ++k) dst[m][k] = *(const PG8_LAS bf16x8*)(lds + PG8_SA(b, h) + aoff + m * 2048 + k * 1024); } while (0)
#define PG8_LDB(dst, b, h) do { _Pragma("unroll") for (int n = 0; n < 2; ++n) _Pragma("unroll") for (int k = 0; k < 2; ++k) dst[n][k] = *(const PG8_LAS bf16x8*)(lds + PG8_SB(b, h) + boff + n * 2048 + k * 1024); } while (0)
#define PG8_MMA(ai, bj, At, Bt) do { __builtin_amdgcn_s_setprio(1); _Pragma("unroll") for (int m = 0; m < 4; ++m) _Pragma("unroll") for (int n = 0; n < 2; ++n) _Pragma("unroll") for (int k = 0; k < 2; ++k) \
        acc[ai][bj][m][n] = __builtin_amdgcn_mfma_f32_16x16x32_bf16(Bt[n][k], At[m][k], acc[ai][bj][m][n], 0, 0, 0); __builtin_amdgcn_s_setprio(0); } while (0)
#define PG8_WAIT_V(n) asm volatile("s_waitcnt vmcnt(" #n ")" ::: "memory")
#define PG8_WAIT_L(n) asm volatile("s_waitcnt lgkmcnt(" #n ")" ::: "memory")
#define PG8_BAR __builtin_amdgcn_s_barrier()
#define PG8_SCHED __builtin_amdgcn_sched_barrier(0)
    Unit cur, nxt; int ui = 0;
    if (!S.next(0, cur)) return;
    f32x4 acc[2][2][4][2];
#pragma unroll
    for (int a = 0; a < 2; ++a)
#pragma unroll
        for (int b = 0; b < 2; ++b)
#pragma unroll
            for (int m = 0; m < 4; ++m)
#pragma unroll
                for (int n = 0; n < 2; ++n) acc[a][b][m][n] = (f32x4){0.f, 0.f, 0.f, 0.f};
    bf16x8 At[4][2], B0[2][2], B1[2][2];
    const char* cA = (const char*)g.A + (size_t)cur.pm * tstep; const char* cB = (const char*)g.Bt + (size_t)cur.pn * tstep;
    S.a_ready(cur);
    if constexpr (SP2) {
        PG8_STAGE(PG8_SB(0, 0), cB, voffB); PG8_STAGE(PG8_SB(0, 1), cB + hstep, voffB); PG8_STAGE(PG8_SA(0, 0), cA, voffA); PG8_STAGE(PG8_SA(0, 1), cA + hstep, voffA);
        if (wr == 1) PG8_BAR;
        PG8_WAIT_V(2); PG8_BAR;
        PG8_STAGE(PG8_SB(1, 0), cB + kstep, voffB); PG8_STAGE(PG8_SA(1, 0), cA + kstep, voffA); PG8_STAGE(PG8_SB(1, 1), cB + hstep + kstep, voffB);
        PG8_WAIT_V(6); PG8_BAR;
    } else {
        PG8_STAGE(PG8_SB(0, 0), cB, voffB); PG8_STAGE(PG8_SA(0, 0), cA, voffA); PG8_STAGE(PG8_SB(0, 1), cB + hstep, voffB); PG8_STAGE(PG8_SA(0, 1), cA + hstep, voffA);
        if (wr == 1) PG8_BAR;
        PG8_WAIT_V(4); PG8_BAR;
        PG8_STAGE(PG8_SB(1, 0), cB + kstep, voffB); PG8_STAGE(PG8_SA(1, 0), cA + kstep, voffA); PG8_STAGE(PG8_SB(1, 1), cB + hstep + kstep, voffB);
        PG8_WAIT_V(6); PG8_BAR;
    }
    for (;;) {
        const bool has_next = S.next(ui + 1, nxt);
        const char* nA = has_next ? (const char*)g.A + (size_t)nxt.pm * tstep : cA; const char* nB = has_next ? (const char*)g.Bt + (size_t)nxt.pn * tstep : cB;
        for (int t = 0; t < nt; t += 2) {
            const bool last = (t == nt - 2);
            const char* a1 = cA + (size_t)(t + 1) * kstep;
            const char* a2 = last ? nA : cA + (size_t)(t + 2) * kstep; const char* b2 = last ? nB : cB + (size_t)(t + 2) * kstep;
            const char* a3 = a2 + kstep; const char* b3 = b2 + kstep;
            if (last && has_next) S.a_ready(nxt);
            if constexpr (SP2) {
            PG8_LDB(B0, 0, 0); PG8_LDB(B1, 0, 1); PG8_SCHED; PG8_LDA(At, 0, 0); PG8_STAGE(PG8_SA(1, 1), a1 + hstep, voffA);
            PG8_WAIT_V(8); PG8_WAIT_L(0); PG8_BAR; PG8_MMA(0, 0, At, B0); PG8_MMA(0, 1, At, B1); PG8_BAR; PG8_SCHED;
            PG8_LDA(At, 0, 1); PG8_STAGE(PG8_SB(0, 0), b2, voffB); PG8_STAGE(PG8_SB(0, 1), b2 + hstep, voffB); PG8_STAGE(PG8_SA(0, 0), a2, voffA);
            PG8_WAIT_V(8); PG8_WAIT_L(0); PG8_BAR; PG8_MMA(1, 0, At, B0); PG8_MMA(1, 1, At, B1); PG8_BAR; PG8_SCHED;
            PG8_LDB(B0, 1, 0); PG8_LDB(B1, 1, 1); PG8_SCHED; PG8_LDA(At, 1, 0); PG8_STAGE(PG8_SA(0, 1), a2 + hstep, voffA);
            PG8_WAIT_V(8); PG8_WAIT_L(0); PG8_BAR; PG8_MMA(0, 0, At, B0); PG8_MMA(0, 1, At, B1); PG8_BAR; PG8_SCHED;
            PG8_LDA(At, 1, 1); PG8_STAGE(PG8_SB(1, 0), b3, voffB); PG8_STAGE(PG8_SB(1, 1), b3 + hstep, voffB); PG8_STAGE(PG8_SA(1, 0), a3, voffA);
            PG8_WAIT_V(8); PG8_WAIT_L(0); PG8_BAR; PG8_MMA(1, 0, At, B0); PG8_MMA(1, 1, At, B1); PG8_BAR; PG8_SCHED;
            } else {
            PG8_LDB(B0, 0, 0); PG8_SCHED; PG8_LDA(At, 0, 0); PG8_STAGE(PG8_SA(1, 1), a1 + hstep, voffA);
            PG8_WAIT_L(8); PG8_BAR; PG8_WAIT_L(0); PG8_MMA(0, 0, At, B0); PG8_BAR; PG8_SCHED;
            PG8_LDB(B1, 0, 1); PG8_STAGE(PG8_SB(0, 0), b2, voffB);
            PG8_BAR; PG8_WAIT_L(0); PG8_MMA(0, 1, At, B1); PG8_BAR;
            PG8_LDA(At, 0, 1); PG8_STAGE(PG8_SA(0, 0), a2, voffA);
            PG8_BAR; PG8_WAIT_L(0); PG8_MMA(1, 0, At, B0); PG8_BAR; PG8_SCHED;
            PG8_STAGE(PG8_SB(0, 1), b2 + hstep, voffB);
            PG8_WAIT_V(6); PG8_BAR; PG8_MMA(1, 1, At, B1); PG8_BAR;
            PG8_LDB(B0, 1, 0); PG8_SCHED; PG8_LDA(At, 1, 0); PG8_STAGE(PG8_SA(0, 1), a2 + hstep, voffA);
            PG8_WAIT_L(8); PG8_BAR; PG8_WAIT_L(0); PG8_MMA(0, 0, At, B0); PG8_BAR; PG8_SCHED;
            PG8_LDB(B1, 1, 1); PG8_STAGE(PG8_SB(1, 0), b3, voffB);
            PG8_BAR; PG8_WAIT_L(0); PG8_MMA(0, 1, At, B1); PG8_BAR;
            PG8_LDA(At, 1, 1); PG8_STAGE(PG8_SA(1, 0), a3, voffA);
            PG8_BAR; PG8_WAIT_L(0); PG8_MMA(1, 0, At, B0); PG8_BAR; PG8_SCHED;
            PG8_STAGE(PG8_SB(1, 1), b3 + hstep, voffB);
            PG8_WAIT_V(6); PG8_BAR; PG8_MMA(1, 1, At, B1); PG8_BAR;
            }
        }
        if constexpr (ALIGN_EPI) { if (wr == 0) PG8_BAR; }
        if constexpr (!Epi::AFTER_DRAIN) { E(acc, cur, wr, wc, fr, fq); S.done(cur); }
        if (!has_next) break;
#pragma unroll
        for (int a = 0; a < 2; ++a)
#pragma unroll
            for (int b = 0; b < 2; ++b)
#pragma unroll
                for (int m = 0; m < 4; ++m)
#pragma unroll
                    for (int n = 0; n < 2; ++n) acc[a][b][m][n] = (f32x4){0.f, 0.f, 0.f, 0.f};
        cur = nxt; cA = nA; cB = nB; ++ui;
        if constexpr (ALIGN_EPI) { if (wr == 1) PG8_BAR; }
    }
    PG8_WAIT_V(0);
    if constexpr (!ALIGN_EPI) { if (wr == 0) PG8_BAR; }
    PG8_BAR;
    if constexpr (Epi::AFTER_DRAIN) { E.fused(acc, cur, wr, wc, fr, fq, lds, wid, lane); S.done(cur); }
#undef PG8_SA
#undef PG8_SB
#undef PG8_STAGE
#undef PG8_LDA
#undef PG8_LDB
#undef PG8_MMA
#undef PG8_WAIT_V
#undef PG8_WAIT_L
#undef PG8_BAR
#undef PG8_SCHED
}
}

DI void wave_rstd(const float* RS, int rowbase  , int lane, float& r0, float& r1) {
  const float* a = RS + (size_t)(rowbase + lane) * 16; const float* b = a + 128 * 16;
  const float4 a0 = *(const float4*)a, a1 = *(const float4*)(a + 4), a2 = *(const float4*)(a + 8), a3 = *(const float4*)(a + 12);
  const float4 b0 = *(const float4*)b, b1 = *(const float4*)(b + 4), b2 = *(const float4*)(b + 8), b3 = *(const float4*)(b + 12);
  const float sa = ((a0.x + a0.y) + (a0.z + a0.w)) + ((a1.x + a1.y) + (a1.z + a1.w)) + ((a2.x + a2.y) + (a2.z + a2.w)) + ((a3.x + a3.y) + (a3.z + a3.w));
  const float sb = ((b0.x + b0.y) + (b0.z + b0.w)) + ((b1.x + b1.y) + (b1.z + b1.w)) + ((b2.x + b2.y) + (b2.z + b2.w)) + ((b3.x + b3.y) + (b3.z + b3.w));
  r0 = rsqrtf(sa * (1.f / 1024.f) + EPSN); r1 = rsqrtf(sb * (1.f / 1024.f) + EPSN);
}
struct EpiSwiglu {
  static constexpr bool PERM = true, AFTER_DRAIN = false;
  bf16_t* ACT; const float* RS; const float* bias  ;
  DI void operator()(const f32x4 (&acc)[2][2][4][2], const pg8::Unit& u, int wr, int wc, int fr, int fq) const {
    const int row0 = u.pm * 256 + wr * 64 + fr, lane = fq * 16 + fr;
    float rs[2]; wave_rstd(RS, u.pm * 256 + wr * 64, lane, rs[0], rs[1]);
    const float* bp = bias + (size_t)cond_of_row(u.pm * 256) * 5632 + u.pn * 256 + wc * 32 + 8 * fq;
    const f32x4 bg0 = *(const f32x4*)(bp), bg1 = *(const f32x4*)(bp + 4), bu0 = *(const f32x4*)(bp + 128), bu1 = *(const f32x4*)(bp + 132);
#pragma unroll
    for (int ai = 0; ai < 2; ++ai)
#pragma unroll
      for (int m = 0; m < 4; ++m) {
        const float r = __shfl(rs[ai], 16 * m + fr);
        const f32x4 g0 = acc[ai][0][m][0] * r + bg0, g1 = acc[ai][0][m][1] * r + bg1, v0 = acc[ai][1][m][0] * r + bu0, v1 = acc[ai][1][m][1] * r + bu1;
        uint4 w;
        w.x = pack2(silu_f(g0[0]) * v0[0], silu_f(g0[1]) * v0[1]); w.y = pack2(silu_f(g0[2]) * v0[2], silu_f(g0[3]) * v0[3]);
        w.z = pack2(silu_f(g1[0]) * v1[0], silu_f(g1[1]) * v1[1]); w.w = pack2(silu_f(g1[2]) * v1[2], silu_f(g1[3]) * v1[3]);
        *(uint4*)(ACT + (size_t)(row0 + ai * 128 + m * 16) * DFF + u.pn * 128 + wc * 32 + 8 * fq) = w;
      }
  }
};
struct EpiResid {
  static constexpr bool PERM = true, AFTER_DRAIN = false;
  float* X; const float* gate_base; float coef;
  bf16_t* H; float* RS; const float* nxt_g  ; const float* nxt_scale  ;
  DI void operator()(const f32x4 (&acc)[2][2][4][2], const pg8::Unit& u, int wr, int wc, int fr, int fq) const {
    const int row0 = u.pm * 256 + wr * 64 + fr, col0 = u.pn * 256 + wc * 32 + 8 * fq;
    const int cond = cond_of_row(u.pm * 256);
    const float* gv = gate_base + (size_t)cond * 9216 + col0;
    const bool has_next = nxt_g != nullptr;
    float ss[2][4];
#pragma unroll
    for (int ai = 0; ai < 2; ++ai)
#pragma unroll
      for (int m = 0; m < 4; ++m) ss[ai][m] = 0.f;
#pragma unroll
    for (int bj = 0; bj < 2; ++bj) {
      const int co = bj * 128;
      const float4 gg0 = *(const float4*)(gv + co), gg1 = *(const float4*)(gv + co + 4);
      float4 hv0 = make_float4(0.f, 0.f, 0.f, 0.f), hv1 = hv0;
      if (has_next) {
        const float* gp = nxt_g + col0 + co; const float* sp = nxt_scale + (size_t)cond * 9216 + col0 + co;
        const float4 g20 = *(const float4*)gp, g21 = *(const float4*)(gp + 4), s20 = *(const float4*)sp, s21 = *(const float4*)(sp + 4);
        hv0 = make_float4(g20.x * (1.f + s20.x), g20.y * (1.f + s20.y), g20.z * (1.f + s20.z), g20.w * (1.f + s20.w));
        hv1 = make_float4(g21.x * (1.f + s21.x), g21.y * (1.f + s21.y), g21.z * (1.f + s21.z), g21.w * (1.f + s21.w));
      }
#pragma unroll
      for (int ai = 0; ai < 2; ++ai)
#pragma unroll
        for (int m = 0; m < 4; ++m) {
          const size_t off = (size_t)(row0 + ai * 128 + m * 16) * 1024 + col0 + co;
          float4 x0 = *(const float4*)(X + off), x1 = *(const float4*)(X + off + 4);
          const f32x4 a0 = acc[ai][bj][m][0], a1 = acc[ai][bj][m][1];
          x0.x += coef * gg0.x * a0[0]; x0.y += coef * gg0.y * a0[1]; x0.z += coef * gg0.z * a0[2]; x0.w += coef * gg0.w * a0[3];
          x1.x += coef * gg1.x * a1[0]; x1.y += coef * gg1.y * a1[1]; x1.z += coef * gg1.z * a1[2]; x1.w += coef * gg1.w * a1[3];
          *(float4*)(X + off) = x0; *(float4*)(X + off + 4) = x1;
          if (has_next) {
            ss[ai][m] += ((x0.x * x0.x + x0.y * x0.y) + (x0.z * x0.z + x0.w * x0.w)) + ((x1.x * x1.x + x1.y * x1.y) + (x1.z * x1.z + x1.w * x1.w));
            uint4 w; w.x = pack2(x0.x * hv0.x, x0.y * hv0.y); w.y = pack2(x0.z * hv0.z, x0.w * hv0.w); w.z = pack2(x1.x * hv1.x, x1.y * hv1.y); w.w = pack2(x1.z * hv1.z, x1.w * hv1.w);
            *(uint4*)(H + off) = w;
          }
        }
    }
    if (has_next) {
#pragma unroll
      for (int ai = 0; ai < 2; ++ai)
#pragma unroll
        for (int m = 0; m < 4; ++m) {
          float s = ss[ai][m];
          s += __shfl_xor(s, 16); s += __shfl_xor(s, 32);
          if (fq == 0) RS[(size_t)(row0 + ai * 128 + m * 16) * 16 + u.pn * 4 + wc] = s;
        }
    }
  }
};
struct EpiProj {
  static constexpr bool PERM = true, AFTER_DRAIN = false;
  bf16_t* PR; const float* RS; const float* bias  ;
  DI void operator()(const f32x4 (&acc)[2][2][4][2], const pg8::Unit& u, int wr, int wc, int fr, int fq) const {
    const int row0 = u.pm * 256 + wr * 64 + fr, col0 = u.pn * 256 + wc * 32 + 8 * fq, lane = fq * 16 + fr;
    float rs[2]; wave_rstd(RS, u.pm * 256 + wr * 64, lane, rs[0], rs[1]);
    float rr[2][4];
#pragma unroll
    for (int ai = 0; ai < 2; ++ai)
#pragma unroll
      for (int m = 0; m < 4; ++m) rr[ai][m] = __shfl(rs[ai], 16 * m + fr);
    const float* bp = bias + (size_t)cond_of_row(u.pm * 256) * 5632;
#pragma unroll
    for (int bj = 0; bj < 2; ++bj) {
      const int col = col0 + bj * 128;
      if (col < PW) {
        const f32x4 b0 = *(const f32x4*)(bp + col), b1 = *(const f32x4*)(bp + col + 4);
#pragma unroll
        for (int ai = 0; ai < 2; ++ai)
#pragma unroll
          for (int m = 0; m < 4; ++m) {
            const f32x4 a0 = acc[ai][bj][m][0] * rr[ai][m] + b0, a1 = acc[ai][bj][m][1] * rr[ai][m] + b1;
            uint4 w; w.x = pack2(a0[0], a0[1]); w.y = pack2(a0[2], a0[3]); w.z = pack2(a1[0], a1[1]); w.w = pack2(a1[2], a1[3]);
            *(uint4*)(PR + (size_t)(row0 + ai * 128 + m * 16) * PW + col) = w;
          }
      }
    }
  }
};
template <class Epi>
DI void gemm8_run(const bf16_t* acts, const bf16_t* wts, int Nw, int K, const Epi& E, char* dsm) {
  pg8::Gemm g; g.A = acts; g.Bt = wts; g.M = NTOK; g.N = Nw; g.K = K;
  pg8::StaticOrder S; S.init(NTOK, Nw, (int)gridDim.x, (int)blockIdx.x);
  pg8::gemm_phase<Epi, pg8::StaticOrder, true, true>((LDSP unsigned char*)dsm, g, S, E);
}

DI void prep_gla_tile(const Params& p, int l, int tt, char* smem) {
  const int tid = otid();
  const bf16_t* PR = (const bf16_t*)(p.ws + WS_PROJ);
  float* GB = (float*)(p.ws + WS_GB); float* ATOT = (float*)(p.ws + WS_ATOT); float* U = (float*)(p.ws + WS_U);
  const int row0 = tt * 64;
  float* bg = (float*)smem;
  bf16_t* ks = (bf16_t*)(smem + 8192);
  bf16_t* vs = (bf16_t*)(smem + 8192 + 16384);
  {
    {
      const int lane = tid & 63, wv = tid >> 6, fr = lane & 15, fq = lane >> 4;
      const bf16_t* hp = (const bf16_t*)(p.ws + WS_H) + (size_t)(row0 + wv * 16 + fr) * 1024 + 8 * fq;
      const bf16_t* wp = (const bf16_t*)(p.ws + WS_WIN) + ((size_t)l * PWR + OFF_BGW + fr) * 1024 + 8 * fq;
      f32x4 c0 = (f32x4){0.f, 0.f, 0.f, 0.f}, c1 = c0;
#pragma unroll 8
      for (int ks = 0; ks < 32; ++ks) {
        const bf16x8 a = *(const bf16x8*)(hp + 32 * ks), b0 = *(const bf16x8*)(wp + 32 * ks), b1 = *(const bf16x8*)(wp + 16 * 1024 + 32 * ks);
        c0 = __builtin_amdgcn_mfma_f32_16x16x32_bf16(a, b0, c0, 0, 0, 0);
        c1 = __builtin_amdgcn_mfma_f32_16x16x32_bf16(a, b1, c1, 0, 0, 0);
      }
      const float* rsp = (const float*)(p.ws + WS_ROWSS) + (size_t)(row0 + wv * 16 + fr) * 16;
      const float4 r0 = *(const float4*)rsp, r1 = *(const float4*)(rsp + 4), r2 = *(const float4*)(rsp + 8), r3 = *(const float4*)(rsp + 12);
      const float rs = rsqrtf((((r0.x + r0.y) + (r0.z + r0.w)) + ((r1.x + r1.y) + (r1.z + r1.w)) + ((r2.x + r2.y) + (r2.z + r2.w)) + ((r3.x + r3.y) + (r3.z + r3.w))) * (1.f / 1024.f) + EPSN);
      const float* bp = (const float*)(p.ws + WS_BIAS) + ((size_t)(l * 3 + 1) * 3 + cond_of_row(row0)) * 5632 + OFF_BGW;
      const float bb0 = bp[fr], bb1 = bp[16 + fr];
#pragma unroll
      for (int r = 0; r < 4; ++r) {
        const float rr = __shfl(rs, 4 * fq + r);
        float* dst = bg + (wv * 16 + 4 * fq + r) * 32;
        dst[fr] = c0[r] * rr + bb0; dst[16 + fr] = c1[r] * rr + bb1;
      }
    }
#pragma unroll
    for (int q = 0; q < 4; ++q) { const int c = tid + 256 * q, row = c >> 4, ch = c & 15; *(uint4*)(ks + row * 128 + 8 * ch) = *(const uint4*)(PR + (size_t)(row0 + row) * PW + OFF_BK + 8 * ch); }
#pragma unroll
    for (int q = 0; q < 8; ++q) { const int c = tid + 256 * q, row = c >> 5, ch = c & 31; *(uint4*)(vs + row * 256 + 8 * ch) = *(const uint4*)(PR + (size_t)(row0 + row) * PW + OFF_BV + 8 * ch); }
  }
  __syncthreads();
  const int s = tid >> 7, k = tid & 127, h = k >> 5, d = k & 31;
  float w[16];
#pragma unroll
  for (int r = 0; r < 16; ++r) w[r] = p.in[18][((size_t)(l * 2 + s) * 16 + r) * 128 + k];
  const float bias = p.in[19][(l * 2 + s) * 128 + k];
  float acc[64];
#pragma unroll
  for (int x = 0; x < 64; ++x) acc[x] = 0.f;
  float run = 0.f;
#pragma unroll 2
  for (int ii = 0; ii < 64; ++ii) {
    const int j = s ? ii : 63 - ii;
    float z = bias;
#pragma unroll
    for (int r = 0; r < 16; ++r) z += bg[j * 32 + s * 16 + r] * w[r];
    const float ls = fminf(z, 0.f) - 0.6931471805599453f * __builtin_amdgcn_logf(1.f + fast_exp2(-fabsf(z) * LOG2E));
    GB[(size_t)(row0 + j) * 256 + s * 128 + k] = run;
    const float kd = bf2f(ks[j * 128 + k]) * fast_exp2(run * LOG2E);
    run += ls * (1.f / 16.f);
    const bf16_t* vr = vs + j * 256 + h * 64;
#pragma unroll
    for (int x8 = 0; x8 < 8; ++x8) {
      float vv[8]; unpack8(*(const uint4*)(vr + 8 * x8), vv);
#pragma unroll
      for (int e = 0; e < 8; ++e) acc[8 * x8 + e] += kd * vv[e];
    }
  }
  ATOT[tt * 256 + tid] = expf(run);
  ATOT[192 * 256 + tt * 256 + tid] = run;
  float* u = U + (((size_t)tt * 2 + s) * 4 + h) * 2048 + d * 64;
#pragma unroll
  for (int x4 = 0; x4 < 16; ++x4) *(float4*)(u + 4 * x4) = make_float4(acc[4 * x4], acc[4 * x4 + 1], acc[4 * x4 + 2], acc[4 * x4 + 3]);
  __syncthreads();
}

struct TokRaw { uint4 a; uint2 c0, c1, c2; uint4 av, cv; };
DI void tok_load(const bf16_t* PR, int r, int lane, bool ctx, TokRaw& t) {
  const bf16_t* pr = PR + (size_t)r * PW;
  t.a = *(const uint4*)(pr + (lane >> 3) * 64 + 8 * (lane & 7));
  const bf16_t* src = pr + OFF_CQ + (lane >> 2) * 48 + 12 * (lane & 3);
  t.c0 = *(const uint2*)(src); t.c1 = *(const uint2*)(src + 4); t.c2 = *(const uint2*)(src + 8);
  t.av = make_uint4(0, 0, 0, 0); t.cv = make_uint4(0, 0, 0, 0);
  if (ctx) { if (lane < 16) t.av = *(const uint4*)(pr + OFF_AV + 8 * lane); if (lane < 48) t.cv = *(const uint4*)(pr + OFF_CV + 8 * lane); }
}
DI void prep_token(const Params& p, int l, int r, int lane, const TokRaw& t) {
  bf16_t* QA = (bf16_t*)(p.ws + WS_QA); bf16_t* KA = (bf16_t*)(p.ws + WS_KA);
  bf16_t* QC = (bf16_t*)(p.ws + WS_QC); bf16_t* KC = (bf16_t*)(p.ws + WS_KC);
  const float* rope = (const float*)(p.ws + WS_ROPE);
  const float qsA = 0.125f * LOG2E, qsC = 0.14433756729740643f * LOG2E;
  const bool ctx = r < NCTX;
  const int b = ctx ? (r >> 8) : ((r - NCTX) >> 11);
  const int tq = ctx ? (r & 255) : ((r - NCTX) & 2047);
  const int rowpos = tq >> 6, colpos = tq & 63;
  {
    const int v = lane >> 3, s = lane & 7;
    float x[8]; unpack8(t.a, x);
    float ss = 0.f;
#pragma unroll
    for (int e = 0; e < 8; ++e) ss += x[e] * x[e];
    ss += __shfl_xor(ss, 1); ss += __shfl_xor(ss, 2); ss += __shfl_xor(ss, 4);
    const float rstd = rsqrtf(ss * (1.f / 64.f) + EPSN);
    const float* g = (v < 6 ? p.in[16] : p.in[17]) + l * 64 + 8 * s;
    float y[8];
#pragma unroll
    for (int e = 0; e < 8; ++e) y[e] = x[e] * rstd * g[e];
    if (ctx) {
      if (v >= 6) {
        float* o = p.out + O_AK + ((size_t)(b * 4 + l) * 256 + tq) * 128 + (v - 6) * 64 + 8 * s;
        *(float4*)o = make_float4(y[0], y[1], y[2], y[3]); *(float4*)(o + 4) = make_float4(y[4], y[5], y[6], y[7]);
      }
    } else {
      const int pos = (s < 4) ? rowpos : colpos;
      const float* ct = rope + pos * 16 + (s & 1) * 8; const float* st = rope + 1024 + pos * 16 + (s & 1) * 8;
#pragma unroll
      for (int e = 0; e < 8; ++e) {
        const float yp = __shfl_xor(y[e], 2);
        const float c = ct[e], sn = st[e];
        y[e] = (s & 2) ? (yp * sn + y[e] * c) : (y[e] * c - yp * sn);
      }
    }
    if (v < 6) {
#pragma unroll
      for (int e = 0; e < 8; ++e) y[e] *= qsA;
    }
    uint4 w; w.x = pack2(y[0], y[1]); w.y = pack2(y[2], y[3]); w.z = pack2(y[4], y[5]); w.w = pack2(y[6], y[7]);
    if (v < 6) *(uint4*)(QA + (size_t)r * 384 + v * 64 + 8 * s) = w;
    else *(uint4*)(KA + (size_t)r * 128 + (v - 6) * 64 + 8 * s) = w;
  }
  if (ctx && lane < 16) {
    float x[8]; unpack8(t.av, x);
    float* o = p.out + O_AV + ((size_t)(b * 4 + l) * 256 + tq) * 128 + 8 * lane;
    *(float4*)o = make_float4(x[0], x[1], x[2], x[3]); *(float4*)(o + 4) = make_float4(x[4], x[5], x[6], x[7]);
  }
  {
    const int v = lane >> 2, qd = lane & 3;
    float x[12];
    unpack4(t.c0, x); unpack4(t.c1, x + 4); unpack4(t.c2, x + 8);
    float ss = 0.f;
#pragma unroll
    for (int e = 0; e < 12; ++e) ss += x[e] * x[e];
    ss += __shfl_xor(ss, 1); ss += __shfl_xor(ss, 2);
    const float rstd = rsqrtf(ss * (1.f / 48.f) + EPSN);
    const float* g = (v < 8 ? p.in[21] : p.in[22]) + l * 96 + (v & 1) * 48 + 12 * qd;
    float y[12];
#pragma unroll
    for (int e = 0; e < 12; ++e) y[e] = x[e] * rstd * g[e];
    if (ctx) {
      if (v >= 8) {
        float* o = p.out + O_CK + ((size_t)(b * 4 + l) * 256 + tq) * 384 + (v - 8) * 48 + 12 * qd;
        *(float4*)o = make_float4(y[0], y[1], y[2], y[3]); *(float4*)(o + 4) = make_float4(y[4], y[5], y[6], y[7]);
        *(float4*)(o + 8) = make_float4(y[8], y[9], y[10], y[11]);
      }
    } else {
      const int pos = (qd < 2) ? rowpos : colpos;
      const float* ct = rope + 2048 + pos * 12; const float* st = rope + 2048 + 768 + pos * 12;
#pragma unroll
      for (int e = 0; e < 12; ++e) {
        const float yp = __shfl_xor(y[e], 1);
        const float c = ct[e], sn = st[e];
        y[e] = (qd & 1) ? (yp * sn + y[e] * c) : (y[e] * c - yp * sn);
      }
    }
    if (v < 8) {
#pragma unroll
      for (int e = 0; e < 12; ++e) y[e] *= qsC;
    }
    bf16_t* dst = (v < 8 ? QC : KC) + (size_t)r * 512 + (v & 7) * 64;
    uint2 w0, w1, w2; w0.x = pack2(y[0], y[1]); w0.y = pack2(y[2], y[3]); w1.x = pack2(y[4], y[5]); w1.y = pack2(y[6], y[7]);
    w2.x = pack2(y[8], y[9]); w2.y = pack2(y[10], y[11]);
    *(uint2*)(dst + 12 * qd) = w0; *(uint2*)(dst + 12 * qd + 4) = w1; *(uint2*)(dst + 12 * qd + 8) = w2;
    { unsigned z0; asm volatile("v_mov_b32 %0, 0" : "=v"(z0)); *(uint2*)(dst + 48 + 4 * qd) = make_uint2(z0, z0); }
  }
  if (ctx && lane < 48) {
    float x[8]; unpack8(t.cv, x);
    float* o = p.out + O_CV + ((size_t)(b * 4 + l) * 256 + tq) * 384 + 8 * lane;
    *(float4*)o = make_float4(x[0], x[1], x[2], x[3]); *(float4*)(o + 4) = make_float4(x[4], x[5], x[6], x[7]);
  }
}

DI void prep_phase(const Params& p, int l, char* smem) {
  int bx = blockIdx.x, gx = gridDim.x; asm volatile("" : "+s"(bx), "+s"(gx));
  if (gx > 96 && bx < 96) { prep_gla_tile(p, l, obid(), smem); return; }
  if (gx <= 96) for (int tt = obid(); tt < 192; tt += vnb()) prep_gla_tile(p, l, tt, smem);
  const int tx = rtid(), lane = tx & 63;
  const int fb = gx > 96 ? 96 : 0;
  const int gw = (bx - fb) * 8 + (tx >> 6), nw = (gx - fb) * 8;
  const bf16_t* PR = (const bf16_t*)(p.ws + WS_PROJ);
  int r = gw;
  TokRaw cur, nxt;
  if (r < NTOK) tok_load(PR, r, lane, r < NCTX, cur);
#pragma unroll 1
  for (; r < NTOK; r += nw) {
    const int rn = r + nw;
    if (rn < NTOK) tok_load(PR, rn, lane, rn < NCTX, nxt);
    prep_token(p, l, r, lane, cur);
    cur = nxt;
  }
}

typedef unsigned u32x4 __attribute__((ext_vector_type(4)));
struct KVSrc { const bf16_t* k1; const bf16_t* v1; const bf16_t* k2; const bf16_t* v2; int ks1, vs1, ks2, vs2, n1, n2; };
template <int NMAP, int NDT> struct FlashRegs { u32x4 k00, k01, k10, k11, v0, v1, v2; };

template <int NMAP, int NDT>
DI void fl_issue(int kt, const KVSrc& kv, FlashRegs<NMAP, NDT>& R) {
  constexpr int CPR = NDT * 2;
  kt = kt < kv.n1 + kv.n2 ? kt : kv.n1 + kv.n2 - 1;
  const int tid = otid();
  const bf16_t* kb; const bf16_t* vb; int ks, vs;
  if (kt < kv.n1) { kb = kv.k1 + (size_t)kt * 64 * kv.ks1; vb = kv.v1 + (size_t)kt * 64 * kv.vs1; ks = kv.ks1; vs = kv.vs1; }
  else { kb = kv.k2 + (size_t)(kt - kv.n1) * 64 * kv.ks2; vb = kv.v2 + (size_t)(kt - kv.n1) * 64 * kv.vs2; ks = kv.ks2; vs = kv.vs2; }
  R.k00 = *(const u32x4*)(kb + (size_t)(tid >> 3) * ks + (tid & 7) * 8);
  R.k01 = *(const u32x4*)(kb + (size_t)((tid >> 3) + 32) * ks + (tid & 7) * 8);
  if (NMAP == 2) {
    R.k10 = *(const u32x4*)(kb + 64 + (size_t)(tid >> 3) * ks + (tid & 7) * 8);
    R.k11 = *(const u32x4*)(kb + 64 + (size_t)((tid >> 3) + 32) * ks + (tid & 7) * 8);
  } else { R.k10 = R.k00; R.k11 = R.k01; }
  { const int c = tid; R.v0 = *(const u32x4*)(vb + (size_t)(c / CPR) * vs + (c % CPR) * 8); }
  { const int c = tid + 256; R.v1 = *(const u32x4*)(vb + (size_t)(c / CPR) * vs + (c % CPR) * 8); }
  if (NDT == 6) { const int c = tid + 512; R.v2 = *(const u32x4*)(vb + (size_t)(c / CPR) * vs + (c % CPR) * 8); } else R.v2 = R.v1;
}
template <int NMAP, int NDT>
DI void fl_write(char* buf, const FlashRegs<NMAP, NDT>& R) {
  constexpr int CPR = NDT * 2, VSB = NDT * 32 + 32;
  const int tid = otid();
  char* vbuf = buf + NMAP * 8192;
  { const int row = tid >> 3, ch = tid & 7; *(u32x4*)(buf + row * 128 + ((ch ^ (row & 7)) << 4)) = R.k00; }
  { const int row = (tid >> 3) + 32, ch = tid & 7; *(u32x4*)(buf + row * 128 + ((ch ^ (row & 7)) << 4)) = R.k01; }
  if (NMAP == 2) {
    { const int row = tid >> 3, ch = tid & 7; *(u32x4*)(buf + 8192 + row * 128 + ((ch ^ (row & 7)) << 4)) = R.k10; }
    { const int row = (tid >> 3) + 32, ch = tid & 7; *(u32x4*)(buf + 8192 + row * 128 + ((ch ^ (row & 7)) << 4)) = R.k11; }
  }
  { const int c = tid; *(u32x4*)(vbuf + (c / CPR) * VSB + (c % CPR) * 16) = R.v0; }
  { const int c = tid + 256; *(u32x4*)(vbuf + (c / CPR) * VSB + (c % CPR) * 16) = R.v1; }
  if (NDT == 6) { const int c = tid + 512; *(u32x4*)(vbuf + (c / CPR) * VSB + (c % CPR) * 16) = R.v2; }
}
template <int NMAP, int NDT>
DI void fl_compute(const char* buf, const bf16x8 (&qf)[NMAP][2], f32x4 (&oacc)[NMAP][NDT], float (&mrun)[NMAP], float (&lsum)[NMAP], int lane) {
  constexpr int VSB = NDT * 32 + 32;
  const int g = lane >> 4, qq = (lane & 15) >> 2, pp = lane & 3;
  bf16x8 pf[NMAP][2];
#pragma unroll
  for (int m = 0; m < NMAP; ++m) {
    f32x4 sacc[4];
#pragma unroll
    for (int t = 0; t < 4; ++t) sacc[t] = (f32x4){0.f, 0.f, 0.f, 0.f};
#pragma unroll
    for (int ks = 0; ks < 2; ++ks) {
      const int ch = ((ks * 4 + g) ^ (lane & 7)) << 4;
#pragma unroll
      for (int t = 0; t < 4; ++t) {
        const bf16x8 kf = *(const bf16x8*)(buf + m * 8192 + (16 * t + (lane & 15)) * 128 + ch);
        sacc[t] = __builtin_amdgcn_mfma_f32_16x16x32_bf16(kf, qf[m][ks], sacc[t], 0, 0, 0);
      }
    }
    float mx = sacc[0][0];
#pragma unroll
    for (int t = 0; t < 4; ++t)
#pragma unroll
      for (int r = 0; r < 4; ++r) mx = fmaxf(mx, sacc[t][r]);
    mx = fmaxf(mx, __shfl_xor(mx, 16)); mx = fmaxf(mx, __shfl_xor(mx, 32));
    const float mnew = fmaxf(mrun[m], mx);
    const float alpha = fast_exp2(mrun[m] - mnew);
    mrun[m] = mnew;
    float ps = 0.f;
#pragma unroll
    for (int t = 0; t < 4; ++t)
#pragma unroll
      for (int r = 0; r < 4; ++r) { const float pv = fast_exp2(sacc[t][r] - mnew); sacc[t][r] = pv; ps += pv; }
    lsum[m] = lsum[m] * alpha + ps;
#pragma unroll
    for (int d = 0; d < NDT; ++d) oacc[m][d] *= alpha;
#pragma unroll
    for (int ks = 0; ks < 2; ++ks) {
      u32x4 pu;
      pu[0] = pack2(sacc[2 * ks][0], sacc[2 * ks][1]); pu[1] = pack2(sacc[2 * ks][2], sacc[2 * ks][3]);
      pu[2] = pack2(sacc[2 * ks + 1][0], sacc[2 * ks + 1][1]); pu[3] = pack2(sacc[2 * ks + 1][2], sacc[2 * ks + 1][3]);
      pf[m][ks] = __builtin_bit_cast(bf16x8, pu);
    }
  }
  const char* vbuf = buf + NMAP * 8192;
#pragma unroll
  for (int ks = 0; ks < 2; ++ks) {
    const char* vrow = vbuf + (32 * ks + 4 * g + qq) * VSB + pp * 8;
#pragma unroll
    for (int d = 0; d < NDT; ++d) {
      const s16x4 v0 = __builtin_amdgcn_ds_read_tr16_b64_v4i16((LDSP s16x4*)(vrow + d * 32));
      const s16x4 v1 = __builtin_amdgcn_ds_read_tr16_b64_v4i16((LDSP s16x4*)(vrow + 16 * VSB + d * 32));
      const bf16x8 vf = __builtin_shufflevector(v0, v1, 0, 1, 2, 3, 4, 5, 6, 7);
#pragma unroll
      for (int m = 0; m < NMAP; ++m) oacc[m][d] = __builtin_amdgcn_mfma_f32_16x16x32_bf16(vf, pf[m][ks], oacc[m][d], 0, 0, 0);
    }
  }
}

template <int NMAP, int NDT>
DI void flash_run(const bf16_t* __restrict__ qptr, const KVSrc& kv, f32x4 (&oacc)[NMAP][NDT], float (&linv)[NMAP], char* smem) {
  constexpr int BUFB = NMAP * 8192 + 64 * (NDT * 32 + 32);
  const int lane = otid() & 63;
  bf16x8 qf[NMAP][2];
  float mrun[NMAP], lsum[NMAP];
#pragma unroll
  for (int m = 0; m < NMAP; ++m) {
    qf[m][0] = *(const bf16x8*)(qptr + 64 * m); qf[m][1] = *(const bf16x8*)(qptr + 64 * m + 32);
    mrun[m] = -INFINITY; lsum[m] = 0.f;
#pragma unroll
    for (int d = 0; d < NDT; ++d) oacc[m][d] = (f32x4){0.f, 0.f, 0.f, 0.f};
  }
  const int nt = kv.n1 + kv.n2;
  FlashRegs<NMAP, NDT> R0, R1;
  fl_issue<NMAP, NDT>(0, kv, R0);
  fl_issue<NMAP, NDT>(1, kv, R1);
  __syncthreads();
  fl_write<NMAP, NDT>(smem, R0);
  fl_issue<NMAP, NDT>(2, kv, R0);
  __syncthreads();
#pragma unroll 1
  for (int t = 0; t < nt; t += 2) {
    fl_compute<NMAP, NDT>(smem, qf, oacc, mrun, lsum, lane);
    fl_write<NMAP, NDT>(smem + BUFB, R1);
    fl_issue<NMAP, NDT>(t + 3, kv, R1);
    __syncthreads();
    fl_compute<NMAP, NDT>(smem + BUFB, qf, oacc, mrun, lsum, lane);
    fl_write<NMAP, NDT>(smem, R0);
    fl_issue<NMAP, NDT>(t + 4, kv, R0);
    __syncthreads();
  }
#pragma unroll
  for (int m = 0; m < NMAP; ++m) { float l = lsum[m]; l += __shfl_xor(l, 16); l += __shfl_xor(l, 32); linv[m] = 1.f / l; }
}

DI void attn_a_item(const Params& p, int l, bool ctx, int b, int h, int qt, char* smem) {
  const int lane = otid() & 63, wave = otid() >> 6;
  const int seq0 = ctx ? b * 256 : NCTX + b * 2048;
  const int qrow = seq0 + qt * 64 + wave * 16 + (lane & 15);
  const int kvh = h / 3;
  const bf16_t* PR = (const bf16_t*)(p.ws + WS_PROJ);
  KVSrc kv;
  kv.k1 = (const bf16_t*)(p.ws + WS_KA) + (size_t)seq0 * 128 + kvh * 64; kv.ks1 = 128;
  kv.v1 = PR + (size_t)seq0 * PW + OFF_AV + kvh * 64; kv.vs1 = PW;
  kv.n1 = ctx ? 4 : 32; kv.n2 = ctx ? 0 : 8;
  kv.k2 = (const bf16_t*)(p.ws + WS_KAC) + (size_t)((b & 1) * 4 + l) * 512 * 128 + kvh * 64; kv.ks2 = 128;
  kv.v2 = (const bf16_t*)(p.ws + WS_VAC) + (size_t)((b & 1) * 4 + l) * 512 * 128 + kvh * 64; kv.vs2 = 128;
  f32x4 o[1][4]; float linv[1];
  flash_run<1, 4>((const bf16_t*)(p.ws + WS_QA) + (size_t)qrow * 384 + h * 64 + 8 * (lane >> 4), kv, o, linv, smem);
  bf16_t* dst = (bf16_t*)(p.ws + WS_MIX) + (size_t)qrow * 1024 + h * 64 + 4 * (lane >> 4);
  const float li = linv[0];
#pragma unroll
  for (int d = 0; d < 4; ++d) { uint2 w; w.x = pack2(o[0][d][0] * li, o[0][d][1] * li); w.y = pack2(o[0][d][2] * li, o[0][d][3] * li); *(uint2*)(dst + 16 * d) = w; }
}

DI void attn_c_item(const Params& p, int l, bool ctx, int b, int h, int qt, char* smem) {
  const int lane = otid() & 63, wave = otid() >> 6;
  const int seq0 = ctx ? b * 256 : NCTX + b * 2048;
  const int qrow = seq0 + qt * 64 + wave * 16 + (lane & 15);
  const bf16_t* PR = (const bf16_t*)(p.ws + WS_PROJ);
  KVSrc kv;
  kv.ks1 = 512; kv.vs1 = PW; kv.ks2 = 512; kv.vs2 = 384;
  kv.n1 = ctx ? 4 : 32; kv.n2 = ctx ? 0 : 8;
  kv.v1 = PR + (size_t)seq0 * PW + OFF_CV + h * 96;
  kv.v2 = (const bf16_t*)(p.ws + WS_VCC) + (size_t)((b & 1) * 4 + l) * 512 * 384 + h * 96;
  kv.k1 = (const bf16_t*)(p.ws + WS_KC) + (size_t)seq0 * 512 + (h * 2) * 64;
  kv.k2 = (const bf16_t*)(p.ws + WS_KCC) + (size_t)((b & 1) * 4 + l) * 512 * 512 + (h * 2) * 64;
  f32x4 o[2][6]; float linv[2];
  flash_run<2, 6>((const bf16_t*)(p.ws + WS_QC) + (size_t)qrow * 512 + (h * 2) * 64 + 8 * (lane >> 4), kv, o, linv, smem);
  const float lam = ((const float*)(p.ws + WS_MISC))[l];
  const float li0 = linv[0], l1 = linv[1] * lam;
  float ss = 0.f;
#pragma unroll
  for (int d = 0; d < 6; ++d)
#pragma unroll
    for (int r = 0; r < 4; ++r) { const float v = o[0][d][r] * li0 - o[1][d][r] * l1; o[0][d][r] = v; ss += v * v; }
  ss += __shfl_xor(ss, 16); ss += __shfl_xor(ss, 32);
  const float sc = rsqrtf(ss * (1.f / 96.f) + EPSN) * (1.f - p.lam_init[l]);
  const float* g = p.in[24] + l * 96 + 4 * (lane >> 4);
  bf16_t* dst = (bf16_t*)(p.ws + WS_MIX) + (size_t)qrow * 1024 + 640 + h * 96 + 4 * (lane >> 4);
#pragma unroll
  for (int d = 0; d < 6; ++d) {
    const float4 gg = *(const float4*)(g + 16 * d);
    uint2 w; w.x = pack2(o[0][d][0] * sc * gg.x, o[0][d][1] * sc * gg.y); w.y = pack2(o[0][d][2] * sc * gg.z, o[0][d][3] * sc * gg.w);
    *(uint2*)(dst + 16 * d) = w;
  }
}

DI void gla_item(const Params& p, int l, bool ctx, int b, int h, int c, char* smem) {
  const int tid = otid();
  const int seq0 = ctx ? b * 256 : NCTX + b * 2048;
  const int nch = ctx ? 4 : 32;
  const int row0 = seq0 + c * 64, tt0 = seq0 >> 6, tt = tt0 + c;
  const bf16_t* PR = (const bf16_t*)(p.ws + WS_PROJ);
  const float* GB = (const float*)(p.ws + WS_GB); const float* ATOT = (const float*)(p.ws + WS_ATOT); const float* U = (const float*)(p.ws + WS_U);
  float* qd = (float*)smem;
  float* kd = qd + 64 * 36;
  float* vv = kd + 64 * 36;
  float* S = vv + 4096;
  float* sc = S + 2048;
  const int ib = tid >> 4, xb = tid & 15, i0 = ib * 4, x0 = xb * 4;
  float o[4][4];
#pragma unroll
  for (int a = 0; a < 4; ++a)
#pragma unroll
    for (int e = 0; e < 4; ++e) o[a][e] = 0.f;
  for (int s = 0; s < 2; ++s) {
    {
      const int j = tid >> 2, part = tid & 3, kk = h * 32 + part * 8;
      const size_t prow = (size_t)(row0 + j) * PW;
      const uint4 qraw = *(const uint4*)(PR + prow + OFF_BQ + kk), kraw = *(const uint4*)(PR + prow + OFF_BK + kk);
      const float* gbp = GB + (size_t)(row0 + j) * 256 + s * 128 + kk;
      const float* ttp = ATOT + 192 * 256 + tt * 256 + s * 128 + kk;
      const float4 g0 = *(const float4*)gbp, g1 = *(const float4*)(gbp + 4), t0 = *(const float4*)ttp, t1 = *(const float4*)(ttp + 4);
      uint4 vraw0 = make_uint4(0, 0, 0, 0), vraw1 = vraw0;
      if (s == 0) { vraw0 = *(const uint4*)(PR + prow + OFF_BV + h * 64 + part * 16); vraw1 = *(const uint4*)(PR + prow + OFF_BV + h * 64 + part * 16 + 8); }
      float qv[8], kv[8]; unpack8(qraw, qv); unpack8(kraw, kv);
      const float cum[8] = {t0.x - g0.x, t0.y - g0.y, t0.z - g0.z, t0.w - g0.w, t1.x - g1.x, t1.y - g1.y, t1.z - g1.z, t1.w - g1.w};
      float qo[8], ko[8];
#pragma unroll
      for (int e = 0; e < 8; ++e) { qo[e] = qv[e] * 0.17677669529663687f * fast_exp2(cum[e] * LOG2E); ko[e] = kv[e] * fast_exp2(-cum[e] * LOG2E); }
      float* qp = qd + j * 36 + part * 8; float* kp = kd + j * 36 + part * 8;
      *(float4*)qp = make_float4(qo[0], qo[1], qo[2], qo[3]); *(float4*)(qp + 4) = make_float4(qo[4], qo[5], qo[6], qo[7]);
      *(float4*)kp = make_float4(ko[0], ko[1], ko[2], ko[3]); *(float4*)(kp + 4) = make_float4(ko[4], ko[5], ko[6], ko[7]);
      if (s == 0) {
        float x[16]; unpack8(vraw0, x); unpack8(vraw1, x + 8);
        float* vp = vv + j * 64 + part * 16;
#pragma unroll
        for (int e = 0; e < 4; ++e) *(float4*)(vp + 4 * e) = make_float4(x[4 * e], x[4 * e + 1], x[4 * e + 2], x[4 * e + 3]);
      }
    }
    {
      const int d = tid >> 3, v0 = (tid & 7) * 8;
      float S8[8];
      if (ctx) {
#pragma unroll
        for (int e = 0; e < 8; ++e) S8[e] = 0.f;
      } else {
        const float* s0 = p.in[7] + ((((size_t)b * 4 + l) * 2 + s) * 4 + h) * 2048 + d * 64 + v0;
        const float4 a = *(const float4*)s0, bq = *(const float4*)(s0 + 4);
        S8[0] = a.x; S8[1] = a.y; S8[2] = a.z; S8[3] = a.w; S8[4] = bq.x; S8[5] = bq.y; S8[6] = bq.z; S8[7] = bq.w;
      }
      const int nfold = s == 0 ? c : nch - 1 - c;
#pragma unroll 8
      for (int f = 0; f < nfold; ++f) {
        const int t2 = s == 0 ? tt0 + f : tt0 + nch - 1 - f;
        const float a = ATOT[t2 * 256 + s * 128 + h * 32 + d];
        const float* u = U + (((size_t)t2 * 2 + s) * 4 + h) * 2048 + d * 64 + v0;
        const float4 u0 = *(const float4*)u, u1 = *(const float4*)(u + 4);
        S8[0] = a * S8[0] + u0.x; S8[1] = a * S8[1] + u0.y; S8[2] = a * S8[2] + u0.z; S8[3] = a * S8[3] + u0.w;
        S8[4] = a * S8[4] + u1.x; S8[5] = a * S8[5] + u1.y; S8[6] = a * S8[6] + u1.z; S8[7] = a * S8[7] + u1.w;
      }
      *(float4*)(S + d * 64 + v0) = make_float4(S8[0], S8[1], S8[2], S8[3]);
      *(float4*)(S + d * 64 + v0 + 4) = make_float4(S8[4], S8[5], S8[6], S8[7]);
      if (ctx && ((s == 0 && c == nch - 1) || (s == 1 && c == 0))) {
        const float a = ATOT[tt * 256 + s * 128 + h * 32 + d];
        const float* u = U + (((size_t)tt * 2 + s) * 4 + h) * 2048 + d * 64 + v0;
        const float4 u0 = *(const float4*)u, u1 = *(const float4*)(u + 4);
        float* dst = p.out + O_ST + ((((size_t)b * 4 + l) * 2 + s) * 4 + h) * 2048 + d * 64 + v0;
        *(float4*)dst = make_float4(a * S8[0] + u0.x, a * S8[1] + u0.y, a * S8[2] + u0.z, a * S8[3] + u0.w);
        *(float4*)(dst + 4) = make_float4(a * S8[4] + u1.x, a * S8[5] + u1.y, a * S8[6] + u1.z, a * S8[7] + u1.w);
      }
    }
    __syncthreads();
    {
      float a4[4][4];
#pragma unroll
      for (int a = 0; a < 4; ++a)
#pragma unroll
        for (int e = 0; e < 4; ++e) a4[a][e] = 0.f;
#pragma unroll 2
      for (int d4 = 0; d4 < 8; ++d4) {
        float4 q4[4], k4[4];
#pragma unroll
        for (int a = 0; a < 4; ++a) { q4[a] = *(const float4*)(qd + (i0 + a) * 36 + 4 * d4); k4[a] = *(const float4*)(kd + (x0 + a) * 36 + 4 * d4); }
#pragma unroll
        for (int a = 0; a < 4; ++a)
#pragma unroll
          for (int e = 0; e < 4; ++e) a4[a][e] += q4[a].x * k4[e].x + q4[a].y * k4[e].y + q4[a].z * k4[e].z + q4[a].w * k4[e].w;
      }
#pragma unroll
      for (int a = 0; a < 4; ++a) {
        float r4[4];
#pragma unroll
        for (int e = 0; e < 4; ++e) { const int i = i0 + a, j = x0 + e; const bool keep = (s == 0) ? (j <= i) : (j >= i); r4[e] = keep ? a4[a][e] : 0.f; }
        *(float4*)(sc + (i0 + a) * 68 + x0) = make_float4(r4[0], r4[1], r4[2], r4[3]);
      }
    }
    __syncthreads();
    {
#pragma unroll 2
      for (int j = 0; j < 64; j += 4) {
        float4 s4[4], v4[4];
#pragma unroll
        for (int a = 0; a < 4; ++a) { s4[a] = *(const float4*)(sc + (i0 + a) * 68 + j); v4[a] = *(const float4*)(vv + (j + a) * 64 + x0); }
#pragma unroll
        for (int a = 0; a < 4; ++a) {
          o[a][0] += s4[a].x * v4[0].x + s4[a].y * v4[1].x + s4[a].z * v4[2].x + s4[a].w * v4[3].x;
          o[a][1] += s4[a].x * v4[0].y + s4[a].y * v4[1].y + s4[a].z * v4[2].y + s4[a].w * v4[3].y;
          o[a][2] += s4[a].x * v4[0].z + s4[a].y * v4[1].z + s4[a].z * v4[2].z + s4[a].w * v4[3].z;
          o[a][3] += s4[a].x * v4[0].w + s4[a].y * v4[1].w + s4[a].z * v4[2].w + s4[a].w * v4[3].w;
        }
      }
#pragma unroll 2
      for (int d = 0; d < 32; d += 4) {
        float4 q4[4], v4[4];
#pragma unroll
        for (int a = 0; a < 4; ++a) { q4[a] = *(const float4*)(qd + (i0 + a) * 36 + d); v4[a] = *(const float4*)(S + (d + a) * 64 + x0); }
#pragma unroll
        for (int a = 0; a < 4; ++a) {
          o[a][0] += q4[a].x * v4[0].x + q4[a].y * v4[1].x + q4[a].z * v4[2].x + q4[a].w * v4[3].x;
          o[a][1] += q4[a].x * v4[0].y + q4[a].y * v4[1].y + q4[a].z * v4[2].y + q4[a].w * v4[3].y;
          o[a][2] += q4[a].x * v4[0].z + q4[a].y * v4[1].z + q4[a].z * v4[2].z + q4[a].w * v4[3].z;
          o[a][3] += q4[a].x * v4[0].w + q4[a].y * v4[1].w + q4[a].z * v4[2].w + q4[a].w * v4[3].w;
        }
      }
    }
    __syncthreads();
  }
  const float4 gg = *(const float4*)(p.in[20] + l * 64 + x0);
#pragma unroll
  for (int a = 0; a < 4; ++a) {
    float ss = o[a][0] * o[a][0] + o[a][1] * o[a][1] + o[a][2] * o[a][2] + o[a][3] * o[a][3];
    ss += __shfl_xor(ss, 1); ss += __shfl_xor(ss, 2); ss += __shfl_xor(ss, 4); ss += __shfl_xor(ss, 8);
    const float rstd = rsqrtf(ss * (1.f / 64.f) + EPSN);
    const size_t row = row0 + i0 + a;
    float br[4]; unpack4(*(const uint2*)(PR + row * PW + OFF_BR + h * 64 + x0), br);
    uint2 w;
    w.x = pack2(o[a][0] * rstd * gg.x * sigm_silu_acc(br[0]), o[a][1] * rstd * gg.y * sigm_silu_acc(br[1]));
    w.y = pack2(o[a][2] * rstd * gg.z * sigm_silu_acc(br[2]), o[a][3] * rstd * gg.w * sigm_silu_acc(br[3]));
    *(uint2*)((bf16_t*)(p.ws + WS_MIX) + row * 1024 + 384 + h * 64 + x0) = w;
  }
}

DI void gla_item_mfma(const Params& p, int l, bool ctx, int b, int h, int c, char* smem) {
  const int tid = otid(), lane = tid & 63, wave = tid >> 6, g = lane >> 4, fr = lane & 15, qq = fr >> 2, pp = lane & 3;
  const int seq0 = ctx ? b * 256 : NCTX + b * 2048;
  const int nch = ctx ? 4 : 32;
  const int row0 = seq0 + c * 64, tt0 = seq0 >> 6, tt = tt0 + c;
  const bf16_t* PR = (const bf16_t*)(p.ws + WS_PROJ);
  const float* GB = (const float*)(p.ws + WS_GB); const float* ATOT = (const float*)(p.ws + WS_ATOT); const float* U = (const float*)(p.ws + WS_U);
  char* qdb = smem;
  char* kdb = smem + 4096;
  char* vvb = smem + 8192;
  char* Sb = smem + 8192 + 10240;
  f32x4 oacc[4];
#pragma unroll
  for (int vt = 0; vt < 4; ++vt) oacc[vt] = (f32x4){0.f, 0.f, 0.f, 0.f};
#pragma unroll 1
  for (int s = 0; s < 2; ++s) {
    {
      const int j = tid >> 2, part = tid & 3, kk = h * 32 + part * 8;
      const size_t prow = (size_t)(row0 + j) * PW;
      const uint4 qraw = *(const uint4*)(PR + prow + OFF_BQ + kk), kraw = *(const uint4*)(PR + prow + OFF_BK + kk);
      const float* gbp = GB + (size_t)(row0 + j) * 256 + s * 128 + kk;
      const float* ttp = ATOT + 192 * 256 + tt * 256 + s * 128 + kk;
      const float4 g0 = *(const float4*)gbp, g1 = *(const float4*)(gbp + 4), t0 = *(const float4*)ttp, t1 = *(const float4*)(ttp + 4);
      if (s == 0) {
        const uint4 v0 = *(const uint4*)(PR + prow + OFF_BV + h * 64 + part * 16), v1 = *(const uint4*)(PR + prow + OFF_BV + h * 64 + part * 16 + 8);
        *(uint4*)(vvb + j * 160 + part * 32) = v0; *(uint4*)(vvb + j * 160 + part * 32 + 16) = v1;
      }
      float qv[8], kv[8]; unpack8(qraw, qv); unpack8(kraw, kv);
      const float cum[8] = {t0.x - g0.x, t0.y - g0.y, t0.z - g0.z, t0.w - g0.w, t1.x - g1.x, t1.y - g1.y, t1.z - g1.z, t1.w - g1.w};
      float qo[8], ko[8];
#pragma unroll
      for (int e = 0; e < 8; ++e) { qo[e] = qv[e] * 0.17677669529663687f * fast_exp2(cum[e] * LOG2E); ko[e] = kv[e] * fast_exp2(-cum[e] * LOG2E); }
      uint4 qw, kw;
      qw.x = pack2(qo[0], qo[1]); qw.y = pack2(qo[2], qo[3]); qw.z = pack2(qo[4], qo[5]); qw.w = pack2(qo[6], qo[7]);
      kw.x = pack2(ko[0], ko[1]); kw.y = pack2(ko[2], ko[3]); kw.z = pack2(ko[4], ko[5]); kw.w = pack2(ko[6], ko[7]);
      *(uint4*)(qdb + j * 64 + part * 16) = qw; *(uint4*)(kdb + j * 64 + part * 16) = kw;
    }
    {
      const int d = tid >> 3, v0 = (tid & 7) * 8;
      float S8[8];
      if (ctx) {
#pragma unroll
        for (int e = 0; e < 8; ++e) S8[e] = 0.f;
      } else {
        const float* s0 = p.in[7] + ((((size_t)b * 4 + l) * 2 + s) * 4 + h) * 2048 + d * 64 + v0;
        const float4 a = *(const float4*)s0, bq = *(const float4*)(s0 + 4);
        S8[0] = a.x; S8[1] = a.y; S8[2] = a.z; S8[3] = a.w; S8[4] = bq.x; S8[5] = bq.y; S8[6] = bq.z; S8[7] = bq.w;
      }
      const int nfold = s == 0 ? c : nch - 1 - c;
#pragma unroll 8
      for (int f = 0; f < nfold; ++f) {
        const int t2 = s == 0 ? tt0 + f : tt0 + nch - 1 - f;
        const float a = ATOT[t2 * 256 + s * 128 + h * 32 + d];
        const float* u = U + (((size_t)t2 * 2 + s) * 4 + h) * 2048 + d * 64 + v0;
        const float4 u0 = *(const float4*)u, u1 = *(const float4*)(u + 4);
        S8[0] = a * S8[0] + u0.x; S8[1] = a * S8[1] + u0.y; S8[2] = a * S8[2] + u0.z; S8[3] = a * S8[3] + u0.w;
        S8[4] = a * S8[4] + u1.x; S8[5] = a * S8[5] + u1.y; S8[6] = a * S8[6] + u1.z; S8[7] = a * S8[7] + u1.w;
      }
      uint4 sw; sw.x = pack2(S8[0], S8[1]); sw.y = pack2(S8[2], S8[3]); sw.z = pack2(S8[4], S8[5]); sw.w = pack2(S8[6], S8[7]);
      *(uint4*)(Sb + d * 160 + v0 * 2) = sw;
      if (ctx && ((s == 0 && c == nch - 1) || (s == 1 && c == 0))) {
        const float a = ATOT[tt * 256 + s * 128 + h * 32 + d];
        const float* u = U + (((size_t)tt * 2 + s) * 4 + h) * 2048 + d * 64 + v0;
        const float4 u0 = *(const float4*)u, u1 = *(const float4*)(u + 4);
        float* dst = p.out + O_ST + ((((size_t)b * 4 + l) * 2 + s) * 4 + h) * 2048 + d * 64 + v0;
        *(float4*)dst = make_float4(a * S8[0] + u0.x, a * S8[1] + u0.y, a * S8[2] + u0.z, a * S8[3] + u0.w);
        *(float4*)(dst + 4) = make_float4(a * S8[4] + u1.x, a * S8[5] + u1.y, a * S8[6] + u1.z, a * S8[7] + u1.w);
      }
    }
    __syncthreads();
    {
      const int iq = 16 * wave + fr;
      const bf16x8 qf = *(const bf16x8*)(qdb + iq * 64 + g * 16);
      bf16x8 pf[2];
#pragma unroll
      for (int ks = 0; ks < 2; ++ks) {
        u32x4 pu;
#pragma unroll
        for (int hh = 0; hh < 2; ++hh) {
          const int t = 2 * ks + hh;
          const bf16x8 kf = *(const bf16x8*)(kdb + (16 * t + fr) * 64 + g * 16);
          f32x4 sc = __builtin_amdgcn_mfma_f32_16x16x32_bf16(kf, qf, (f32x4){0.f, 0.f, 0.f, 0.f}, 0, 0, 0);
#pragma unroll
          for (int r = 0; r < 4; ++r) { const int j = 16 * t + 4 * g + r; const bool keep = (s == 0) ? (j <= iq) : (j >= iq); sc[r] = keep ? sc[r] : 0.f; }
          pu[2 * hh] = pack2(sc[0], sc[1]); pu[2 * hh + 1] = pack2(sc[2], sc[3]);
        }
        pf[ks] = __builtin_bit_cast(bf16x8, pu);
      }
#pragma unroll
      for (int ks = 0; ks < 2; ++ks) {
        const char* vrow = vvb + (32 * ks + 4 * g + qq) * 160 + pp * 8;
#pragma unroll
        for (int vt = 0; vt < 4; ++vt) {
          const s16x4 v0 = __builtin_amdgcn_ds_read_tr16_b64_v4i16((LDSP s16x4*)(vrow + vt * 32));
          const s16x4 v1 = __builtin_amdgcn_ds_read_tr16_b64_v4i16((LDSP s16x4*)(vrow + 16 * 160 + vt * 32));
          const bf16x8 vf = __builtin_shufflevector(v0, v1, 0, 1, 2, 3, 4, 5, 6, 7);
          oacc[vt] = __builtin_amdgcn_mfma_f32_16x16x32_bf16(vf, pf[ks], oacc[vt], 0, 0, 0);
        }
      }
      {
        const s16x4 qa = *(const s16x4*)(qdb + iq * 64 + (4 * g) * 2), qb = *(const s16x4*)(qdb + iq * 64 + (16 + 4 * g) * 2);
        const bf16x8 qp = __builtin_shufflevector(qa, qb, 0, 1, 2, 3, 4, 5, 6, 7);
        const char* srow = Sb + (4 * g + qq) * 160 + pp * 8;
#pragma unroll
        for (int vt = 0; vt < 4; ++vt) {
          const s16x4 s0 = __builtin_amdgcn_ds_read_tr16_b64_v4i16((LDSP s16x4*)(srow + vt * 32));
          const s16x4 s1 = __builtin_amdgcn_ds_read_tr16_b64_v4i16((LDSP s16x4*)(srow + 16 * 160 + vt * 32));
          const bf16x8 sf = __builtin_shufflevector(s0, s1, 0, 1, 2, 3, 4, 5, 6, 7);
          oacc[vt] = __builtin_amdgcn_mfma_f32_16x16x32_bf16(sf, qp, oacc[vt], 0, 0, 0);
        }
      }
    }
    __syncthreads();
  }
  float ss = 0.f;
#pragma unroll
  for (int vt = 0; vt < 4; ++vt)
#pragma unroll
    for (int r = 0; r < 4; ++r) ss += oacc[vt][r] * oacc[vt][r];
  ss += __shfl_xor(ss, 16); ss += __shfl_xor(ss, 32);
  const float rstd = rsqrtf(ss * (1.f / 64.f) + EPSN);
  const size_t row = row0 + 16 * wave + fr;
#pragma unroll
  for (int vt = 0; vt < 4; ++vt) {
    const int v = 16 * vt + 4 * g;
    const float4 gg = *(const float4*)(p.in[20] + l * 64 + v);
    float br[4]; unpack4(*(const uint2*)(PR + row * PW + OFF_BR + h * 64 + v), br);
    uint2 w;
    w.x = pack2(oacc[vt][0] * rstd * gg.x * sigm_silu_acc(br[0]), oacc[vt][1] * rstd * gg.y * sigm_silu_acc(br[1]));
    w.y = pack2(oacc[vt][2] * rstd * gg.z * sigm_silu_acc(br[2]), oacc[vt][3] * rstd * gg.w * sigm_silu_acc(br[3]));
    *(uint2*)((bf16_t*)(p.ws + WS_MIX) + row * 1024 + 384 + h * 64 + v) = w;
  }
}

DI void mixer_phase(const Params& p, int l, int cidx, char* smem) {
  unsigned* ctr = (unsigned*)(p.ws + WS_MISC + 64) + cidx;
  extern __shared__ __attribute__((aligned(16))) char dsm[];
  LDSP int* sidx = (LDSP int*)(dsm + 131072 + 16);
  constexpr int M_CL = PROBE == 21 ? 2 : 1, M_AL = PROBE == 22 ? 2 : 1, M_GL = PROBE == 23 ? 2 : 1, M_CC = PROBE == 24 ? 2 : 1, M_AC = PROBE == 25 ? 2 : 1, M_GC = PROBE == 26 ? 2 : 1;
  constexpr int N_CL = 256 * M_CL, N_AL = 384 * M_AL, N_GL = 256 * M_GL, N_CC = 512 * M_CC, N_AC = 768 * M_AC, N_GC = 512 * M_GC;
  constexpr int E0 = N_CL, E1 = E0 + N_AL, E2 = E1 + N_GL, E3 = E2 + N_CC, E4 = E3 + N_AC, E5 = E4 + N_GC;
  for (;;) {
    __syncthreads();
    if (threadIdx.x == 0) *sidx = (int)atomicAdd(ctr, 2u);
    __syncthreads();
    const int it = *sidx + ohalf();
    if (it >= E5) break;
    int typ, r; bool ctx;
    if (it < E0) { typ = 0; r = (it) % 256; ctx = false; }
    else if (it < E1) { typ = 1; r = (it - E0) % 384; ctx = false; }
    else if (it < E2) { typ = 2; r = (it - E1) % 256; ctx = false; }
    else if (it < E3) { typ = 0; r = (it - E2) % 512; ctx = true; }
    else if (it < E4) { typ = 1; r = (it - E3) % 768; ctx = true; }
    else { typ = 2; r = (it - E4) % 512; ctx = true; }
    const int sh = ctx ? 2 : 5, nq = 1 << sh;
    const int sub = r & (nq - 1), bh = r >> sh;
    if (typ == 0) attn_c_item(p, l, ctx, bh >> 2, bh & 3, sub, smem);
    else if (typ == 1) attn_a_item(p, l, ctx, bh / 6, bh % 6, sub, smem);
    else gla_item_mfma(p, l, ctx, bh >> 2, bh & 3, sub, smem);
  }
}

constexpr int DYN_LDS = 131072 + 64;
typedef const __attribute__((address_space(4))) Params* ParamsK;
DI ParamsK kparams() { ParamsK q = (ParamsK)__builtin_amdgcn_kernarg_segment_ptr(); asm volatile("" : "+s"(q)); return q; }
__global__ void __launch_bounds__(512, 2) fwd_megakernel(Params p_unused) {
  extern __shared__ __attribute__((aligned(16))) char dsm[];
  cg::grid_group grid = cg::this_grid();
  if (gridDim.y == 2) grid.sync();
  const Params& p = *(const Params*)kparams();
  volatile LDSP unsigned* xbw = (volatile LDSP unsigned*)(dsm + 131072);
  if (threadIdx.x == 0) { xbw[0] = 0u; xbw[1] = 0u; xbw[2] = 0u; xbw[3] = 0u; }
  __syncthreads();
  const XcdBarrier xb = xcd_barrier_post((unsigned*)(p.ws + WS_BAR), xbw);
  char* smem = dsm + ohalf() * 65536;
  phase0(p, (float*)smem);
  xcd_barrier(xb);
#pragma unroll 1
  for (int ph = 0; ph < 44; ++ph) {
    const int l = ph / 11, q = ph - l * 11;
    const Params& p = *(const Params*)kparams();
    const float* mod = (const float*)(p.ws + WS_MOD);
    const bf16_t* H = (const bf16_t*)(p.ws + WS_H);
    const bf16_t* ACT = (const bf16_t*)(p.ws + WS_ACT);
    const bf16_t* MIX = (const bf16_t*)(p.ws + WS_MIX);
    const float* modl = mod + (size_t)l * 3 * 9216;
    int nrep = 1;
#if PROBE
    if (PROBE == 1) nrep = (q == 1 || q == 9 || q == 2 || q == 10 || q == 7 || q == 4) ? 2 : 1;
    if (PROBE == 2) nrep = (q == 6) ? 2 : 1;
    if (PROBE == 3) nrep = (q == 5) ? 2 : 1;
    if (PROBE == 4) nrep = (q == 0 || q == 3 || q == 8) ? 2 : 1;
    if (PROBE == 5) nrep = 2;
#endif
#pragma unroll 1
    for (int rep = 0; rep < nrep; ++rep) {
#if PROBE == 5
    if (rep == 1) { xcd_barrier(xb); xcd_barrier(xb); xcd_barrier(xb); continue; }
#endif
    if (q == 3 || q == 8 || (q == 0 && l > 0)) continue;
    const float* RS = (const float*)(p.ws + WS_ROWSS);
    const float* BIAS = (const float*)(p.ws + WS_BIAS);
    if (q == 0) {
      norm0_bias_phase(p);
    } else if (q == 1 || q == 9) {
      const int f = q == 1 ? 0 : 1;
      { EpiSwiglu E; E.ACT = (bf16_t*)(p.ws + WS_ACT); E.RS = RS; E.bias = BIAS + (size_t)(l * 3 + (f ? 2 : 0)) * 3 * 5632;
        gemm8_run(H, (const bf16_t*)(p.ws + WS_WGU) + (size_t)(l * 2 + f) * 5632 * 1024, 5632, 1024, E, dsm); }
      if (l < 3 && rep == 0 && blockIdx.x >= 32) convert_slice(p, l + 1, f * 1344, f * 1344 + 1344, 32, (float*)smem);
    } else if (q == 2 || q == 10 || q == 7) {
      const bf16_t* A; const bf16_t* Bt; int lda, K; const float* gb; float coef; int nl, nsub;
      if (q == 7) { A = MIX; lda = 1024; K = 1024; Bt = (const bf16_t*)(p.ws + WS_WOUT) + (size_t)l * 1024 * 1024; gb = modl + 5 * 1024; coef = 1.0f; nl = l; nsub = 2; }
      else { const int f = q == 2 ? 0 : 1; A = ACT; lda = DFF; K = DFF; Bt = (const bf16_t*)(p.ws + WS_WD) + (size_t)(l * 2 + f) * 1024 * 2816; gb = modl + (f == 0 ? 2 : 8) * 1024; coef = 0.5f;
             nl = f == 0 ? l : l + 1; nsub = f == 0 ? 1 : 0; }
      (void)lda;
      if (l < 3 && rep == 0 && q == 10 && blockIdx.x >= 192) bias_from_f32(p, l + 1, dsm);
      { EpiResid E; E.X = p.out; E.gate_base = gb; E.coef = rep ? 0.f : coef; E.H = (bf16_t*)(p.ws + WS_H); E.RS = (float*)(p.ws + WS_ROWSS);
        E.nxt_g = nl < 4 ? p.in[11] + (nl * 3 + nsub) * 1024 : nullptr; E.nxt_scale = mod + (size_t)(nl < 4 ? nl : 0) * 3 * 9216 + (3 * nsub + 1) * 1024;
        gemm8_run(A, Bt, 1024, K, E, dsm); }
    } else if (q == 4) {
      { EpiProj E; E.PR = (bf16_t*)(p.ws + WS_PROJ); E.RS = RS; E.bias = BIAS + (size_t)(l * 3 + 1) * 3 * 5632;
        gemm8_run(H, (const bf16_t*)(p.ws + WS_WIN) + (size_t)l * PWR * 1024, PWP, 1024, E, dsm); }
    } else if (q == 5) {
      prep_phase(p, l, smem);
    } else {
      mixer_phase(p, l, l + 4 * rep, smem);
    }
    xcd_barrier(xb);
    }
  }
}

extern "C" void kernel_launch(void* const* d_in, const int* in_sizes, int n_in,
                              void* d_out, int out_size, void* d_ws, size_t ws_size,
                              hipStream_t stream) {
  static int grid_blocks = 0;
  if (!grid_blocks) {
    int dev = 0, cus = 0, per_cu = 0;
    (void)hipGetDevice(&dev);
    (void)hipDeviceGetAttribute(&cus, hipDeviceAttributeMultiprocessorCount, dev);
    (void)hipFuncSetAttribute((const void*)fwd_megakernel, hipFuncAttributeMaxDynamicSharedMemorySize, DYN_LDS);
    (void)hipOccupancyMaxActiveBlocksPerMultiprocessor(&per_cu, fwd_megakernel, 512, DYN_LDS);
    if (per_cu < 1) per_cu = 1;
    grid_blocks = cus;
    grid_blocks -= grid_blocks % 8;
  }
  Params p{};
  for (int i = 0; i < 26; ++i) p.in[i] = (const float*)d_in[i];
  p.out = (float*)d_out;
  p.ws = (char*)d_ws;
  for (int i = 0; i < 16; ++i) p.freqA[i] = powf(10000.0f, -(float)i / 16.0f);
  for (int i = 0; i < 12; ++i) p.freqC[i] = powf(10000.0f, -(float)i / 12.0f);
  for (int l = 0; l < 4; ++l) p.lam_init[l] = (float)(0.8 - 0.6 * exp(-0.3 * l));
  (void)hipMemsetAsync((char*)d_ws + WS_BAR, 0, XCD_BAR_WORDS_C * 4, stream);
  void* args[] = {&p};
  hipError_t e = hipLaunchCooperativeKernel((void*)fwd_megakernel, dim3(grid_blocks), dim3(512), args, DYN_LDS, stream);
  if (e != hipSuccess) fprintf(stderr, "cooperative launch failed: %s (grid %d)\n", hipGetErrorString(e), grid_blocks);
}
```

```cpp
#include <hip/hip_runtime.h>
#include <hip/hip_cooperative_groups.h>
#include <cstdio>
#include <cmath>
namespace cg = cooperative_groups;
#ifndef PROBE
#define PROBE 0
#endif

typedef unsigned short bf16_t;
typedef short bf16x8 __attribute__((ext_vector_type(8)));
typedef short s16x4 __attribute__((ext_vector_type(4)));
typedef float f32x4 __attribute__((ext_vector_type(4)));
#define LDSP __attribute__((address_space(3)))
#define DI __device__ __forceinline__

constexpr int DM = 1024, DFF = 2816, NTOK = 12288, NCTX = 8192, PW = 2560, PWP = 2560, PWR = 2592;
constexpr int OFF_AQ = 0, OFF_AK = 384, OFF_AV = 512, OFF_BQ = 640, OFF_BK = 768, OFF_BV = 896,
              OFF_BR = 1152, OFF_CQ = 1408, OFF_CK = 1792, OFF_CV = 2176, OFF_BGW = 2560;
constexpr float EPSN = 1e-6f;
constexpr float LOG2E = 1.4426950408889634f;
constexpr size_t O_YP = 0, O_YS = 8388608, O_AK = 12582912, O_AV = 16777216, O_CK = 20971520, O_CV = 33554432, O_ST = 46137344;

constexpr size_t XCD_BAR_WORDS_C = 3456;
constexpr size_t al256(size_t x) { return (x + 255) & ~(size_t)255; }
constexpr size_t WS_MOD = 0;
constexpr size_t WS_MISC = al256(WS_MOD + 4ull * 3 * 9216 * 4);
constexpr size_t WS_ROPE = WS_MISC + 256;
constexpr size_t WS_WGU = al256(WS_ROPE + (1024 * 2 + 768 * 2) * 4);
constexpr size_t WS_WD = WS_WGU + 8ull * 5632 * 1024 * 2;
constexpr size_t WS_WIN = WS_WD + 8ull * 1024 * 2816 * 2;
constexpr size_t WS_WOUT = WS_WIN + 4ull * PWR * 1024 * 2;
constexpr size_t WS_H = WS_WOUT + 4ull * 1024 * 1024 * 2;
constexpr size_t WS_MIX = WS_H + (size_t)NTOK * 1024 * 2;
constexpr size_t WS_ACT = WS_MIX + (size_t)NTOK * 1024 * 2;
constexpr size_t WS_PROJ = WS_ACT + (size_t)NTOK * DFF * 2;
constexpr size_t WS_QA = WS_PROJ + (size_t)NTOK * PW * 2;
constexpr size_t WS_KA = WS_QA + (size_t)NTOK * 384 * 2;
constexpr size_t WS_QC = WS_KA + (size_t)NTOK * 128 * 2;
constexpr size_t WS_KC = WS_QC + (size_t)NTOK * 512 * 2;
constexpr size_t WS_GB = WS_KC + (size_t)NTOK * 512 * 2;
constexpr size_t WS_ATOT = WS_GB + (size_t)NTOK * 256 * 4;
constexpr size_t WS_U = WS_ATOT + 2 * 192ull * 256 * 4;
constexpr size_t WS_KAC = WS_U + 192ull * 2 * 4 * 2048 * 4;
constexpr size_t WS_VAC = WS_KAC + 2ull * 4 * 512 * 128 * 2;
constexpr size_t WS_KCC = WS_VAC + 2ull * 4 * 512 * 128 * 2;
constexpr size_t WS_VCC = WS_KCC + 2ull * 4 * 512 * 512 * 2;
constexpr size_t WS_BAR = WS_VCC + 2ull * 4 * 512 * 384 * 2;
constexpr size_t WS_ROWSS = al256(WS_BAR + XCD_BAR_WORDS_C * 4);
constexpr size_t WS_BIAS = WS_ROWSS + (size_t)NTOK * 16 * 4;
constexpr size_t WS_END = WS_BIAS + 4ull * 3 * 3 * 5632 * 4;

struct Params {
  const float* in[26];
  float* out;
  char* ws;
  float freqA[16];
  float freqC[12];
  float lam_init[4];
};

DI float bf2f(bf16_t v) { return __uint_as_float(((unsigned)v) << 16); }
DI bf16_t f2bf(float f) { unsigned u = __float_as_uint(f); u += 0x7fffu + ((u >> 16) & 1u); return (bf16_t)(u >> 16); }
typedef float f32x2_t __attribute__((ext_vector_type(2)));
typedef __bf16 bf16x2_t __attribute__((ext_vector_type(2)));
DI unsigned pack2(float lo, float hi) { const f32x2_t v = {lo, hi}; return __builtin_bit_cast(unsigned, __builtin_convertvector(v, bf16x2_t)); }
DI float fast_exp2(float x) { return __builtin_amdgcn_exp2f(x); }
DI float fast_rcp(float x) { return __builtin_amdgcn_rcpf(x); }
DI float silu_f(float g) { return g * fast_rcp(1.f + fast_exp2(-g * LOG2E)); }
DI float sigm_silu_acc(float g) { return g / (1.f + expf(-g)); }
DI void unpack8(uint4 v, float* x) {
  x[0] = __uint_as_float(v.x << 16); x[1] = __uint_as_float(v.x & 0xffff0000u);
  x[2] = __uint_as_float(v.y << 16); x[3] = __uint_as_float(v.y & 0xffff0000u);
  x[4] = __uint_as_float(v.z << 16); x[5] = __uint_as_float(v.z & 0xffff0000u);
  x[6] = __uint_as_float(v.w << 16); x[7] = __uint_as_float(v.w & 0xffff0000u);
}
DI void unpack4(uint2 v, float* x) {
  x[0] = __uint_as_float(v.x << 16); x[1] = __uint_as_float(v.x & 0xffff0000u);
  x[2] = __uint_as_float(v.y << 16); x[3] = __uint_as_float(v.y & 0xffff0000u);
}
DI int otid() { int t = threadIdx.x & 255; asm volatile("" : "+v"(t)); return t; }
DI int ohalf() { return __builtin_amdgcn_readfirstlane((int)(threadIdx.x >> 8)); }
DI int obid() { int b = blockIdx.x * 2 + ohalf(); asm volatile("" : "+s"(b)); return b; }
DI int vnb() { return gridDim.x * 2; }
DI int rtid() { int t = threadIdx.x; asm volatile("" : "+v"(t)); return t; }
DI int cond_of_row(int row) { return row < NCTX ? 0 : 1 + ((row - NCTX) >> 11); }


#define XB_TMO      128
#define XB_XCNT(j)  (256  + 64 * (j))
#define XB_XSUB(j)  (1280 + 64 * (j))
#define XB_XGEN(j)  (2304 + 64 * (j))
#define XB_TOP      3328
#define XB_TOPGEN   3392
#define XCD_BAR_WORDS 3456
#define XB_SPIN_CAP (1u << 22)
DI unsigned xb_ld(unsigned* p) { return __hip_atomic_load(p, __ATOMIC_RELAXED, __HIP_MEMORY_SCOPE_AGENT); }
DI unsigned xb_add(unsigned* p, unsigned v) { return __hip_atomic_fetch_add(p, v, __ATOMIC_RELAXED, __HIP_MEMORY_SCOPE_AGENT); }
DI unsigned xb_xcc_id() { return (unsigned)__builtin_amdgcn_s_getreg((3 << 11) | 20) & 0xFu; }
#define XB_SPIN(cond, bar) do { unsigned _sp = 0; while (cond) { __builtin_amdgcn_s_sleep(1); \
    if ((++_sp & 255u) == 0u) { if (xb_ld(&(bar)[XB_TMO])) break; if (_sp > XB_SPIN_CAP) { atomicAdd(&(bar)[XB_TMO], 1u); break; } } } } while (0)
struct XcdBarrier { unsigned* bar; unsigned x; volatile LDSP unsigned* st; };
DI XcdBarrier xcd_barrier_post(unsigned* bar, volatile LDSP unsigned* st) {
  XcdBarrier b; b.bar = bar; b.x = xb_xcc_id(); b.st = st;
  if (threadIdx.x == 0) (void)xb_add(&bar[XB_XCNT(b.x)], 1u);
  return b;
}
DI void xcd_barrier_complete(unsigned* bar, unsigned x, unsigned& nloc, unsigned& nx) {
  const unsigned G = gridDim.x * gridDim.y * gridDim.z;
  unsigned sum, cnt, mine, sp = 0u;
  for (;;) {
    sum = 0u; cnt = 0u; mine = 0u;
#pragma unroll
    for (unsigned j = 0; j < 16; ++j) { const unsigned c = xb_ld(&bar[XB_XCNT(j)]); sum += c; cnt += (c > 0u) ? 1u : 0u; mine = (j == x) ? c : mine; }
    if (sum == G) break;
    __builtin_amdgcn_s_sleep(1);
    if ((++sp & 255u) == 0u) { if (xb_ld(&bar[XB_TMO])) break; if (sp > XB_SPIN_CAP) { atomicAdd(&bar[XB_TMO], 1u); break; } }
  }
  nloc = mine > 0u ? mine : 1u; nx = cnt > 0u ? cnt : 1u;
}
DI void xcd_barrier(const XcdBarrier& b_) {
  asm volatile("s_waitcnt vmcnt(0)" ::: "memory");
  __syncthreads();
  if (threadIdx.x == 0) {
    XcdBarrier b; b.st = b_.st;
    { unsigned* q = b_.bar; asm volatile("" : "+s"(q)); b.bar = q; }
    { unsigned xx = xb_xcc_id(); asm volatile("" : "+s"(xx)); b.x = xx; }
    unsigned* bar = b.bar;
    __builtin_amdgcn_s_waitcnt(0);
    unsigned nloc = b.st[0], nx = b.st[1];
    if (nloc == 0u) { xcd_barrier_complete(bar, b.x, nloc, nx); b.st[0] = nloc; b.st[1] = nx; }
    const unsigned old = xb_add(&bar[XB_XSUB(b.x)], 1u);
    const unsigned gen = old / nloc;
    if (old + 1u == (gen + 1u) * nloc) {
      __builtin_amdgcn_fence(__ATOMIC_RELEASE, "agent");
      asm volatile("s_waitcnt vmcnt(0)" ::: "memory");
      const unsigned og = xb_add(&bar[XB_TOP], 1u);
      const unsigned tg = og / nx;
      if (og + 1u == (tg + 1u) * nx) xb_add(&bar[XB_TOPGEN], 1u);
      else XB_SPIN(xb_ld(&bar[XB_TOPGEN]) == tg, bar);
      __builtin_amdgcn_fence(__ATOMIC_ACQUIRE, "agent");
      xb_add(&bar[XB_XGEN(b.x)], 1u);
      asm volatile("s_waitcnt vmcnt(0)" ::: "memory");
    } else {
      XB_SPIN(xb_ld(&bar[XB_XGEN(b.x)]) == gen, bar);
      __builtin_amdgcn_fence(__ATOMIC_ACQUIRE, "agent");
      asm volatile("s_waitcnt vmcnt(0)" ::: "memory");
    }
  }
  __syncthreads();
}

DI void transpose_tile(const float* __restrict__ src, int K, int N, bf16_t* __restrict__ dst, int mode, int kt, int nt, float* sm) {
  const int t = otid();
  const int k0 = kt * 64, n0 = nt * 64;
#pragma unroll
  for (int i = 0; i < 4; ++i) {
    const int idx = t + 256 * i, r = idx >> 4, c4 = idx & 15;
    float4 v = make_float4(0.f, 0.f, 0.f, 0.f);
    if (n0 + 4 * c4 < N) v = *(const float4*)(src + (size_t)(k0 + r) * N + n0 + 4 * c4);
    float* d = sm + r * 65 + 4 * c4;
    d[0] = v.x; d[1] = v.y; d[2] = v.z; d[3] = v.w;
  }
  __syncthreads();
#pragma unroll
  for (int i = 0; i < 2; ++i) {
    const int idx = t + 256 * i, nl = idx >> 3, kc = idx & 7;
    const int n = n0 + nl;
    if (n < N) {
      float x[8];
#pragma unroll
      for (int e = 0; e < 8; ++e) x[e] = sm[(8 * kc + e) * 65 + nl];
      uint4 w; w.x = pack2(x[0], x[1]); w.y = pack2(x[2], x[3]); w.z = pack2(x[4], x[5]); w.w = pack2(x[6], x[7]);
      int drow = n;
      if (mode == 1) drow = (n >> 4) * 32 + (n & 15);
      else if (mode == 2) drow = (n >> 4) * 32 + 16 + (n & 15);
      *(uint4*)(dst + (size_t)drow * K + k0 + 8 * kc) = w;
    }
  }
  __syncthreads();
}

DI void adaln_item(const Params& p, int it, float* sm) {
  const int t = otid();
  const int l = it / 72, chunk = it % 72, j0 = chunk * 128;
  float* scond = sm;
  float* red = sm + 3072;
  for (int i = t; i < 3072; i += 256) {
    const int c = i >> 10, k = i & 1023;
    const float v = (c == 0) ? p.in[8][k] : p.in[2][(c - 1) * 1024 + k];
    scond[i] = sigm_silu_acc(v);
  }
  __syncthreads();
  const int cgp = t & 31, kg = t >> 5;
  const float* w = p.in[9] + (size_t)l * 1024 * 9216 + j0 + 4 * cgp;
  float acc[3][4];
#pragma unroll
  for (int c = 0; c < 3; ++c)
#pragma unroll
    for (int e = 0; e < 4; ++e) acc[c][e] = 0.f;
#pragma unroll 8
  for (int kk = 0; kk < 128; ++kk) {
    const int k = kg * 128 + kk;
    const float4 wv = *(const float4*)(w + (size_t)k * 9216);
#pragma unroll
    for (int c = 0; c < 3; ++c) {
      const float s = scond[c * 1024 + k];
      acc[c][0] += s * wv.x; acc[c][1] += s * wv.y; acc[c][2] += s * wv.z; acc[c][3] += s * wv.w;
    }
  }
#pragma unroll
  for (int c = 0; c < 3; ++c)
#pragma unroll
    for (int e = 0; e < 4; ++e) red[(kg * 3 + c) * 128 + 4 * cgp + e] = acc[c][e];
  __syncthreads();
  float* mod = (float*)(p.ws + WS_MOD);
  for (int o = t; o < 384; o += 256) {
    const int c = o >> 7, j = o & 127;
    float s = p.in[10][l * 9216 + j0 + j];
#pragma unroll
    for (int g = 0; g < 8; ++g) s += red[(g * 3 + c) * 128 + j];
    mod[(l * 3 + c) * 9216 + j0 + j] = s;
  }
  __syncthreads();
}

DI void sincos_tab(float pos, float freq, float& cs, float& sn) {
  const double a = (double)pos * (double)freq;
  const double twopi = 6.283185307179586476925286766559;
  const double k = rint(a / twopi);
  const double r = (a - k * twopi) * 0.25;
  const double r2 = r * r;
  double s = r * (1.0 + r2 * (-1.0 / 6 + r2 * (1.0 / 120 + r2 * (-1.0 / 5040 + r2 * (1.0 / 362880 + r2 * (-1.0 / 39916800 + r2 * (1.0 / 6227020800.0)))))));
  double c = 1.0 + r2 * (-0.5 + r2 * (1.0 / 24 + r2 * (-1.0 / 720 + r2 * (1.0 / 40320 + r2 * (-1.0 / 3628800 + r2 * (1.0 / 479001600.0 + r2 * (-1.0 / 87178291200.0)))))));
  double s2 = 2.0 * s * c, c2 = 1.0 - 2.0 * s * s;
  double s4 = 2.0 * s2 * c2, c4 = 1.0 - 2.0 * s2 * s2;
  cs = (float)c4; sn = (float)s4;
}

struct TDesc { const float* src; bf16_t* dst; int K, N, mode, kt, nt; };
DI TDesc tile_desc(const Params& p, int r) {
  TDesc d;
  const int l = r / 5136; r -= l * 5136;
  if (r < 4224) {
    const int f = r / 2112; r -= f * 2112;
    const int which = r / 704; r -= which * 704;
    const int lf = l * 2 + f;
    if (which < 2) { d.src = p.in[which == 0 ? 12 : 13] + (size_t)lf * 1024 * 2816; d.dst = (bf16_t*)(p.ws + WS_WGU) + (size_t)lf * 5632 * 1024; d.K = 1024; d.N = 2816; d.mode = which + 1; d.kt = r / 44; d.nt = r % 44; }
    else { d.src = p.in[14] + (size_t)lf * 2816 * 1024; d.dst = (bf16_t*)(p.ws + WS_WD) + (size_t)lf * 1024 * 2816; d.K = 2816; d.N = 1024; d.mode = 0; d.kt = r / 16; d.nt = r % 16; }
  } else if (r < 4224 + 656) {
    r -= 4224;
    d.src = p.in[15] + (size_t)l * 1024 * PWR; d.dst = (bf16_t*)(p.ws + WS_WIN) + (size_t)l * PWR * 1024; d.K = 1024; d.N = PWR; d.mode = 3; d.kt = r / 41; d.nt = r % 41;
  } else {
    r -= 4224 + 656;
    d.src = p.in[25] + (size_t)l * 1024 * 1024; d.dst = (bf16_t*)(p.ws + WS_WOUT) + (size_t)l * 1024 * 1024; d.K = 1024; d.N = 1024; d.mode = 0; d.kt = r / 16; d.nt = r % 16;
  }
  return d;
}
DI void tile_load(const TDesc& d, int t, f32x4 (&v)[4]) {
  const int k0 = d.kt * 64, n0 = d.nt * 64;
#pragma unroll
  for (int i = 0; i < 4; ++i) {
    const int idx = t + 256 * i, r = idx >> 4, c4 = idx & 15;
    v[i] = (f32x4){0.f, 0.f, 0.f, 0.f};
    if (n0 + 4 * c4 < d.N) v[i] = __builtin_nontemporal_load((const f32x4*)(d.src + (size_t)(k0 + r) * d.N + n0 + 4 * c4));
  }
}
DI void tile_store(const TDesc& d, int t, const f32x4 (&v)[4], float* sm) {
  const int k0 = d.kt * 64, n0 = d.nt * 64;
#pragma unroll
  for (int i = 0; i < 4; ++i) {
    const int idx = t + 256 * i, r = idx >> 4, c4 = idx & 15;
    float* q = sm + r * 65 + 4 * c4;
    q[0] = v[i][0]; q[1] = v[i][1]; q[2] = v[i][2]; q[3] = v[i][3];
  }
  __syncthreads();
#pragma unroll
  for (int i = 0; i < 2; ++i) {
    const int idx = t + 256 * i, nl = idx >> 3, kc = idx & 7;
    const int n = n0 + nl;
    if (n < d.N) {
      float x[8];
#pragma unroll
      for (int e = 0; e < 8; ++e) x[e] = sm[(8 * kc + e) * 65 + nl];
      uint4 w; w.x = pack2(x[0], x[1]); w.y = pack2(x[2], x[3]); w.z = pack2(x[4], x[5]); w.w = pack2(x[6], x[7]);
      int drow = n;
      if (d.mode == 1) drow = (n >> 7) * 256 + (n & 127);
      else if (d.mode == 2) drow = (n >> 7) * 256 + 128 + (n & 127);
      else if (d.mode == 3) drow = n < 1152 ? n : (n < 1184 ? OFF_BGW + (n - 1152) : n - 32);
      *(uint4*)(d.dst + (size_t)drow * d.K + k0 + 8 * kc) = w;
    }
  }
  __syncthreads();
}

DI void convert_slice(const Params& p, int layer, int t_begin, int t_end, int first_blk, float* sm) {
  const int t = otid();
  const int nworkers = (gridDim.x - first_blk) * 2, w = (blockIdx.x - first_blk) * 2 + ohalf();
  int r = t_begin + w;
  f32x4 cur[4], nxt[4];
  TDesc dc = tile_desc(p, layer * 5136 + (r < t_end ? r : t_begin));
  if (r < t_end) tile_load(dc, t, cur);
#pragma unroll 1
  for (; r < t_end; r += nworkers) {
    const int rn = r + nworkers;
    TDesc dn = tile_desc(p, layer * 5136 + (rn < t_end ? rn : t_begin));
    if (rn < t_end) tile_load(dn, t, nxt);
    tile_store(dc, t, cur, sm);
    dc = dn;
#pragma unroll
    for (int i = 0; i < 4; ++i) cur[i] = nxt[i];
  }
}
DI void bias_from_f32(const Params& p, int layer, char* dsm) {
  const int tx = rtid(), lane = tx & 63, kc = tx >> 6;
  float* shl = (float*)dsm;
  float* red = shl + 3072;
  const float* mod = (const float*)(p.ws + WS_MOD);
  float* BIAS = (float*)(p.ws + WS_BIAS);
  const int nidle = gridDim.x - 192, me = blockIdx.x - 192;
#pragma unroll 1
  for (int task = me; task < 55; task += nidle) {
    const int mi = task / 11, ch = task - mi * 11;
    const int sub = mi < 2 ? 0 : (mi == 2 ? 1 : 2);
    const int N = mi == 2 ? PWR : 2816;
    const float* W = mi == 2 ? p.in[15] + (size_t)layer * 1024 * PWR
                             : p.in[(mi == 0 || mi == 3) ? 12 : 13] + (size_t)(layer * 2 + (mi < 2 ? 0 : 1)) * 1024 * 2816;
    __syncthreads();
    for (int i = tx; i < 3072; i += 512) { const int c = i >> 10, k = i & 1023; shl[i] = mod[((size_t)layer * 3 + c) * 9216 + (size_t)(3 * sub) * 1024 + k]; }
    __syncthreads();
    const int n = ch * 256 + lane * 4;
    f32x4 a0 = (f32x4){0.f, 0.f, 0.f, 0.f}, a1 = a0, a2 = a0;
    if (n < N) {
      const float* wp = W + (size_t)(kc * 128) * N + n;
#pragma unroll 8
      for (int i = 0; i < 128; ++i) {
        const f32x4 wv = *(const f32x4*)(wp + (size_t)i * N);
        const int k = kc * 128 + i;
        a0 += wv * shl[k]; a1 += wv * shl[1024 + k]; a2 += wv * shl[2048 + k];
      }
    }
    *(f32x4*)(red + (kc * 3 + 0) * 256 + lane * 4) = a0; *(f32x4*)(red + (kc * 3 + 1) * 256 + lane * 4) = a1; *(f32x4*)(red + (kc * 3 + 2) * 256 + lane * 4) = a2;
    __syncthreads();
    for (int o = tx; o < 768; o += 512) {
      const int c = o >> 8, j = o & 255, nn = ch * 256 + j;
      float s = 0.f;
#pragma unroll
      for (int g = 0; g < 8; ++g) s += red[(g * 3 + c) * 256 + j];
      if (nn < N) {
        int col;
        if (mi == 2) col = nn < 1152 ? nn : (nn < 1184 ? OFF_BGW + (nn - 1152) : nn - 32);
        else col = (nn >> 7) * 256 + (nn & 127) + ((mi == 1 || mi == 4) ? 128 : 0);
        BIAS[((size_t)(layer * 3 + sub) * 3 + c) * 5632 + col] = s;
      }
    }
  }
  __syncthreads();
}

DI void phase0(const Params& p, float* sm) {
  const int nb = vnb(), bid = obid(), t = otid();
#if PROBE == 6
  for (int prep_ = 0; prep_ < 2; ++prep_) {
#endif
  if (bid < 288) adaln_item(p, bid, sm);
  {
    const int n_tiles = 5136 + 3 * 2448;
    auto gid = [](int q) { return q < 5136 ? q : ((q - 5136) / 2448 + 1) * 5136 + 2688 + (q - 5136) % 2448; };
    int r, stride, lim;
    if (nb == 512) { if (bid < 288) { r = bid; stride = 288; lim = 5760; } else { r = 5760 + (bid - 288); stride = 224; lim = n_tiles; } }
    else { r = bid; stride = nb; lim = n_tiles; }
    f32x4 cur[4], nxt[4];
    TDesc dc = tile_desc(p, gid(r < lim ? r : 0));
    if (r < lim) tile_load(dc, t, cur);
#pragma unroll 1
    for (; r < lim; r += stride) {
      const int rn = r + stride;
      TDesc dn = tile_desc(p, gid(rn < lim ? rn : 0));
      if (rn < lim) tile_load(dn, t, nxt);
      tile_store(dc, t, cur, sm);
      dc = dn;
#pragma unroll
      for (int i = 0; i < 4; ++i) cur[i] = nxt[i];
    }
  }
#if PROBE == 6
  }
#endif
  #define gt ((size_t)(blockIdx.x * 512 + rtid()))
  const size_t gs = (size_t)gridDim.x * 512;
  {
    float4* dst = (float4*)p.out;
    const float4* s0 = (const float4*)p.in[0];
    const float4* s1 = (const float4*)p.in[1];
    const size_t n0 = (size_t)NCTX * 256, n1 = (size_t)NTOK * 256;
    for (size_t i = gt; i < n1; i += gs) dst[i] = (i < n0) ? s0[i] : s1[i - n0];
  }
  {
    bf16_t* kac = (bf16_t*)(p.ws + WS_KAC); bf16_t* vac = (bf16_t*)(p.ws + WS_VAC);
    for (size_t i = gt; i < 524288 / 4; i += gs) {
      const float4 a = ((const float4*)p.in[3])[i], b = ((const float4*)p.in[4])[i];
      uint2 wa, wb; wa.x = pack2(a.x, a.y); wa.y = pack2(a.z, a.w); wb.x = pack2(b.x, b.y); wb.y = pack2(b.z, b.w);
      ((uint2*)kac)[i] = wa; ((uint2*)vac)[i] = wb;
    }
    bf16_t* vcc = (bf16_t*)(p.ws + WS_VCC);
    for (size_t i = gt; i < 1572864 / 4; i += gs) {
      const float4 a = ((const float4*)p.in[6])[i];
      uint2 wa; wa.x = pack2(a.x, a.y); wa.y = pack2(a.z, a.w);
      ((uint2*)vcc)[i] = wa;
    }
    bf16_t* kcc = (bf16_t*)(p.ws + WS_KCC);
    for (size_t i = gt; i < 4096ull * 8 * 16; i += gs) {
      const size_t rv = i >> 4; const int g = (int)(i & 15);
      uint2 w = make_uint2(0, 0);
      if (g < 12) { const float4 a = *(const float4*)(p.in[5] + rv * 48 + 4 * g); w.x = pack2(a.x, a.y); w.y = pack2(a.z, a.w); }
      *(uint2*)(kcc + rv * 64 + 4 * g) = w;
    }
  }
  {
    float* rope = (float*)(p.ws + WS_ROPE);
    for (size_t i = gt; i < 1024 + 768; i += gs) {
      if (i < 1024) { const int pos = (int)i >> 4, f = (int)i & 15; float c, s; sincos_tab((float)pos, p.freqA[f], c, s); rope[i] = c; rope[1024 + i] = s; }
      else { const int j = (int)i - 1024; const int pos = j / 12, f = j % 12; float c, s; sincos_tab((float)pos, p.freqC[f], c, s); rope[2048 + j] = c; rope[2048 + 768 + j] = s; }
    }
    if (gt < 4) {
      const float* lc = p.in[23] + gt * 4 * 48;
      float s1 = 0.f, s2 = 0.f;
      for (int d = 0; d < 48; ++d) { s1 += lc[d] * lc[48 + d]; s2 += lc[96 + d] * lc[144 + d]; }
      ((float*)(p.ws + WS_MISC))[gt] = expf(s1) - expf(s2) + p.lam_init[gt];
      ((unsigned*)(p.ws + WS_MISC + 64))[gt] = 0u; ((unsigned*)(p.ws + WS_MISC + 64))[gt + 4] = 0u;
    }
  }
}
#undef gt

DI void norm0_bias_phase(const Params& p) {
  const int tx = rtid(); const int lane = tx & 63;
  const int gw = blockIdx.x * 8 + (tx >> 6), nw = gridDim.x * 8;
  const float* mod = (const float*)(p.ws + WS_MOD);
  {
    const float* g = p.in[11];
    bf16_t* H = (bf16_t*)(p.ws + WS_H);
    float* RS = (float*)(p.ws + WS_ROWSS);
    for (int row = gw; row < NTOK; row += nw) {
      const float* x = p.out + (size_t)row * 1024;
      float4 v[4]; float ss = 0.f;
#pragma unroll
      for (int c = 0; c < 4; ++c) { v[c] = *(const float4*)(x + c * 256 + lane * 4); ss += v[c].x * v[c].x + v[c].y * v[c].y + v[c].z * v[c].z + v[c].w * v[c].w; }
#pragma unroll
      for (int o = 32; o >= 1; o >>= 1) ss += __shfl_xor(ss, o);
      if (lane < 16) RS[(size_t)row * 16 + lane] = lane == 0 ? ss : 0.f;
      const float* mrow = mod + ((size_t)cond_of_row(row)) * 9216;
#pragma unroll
      for (int c = 0; c < 4; ++c) {
        const int j = c * 256 + lane * 4;
        const float4 gg = *(const float4*)(g + j), sc = *(const float4*)(mrow + 1024 + j);
        uint2 w; w.x = pack2(v[c].x * gg.x * (1.f + sc.x), v[c].y * gg.y * (1.f + sc.y)); w.y = pack2(v[c].z * gg.z * (1.f + sc.z), v[c].w * gg.w * (1.f + sc.w));
        *(uint2*)(H + (size_t)row * 1024 + j) = w;
      }
    }
  }
  {
    float* BIAS = (float*)(p.ws + WS_BIAS);
#pragma unroll 1
    for (int grp = 0; grp < 3; ++grp) {
      const int l = grp / 3, sub = grp - l * 3;
      const int ncol = sub == 1 ? PWR : 5632;
      const bf16_t* Wt = sub == 1 ? (const bf16_t*)(p.ws + WS_WIN) + (size_t)l * PWR * 1024 : (const bf16_t*)(p.ws + WS_WGU) + (size_t)(l * 2 + (sub >> 1)) * 5632 * 1024;
      float sh[3][16];
#pragma unroll
      for (int c = 0; c < 3; ++c) {
        const float* sp = mod + ((size_t)l * 3 + c) * 9216 + (size_t)(3 * sub) * 1024 + lane * 16;
#pragma unroll
        for (int q = 0; q < 4; ++q) { const float4 t = *(const float4*)(sp + 4 * q); sh[c][4 * q] = t.x; sh[c][4 * q + 1] = t.y; sh[c][4 * q + 2] = t.z; sh[c][4 * q + 3] = t.w; }
      }
#pragma unroll 2
      for (int n = gw; n < ncol; n += nw) {
        float w[16]; unpack8(*(const uint4*)(Wt + (size_t)n * 1024 + lane * 16), w); unpack8(*(const uint4*)(Wt + (size_t)n * 1024 + lane * 16 + 8), w + 8);
        float d0 = 0.f, d1 = 0.f, d2 = 0.f;
#pragma unroll
        for (int e = 0; e < 16; ++e) { d0 += sh[0][e] * w[e]; d1 += sh[1][e] * w[e]; d2 += sh[2][e] * w[e]; }
#pragma unroll
        for (int o = 32; o >= 1; o >>= 1) { d0 += __shfl_xor(d0, o); d1 += __shfl_xor(d1, o); d2 += __shfl_xor(d2, o); }
        if (lane < 3) BIAS[((size_t)grp * 3 + lane) * 5632 + n] = lane == 0 ? d0 : (lane == 1 ? d1 : d2);
      }
    }
  }
}

enum { EPI_SWIGLU = 0, EPI_RESID = 1, EPI_PROJ = 2 };

template <int EPI>
DI void gemm_phase(const Params& p, const bf16_t* __restrict__ A, int lda, const bf16_t* __restrict__ Bt, int K, int NT,
                   const float* __restrict__ gate_base  , float coef, char* smem) {
  const int tid = otid(), lane = tid & 63, wave = tid >> 6, wm = wave >> 1, wn = wave & 1;
  const int nb = vnb(), xcd = obid() & 7, slot = obid() >> 3, slots = nb >> 3;
  const int per_x = 12 * NT;
  const int nk = K >> 6;
  char* As = smem;
  char* Bs = smem + 32768;
  for (int q = slot; q < per_x; q += slots) {
    const int grp = q / (4 * NT), r = q - grp * 4 * NT, nt = r >> 2, mtl = r & 3, mt = (grp * 4 + mtl) * 8 + xcd;
    const int m0 = mt * 128, n0 = nt * 128;
    f32x4 acc[4][4];
#pragma unroll
    for (int i = 0; i < 4; ++i)
#pragma unroll
      for (int j = 0; j < 4; ++j) acc[i][j] = (f32x4){0.f, 0.f, 0.f, 0.f};
    const bf16_t* Ag = A + (size_t)(m0 + (tid >> 3)) * lda + (tid & 7) * 8;
    const bf16_t* Bg = Bt + (size_t)(n0 + (tid >> 3)) * K + (tid & 7) * 8;
    const int lrow = tid >> 3, lch = tid & 7;
    uint4 ra[4], rb[4];
#pragma unroll
    for (int i = 0; i < 4; ++i) { ra[i] = *(const uint4*)(Ag + (size_t)(32 * i) * lda); rb[i] = *(const uint4*)(Bg + (size_t)(32 * i) * K); }
#pragma unroll
    for (int i = 0; i < 4; ++i) {
      const int row = lrow + 32 * i; const int off = row * 128 + ((lch ^ (row & 7)) << 4);
      *(uint4*)(As + off) = ra[i]; *(uint4*)(Bs + off) = rb[i];
    }
    __syncthreads();
    for (int kt = 0; kt < nk; ++kt) {
      const int cur = kt & 1;
      if (kt + 1 < nk) {
        const int k0 = (kt + 1) * 64;
#pragma unroll
        for (int i = 0; i < 4; ++i) { ra[i] = *(const uint4*)(Ag + (size_t)(32 * i) * lda + k0); rb[i] = *(const uint4*)(Bg + (size_t)(32 * i) * K + k0); }
      }
      const char* as = As + cur * 16384; const char* bs = Bs + cur * 16384;
#pragma unroll
      for (int ks = 0; ks < 2; ++ks) {
        bf16x8 ax[4], bw[4];
        const int ch = ((ks * 4 + (lane >> 4)) ^ (lane & 7)) << 4;
#pragma unroll
        for (int i = 0; i < 4; ++i) {
          ax[i] = *(const bf16x8*)(as + (wm * 64 + i * 16 + (lane & 15)) * 128 + ch);
          bw[i] = *(const bf16x8*)(bs + (wn * 64 + i * 16 + (lane & 15)) * 128 + ch);
        }
#pragma unroll
        for (int mi = 0; mi < 4; ++mi)
#pragma unroll
          for (int ni = 0; ni < 4; ++ni) acc[mi][ni] = __builtin_amdgcn_mfma_f32_16x16x32_bf16(bw[ni], ax[mi], acc[mi][ni], 0, 0, 0);
      }
      if (kt + 1 < nk) {
        const int nxt = cur ^ 1;
#pragma unroll
        for (int i = 0; i < 4; ++i) {
          const int row = lrow + 32 * i; const int off = nxt * 16384 + row * 128 + ((lch ^ (row & 7)) << 4);
          *(uint4*)(As + off) = ra[i]; *(uint4*)(Bs + off) = rb[i];
        }
      }
      __syncthreads();
    }
    const int tok0 = m0 + wm * 64 + (lane & 15);
    const int nc0 = n0 + wn * 64 + (lane >> 4) * 4;
    if (EPI == EPI_SWIGLU) {
      bf16_t* ACT = (bf16_t*)(p.ws + WS_ACT);
#pragma unroll
      for (int mi = 0; mi < 4; ++mi) {
        const size_t rowoff = (size_t)(tok0 + mi * 16) * DFF;
#pragma unroll
        for (int pr = 0; pr < 2; ++pr) {
          const f32x4 g = acc[mi][2 * pr], u = acc[mi][2 * pr + 1];
          const int ffc = ((n0 + wn * 64) >> 1) + pr * 16 + (lane >> 4) * 4;
          uint2 w; w.x = pack2(silu_f(g[0]) * u[0], silu_f(g[1]) * u[1]); w.y = pack2(silu_f(g[2]) * u[2], silu_f(g[3]) * u[3]);
          *(uint2*)(ACT + rowoff + ffc) = w;
        }
      }
    } else if (EPI == EPI_RESID) {
      const float* gv = gate_base + (size_t)cond_of_row(m0) * 9216;
#pragma unroll
      for (int ni = 0; ni < 4; ++ni) {
        const int n = nc0 + ni * 16;
        const float4 gg = *(const float4*)(gv + n);
#pragma unroll
        for (int mi = 0; mi < 4; ++mi) {
          float* xp = p.out + (size_t)(tok0 + mi * 16) * 1024 + n;
          float4 xv = *(const float4*)xp;
          xv.x += coef * gg.x * acc[mi][ni][0]; xv.y += coef * gg.y * acc[mi][ni][1];
          xv.z += coef * gg.z * acc[mi][ni][2]; xv.w += coef * gg.w * acc[mi][ni][3];
          *(float4*)xp = xv;
        }
      }
    } else {
      bf16_t* PR = (bf16_t*)(p.ws + WS_PROJ);
#pragma unroll
      for (int ni = 0; ni < 4; ++ni) {
        const int n = nc0 + ni * 16;
        if (n < PW) {
#pragma unroll
          for (int mi = 0; mi < 4; ++mi) {
            uint2 w; w.x = pack2(acc[mi][ni][0], acc[mi][ni][1]); w.y = pack2(acc[mi][ni][2], acc[mi][ni][3]);
            *(uint2*)(PR + (size_t)(tok0 + mi * 16) * PW + n) = w;
          }
        }
      }
    }
  }
}


namespace pg8 {
#define PG8_LAS __attribute__((address_space(3)))
typedef unsigned short bf16_t;
typedef short bf16x8 __attribute__((ext_vector_type(8)));
typedef float f32x4 __attribute__((ext_vector_type(4)));
typedef unsigned u32x4 __attribute__((ext_vector_type(4)));
constexpr int BM = 256, BK = 64, HALF = 128, HTB = HALF * BK * 2  , STAGE_BYTES = 8 * HTB, NXCD = 8, WGM = 8;

__host__ __device__ __forceinline__ int lds_byte(int r, int c) { const int st = (r >> 4) * 2 + (c >> 5), rr = r & 15, cc = c & 31, ob = rr * 64 + cc * 2; return st * 1024 + (ob ^ (((ob >> 9) & 1) << 5)); }
__host__ __device__ __forceinline__ void stage_rc(int b, int& R, int& C) { const int st = b / 1024, sb = b % 1024, swz = sb ^ (((sb >> 9) & 1) << 5); R = (st >> 1) * 16 + swz / 64; C = (st & 1) * 32 + (swz % 64) / 2; }
__host__ __device__ __forceinline__ int perm32(int rho) { const int n = rho >> 4, i = rho & 15; return 8 * (i >> 2) + 4 * n + (i & 3); }

struct Unit { int pm, pn; };
struct Gemm { const bf16_t* A; const bf16_t* Bt; int M, N, K; };

struct StaticOrder {
    int nM, nN, nwg, G, c;
    __host__ __device__ void init(int M, int N, int G_, int c_) { nM = M / BM; nN = N / BM; nwg = nM * nN; G = G_; c = c_; }
    __host__ __device__ bool next(int i, Unit& u) const {
        const long L = (long)i * G + c; if (L >= nwg) return false;
        int wgid = (int)L; { const int q = nwg / NXCD, r = nwg % NXCD, xcd = wgid % NXCD, off = wgid / NXCD; wgid = (xcd < r ? xcd * (q + 1) : r * (q + 1) + (xcd - r) * q) + off; }
        const int nig = WGM * nN, gid = wgid / nig, fm = gid * WGM, gsz = (nM - fm) < WGM ? (nM - fm) : WGM;
        u.pm = fm + ((wgid % nig) % gsz); u.pn = (wgid % nig) / gsz; return true;
    }
    __device__ __forceinline__ void a_ready(const Unit&) const {}
    __device__ __forceinline__ void done(const Unit&) const {}
};
template <class Epi, class Sched, bool ALIGN_EPI = false, bool SP2 = false>
__device__ __forceinline__ void gemm_phase(PG8_LAS unsigned char* lds, const Gemm g, const Sched& S, const Epi& E) {
    const int tid = rtid(), wid = __builtin_amdgcn_readfirstlane(tid >> 6), lane = tid & 63, wr = wid >> 2, wc = wid & 3, fr = lane & 15, fq = lane >> 4;
    const int K = g.K, nt = K / BK;
    unsigned voffA[2], voffB[2];
#pragma unroll
    for (int i = 0; i < 2; ++i) { int R, C; stage_rc(tid * 16 + i * 8192, R, C); const int Rb = Epi::PERM ? ((R & ~31) + perm32(R & 31)) : R;
        voffA[i] = (unsigned)(R * K + C) * 2u; voffB[i] = (unsigned)(Rb * K + C) * 2u; }
    const size_t kstep = (size_t)(BK * 2);
    const size_t hstep = (size_t)HALF * K * 2;
    const size_t tstep = 2 * hstep;
    const unsigned ldsw = (unsigned)wid * 1024u;
    const int aoff = lds_byte(wr * 64 + fr, fq * 8), boff = lds_byte(wc * 32 + fr, fq * 8);
#define PG8_SA(b, h) (((b) * 2 + (h)) * HTB)
#define PG8_SB(b, h) ((4 + (b) * 2 + (h)) * HTB)
#define PG8_STAGE(bufoff, gbase, voff) do { _Pragma("unroll") for (int _i = 0; _i < 2; ++_i) \
        __builtin_amdgcn_global_load_lds((const unsigned*)((const char*)(gbase) + (voff)[_i]), (PG8_LAS unsigned*)(lds + (bufoff) + ldsw + _i * 8192), 16, 0, 0); } while (0)
#define PG8_LDA(dst, b, h) do { _Pragma("unroll") for (int m = 0; m < 4; ++m) _Pragma("unroll") for (int k = 0; k < 2; ++k) dst[m][k] = *(const PG8_LAS bf16x8*)(lds + PG8_SA(b, h) + aoff + m * 2048 + k * 1024); } while (0)
#define PG8_LDB(dst, b, h) do { _Pragma("unroll") for (int n = 0; n < 2; ++n) _Pragma("unroll") for (int k = 0; k < 2; ++k) dst[n][k] = *(const PG8_LAS bf16x8*)(lds + PG8_SB(b, h) + boff + n * 2048 + k * 1024); } while (0)
#define PG8_MMA(ai, bj, At, Bt) do { __builtin_amdgcn_s_setprio(1); _Pragma("unroll") for (int m = 0; m < 4; ++m) _Pragma("unroll") for (int n = 0; n < 2; ++n) _Pragma("unroll") for (int k = 0; k < 2; ++k) \
        acc[ai][bj][m][n] = __builtin_amdgcn_mfma_f32_16x16x32_bf16(Bt[n][k], At[m][k], acc[ai][bj][m][n], 0, 0, 0); __builtin_amdgcn_s_setprio(0); } while (0)
#define PG8_WAIT_V(n) asm volatile("s_waitcnt vmcnt(" #n ")" ::: "memory")
#define PG8_WAIT_L(n) asm volatile("s_waitcnt lgkmcnt(" #n ")" ::: "memory")
#define PG8_BAR __builtin_amdgcn_s_barrier()
#define PG8_SCHED __builtin_amdgcn_sched_barrier(0)
    Unit cur, nxt; int ui = 0;
    if (!S.next(0, cur)) return;
    f32x4 acc[2][2][4][2];
#pragma unroll
    for (int a = 0; a < 2; ++a)
#pragma unroll
        for (int b = 0; b < 2; ++b)
#pragma unroll
            for (int m = 0; m < 4; ++m)
#pragma unroll
                for (int n = 0; n < 2; ++n) acc[a][b][m][n] = (f32x4){0.f, 0.f, 0.f, 0.f};
    bf16x8 At[4][2], B0[2][2], B1[2][2];
    const char* cA = (const char*)g.A + (size_t)cur.pm * tstep; const char* cB = (const char*)g.Bt + (size_t)cur.pn * tstep;
    S.a_ready(cur);
    if constexpr (SP2) {
        PG8_STAGE(PG8_SB(0, 0), cB, voffB); PG8_STAGE(PG8_SB(0, 1), cB + hstep, voffB); PG8_STAGE(PG8_SA(0, 0), cA, voffA); PG8_STAGE(PG8_SA(0, 1), cA + hstep, voffA);
        if (wr == 1) PG8_BAR;
        PG8_WAIT_V(2); PG8_BAR;
        PG8_STAGE(PG8_SB(1, 0), cB + kstep, voffB); PG8_STAGE(PG8_SA(1, 0), cA + kstep, voffA); PG8_STAGE(PG8_SB(1, 1), cB + hstep + kstep, voffB);
        PG8_WAIT_V(6); PG8_BAR;
    } else {
        PG8_STAGE(PG8_SB(0, 0), cB, voffB); PG8_STAGE(PG8_SA(0, 0), cA, voffA); PG8_STAGE(PG8_SB(0, 1), cB + hstep, voffB); PG8_STAGE(PG8_SA(0, 1), cA + hstep, voffA);
        if (wr == 1) PG8_BAR;
        PG8_WAIT_V(4); PG8_BAR;
        PG8_STAGE(PG8_SB(1, 0), cB + kstep, voffB); PG8_STAGE(PG8_SA(1, 0), cA + kstep, voffA); PG8_STAGE(PG8_SB(1, 1), cB + hstep + kstep, voffB);
        PG8_WAIT_V(6); PG8_BAR;
    }
    for (;;) {
        const bool has_next = S.next(ui + 1, nxt);
        const char* nA = has_next ? (const char*)g.A + (size_t)nxt.pm * tstep : cA; const char* nB = has_next ? (const char*)g.Bt + (size_t)nxt.pn * tstep : cB;
        for (int t = 0; t < nt; t += 2) {
            const bool last = (t == nt - 2);
            const char* a1 = cA + (size_t)(t + 1) * kstep;
            const char* a2 = last ? nA : cA + (size_t)(t + 2) * kstep; const char* b2 = last ? nB : cB + (size_t)(t + 2) * kstep;
            const char* a3 = a2 + kstep; const char* b3 = b2 + kstep;
            if (last && has_next) S.a_ready(nxt);
            if constexpr (SP2) {
            PG8_LDB(B0, 0, 0); PG8_LDB(B1, 0, 1); PG8_SCHED; PG8_LDA(At, 0, 0); PG8_STAGE(PG8_SA(1, 1), a1 + hstep, voffA);
            PG8_WAIT_V(8); PG8_WAIT_L(0); PG8_BAR; PG8_MMA(0, 0, At, B0); PG8_MMA(0, 1, At, B1); PG8_BAR; PG8_SCHED;
            PG8_LDA(At, 0, 1); PG8_STAGE(PG8_SB(0, 0), b2, voffB); PG8_STAGE(PG8_SB(0, 1), b2 + hstep, voffB); PG8_STAGE(PG8_SA(0, 0), a2, voffA);
            PG8_WAIT_V(8); PG8_WAIT_L(0); PG8_BAR; PG8_MMA(1, 0, At, B0); PG8_MMA(1, 1, At, B1); PG8_BAR; PG8_SCHED;
            PG8_LDB(B0, 1, 0); PG8_LDB(B1, 1, 1); PG8_SCHED; PG8_LDA(At, 1, 0); PG8_STAGE(PG8_SA(0, 1), a2 + hstep, voffA);
            PG8_WAIT_V(8); PG8_WAIT_L(0); PG8_BAR; PG8_MMA(0, 0, At, B0); PG8_MMA(0, 1, At, B1); PG8_BAR; PG8_SCHED;
            PG8_LDA(At, 1, 1); PG8_STAGE(PG8_SB(1, 0), b3, voffB); PG8_STAGE(PG8_SB(1, 1), b3 + hstep, voffB); PG8_STAGE(PG8_SA(1, 0), a3, voffA);
            PG8_WAIT_V(8); PG8_WAIT_L(0); PG8_BAR; PG8_MMA(1, 0, At, B0); PG8_MMA(1, 1, At, B1); PG8_BAR; PG8_SCHED;
            } else {
            PG8_LDB(B0, 0, 0); PG8_SCHED; PG8_LDA(At, 0, 0); PG8_STAGE(PG8_SA(1, 1), a1 + hstep, voffA);
            PG8_WAIT_L(8); PG8_BAR; PG8_WAIT_L(0); PG8_MMA(0, 0, At, B0); PG8_BAR; PG8_SCHED;
            PG8_LDB(B1, 0, 1); PG8_STAGE(PG8_SB(0, 0), b2, voffB);
            PG8_BAR; PG8_WAIT_L(0); PG8_MMA(0, 1, At, B1); PG8_BAR;
            PG8_LDA(At, 0, 1); PG8_STAGE(PG8_SA(0, 0), a2, voffA);
            PG8_BAR; PG8_WAIT_L(0); PG8_MMA(1, 0, At, B0); PG8_BAR; PG8_SCHED;
            PG8_STAGE(PG8_SB(0, 1), b2 + hstep, voffB);
            PG8_WAIT_V(6); PG8_BAR; PG8_MMA(1, 1, At, B1); PG8_BAR;
            PG8_LDB(B0, 1, 0); PG8_SCHED; PG8_LDA(At, 1, 0); PG8_STAGE(PG8_SA(0, 1), a2 + hstep, voffA);
            PG8_WAIT_L(8); PG8_BAR; PG8_WAIT_L(0); PG8_MMA(0, 0, At, B0); PG8_BAR; PG8_SCHED;
            PG8_LDB(B1, 1, 1); PG8_STAGE(PG8_SB(1, 0), b3, voffB);
            PG8_BAR; PG8_WAIT_L(0); PG8_MMA(0, 1, At, B1); PG8_BAR;
            PG8_LDA(At, 1, 1); PG8_STAGE(PG8_SA(1, 0), a3, voffA);
            PG8_BAR; PG8_WAIT_L(0); PG8_MMA(1, 0, At, B0); PG8_BAR; PG8_SCHED;
            PG8_STAGE(PG8_SB(1, 1), b3 + hstep, voffB);
            PG8_WAIT_V(6); PG8_BAR; PG8_MMA(1, 1, At, B1); PG8_BAR;
            }
        }
        if constexpr (ALIGN_EPI) { if (wr == 0) PG8_BAR; }
        if constexpr (!Epi::AFTER_DRAIN) { E(acc, cur, wr, wc, fr, fq); S.done(cur); }
        if (!has_next) break;
#pragma unroll
        for (int a = 0; a < 2; ++a)
#pragma unroll
            for (int b = 0; b < 2; ++b)
#pragma unroll
                for (int m = 0; m < 4; ++m)
#pragma unroll
                    for (int n = 0; n < 2; ++n) acc[a][b][m][n] = (f32x4){0.f, 0.f, 0.f, 0.f};
        cur = nxt; cA = nA; cB = nB; ++ui;
        if constexpr (ALIGN_EPI) { if (wr == 1) PG8_BAR; }
    }
    PG8_WAIT_V(0);
    if constexpr (!ALIGN_EPI) { if (wr == 0) PG8_BAR; }
    PG8_BAR;
    if constexpr (Epi::AFTER_DRAIN) { E.fused(acc, cur, wr, wc, fr, fq, lds, wid, lane); S.done(cur); }
#undef PG8_SA
#undef PG8_SB
#undef PG8_STAGE
#undef PG8_LDA
#undef PG8_LDB
#undef PG8_MMA
#undef PG8_WAIT_V
#undef PG8_WAIT_L
#undef PG8_BAR
#undef PG8_SCHED
}
}

DI void wave_rstd(const float* RS, int rowbase  , int lane, float& r0, float& r1) {
  const float* a = RS + (size_t)(rowbase + lane) * 16; const float* b = a + 128 * 16;
  const float4 a0 = *(const float4*)a, a1 = *(const float4*)(a + 4), a2 = *(const float4*)(a + 8), a3 = *(const float4*)(a + 12);
  const float4 b0 = *(const float4*)b, b1 = *(const float4*)(b + 4), b2 = *(const float4*)(b + 8), b3 = *(const float4*)(b + 12);
  const float sa = ((a0.x + a0.y) + (a0.z + a0.w)) + ((a1.x + a1.y) + (a1.z + a1.w)) + ((a2.x + a2.y) + (a2.z + a2.w)) + ((a3.x + a3.y) + (a3.z + a3.w));
  const float sb = ((b0.x + b0.y) + (b0.z + b0.w)) + ((b1.x + b1.y) + (b1.z + b1.w)) + ((b2.x + b2.y) + (b2.z + b2.w)) + ((b3.x + b3.y) + (b3.z + b3.w));
  r0 = rsqrtf(sa * (1.f / 1024.f) + EPSN); r1 = rsqrtf(sb * (1.f / 1024.f) + EPSN);
}
struct EpiSwiglu {
  static constexpr bool PERM = true, AFTER_DRAIN = false;
  bf16_t* ACT; const float* RS; const float* bias  ;
  DI void operator()(const f32x4 (&acc)[2][2][4][2], const pg8::Unit& u, int wr, int wc, int fr, int fq) const {
    const int row0 = u.pm * 256 + wr * 64 + fr, lane = fq * 16 + fr;
    float rs[2]; wave_rstd(RS, u.pm * 256 + wr * 64, lane, rs[0], rs[1]);
    const float* bp = bias + (size_t)cond_of_row(u.pm * 256) * 5632 + u.pn * 256 + wc * 32 + 8 * fq;
    const f32x4 bg0 = *(const f32x4*)(bp), bg1 = *(const f32x4*)(bp + 4), bu0 = *(const f32x4*)(bp + 128), bu1 = *(const f32x4*)(bp + 132);
#pragma unroll
    for (int ai = 0; ai < 2; ++ai)
#pragma unroll
      for (int m = 0; m < 4; ++m) {
        const float r = __shfl(rs[ai], 16 * m + fr);
        const f32x4 g0 = acc[ai][0][m][0] * r + bg0, g1 = acc[ai][0][m][1] * r + bg1, v0 = acc[ai][1][m][0] * r + bu0, v1 = acc[ai][1][m][1] * r + bu1;
        uint4 w;
        w.x = pack2(silu_f(g0[0]) * v0[0], silu_f(g0[1]) * v0[1]); w.y = pack2(silu_f(g0[2]) * v0[2], silu_f(g0[3]) * v0[3]);
        w.z = pack2(silu_f(g1[0]) * v1[0], silu_f(g1[1]) * v1[1]); w.w = pack2(silu_f(g1[2]) * v1[2], silu_f(g1[3]) * v1[3]);
        *(uint4*)(ACT + (size_t)(row0 + ai * 128 + m * 16) * DFF + u.pn * 128 + wc * 32 + 8 * fq) = w;
      }
  }
};
struct EpiResid {
  static constexpr bool PERM = true, AFTER_DRAIN = false;
  float* X; const float* gate_base; float coef;
  bf16_t* H; float* RS; const float* nxt_g  ; const float* nxt_scale  ;
  DI void operator()(const f32x4 (&acc)[2][2][4][2], const pg8::Unit& u, int wr, int wc, int fr, int fq) const {
    const int row0 = u.pm * 256 + wr * 64 + fr, col0 = u.pn * 256 + wc * 32 + 8 * fq;
    const int cond = cond_of_row(u.pm * 256);
    const float* gv = gate_base + (size_t)cond * 9216 + col0;
    const bool has_next = nxt_g != nullptr;
    float ss[2][4];
#pragma unroll
    for (int ai = 0; ai < 2; ++ai)
#pragma unroll
      for (int m = 0; m < 4; ++m) ss[ai][m] = 0.f;
#pragma unroll
    for (int bj = 0; bj < 2; ++bj) {
      const int co = bj * 128;
      const float4 gg0 = *(const float4*)(gv + co), gg1 = *(const float4*)(gv + co + 4);
      float4 hv0 = make_float4(0.f, 0.f, 0.f, 0.f), hv1 = hv0;
      if (has_next) {
        const float* gp = nxt_g + col0 + co; const float* sp = nxt_scale + (size_t)cond * 9216 + col0 + co;
        const float4 g20 = *(const float4*)gp, g21 = *(const float4*)(gp + 4), s20 = *(const float4*)sp, s21 = *(const float4*)(sp + 4);
        hv0 = make_float4(g20.x * (1.f + s20.x), g20.y * (1.f + s20.y), g20.z * (1.f + s20.z), g20.w * (1.f + s20.w));
        hv1 = make_float4(g21.x * (1.f + s21.x), g21.y * (1.f + s21.y), g21.z * (1.f + s21.z), g21.w * (1.f + s21.w));
      }
#pragma unroll
      for (int ai = 0; ai < 2; ++ai)
#pragma unroll
        for (int m = 0; m < 4; ++m) {
          const size_t off = (size_t)(row0 + ai * 128 + m * 16) * 1024 + col0 + co;
          float4 x0 = *(const float4*)(X + off), x1 = *(const float4*)(X + off + 4);
          const f32x4 a0 = acc[ai][bj][m][0], a1 = acc[ai][bj][m][1];
          x0.x += coef * gg0.x * a0[0]; x0.y += coef * gg0.y * a0[1]; x0.z += coef * gg0.z * a0[2]; x0.w += coef * gg0.w * a0[3];
          x1.x += coef * gg1.x * a1[0]; x1.y += coef * gg1.y * a1[1]; x1.z += coef * gg1.z * a1[2]; x1.w += coef * gg1.w * a1[3];
          *(float4*)(X + off) = x0; *(float4*)(X + off + 4) = x1;
          if (has_next) {
            ss[ai][m] += ((x0.x * x0.x + x0.y * x0.y) + (x0.z * x0.z + x0.w * x0.w)) + ((x1.x * x1.x + x1.y * x1.y) + (x1.z * x1.z + x1.w * x1.w));
            uint4 w; w.x = pack2(x0.x * hv0.x, x0.y * hv0.y); w.y = pack2(x0.z * hv0.z, x0.w * hv0.w); w.z = pack2(x1.x * hv1.x, x1.y * hv1.y); w.w = pack2(x1.z * hv1.z, x1.w * hv1.w);
            *(uint4*)(H + off) = w;
          }
        }
    }
    if (has_next) {
#pragma unroll
      for (int ai = 0; ai < 2; ++ai)
#pragma unroll
        for (int m = 0; m < 4; ++m) {
          float s = ss[ai][m];
          s += __shfl_xor(s, 16); s += __shfl_xor(s, 32);
          if (fq == 0) RS[(size_t)(row0 + ai * 128 + m * 16) * 16 + u.pn * 4 + wc] = s;
        }
    }
  }
};
struct EpiProj {
  static constexpr bool PERM = true, AFTER_DRAIN = false;
  bf16_t* PR; const float* RS; const float* bias  ;
  DI void operator()(const f32x4 (&acc)[2][2][4][2], const pg8::Unit& u, int wr, int wc, int fr, int fq) const {
    const int row0 = u.pm * 256 + wr * 64 + fr, col0 = u.pn * 256 + wc * 32 + 8 * fq, lane = fq * 16 + fr;
    float rs[2]; wave_rstd(RS, u.pm * 256 + wr * 64, lane, rs[0], rs[1]);
    float rr[2][4];
#pragma unroll
    for (int ai = 0; ai < 2; ++ai)
#pragma unroll
      for (int m = 0; m < 4; ++m) rr[ai][m] = __shfl(rs[ai], 16 * m + fr);
    const float* bp = bias + (size_t)cond_of_row(u.pm * 256) * 5632;
#pragma unroll
    for (int bj = 0; bj < 2; ++bj) {
      const int col = col0 + bj * 128;
      if (col < PW) {
        const f32x4 b0 = *(const f32x4*)(bp + col), b1 = *(const f32x4*)(bp + col + 4);
#pragma unroll
        for (int ai = 0; ai < 2; ++ai)
#pragma unroll
          for (int m = 0; m < 4; ++m) {
            const f32x4 a0 = acc[ai][bj][m][0] * rr[ai][m] + b0, a1 = acc[ai][bj][m][1] * rr[ai][m] + b1;
            uint4 w; w.x = pack2(a0[0], a0[1]); w.y = pack2(a0[2], a0[3]); w.z = pack2(a1[0], a1[1]); w.w = pack2(a1[2], a1[3]);
            *(uint4*)(PR + (size_t)(row0 + ai * 128 + m * 16) * PW + col) = w;
          }
      }
    }
  }
};
template <class Epi>
DI void gemm8_run(const bf16_t* acts, const bf16_t* wts, int Nw, int K, const Epi& E, char* dsm) {
  pg8::Gemm g; g.A = acts; g.Bt = wts; g.M = NTOK; g.N = Nw; g.K = K;
  pg8::StaticOrder S; S.init(NTOK, Nw, (int)gridDim.x, (int)blockIdx.x);
  pg8::gemm_phase<Epi, pg8::StaticOrder, true, true>((LDSP unsigned char*)dsm, g, S, E);
}

DI void prep_gla_tile(const Params& p, int l, int tt, char* smem) {
  const int tid = otid();
  const bf16_t* PR = (const bf16_t*)(p.ws + WS_PROJ);
  float* GB = (float*)(p.ws + WS_GB); float* ATOT = (float*)(p.ws + WS_ATOT); float* U = (float*)(p.ws + WS_U);
  const int row0 = tt * 64;
  float* bg = (float*)smem;
  bf16_t* ks = (bf16_t*)(smem + 8192);
  bf16_t* vs = (bf16_t*)(smem + 8192 + 16384);
  {
    {
      const int lane = tid & 63, wv = tid >> 6, fr = lane & 15, fq = lane >> 4;
      const bf16_t* hp = (const bf16_t*)(p.ws + WS_H) + (size_t)(row0 + wv * 16 + fr) * 1024 + 8 * fq;
      const bf16_t* wp = (const bf16_t*)(p.ws + WS_WIN) + ((size_t)l * PWR + OFF_BGW + fr) * 1024 + 8 * fq;
      f32x4 c0 = (f32x4){0.f, 0.f, 0.f, 0.f}, c1 = c0;
#pragma unroll 8
      for (int ks = 0; ks < 32; ++ks) {
        const bf16x8 a = *(const bf16x8*)(hp + 32 * ks), b0 = *(const bf16x8*)(wp + 32 * ks), b1 = *(const bf16x8*)(wp + 16 * 1024 + 32 * ks);
        c0 = __builtin_amdgcn_mfma_f32_16x16x32_bf16(a, b0, c0, 0, 0, 0);
        c1 = __builtin_amdgcn_mfma_f32_16x16x32_bf16(a, b1, c1, 0, 0, 0);
      }
      const float* rsp = (const float*)(p.ws + WS_ROWSS) + (size_t)(row0 + wv * 16 + fr) * 16;
      const float4 r0 = *(const float4*)rsp, r1 = *(const float4*)(rsp + 4), r2 = *(const float4*)(rsp + 8), r3 = *(const float4*)(rsp + 12);
      const float rs = rsqrtf((((r0.x + r0.y) + (r0.z + r0.w)) + ((r1.x + r1.y) + (r1.z + r1.w)) + ((r2.x + r2.y) + (r2.z + r2.w)) + ((r3.x + r3.y) + (r3.z + r3.w))) * (1.f / 1024.f) + EPSN);
      const float* bp = (const float*)(p.ws + WS_BIAS) + ((size_t)(l * 3 + 1) * 3 + cond_of_row(row0)) * 5632 + OFF_BGW;
      const float bb0 = bp[fr], bb1 = bp[16 + fr];
#pragma unroll
      for (int r = 0; r < 4; ++r) {
        const float rr = __shfl(rs, 4 * fq + r);
        float* dst = bg + (wv * 16 + 4 * fq + r) * 32;
        dst[fr] = c0[r] * rr + bb0; dst[16 + fr] = c1[r] * rr + bb1;
      }
    }
#pragma unroll
    for (int q = 0; q < 4; ++q) { const int c = tid + 256 * q, row = c >> 4, ch = c & 15; *(uint4*)(ks + row * 128 + 8 * ch) = *(const uint4*)(PR + (size_t)(row0 + row) * PW + OFF_BK + 8 * ch); }
#pragma unroll
    for (int q = 0; q < 8; ++q) { const int c = tid + 256 * q, row = c >> 5, ch = c & 31; *(uint4*)(vs + row * 256 + 8 * ch) = *(const uint4*)(PR + (size_t)(row0 + row) * PW + OFF_BV + 8 * ch); }
  }
  __syncthreads();
  const int s = tid >> 7, k = tid & 127, h = k >> 5, d = k & 31;
  float w[16];
#pragma unroll
  for (int r = 0; r < 16; ++r) w[r] = p.in[18][((size_t)(l * 2 + s) * 16 + r) * 128 + k];
  const float bias = p.in[19][(l * 2 + s) * 128 + k];
  float acc[64];
#pragma unroll
  for (int x = 0; x < 64; ++x) acc[x] = 0.f;
  float run = 0.f;
#pragma unroll 2
  for (int ii = 0; ii < 64; ++ii) {
    const int j = s ? ii : 63 - ii;
    float z = bias;
#pragma unroll
    for (int r = 0; r < 16; ++r) z += bg[j * 32 + s * 16 + r] * w[r];
    const float ls = fminf(z, 0.f) - 0.6931471805599453f * __builtin_amdgcn_logf(1.f + fast_exp2(-fabsf(z) * LOG2E));
    GB[(size_t)(row0 + j) * 256 + s * 128 + k] = run;
    const float kd = bf2f(ks[j * 128 + k]) * fast_exp2(run * LOG2E);
    run += ls * (1.f / 16.f);
    const bf16_t* vr = vs + j * 256 + h * 64;
#pragma unroll
    for (int x8 = 0; x8 < 8; ++x8) {
      float vv[8]; unpack8(*(const uint4*)(vr + 8 * x8), vv);
#pragma unroll
      for (int e = 0; e < 8; ++e) acc[8 * x8 + e] += kd * vv[e];
    }
  }
  ATOT[tt * 256 + tid] = expf(run);
  ATOT[192 * 256 + tt * 256 + tid] = run;
  float* u = U + (((size_t)tt * 2 + s) * 4 + h) * 2048 + d * 64;
#pragma unroll
  for (int x4 = 0; x4 < 16; ++x4) *(float4*)(u + 4 * x4) = make_float4(acc[4 * x4], acc[4 * x4 + 1], acc[4 * x4 + 2], acc[4 * x4 + 3]);
  __syncthreads();
}

struct TokRaw { uint4 a; uint2 c0, c1, c2; uint4 av, cv; };
DI void tok_load(const bf16_t* PR, int r, int lane, bool ctx, TokRaw& t) {
  const bf16_t* pr = PR + (size_t)r * PW;
  t.a = *(const uint4*)(pr + (lane >> 3) * 64 + 8 * (lane & 7));
  const bf16_t* src = pr + OFF_CQ + (lane >> 2) * 48 + 12 * (lane & 3);
  t.c0 = *(const uint2*)(src); t.c1 = *(const uint2*)(src + 4); t.c2 = *(const uint2*)(src + 8);
  t.av = make_uint4(0, 0, 0, 0); t.cv = make_uint4(0, 0, 0, 0);
  if (ctx) { if (lane < 16) t.av = *(const uint4*)(pr + OFF_AV + 8 * lane); if (lane < 48) t.cv = *(const uint4*)(pr + OFF_CV + 8 * lane); }
}
DI void prep_token(const Params& p, int l, int r, int lane, const TokRaw& t) {
  bf16_t* QA = (bf16_t*)(p.ws + WS_QA); bf16_t* KA = (bf16_t*)(p.ws + WS_KA);
  bf16_t* QC = (bf16_t*)(p.ws + WS_QC); bf16_t* KC = (bf16_t*)(p.ws + WS_KC);
  const float* rope = (const float*)(p.ws + WS_ROPE);
  const float qsA = 0.125f * LOG2E, qsC = 0.14433756729740643f * LOG2E;
  const bool ctx = r < NCTX;
  const int b = ctx ? (r >> 8) : ((r - NCTX) >> 11);
  const int tq = ctx ? (r & 255) : ((r - NCTX) & 2047);
  const int rowpos = tq >> 6, colpos = tq & 63;
  float gA[8], cA[8], sA[8], gC[12], cC[12], sC[12];
  {
    const int vA = lane >> 3, sA_ = lane & 7, vC = lane >> 2, qdC = lane & 3;
    const float* ga = (vA < 6 ? p.in[16] : p.in[17]) + l * 64 + 8 * sA_;
    const float4 g0 = *(const float4*)ga, g1 = *(const float4*)(ga + 4);
    gA[0] = g0.x; gA[1] = g0.y; gA[2] = g0.z; gA[3] = g0.w; gA[4] = g1.x; gA[5] = g1.y; gA[6] = g1.z; gA[7] = g1.w;
    const float* gc = (vC < 8 ? p.in[21] : p.in[22]) + l * 96 + (vC & 1) * 48 + 12 * qdC;
    const float4 h0 = *(const float4*)gc, h1 = *(const float4*)(gc + 4), h2 = *(const float4*)(gc + 8);
    gC[0] = h0.x; gC[1] = h0.y; gC[2] = h0.z; gC[3] = h0.w; gC[4] = h1.x; gC[5] = h1.y; gC[6] = h1.z; gC[7] = h1.w; gC[8] = h2.x; gC[9] = h2.y; gC[10] = h2.z; gC[11] = h2.w;
#pragma unroll
    for (int e = 0; e < 8; ++e) { cA[e] = 1.f; sA[e] = 0.f; }
#pragma unroll
    for (int e = 0; e < 12; ++e) { cC[e] = 1.f; sC[e] = 0.f; }
    if (!ctx) {
      const int posA = (sA_ < 4) ? rowpos : colpos, posC = (qdC < 2) ? rowpos : colpos;
      const float* ct = rope + posA * 16 + (sA_ & 1) * 8; const float* st = rope + 1024 + posA * 16 + (sA_ & 1) * 8;
      const float4 c0 = *(const float4*)ct, c1 = *(const float4*)(ct + 4), s0 = *(const float4*)st, s1 = *(const float4*)(st + 4);
      cA[0] = c0.x; cA[1] = c0.y; cA[2] = c0.z; cA[3] = c0.w; cA[4] = c1.x; cA[5] = c1.y; cA[6] = c1.z; cA[7] = c1.w;
      sA[0] = s0.x; sA[1] = s0.y; sA[2] = s0.z; sA[3] = s0.w; sA[4] = s1.x; sA[5] = s1.y; sA[6] = s1.z; sA[7] = s1.w;
      const float* ct2 = rope + 2048 + posC * 12; const float* st2 = rope + 2048 + 768 + posC * 12;
      const float4 d0 = *(const float4*)ct2, d1 = *(const float4*)(ct2 + 4), d2 = *(const float4*)(ct2 + 8), e0 = *(const float4*)st2, e1 = *(const float4*)(st2 + 4), e2 = *(const float4*)(st2 + 8);
      cC[0] = d0.x; cC[1] = d0.y; cC[2] = d0.z; cC[3] = d0.w; cC[4] = d1.x; cC[5] = d1.y; cC[6] = d1.z; cC[7] = d1.w; cC[8] = d2.x; cC[9] = d2.y; cC[10] = d2.z; cC[11] = d2.w;
      sC[0] = e0.x; sC[1] = e0.y; sC[2] = e0.z; sC[3] = e0.w; sC[4] = e1.x; sC[5] = e1.y; sC[6] = e1.z; sC[7] = e1.w; sC[8] = e2.x; sC[9] = e2.y; sC[10] = e2.z; sC[11] = e2.w;
    }
  }
  {
    const int v = lane >> 3, s = lane & 7;
    float x[8]; unpack8(t.a, x);
    float ss = 0.f;
#pragma unroll
    for (int e = 0; e < 8; ++e) ss += x[e] * x[e];
    ss += __shfl_xor(ss, 1); ss += __shfl_xor(ss, 2); ss += __shfl_xor(ss, 4);
    const float rstd = rsqrtf(ss * (1.f / 64.f) + EPSN);
    float y[8];
#pragma unroll
    for (int e = 0; e < 8; ++e) y[e] = x[e] * rstd * gA[e];
    if (ctx) {
      if (v >= 6) {
        float* o = p.out + O_AK + ((size_t)(b * 4 + l) * 256 + tq) * 128 + (v - 6) * 64 + 8 * s;
        *(float4*)o = make_float4(y[0], y[1], y[2], y[3]); *(float4*)(o + 4) = make_float4(y[4], y[5], y[6], y[7]);
      }
    } else {
#pragma unroll
      for (int e = 0; e < 8; ++e) {
        const float yp = __shfl_xor(y[e], 2);
        const float c = cA[e], sn = sA[e];
        y[e] = (s & 2) ? (yp * sn + y[e] * c) : (y[e] * c - yp * sn);
      }
    }
    if (v < 6) {
#pragma unroll
      for (int e = 0; e < 8; ++e) y[e] *= qsA;
    }
    uint4 w; w.x = pack2(y[0], y[1]); w.y = pack2(y[2], y[3]); w.z = pack2(y[4], y[5]); w.w = pack2(y[6], y[7]);
    if (v < 6) *(uint4*)(QA + (size_t)r * 384 + v * 64 + 8 * s) = w;
    else *(uint4*)(KA + (size_t)r * 128 + (v - 6) * 64 + 8 * s) = w;
  }
  if (ctx && lane < 16) {
    float x[8]; unpack8(t.av, x);
    float* o = p.out + O_AV + ((size_t)(b * 4 + l) * 256 + tq) * 128 + 8 * lane;
    *(float4*)o = make_float4(x[0], x[1], x[2], x[3]); *(float4*)(o + 4) = make_float4(x[4], x[5], x[6], x[7]);
  }
  {
    const int v = lane >> 2, qd = lane & 3;
    float x[12];
    unpack4(t.c0, x); unpack4(t.c1, x + 4); unpack4(t.c2, x + 8);
    float ss = 0.f;
#pragma unroll
    for (int e = 0; e < 12; ++e) ss += x[e] * x[e];
    ss += __shfl_xor(ss, 1); ss += __shfl_xor(ss, 2);
    const float rstd = rsqrtf(ss * (1.f / 48.f) + EPSN);
    float y[12];
#pragma unroll
    for (int e = 0; e < 12; ++e) y[e] = x[e] * rstd * gC[e];
    if (ctx) {
      if (v >= 8) {
        float* o = p.out + O_CK + ((size_t)(b * 4 + l) * 256 + tq) * 384 + (v - 8) * 48 + 12 * qd;
        *(float4*)o = make_float4(y[0], y[1], y[2], y[3]); *(float4*)(o + 4) = make_float4(y[4], y[5], y[6], y[7]);
        *(float4*)(o + 8) = make_float4(y[8], y[9], y[10], y[11]);
      }
    } else {
#pragma unroll
      for (int e = 0; e < 12; ++e) {
        const float yp = __shfl_xor(y[e], 1);
        const float c = cC[e], sn = sC[e];
        y[e] = (qd & 1) ? (yp * sn + y[e] * c) : (y[e] * c - yp * sn);
      }
    }
    if (v < 8) {
#pragma unroll
      for (int e = 0; e < 12; ++e) y[e] *= qsC;
    }
    bf16_t* dst = (v < 8 ? QC : KC) + (size_t)r * 512 + (v & 7) * 64;
    uint2 w0, w1, w2; w0.x = pack2(y[0], y[1]); w0.y = pack2(y[2], y[3]); w1.x = pack2(y[4], y[5]); w1.y = pack2(y[6], y[7]);
    w2.x = pack2(y[8], y[9]); w2.y = pack2(y[10], y[11]);
    *(uint2*)(dst + 12 * qd) = w0; *(uint2*)(dst + 12 * qd + 4) = w1; *(uint2*)(dst + 12 * qd + 8) = w2;
    { unsigned z0; asm volatile("v_mov_b32 %0, 0" : "=v"(z0)); *(uint2*)(dst + 48 + 4 * qd) = make_uint2(z0, z0); }
  }
  if (ctx && lane < 48) {
    float x[8]; unpack8(t.cv, x);
    float* o = p.out + O_CV + ((size_t)(b * 4 + l) * 256 + tq) * 384 + 8 * lane;
    *(float4*)o = make_float4(x[0], x[1], x[2], x[3]); *(float4*)(o + 4) = make_float4(x[4], x[5], x[6], x[7]);
  }
}

DI void prep_phase(const Params& p, int l, char* smem) {
  int bx = blockIdx.x, gx = gridDim.x; asm volatile("" : "+s"(bx), "+s"(gx));
  if (gx > 96 && bx < 96) { prep_gla_tile(p, l, obid(), smem); return; }
  if (gx <= 96) for (int tt = obid(); tt < 192; tt += vnb()) prep_gla_tile(p, l, tt, smem);
  const int tx = rtid(), lane = tx & 63;
  const int fb = gx > 96 ? 96 : 0;
  const int gw = (bx - fb) * 8 + (tx >> 6), nw = (gx - fb) * 8;
  const bf16_t* PR = (const bf16_t*)(p.ws + WS_PROJ);
  int r = gw;
  TokRaw cur, nxt;
  if (r < NTOK) tok_load(PR, r, lane, r < NCTX, cur);
#pragma unroll 1
  for (; r < NTOK; r += nw) {
    const int rn = r + nw;
    if (rn < NTOK) tok_load(PR, rn, lane, rn < NCTX, nxt);
    prep_token(p, l, r, lane, cur);
    cur = nxt;
  }
}

typedef unsigned u32x4 __attribute__((ext_vector_type(4)));
struct KVSrc { const bf16_t* k1; const bf16_t* v1; const bf16_t* k2; const bf16_t* v2; int ks1, vs1, ks2, vs2, n1, n2; };
template <int NMAP, int NDT> struct FlashRegs { u32x4 k00, k01, k10, k11, v0, v1, v2; };

template <int NMAP, int NDT>
DI void fl_issue(int kt, const KVSrc& kv, FlashRegs<NMAP, NDT>& R) {
  constexpr int CPR = NDT * 2;
  kt = kt < kv.n1 + kv.n2 ? kt : kv.n1 + kv.n2 - 1;
  const int tid = otid();
  const bf16_t* kb; const bf16_t* vb; int ks, vs;
  if (kt < kv.n1) { kb = kv.k1 + (size_t)kt * 64 * kv.ks1; vb = kv.v1 + (size_t)kt * 64 * kv.vs1; ks = kv.ks1; vs = kv.vs1; }
  else { kb = kv.k2 + (size_t)(kt - kv.n1) * 64 * kv.ks2; vb = kv.v2 + (size_t)(kt - kv.n1) * 64 * kv.vs2; ks = kv.ks2; vs = kv.vs2; }
  R.k00 = *(const u32x4*)(kb + (size_t)(tid >> 3) * ks + (tid & 7) * 8);
  R.k01 = *(const u32x4*)(kb + (size_t)((tid >> 3) + 32) * ks + (tid & 7) * 8);
  if (NMAP == 2) {
    R.k10 = *(const u32x4*)(kb + 64 + (size_t)(tid >> 3) * ks + (tid & 7) * 8);
    R.k11 = *(const u32x4*)(kb + 64 + (size_t)((tid >> 3) + 32) * ks + (tid & 7) * 8);
  } else { R.k10 = R.k00; R.k11 = R.k01; }
  { const int c = tid; R.v0 = *(const u32x4*)(vb + (size_t)(c / CPR) * vs + (c % CPR) * 8); }
  { const int c = tid + 256; R.v1 = *(const u32x4*)(vb + (size_t)(c / CPR) * vs + (c % CPR) * 8); }
  if (NDT == 6) { const int c = tid + 512; R.v2 = *(const u32x4*)(vb + (size_t)(c / CPR) * vs + (c % CPR) * 8); } else R.v2 = R.v1;
}
template <int NMAP, int NDT>
DI void fl_write(char* buf, const FlashRegs<NMAP, NDT>& R) {
  constexpr int CPR = NDT * 2, VSB = NDT * 32 + 32;
  const int tid = otid();
  char* vbuf = buf + NMAP * 8192;
  { const int row = tid >> 3, ch = tid & 7; *(u32x4*)(buf + row * 128 + ((ch ^ (row & 7)) << 4)) = R.k00; }
  { const int row = (tid >> 3) + 32, ch = tid & 7; *(u32x4*)(buf + row * 128 + ((ch ^ (row & 7)) << 4)) = R.k01; }
  if (NMAP == 2) {
    { const int row = tid >> 3, ch = tid & 7; *(u32x4*)(buf + 8192 + row * 128 + ((ch ^ (row & 7)) << 4)) = R.k10; }
    { const int row = (tid >> 3) + 32, ch = tid & 7; *(u32x4*)(buf + 8192 + row * 128 + ((ch ^ (row & 7)) << 4)) = R.k11; }
  }
  { const int c = tid; *(u32x4*)(vbuf + (c / CPR) * VSB + (c % CPR) * 16) = R.v0; }
  { const int c = tid + 256; *(u32x4*)(vbuf + (c / CPR) * VSB + (c % CPR) * 16) = R.v1; }
  if (NDT == 6) { const int c = tid + 512; *(u32x4*)(vbuf + (c / CPR) * VSB + (c % CPR) * 16) = R.v2; }
}
template <int NMAP, int NDT>
DI void fl_compute(const char* buf, const bf16x8 (&qf)[NMAP][2], f32x4 (&oacc)[NMAP][NDT], float (&mrun)[NMAP], float (&lsum)[NMAP], int lane) {
  constexpr int VSB = NDT * 32 + 32;
  const int g = lane >> 4, qq = (lane & 15) >> 2, pp = lane & 3;
  bf16x8 pf[NMAP][2];
#pragma unroll
  for (int m = 0; m < NMAP; ++m) {
    f32x4 sacc[4];
#pragma unroll
    for (int t = 0; t < 4; ++t) sacc[t] = (f32x4){0.f, 0.f, 0.f, 0.f};
#pragma unroll
    for (int ks = 0; ks < 2; ++ks) {
      const int ch = ((ks * 4 + g) ^ (lane & 7)) << 4;
#pragma unroll
      for (int t = 0; t < 4; ++t) {
        const bf16x8 kf = *(const bf16x8*)(buf + m * 8192 + (16 * t + (lane & 15)) * 128 + ch);
        sacc[t] = __builtin_amdgcn_mfma_f32_16x16x32_bf16(kf, qf[m][ks], sacc[t], 0, 0, 0);
      }
    }
    float mx = sacc[0][0];
#pragma unroll
    for (int t = 0; t < 4; ++t)
#pragma unroll
      for (int r = 0; r < 4; ++r) mx = fmaxf(mx, sacc[t][r]);
    mx = fmaxf(mx, __shfl_xor(mx, 16)); mx = fmaxf(mx, __shfl_xor(mx, 32));
    const float mnew = fmaxf(mrun[m], mx);
    const float alpha = fast_exp2(mrun[m] - mnew);
    mrun[m] = mnew;
    float ps = 0.f;
#pragma unroll
    for (int t = 0; t < 4; ++t)
#pragma unroll
      for (int r = 0; r < 4; ++r) { const float pv = fast_exp2(sacc[t][r] - mnew); sacc[t][r] = pv; ps += pv; }
    lsum[m] = lsum[m] * alpha + ps;
#pragma unroll
    for (int d = 0; d < NDT; ++d) oacc[m][d] *= alpha;
#pragma unroll
    for (int ks = 0; ks < 2; ++ks) {
      u32x4 pu;
      pu[0] = pack2(sacc[2 * ks][0], sacc[2 * ks][1]); pu[1] = pack2(sacc[2 * ks][2], sacc[2 * ks][3]);
      pu[2] = pack2(sacc[2 * ks + 1][0], sacc[2 * ks + 1][1]); pu[3] = pack2(sacc[2 * ks + 1][2], sacc[2 * ks + 1][3]);
      pf[m][ks] = __builtin_bit_cast(bf16x8, pu);
    }
  }
  const char* vbuf = buf + NMAP * 8192;
#pragma unroll
  for (int ks = 0; ks < 2; ++ks) {
    const char* vrow = vbuf + (32 * ks + 4 * g + qq) * VSB + pp * 8;
#pragma unroll
    for (int d = 0; d < NDT; ++d) {
      const s16x4 v0 = __builtin_amdgcn_ds_read_tr16_b64_v4i16((LDSP s16x4*)(vrow + d * 32));
      const s16x4 v1 = __builtin_amdgcn_ds_read_tr16_b64_v4i16((LDSP s16x4*)(vrow + 16 * VSB + d * 32));
      const bf16x8 vf = __builtin_shufflevector(v0, v1, 0, 1, 2, 3, 4, 5, 6, 7);
#pragma unroll
      for (int m = 0; m < NMAP; ++m) oacc[m][d] = __builtin_amdgcn_mfma_f32_16x16x32_bf16(vf, pf[m][ks], oacc[m][d], 0, 0, 0);
    }
  }
}

template <int NMAP, int NDT>
DI void flash_run(const bf16_t* __restrict__ qptr, const KVSrc& kv, f32x4 (&oacc)[NMAP][NDT], float (&linv)[NMAP], char* smem) {
  constexpr int BUFB = NMAP * 8192 + 64 * (NDT * 32 + 32);
  const int lane = otid() & 63;
  bf16x8 qf[NMAP][2];
  float mrun[NMAP], lsum[NMAP];
#pragma unroll
  for (int m = 0; m < NMAP; ++m) {
    qf[m][0] = *(const bf16x8*)(qptr + 64 * m); qf[m][1] = *(const bf16x8*)(qptr + 64 * m + 32);
    mrun[m] = -INFINITY; lsum[m] = 0.f;
#pragma unroll
    for (int d = 0; d < NDT; ++d) oacc[m][d] = (f32x4){0.f, 0.f, 0.f, 0.f};
  }
  const int nt = kv.n1 + kv.n2;
  FlashRegs<NMAP, NDT> R0, R1;
  fl_issue<NMAP, NDT>(0, kv, R0);
  fl_issue<NMAP, NDT>(1, kv, R1);
  __syncthreads();
  fl_write<NMAP, NDT>(smem, R0);
  fl_issue<NMAP, NDT>(2, kv, R0);
  __syncthreads();
#pragma unroll 1
  for (int t = 0; t < nt; t += 2) {
    fl_compute<NMAP, NDT>(smem, qf, oacc, mrun, lsum, lane);
    fl_write<NMAP, NDT>(smem + BUFB, R1);
    fl_issue<NMAP, NDT>(t + 3, kv, R1);
    __syncthreads();
    fl_compute<NMAP, NDT>(smem + BUFB, qf, oacc, mrun, lsum, lane);
    fl_write<NMAP, NDT>(smem, R0);
    fl_issue<NMAP, NDT>(t + 4, kv, R0);
    __syncthreads();
  }
#pragma unroll
  for (int m = 0; m < NMAP; ++m) { float l = lsum[m]; l += __shfl_xor(l, 16); l += __shfl_xor(l, 32); linv[m] = 1.f / l; }
}

DI void attn_a_item(const Params& p, int l, bool ctx, int b, int h, int qt, char* smem) {
  const int lane = otid() & 63, wave = otid() >> 6;
  const int seq0 = ctx ? b * 256 : NCTX + b * 2048;
  const int qrow = seq0 + qt * 64 + wave * 16 + (lane & 15);
  const int kvh = h / 3;
  const bf16_t* PR = (const bf16_t*)(p.ws + WS_PROJ);
  KVSrc kv;
  kv.k1 = (const bf16_t*)(p.ws + WS_KA) + (size_t)seq0 * 128 + kvh * 64; kv.ks1 = 128;
  kv.v1 = PR + (size_t)seq0 * PW + OFF_AV + kvh * 64; kv.vs1 = PW;
  kv.n1 = ctx ? 4 : 32; kv.n2 = ctx ? 0 : 8;
  kv.k2 = (const bf16_t*)(p.ws + WS_KAC) + (size_t)((b & 1) * 4 + l) * 512 * 128 + kvh * 64; kv.ks2 = 128;
  kv.v2 = (const bf16_t*)(p.ws + WS_VAC) + (size_t)((b & 1) * 4 + l) * 512 * 128 + kvh * 64; kv.vs2 = 128;
  f32x4 o[1][4]; float linv[1];
  flash_run<1, 4>((const bf16_t*)(p.ws + WS_QA) + (size_t)qrow * 384 + h * 64 + 8 * (lane >> 4), kv, o, linv, smem);
  bf16_t* dst = (bf16_t*)(p.ws + WS_MIX) + (size_t)qrow * 1024 + h * 64 + 4 * (lane >> 4);
  const float li = linv[0];
#pragma unroll
  for (int d = 0; d < 4; ++d) { uint2 w; w.x = pack2(o[0][d][0] * li, o[0][d][1] * li); w.y = pack2(o[0][d][2] * li, o[0][d][3] * li); *(uint2*)(dst + 16 * d) = w; }
}

DI void attn_c_item(const Params& p, int l, bool ctx, int b, int h, int qt, char* smem) {
  const int lane = otid() & 63, wave = otid() >> 6;
  const int seq0 = ctx ? b * 256 : NCTX + b * 2048;
  const int qrow = seq0 + qt * 64 + wave * 16 + (lane & 15);
  const bf16_t* PR = (const bf16_t*)(p.ws + WS_PROJ);
  KVSrc kv;
  kv.ks1 = 512; kv.vs1 = PW; kv.ks2 = 512; kv.vs2 = 384;
  kv.n1 = ctx ? 4 : 32; kv.n2 = ctx ? 0 : 8;
  kv.v1 = PR + (size_t)seq0 * PW + OFF_CV + h * 96;
  kv.v2 = (const bf16_t*)(p.ws + WS_VCC) + (size_t)((b & 1) * 4 + l) * 512 * 384 + h * 96;
  kv.k1 = (const bf16_t*)(p.ws + WS_KC) + (size_t)seq0 * 512 + (h * 2) * 64;
  kv.k2 = (const bf16_t*)(p.ws + WS_KCC) + (size_t)((b & 1) * 4 + l) * 512 * 512 + (h * 2) * 64;
  f32x4 o[2][6]; float linv[2];
  flash_run<2, 6>((const bf16_t*)(p.ws + WS_QC) + (size_t)qrow * 512 + (h * 2) * 64 + 8 * (lane >> 4), kv, o, linv, smem);
  const float lam = ((const float*)(p.ws + WS_MISC))[l];
  const float li0 = linv[0], l1 = linv[1] * lam;
  float ss = 0.f;
#pragma unroll
  for (int d = 0; d < 6; ++d)
#pragma unroll
    for (int r = 0; r < 4; ++r) { const float v = o[0][d][r] * li0 - o[1][d][r] * l1; o[0][d][r] = v; ss += v * v; }
  ss += __shfl_xor(ss, 16); ss += __shfl_xor(ss, 32);
  const float sc = rsqrtf(ss * (1.f / 96.f) + EPSN) * (1.f - p.lam_init[l]);
  const float* g = p.in[24] + l * 96 + 4 * (lane >> 4);
  bf16_t* dst = (bf16_t*)(p.ws + WS_MIX) + (size_t)qrow * 1024 + 640 + h * 96 + 4 * (lane >> 4);
  float4 gg[6];
#pragma unroll
  for (int d = 0; d < 6; ++d) gg[d] = *(const float4*)(g + 16 * d);
#pragma unroll
  for (int d = 0; d < 6; ++d) {
    uint2 w; w.x = pack2(o[0][d][0] * sc * gg[d].x, o[0][d][1] * sc * gg[d].y); w.y = pack2(o[0][d][2] * sc * gg[d].z, o[0][d][3] * sc * gg[d].w);
    *(uint2*)(dst + 16 * d) = w;
  }
}

DI void gla_item(const Params& p, int l, bool ctx, int b, int h, int c, char* smem) {
  const int tid = otid();
  const int seq0 = ctx ? b * 256 : NCTX + b * 2048;
  const int nch = ctx ? 4 : 32;
  const int row0 = seq0 + c * 64, tt0 = seq0 >> 6, tt = tt0 + c;
  const bf16_t* PR = (const bf16_t*)(p.ws + WS_PROJ);
  const float* GB = (const float*)(p.ws + WS_GB); const float* ATOT = (const float*)(p.ws + WS_ATOT); const float* U = (const float*)(p.ws + WS_U);
  float* qd = (float*)smem;
  float* kd = qd + 64 * 36;
  float* vv = kd + 64 * 36;
  float* S = vv + 4096;
  float* sc = S + 2048;
  const int ib = tid >> 4, xb = tid & 15, i0 = ib * 4, x0 = xb * 4;
  float o[4][4];
#pragma unroll
  for (int a = 0; a < 4; ++a)
#pragma unroll
    for (int e = 0; e < 4; ++e) o[a][e] = 0.f;
  for (int s = 0; s < 2; ++s) {
    {
      const int j = tid >> 2, part = tid & 3, kk = h * 32 + part * 8;
      const size_t prow = (size_t)(row0 + j) * PW;
      const uint4 qraw = *(const uint4*)(PR + prow + OFF_BQ + kk), kraw = *(const uint4*)(PR + prow + OFF_BK + kk);
      const float* gbp = GB + (size_t)(row0 + j) * 256 + s * 128 + kk;
      const float* ttp = ATOT + 192 * 256 + tt * 256 + s * 128 + kk;
      const float4 g0 = *(const float4*)gbp, g1 = *(const float4*)(gbp + 4), t0 = *(const float4*)ttp, t1 = *(const float4*)(ttp + 4);
      uint4 vraw0 = make_uint4(0, 0, 0, 0), vraw1 = vraw0;
      if (s == 0) { vraw0 = *(const uint4*)(PR + prow + OFF_BV + h * 64 + part * 16); vraw1 = *(const uint4*)(PR + prow + OFF_BV + h * 64 + part * 16 + 8); }
      float qv[8], kv[8]; unpack8(qraw, qv); unpack8(kraw, kv);
      const float cum[8] = {t0.x - g0.x, t0.y - g0.y, t0.z - g0.z, t0.w - g0.w, t1.x - g1.x, t1.y - g1.y, t1.z - g1.z, t1.w - g1.w};
      float qo[8], ko[8];
#pragma unroll
      for (int e = 0; e < 8; ++e) { qo[e] = qv[e] * 0.17677669529663687f * fast_exp2(cum[e] * LOG2E); ko[e] = kv[e] * fast_exp2(-cum[e] * LOG2E); }
      float* qp = qd + j * 36 + part * 8; float* kp = kd + j * 36 + part * 8;
      *(float4*)qp = make_float4(qo[0], qo[1], qo[2], qo[3]); *(float4*)(qp + 4) = make_float4(qo[4], qo[5], qo[6], qo[7]);
      *(float4*)kp = make_float4(ko[0], ko[1], ko[2], ko[3]); *(float4*)(kp + 4) = make_float4(ko[4], ko[5], ko[6], ko[7]);
      if (s == 0) {
        float x[16]; unpack8(vraw0, x); unpack8(vraw1, x + 8);
        float* vp = vv + j * 64 + part * 16;
#pragma unroll
        for (int e = 0; e < 4; ++e) *(float4*)(vp + 4 * e) = make_float4(x[4 * e], x[4 * e + 1], x[4 * e + 2], x[4 * e + 3]);
      }
    }
    {
      const int d = tid >> 3, v0 = (tid & 7) * 8;
      float S8[8];
      if (ctx) {
#pragma unroll
        for (int e = 0; e < 8; ++e) S8[e] = 0.f;
      } else {
        const float* s0 = p.in[7] + ((((size_t)b * 4 + l) * 2 + s) * 4 + h) * 2048 + d * 64 + v0;
        const float4 a = *(const float4*)s0, bq = *(const float4*)(s0 + 4);
        S8[0] = a.x; S8[1] = a.y; S8[2] = a.z; S8[3] = a.w; S8[4] = bq.x; S8[5] = bq.y; S8[6] = bq.z; S8[7] = bq.w;
      }
      const int nfold = s == 0 ? c : nch - 1 - c;
#pragma unroll 8
      for (int f = 0; f < nfold; ++f) {
        const int t2 = s == 0 ? tt0 + f : tt0 + nch - 1 - f;
        const float a = ATOT[t2 * 256 + s * 128 + h * 32 + d];
        const float* u = U + (((size_t)t2 * 2 + s) * 4 + h) * 2048 + d * 64 + v0;
        const float4 u0 = *(const float4*)u, u1 = *(const float4*)(u + 4);
        S8[0] = a * S8[0] + u0.x; S8[1] = a * S8[1] + u0.y; S8[2] = a * S8[2] + u0.z; S8[3] = a * S8[3] + u0.w;
        S8[4] = a * S8[4] + u1.x; S8[5] = a * S8[5] + u1.y; S8[6] = a * S8[6] + u1.z; S8[7] = a * S8[7] + u1.w;
      }
      *(float4*)(S + d * 64 + v0) = make_float4(S8[0], S8[1], S8[2], S8[3]);
      *(float4*)(S + d * 64 + v0 + 4) = make_float4(S8[4], S8[5], S8[6], S8[7]);
      if (ctx && ((s == 0 && c == nch - 1) || (s == 1 && c == 0))) {
        const float a = ATOT[tt * 256 + s * 128 + h * 32 + d];
        const float* u = U + (((size_t)tt * 2 + s) * 4 + h) * 2048 + d * 64 + v0;
        const float4 u0 = *(const float4*)u, u1 = *(const float4*)(u + 4);
        float* dst = p.out + O_ST + ((((size_t)b * 4 + l) * 2 + s) * 4 + h) * 2048 + d * 64 + v0;
        *(float4*)dst = make_float4(a * S8[0] + u0.x, a * S8[1] + u0.y, a * S8[2] + u0.z, a * S8[3] + u0.w);
        *(float4*)(dst + 4) = make_float4(a * S8[4] + u1.x, a * S8[5] + u1.y, a * S8[6] + u1.z, a * S8[7] + u1.w);
      }
    }
    __syncthreads();
    {
      float a4[4][4];
#pragma unroll
      for (int a = 0; a < 4; ++a)
#pragma unroll
        for (int e = 0; e < 4; ++e) a4[a][e] = 0.f;
#pragma unroll 2
      for (int d4 = 0; d4 < 8; ++d4) {
        float4 q4[4], k4[4];
#pragma unroll
        for (int a = 0; a < 4; ++a) { q4[a] = *(const float4*)(qd + (i0 + a) * 36 + 4 * d4); k4[a] = *(const float4*)(kd + (x0 + a) * 36 + 4 * d4); }
#pragma unroll
        for (int a = 0; a < 4; ++a)
#pragma unroll
          for (int e = 0; e < 4; ++e) a4[a][e] += q4[a].x * k4[e].x + q4[a].y * k4[e].y + q4[a].z * k4[e].z + q4[a].w * k4[e].w;
      }
#pragma unroll
      for (int a = 0; a < 4; ++a) {
        float r4[4];
#pragma unroll
        for (int e = 0; e < 4; ++e) { const int i = i0 + a, j = x0 + e; const bool keep = (s == 0) ? (j <= i) : (j >= i); r4[e] = keep ? a4[a][e] : 0.f; }
        *(float4*)(sc + (i0 + a) * 68 + x0) = make_float4(r4[0], r4[1], r4[2], r4[3]);
      }
    }
    __syncthreads();
    {
#pragma unroll 2
      for (int j = 0; j < 64; j += 4) {
        float4 s4[4], v4[4];
#pragma unroll
        for (int a = 0; a < 4; ++a) { s4[a] = *(const float4*)(sc + (i0 + a) * 68 + j); v4[a] = *(const float4*)(vv + (j + a) * 64 + x0); }
#pragma unroll
        for (int a = 0; a < 4; ++a) {
          o[a][0] += s4[a].x * v4[0].x + s4[a].y * v4[1].x + s4[a].z * v4[2].x + s4[a].w * v4[3].x;
          o[a][1] += s4[a].x * v4[0].y + s4[a].y * v4[1].y + s4[a].z * v4[2].y + s4[a].w * v4[3].y;
          o[a][2] += s4[a].x * v4[0].z + s4[a].y * v4[1].z + s4[a].z * v4[2].z + s4[a].w * v4[3].z;
          o[a][3] += s4[a].x * v4[0].w + s4[a].y * v4[1].w + s4[a].z * v4[2].w + s4[a].w * v4[3].w;
        }
      }
#pragma unroll 2
      for (int d = 0; d < 32; d += 4) {
        float4 q4[4], v4[4];
#pragma unroll
        for (int a = 0; a < 4; ++a) { q4[a] = *(const float4*)(qd + (i0 + a) * 36 + d); v4[a] = *(const float4*)(S + (d + a) * 64 + x0); }
#pragma unroll
        for (int a = 0; a < 4; ++a) {
          o[a][0] += q4[a].x * v4[0].x + q4[a].y * v4[1].x + q4[a].z * v4[2].x + q4[a].w * v4[3].x;
          o[a][1] += q4[a].x * v4[0].y + q4[a].y * v4[1].y + q4[a].z * v4[2].y + q4[a].w * v4[3].y;
          o[a][2] += q4[a].x * v4[0].z + q4[a].y * v4[1].z + q4[a].z * v4[2].z + q4[a].w * v4[3].z;
          o[a][3] += q4[a].x * v4[0].w + q4[a].y * v4[1].w + q4[a].z * v4[2].w + q4[a].w * v4[3].w;
        }
      }
    }
    __syncthreads();
  }
  const float4 gg = *(const float4*)(p.in[20] + l * 64 + x0);
#pragma unroll
  for (int a = 0; a < 4; ++a) {
    float ss = o[a][0] * o[a][0] + o[a][1] * o[a][1] + o[a][2] * o[a][2] + o[a][3] * o[a][3];
    ss += __shfl_xor(ss, 1); ss += __shfl_xor(ss, 2); ss += __shfl_xor(ss, 4); ss += __shfl_xor(ss, 8);
    const float rstd = rsqrtf(ss * (1.f / 64.f) + EPSN);
    const size_t row = row0 + i0 + a;
    float br[4]; unpack4(*(const uint2*)(PR + row * PW + OFF_BR + h * 64 + x0), br);
    uint2 w;
    w.x = pack2(o[a][0] * rstd * gg.x * sigm_silu_acc(br[0]), o[a][1] * rstd * gg.y * sigm_silu_acc(br[1]));
    w.y = pack2(o[a][2] * rstd * gg.z * sigm_silu_acc(br[2]), o[a][3] * rstd * gg.w * sigm_silu_acc(br[3]));
    *(uint2*)((bf16_t*)(p.ws + WS_MIX) + row * 1024 + 384 + h * 64 + x0) = w;
  }
}

DI void gla_item_mfma(const Params& p, int l, bool ctx, int b, int h, int c, char* smem) {
  const int tid = otid(), lane = tid & 63, wave = tid >> 6, g = lane >> 4, fr = lane & 15, qq = fr >> 2, pp = lane & 3;
  const int seq0 = ctx ? b * 256 : NCTX + b * 2048;
  const int nch = ctx ? 4 : 32;
  const int row0 = seq0 + c * 64, tt0 = seq0 >> 6, tt = tt0 + c;
  const bf16_t* PR = (const bf16_t*)(p.ws + WS_PROJ);
  const float* GB = (const float*)(p.ws + WS_GB); const float* ATOT = (const float*)(p.ws + WS_ATOT); const float* U = (const float*)(p.ws + WS_U);
  char* qdb = smem;
  char* kdb = smem + 4096;
  char* vvb = smem + 8192;
  char* Sb = smem + 8192 + 10240;
  f32x4 oacc[4];
#pragma unroll
  for (int vt = 0; vt < 4; ++vt) oacc[vt] = (f32x4){0.f, 0.f, 0.f, 0.f};
#pragma unroll 1
  for (int s = 0; s < 2; ++s) {
    {
      const int j = tid >> 2, part = tid & 3, kk = h * 32 + part * 8;
      const size_t prow = (size_t)(row0 + j) * PW;
      const uint4 qraw = *(const uint4*)(PR + prow + OFF_BQ + kk), kraw = *(const uint4*)(PR + prow + OFF_BK + kk);
      const float* gbp = GB + (size_t)(row0 + j) * 256 + s * 128 + kk;
      const float* ttp = ATOT + 192 * 256 + tt * 256 + s * 128 + kk;
      const float4 g0 = *(const float4*)gbp, g1 = *(const float4*)(gbp + 4), t0 = *(const float4*)ttp, t1 = *(const float4*)(ttp + 4);
      if (s == 0) {
        const uint4 v0 = *(const uint4*)(PR + prow + OFF_BV + h * 64 + part * 16), v1 = *(const uint4*)(PR + prow + OFF_BV + h * 64 + part * 16 + 8);
        *(uint4*)(vvb + j * 160 + part * 32) = v0; *(uint4*)(vvb + j * 160 + part * 32 + 16) = v1;
      }
      float qv[8], kv[8]; unpack8(qraw, qv); unpack8(kraw, kv);
      const float cum[8] = {t0.x - g0.x, t0.y - g0.y, t0.z - g0.z, t0.w - g0.w, t1.x - g1.x, t1.y - g1.y, t1.z - g1.z, t1.w - g1.w};
      float qo[8], ko[8];
#pragma unroll
      for (int e = 0; e < 8; ++e) { qo[e] = qv[e] * 0.17677669529663687f * fast_exp2(cum[e] * LOG2E); ko[e] = kv[e] * fast_exp2(-cum[e] * LOG2E); }
      uint4 qw, kw;
      qw.x = pack2(qo[0], qo[1]); qw.y = pack2(qo[2], qo[3]); qw.z = pack2(qo[4], qo[5]); qw.w = pack2(qo[6], qo[7]);
      kw.x = pack2(ko[0], ko[1]); kw.y = pack2(ko[2], ko[3]); kw.z = pack2(ko[4], ko[5]); kw.w = pack2(ko[6], ko[7]);
      *(uint4*)(qdb + j * 64 + part * 16) = qw; *(uint4*)(kdb + j * 64 + part * 16) = kw;
    }
    {
      const int d = tid >> 3, v0 = (tid & 7) * 8;
      float S8[8];
      if (ctx) {
#pragma unroll
        for (int e = 0; e < 8; ++e) S8[e] = 0.f;
      } else {
        const float* s0 = p.in[7] + ((((size_t)b * 4 + l) * 2 + s) * 4 + h) * 2048 + d * 64 + v0;
        const float4 a = *(const float4*)s0, bq = *(const float4*)(s0 + 4);
        S8[0] = a.x; S8[1] = a.y; S8[2] = a.z; S8[3] = a.w; S8[4] = bq.x; S8[5] = bq.y; S8[6] = bq.z; S8[7] = bq.w;
      }
      const int nfold = s == 0 ? c : nch - 1 - c;
      const float* ap = ATOT + s * 128 + h * 32 + d;
      const float* up = U + ((size_t)s * 4 + h) * 2048 + d * 64 + v0;
      const int tstart = s == 0 ? tt0 : tt0 + nch - 1, tstep = s == 0 ? 1 : -1;
      int f = 0;
#pragma unroll 1
      for (; f + 4 <= nfold; f += 4) {
        float a4[4]; float4 ua[4], ub[4];
#pragma unroll
        for (int q = 0; q < 4; ++q) {
          const int t2 = tstart + tstep * (f + q);
          a4[q] = ap[t2 * 256];
          const float* u = up + (size_t)t2 * 2 * 4 * 2048;
          ua[q] = *(const float4*)u; ub[q] = *(const float4*)(u + 4);
        }
#pragma unroll
        for (int q = 0; q < 4; ++q) {
          const float a = a4[q];
          S8[0] = a * S8[0] + ua[q].x; S8[1] = a * S8[1] + ua[q].y; S8[2] = a * S8[2] + ua[q].z; S8[3] = a * S8[3] + ua[q].w;
          S8[4] = a * S8[4] + ub[q].x; S8[5] = a * S8[5] + ub[q].y; S8[6] = a * S8[6] + ub[q].z; S8[7] = a * S8[7] + ub[q].w;
        }
      }
#pragma unroll 1
      for (; f < nfold; ++f) {
        const int t2 = tstart + tstep * f;
        const float a = ap[t2 * 256];
        const float* u = up + (size_t)t2 * 2 * 4 * 2048;
        const float4 u0 = *(const float4*)u, u1 = *(const float4*)(u + 4);
        S8[0] = a * S8[0] + u0.x; S8[1] = a * S8[1] + u0.y; S8[2] = a * S8[2] + u0.z; S8[3] = a * S8[3] + u0.w;
        S8[4] = a * S8[4] + u1.x; S8[5] = a * S8[5] + u1.y; S8[6] = a * S8[6] + u1.z; S8[7] = a * S8[7] + u1.w;
      }
      uint4 sw; sw.x = pack2(S8[0], S8[1]); sw.y = pack2(S8[2], S8[3]); sw.z = pack2(S8[4], S8[5]); sw.w = pack2(S8[6], S8[7]);
      *(uint4*)(Sb + d * 160 + v0 * 2) = sw;
      if (ctx && ((s == 0 && c == nch - 1) || (s == 1 && c == 0))) {
        const float a = ATOT[tt * 256 + s * 128 + h * 32 + d];
        const float* u = U + (((size_t)tt * 2 + s) * 4 + h) * 2048 + d * 64 + v0;
        const float4 u0 = *(const float4*)u, u1 = *(const float4*)(u + 4);
        float* dst = p.out + O_ST + ((((size_t)b * 4 + l) * 2 + s) * 4 + h) * 2048 + d * 64 + v0;
        *(float4*)dst = make_float4(a * S8[0] + u0.x, a * S8[1] + u0.y, a * S8[2] + u0.z, a * S8[3] + u0.w);
        *(float4*)(dst + 4) = make_float4(a * S8[4] + u1.x, a * S8[5] + u1.y, a * S8[6] + u1.z, a * S8[7] + u1.w);
      }
    }
    __syncthreads();
    {
      const int iq = 16 * wave + fr;
      const bf16x8 qf = *(const bf16x8*)(qdb + iq * 64 + g * 16);
      bf16x8 pf[2];
#pragma unroll
      for (int ks = 0; ks < 2; ++ks) {
        u32x4 pu;
#pragma unroll
        for (int hh = 0; hh < 2; ++hh) {
          const int t = 2 * ks + hh;
          const bf16x8 kf = *(const bf16x8*)(kdb + (16 * t + fr) * 64 + g * 16);
          f32x4 sc = __builtin_amdgcn_mfma_f32_16x16x32_bf16(kf, qf, (f32x4){0.f, 0.f, 0.f, 0.f}, 0, 0, 0);
#pragma unroll
          for (int r = 0; r < 4; ++r) { const int j = 16 * t + 4 * g + r; const bool keep = (s == 0) ? (j <= iq) : (j >= iq); sc[r] = keep ? sc[r] : 0.f; }
          pu[2 * hh] = pack2(sc[0], sc[1]); pu[2 * hh + 1] = pack2(sc[2], sc[3]);
        }
        pf[ks] = __builtin_bit_cast(bf16x8, pu);
      }
#pragma unroll
      for (int ks = 0; ks < 2; ++ks) {
        const char* vrow = vvb + (32 * ks + 4 * g + qq) * 160 + pp * 8;
#pragma unroll
        for (int vt = 0; vt < 4; ++vt) {
          const s16x4 v0 = __builtin_amdgcn_ds_read_tr16_b64_v4i16((LDSP s16x4*)(vrow + vt * 32));
          const s16x4 v1 = __builtin_amdgcn_ds_read_tr16_b64_v4i16((LDSP s16x4*)(vrow + 16 * 160 + vt * 32));
          const bf16x8 vf = __builtin_shufflevector(v0, v1, 0, 1, 2, 3, 4, 5, 6, 7);
          oacc[vt] = __builtin_amdgcn_mfma_f32_16x16x32_bf16(vf, pf[ks], oacc[vt], 0, 0, 0);
        }
      }
      {
        const s16x4 qa = *(const s16x4*)(qdb + iq * 64 + (4 * g) * 2), qb = *(const s16x4*)(qdb + iq * 64 + (16 + 4 * g) * 2);
        const bf16x8 qp = __builtin_shufflevector(qa, qb, 0, 1, 2, 3, 4, 5, 6, 7);
        const char* srow = Sb + (4 * g + qq) * 160 + pp * 8;
#pragma unroll
        for (int vt = 0; vt < 4; ++vt) {
          const s16x4 s0 = __builtin_amdgcn_ds_read_tr16_b64_v4i16((LDSP s16x4*)(srow + vt * 32));
          const s16x4 s1 = __builtin_amdgcn_ds_read_tr16_b64_v4i16((LDSP s16x4*)(srow + 16 * 160 + vt * 32));
          const bf16x8 sf = __builtin_shufflevector(s0, s1, 0, 1, 2, 3, 4, 5, 6, 7);
          oacc[vt] = __builtin_amdgcn_mfma_f32_16x16x32_bf16(sf, qp, oacc[vt], 0, 0, 0);
        }
      }
    }
    __syncthreads();
  }
  float ss = 0.f;
#pragma unroll
  for (int vt = 0; vt < 4; ++vt)
#pragma unroll
    for (int r = 0; r < 4; ++r) ss += oacc[vt][r] * oacc[vt][r];
  ss += __shfl_xor(ss, 16); ss += __shfl_xor(ss, 32);
  const float rstd = rsqrtf(ss * (1.f / 64.f) + EPSN);
  const size_t row = row0 + 16 * wave + fr;
  float4 ggv[4]; uint2 brv[4];
#pragma unroll
  for (int vt = 0; vt < 4; ++vt) { const int v = 16 * vt + 4 * g; ggv[vt] = *(const float4*)(p.in[20] + l * 64 + v); brv[vt] = *(const uint2*)(PR + row * PW + OFF_BR + h * 64 + v); }
#pragma unroll
  for (int vt = 0; vt < 4; ++vt) {
    const int v = 16 * vt + 4 * g;
    const float4 gg = ggv[vt];
    float br[4]; unpack4(brv[vt], br);
    uint2 w;
    w.x = pack2(oacc[vt][0] * rstd * gg.x * sigm_silu_acc(br[0]), oacc[vt][1] * rstd * gg.y * sigm_silu_acc(br[1]));
    w.y = pack2(oacc[vt][2] * rstd * gg.z * sigm_silu_acc(br[2]), oacc[vt][3] * rstd * gg.w * sigm_silu_acc(br[3]));
    *(uint2*)((bf16_t*)(p.ws + WS_MIX) + row * 1024 + 384 + h * 64 + v) = w;
  }
}

DI void mixer_phase(const Params& p, int l, int cidx, char* smem) {
  unsigned* ctr = (unsigned*)(p.ws + WS_MISC + 64) + cidx;
  extern __shared__ __attribute__((aligned(16))) char dsm[];
  LDSP int* sidx = (LDSP int*)(dsm + 131072 + 16);
  constexpr int M_CL = PROBE == 21 ? 2 : 1, M_AL = PROBE == 22 ? 2 : 1, M_GL = PROBE == 23 ? 2 : 1, M_CC = PROBE == 24 ? 2 : 1, M_AC = PROBE == 25 ? 2 : 1, M_GC = PROBE == 26 ? 2 : 1;
  constexpr int N_CL = 256 * M_CL, N_AL = 384 * M_AL, N_GL = 256 * M_GL, N_CC = 512 * M_CC, N_AC = 768 * M_AC, N_GC = 512 * M_GC;
  constexpr int E0 = N_CL, E1 = E0 + N_AL, E2 = E1 + N_GL, E3 = E2 + N_CC, E4 = E3 + N_AC, E5 = E4 + N_GC;
  for (;;) {
    __syncthreads();
    if (threadIdx.x == 0) *sidx = (int)atomicAdd(ctr, 2u);
    __syncthreads();
    const int it = *sidx + ohalf();
    if (it >= E5) break;
    int typ, r; bool ctx;
    if (it < E0) { typ = 0; r = (it) % 256; ctx = false; }
    else if (it < E1) { typ = 1; r = (it - E0) % 384; ctx = false; }
    else if (it < E2) { typ = 2; r = (it - E1) % 256; ctx = false; }
    else if (it < E3) { typ = 0; r = (it - E2) % 512; ctx = true; }
    else if (it < E4) { typ = 1; r = (it - E3) % 768; ctx = true; }
    else { typ = 2; r = (it - E4) % 512; ctx = true; }
    const int sh = ctx ? 2 : 5, nq = 1 << sh;
    const int sub = r & (nq - 1), bh = r >> sh;
    if (typ == 0) attn_c_item(p, l, ctx, bh >> 2, bh & 3, sub, smem);
    else if (typ == 1) attn_a_item(p, l, ctx, bh / 6, bh % 6, sub, smem);
    else gla_item_mfma(p, l, ctx, bh >> 2, bh & 3, sub, smem);
  }
}

constexpr int DYN_LDS = 131072 + 64;
typedef const __attribute__((address_space(4))) Params* ParamsK;
DI ParamsK kparams() { ParamsK q = (ParamsK)__builtin_amdgcn_kernarg_segment_ptr(); asm volatile("" : "+s"(q)); return q; }
__global__ void __launch_bounds__(512, 2) fwd_megakernel(Params p_unused) {
  extern __shared__ __attribute__((aligned(16))) char dsm[];
  cg::grid_group grid = cg::this_grid();
  if (gridDim.y == 2) grid.sync();
  const Params& p = *(const Params*)kparams();
  volatile LDSP unsigned* xbw = (volatile LDSP unsigned*)(dsm + 131072);
  if (threadIdx.x == 0) { xbw[0] = 0u; xbw[1] = 0u; xbw[2] = 0u; xbw[3] = 0u; }
  __syncthreads();
  const XcdBarrier xb = xcd_barrier_post((unsigned*)(p.ws + WS_BAR), xbw);
  char* smem = dsm + ohalf() * 65536;
  phase0(p, (float*)smem);
  xcd_barrier(xb);
#pragma unroll 1
  for (int ph = 0; ph < 44; ++ph) {
    const int l = ph / 11, q = ph - l * 11;
    const Params& p = *(const Params*)kparams();
    const float* mod = (const float*)(p.ws + WS_MOD);
    const bf16_t* H = (const bf16_t*)(p.ws + WS_H);
    const bf16_t* ACT = (const bf16_t*)(p.ws + WS_ACT);
    const bf16_t* MIX = (const bf16_t*)(p.ws + WS_MIX);
    const float* modl = mod + (size_t)l * 3 * 9216;
    int nrep = 1;
#if PROBE
    if (PROBE == 1) nrep = (q == 1 || q == 9 || q == 2 || q == 10 || q == 7 || q == 4) ? 2 : 1;
    if (PROBE == 2) nrep = (q == 6) ? 2 : 1;
    if (PROBE == 3) nrep = (q == 5) ? 2 : 1;
    if (PROBE == 4) nrep = (q == 0 || q == 3 || q == 8) ? 2 : 1;
    if (PROBE == 5) nrep = 2;
#endif
#pragma unroll 1
    for (int rep = 0; rep < nrep; ++rep) {
#if PROBE == 5
    if (rep == 1) { xcd_barrier(xb); xcd_barrier(xb); xcd_barrier(xb); continue; }
#endif
    if (q == 3 || q == 8 || (q == 0 && l > 0)) continue;
    const float* RS = (const float*)(p.ws + WS_ROWSS);
    const float* BIAS = (const float*)(p.ws + WS_BIAS);
    if (q == 0) {
      norm0_bias_phase(p);
    } else if (q == 1 || q == 9) {
      const int f = q == 1 ? 0 : 1;
      { EpiSwiglu E; E.ACT = (bf16_t*)(p.ws + WS_ACT); E.RS = RS; E.bias = BIAS + (size_t)(l * 3 + (f ? 2 : 0)) * 3 * 5632;
        gemm8_run(H, (const bf16_t*)(p.ws + WS_WGU) + (size_t)(l * 2 + f) * 5632 * 1024, 5632, 1024, E, dsm); }
      if (l < 3 && rep == 0 && blockIdx.x >= 32) convert_slice(p, l + 1, f * 1344, f * 1344 + 1344, 32, (float*)smem);
    } else if (q == 2 || q == 10 || q == 7) {
      const bf16_t* A; const bf16_t* Bt; int lda, K; const float* gb; float coef; int nl, nsub;
      if (q == 7) { A = MIX; lda = 1024; K = 1024; Bt = (const bf16_t*)(p.ws + WS_WOUT) + (size_t)l * 1024 * 1024; gb = modl + 5 * 1024; coef = 1.0f; nl = l; nsub = 2; }
      else { const int f = q == 2 ? 0 : 1; A = ACT; lda = DFF; K = DFF; Bt = (const bf16_t*)(p.ws + WS_WD) + (size_t)(l * 2 + f) * 1024 * 2816; gb = modl + (f == 0 ? 2 : 8) * 1024; coef = 0.5f;
             nl = f == 0 ? l : l + 1; nsub = f == 0 ? 1 : 0; }
      (void)lda;
      if (l < 3 && rep == 0 && q == 10 && blockIdx.x >= 192) bias_from_f32(p, l + 1, dsm);
      { EpiResid E; E.X = p.out; E.gate_base = gb; E.coef = rep ? 0.f : coef; E.H = (bf16_t*)(p.ws + WS_H); E.RS = (float*)(p.ws + WS_ROWSS);
        E.nxt_g = nl < 4 ? p.in[11] + (nl * 3 + nsub) * 1024 : nullptr; E.nxt_scale = mod + (size_t)(nl < 4 ? nl : 0) * 3 * 9216 + (3 * nsub + 1) * 1024;
        gemm8_run(A, Bt, 1024, K, E, dsm); }
    } else if (q == 4) {
      { EpiProj E; E.PR = (bf16_t*)(p.ws + WS_PROJ); E.RS = RS; E.bias = BIAS + (size_t)(l * 3 + 1) * 3 * 5632;
        gemm8_run(H, (const bf16_t*)(p.ws + WS_WIN) + (size_t)l * PWR * 1024, PWP, 1024, E, dsm); }
    } else if (q == 5) {
      prep_phase(p, l, smem);
    } else {
      mixer_phase(p, l, l + 4 * rep, smem);
    }
    xcd_barrier(xb);
    }
  }
}

extern "C" void kernel_launch(void* const* d_in, const int* in_sizes, int n_in,
                              void* d_out, int out_size, void* d_ws, size_t ws_size,
                              hipStream_t stream) {
  static int grid_blocks = 0;
  if (!grid_blocks) {
    int dev = 0, cus = 0, per_cu = 0;
    (void)hipGetDevice(&dev);
    (void)hipDeviceGetAttribute(&cus, hipDeviceAttributeMultiprocessorCount, dev);
    (void)hipFuncSetAttribute((const void*)fwd_megakernel, hipFuncAttributeMaxDynamicSharedMemorySize, DYN_LDS);
    (void)hipOccupancyMaxActiveBlocksPerMultiprocessor(&per_cu, fwd_megakernel, 512, DYN_LDS);
    if (per_cu < 1) per_cu = 1;
    grid_blocks = cus;
    grid_blocks -= grid_blocks % 8;
  }
  Params p{};
  for (int i = 0; i < 26; ++i) p.in[i] = (const float*)d_in[i];
  p.out = (float*)d_out;
  p.ws = (char*)d_ws;
  for (int i = 0; i < 16; ++i) p.freqA[i] = powf(10000.0f, -(float)i / 16.0f);
  for (int i = 0; i < 12; ++i) p.freqC[i] = powf(10000.0f, -(float)i / 12.0f);
  for (int l = 0; l < 4; ++l) p.lam_init[l] = (float)(0.8 - 0.6 * exp(-0.3 * l));
  (void)hipMemsetAsync((char*)d_ws + WS_BAR, 0, XCD_BAR_WORDS_C * 4, stream);
  void* args[] = {&p};
  hipError_t e = hipLaunchCooperativeKernel((void*)fwd_megakernel, dim3(grid_blocks), dim3(512), args, DYN_LDS, stream);
  if (e != hipSuccess) fprintf(stderr, "cooperative launch failed: %s (grid %d)\n", hipGetErrorString(e), grid_blocks);
}
```

```cpp
#include <hip/hip_runtime.h>
#include <hip/hip_cooperative_groups.h>
#include <cstdio>
#include <cmath>
namespace cg = cooperative_groups;
#ifndef PROBE
#define PROBE 0
#endif

typedef unsigned short bf16_t;
typedef short bf16x8 __attribute__((ext_vector_type(8)));
typedef short s16x4 __attribute__((ext_vector_type(4)));
typedef float f32x4 __attribute__((ext_vector_type(4)));
#define LDSP __attribute__((address_space(3)))
#define DI __device__ __forceinline__

constexpr int DM = 1024, DFF = 2816, NTOK = 12288, NCTX = 8192, PW = 2560, PWP = 2560, PWR = 2592;
constexpr int OFF_AQ = 0, OFF_AK = 384, OFF_AV = 512, OFF_BQ = 640, OFF_BK = 768, OFF_BV = 896,
              OFF_BR = 1152, OFF_CQ = 1408, OFF_CK = 1792, OFF_CV = 2176, OFF_BGW = 2560;
constexpr float EPSN = 1e-6f;
constexpr float LOG2E = 1.4426950408889634f;
constexpr size_t O_YP = 0, O_YS = 8388608, O_AK = 12582912, O_AV = 16777216, O_CK = 20971520, O_CV = 33554432, O_ST = 46137344;

constexpr size_t XCD_BAR_WORDS_C = 3456;
constexpr size_t al256(size_t x) { return (x + 255) & ~(size_t)255; }
constexpr size_t WS_MOD = 0;
constexpr size_t WS_MISC = al256(WS_MOD + 4ull * 3 * 9216 * 4);
constexpr size_t WS_ROPE = WS_MISC + 256;
constexpr size_t WS_WGU = al256(WS_ROPE + (1024 * 2 + 768 * 2) * 4);
constexpr size_t WS_WD = WS_WGU + 8ull * 5632 * 1024 * 2;
constexpr size_t WS_WIN = WS_WD + 8ull * 1024 * 2816 * 2;
constexpr size_t WS_WOUT = WS_WIN + 4ull * PWR * 1024 * 2;
constexpr size_t WS_H = WS_WOUT + 4ull * 1024 * 1024 * 2;
constexpr size_t WS_MIX = WS_H + (size_t)NTOK * 1024 * 2;
constexpr size_t WS_ACT = WS_MIX + (size_t)NTOK * 1024 * 2;
constexpr size_t WS_PROJ = WS_ACT + (size_t)NTOK * DFF * 2;
constexpr size_t WS_QA = WS_PROJ + (size_t)NTOK * PW * 2;
constexpr size_t WS_KA = WS_QA + (size_t)NTOK * 384 * 2;
constexpr size_t WS_QC = WS_KA + (size_t)NTOK * 128 * 2;
constexpr size_t WS_KC = WS_QC + (size_t)NTOK * 512 * 2;
constexpr size_t WS_GB = WS_KC + (size_t)NTOK * 512 * 2;
constexpr size_t WS_ATOT = WS_GB + (size_t)NTOK * 256 * 4;
constexpr size_t WS_U = WS_ATOT + 2 * 192ull * 256 * 4;
constexpr size_t WS_KAC = WS_U + 192ull * 2 * 4 * 2048 * 4;
constexpr size_t WS_VAC = WS_KAC + 2ull * 4 * 512 * 128 * 2;
constexpr size_t WS_KCC = WS_VAC + 2ull * 4 * 512 * 128 * 2;
constexpr size_t WS_VCC = WS_KCC + 2ull * 4 * 512 * 512 * 2;
constexpr size_t WS_BAR = WS_VCC + 2ull * 4 * 512 * 384 * 2;
constexpr size_t WS_ROWSS = al256(WS_BAR + XCD_BAR_WORDS_C * 4);
constexpr size_t WS_BIAS = WS_ROWSS + (size_t)NTOK * 16 * 4;
constexpr size_t WS_END = WS_BIAS + 4ull * 3 * 3 * 5632 * 4;

struct Params {
  const float* in[26];
  float* out;
  char* ws;
  float freqA[16];
  float freqC[12];
  float lam_init[4];
};

DI float bf2f(bf16_t v) { return __uint_as_float(((unsigned)v) << 16); }
DI bf16_t f2bf(float f) { unsigned u = __float_as_uint(f); u += 0x7fffu + ((u >> 16) & 1u); return (bf16_t)(u >> 16); }
typedef float f32x2_t __attribute__((ext_vector_type(2)));
typedef __bf16 bf16x2_t __attribute__((ext_vector_type(2)));
DI unsigned pack2(float lo, float hi) { const f32x2_t v = {lo, hi}; return __builtin_bit_cast(unsigned, __builtin_convertvector(v, bf16x2_t)); }
DI float fast_exp2(float x) { return __builtin_amdgcn_exp2f(x); }
DI float fast_rcp(float x) { return __builtin_amdgcn_rcpf(x); }
DI float silu_f(float g) { return g * fast_rcp(1.f + fast_exp2(-g * LOG2E)); }
DI float sigm_silu_acc(float g) { return g / (1.f + expf(-g)); }
DI void unpack8(uint4 v, float* x) {
  x[0] = __uint_as_float(v.x << 16); x[1] = __uint_as_float(v.x & 0xffff0000u);
  x[2] = __uint_as_float(v.y << 16); x[3] = __uint_as_float(v.y & 0xffff0000u);
  x[4] = __uint_as_float(v.z << 16); x[5] = __uint_as_float(v.z & 0xffff0000u);
  x[6] = __uint_as_float(v.w << 16); x[7] = __uint_as_float(v.w & 0xffff0000u);
}
DI void unpack4(uint2 v, float* x) {
  x[0] = __uint_as_float(v.x << 16); x[1] = __uint_as_float(v.x & 0xffff0000u);
  x[2] = __uint_as_float(v.y << 16); x[3] = __uint_as_float(v.y & 0xffff0000u);
}
DI int otid() { int t = threadIdx.x & 255; asm volatile("" : "+v"(t)); return t; }
DI int ohalf() { return __builtin_amdgcn_readfirstlane((int)(threadIdx.x >> 8)); }
DI int obid() { int b = blockIdx.x * 2 + ohalf(); asm volatile("" : "+s"(b)); return b; }
DI int vnb() { return gridDim.x * 2; }
DI int rtid() { int t = threadIdx.x; asm volatile("" : "+v"(t)); return t; }
DI int cond_of_row(int row) { return row < NCTX ? 0 : 1 + ((row - NCTX) >> 11); }


#define XB_TMO      128
#define XB_XCNT(j)  (256  + 64 * (j))
#define XB_XSUB(j)  (1280 + 64 * (j))
#define XB_XGEN(j)  (2304 + 64 * (j))
#define XB_TOP      3328
#define XB_TOPGEN   3392
#define XCD_BAR_WORDS 3456
#define XB_SPIN_CAP (1u << 22)
DI unsigned xb_ld(unsigned* p) { return __hip_atomic_load(p, __ATOMIC_RELAXED, __HIP_MEMORY_SCOPE_AGENT); }
DI unsigned xb_add(unsigned* p, unsigned v) { return __hip_atomic_fetch_add(p, v, __ATOMIC_RELAXED, __HIP_MEMORY_SCOPE_AGENT); }
DI unsigned xb_xcc_id() { return (unsigned)__builtin_amdgcn_s_getreg((3 << 11) | 20) & 0xFu; }
#define XB_SPIN(cond, bar) do { unsigned _sp = 0; while (cond) { __builtin_amdgcn_s_sleep(1); \
    if ((++_sp & 255u) == 0u) { if (xb_ld(&(bar)[XB_TMO])) break; if (_sp > XB_SPIN_CAP) { atomicAdd(&(bar)[XB_TMO], 1u); break; } } } } while (0)
struct XcdBarrier { unsigned* bar; unsigned x; volatile LDSP unsigned* st; };
DI XcdBarrier xcd_barrier_post(unsigned* bar, volatile LDSP unsigned* st) {
  XcdBarrier b; b.bar = bar; b.x = xb_xcc_id(); b.st = st;
  if (threadIdx.x == 0) (void)xb_add(&bar[XB_XCNT(b.x)], 1u);
  return b;
}
DI void xcd_barrier_complete(unsigned* bar, unsigned x, unsigned& nloc, unsigned& nx) {
  const unsigned G = gridDim.x * gridDim.y * gridDim.z;
  unsigned sum, cnt, mine, sp = 0u;
  for (;;) {
    sum = 0u; cnt = 0u; mine = 0u;
#pragma unroll
    for (unsigned j = 0; j < 16; ++j) { const unsigned c = xb_ld(&bar[XB_XCNT(j)]); sum += c; cnt += (c > 0u) ? 1u : 0u; mine = (j == x) ? c : mine; }
    if (sum == G) break;
    __builtin_amdgcn_s_sleep(1);
    if ((++sp & 255u) == 0u) { if (xb_ld(&bar[XB_TMO])) break; if (sp > XB_SPIN_CAP) { atomicAdd(&bar[XB_TMO], 1u); break; } }
  }
  nloc = mine > 0u ? mine : 1u; nx = cnt > 0u ? cnt : 1u;
}
DI void xcd_barrier(const XcdBarrier& b_) {
  asm volatile("s_waitcnt vmcnt(0)" ::: "memory");
  __syncthreads();
  if (threadIdx.x == 0) {
    XcdBarrier b; b.st = b_.st;
    { unsigned* q = b_.bar; asm volatile("" : "+s"(q)); b.bar = q; }
    { unsigned xx = xb_xcc_id(); asm volatile("" : "+s"(xx)); b.x = xx; }
    unsigned* bar = b.bar;
    __builtin_amdgcn_s_waitcnt(0);
    unsigned nloc = b.st[0], nx = b.st[1];
    if (nloc == 0u) { xcd_barrier_complete(bar, b.x, nloc, nx); b.st[0] = nloc; b.st[1] = nx; }
    const unsigned old = xb_add(&bar[XB_XSUB(b.x)], 1u);
    const unsigned gen = old / nloc;
    if (old + 1u == (gen + 1u) * nloc) {
      __builtin_amdgcn_fence(__ATOMIC_RELEASE, "agent");
      asm volatile("s_waitcnt vmcnt(0)" ::: "memory");
      const unsigned og = xb_add(&bar[XB_TOP], 1u);
      const unsigned tg = og / nx;
      if (og + 1u == (tg + 1u) * nx) xb_add(&bar[XB_TOPGEN], 1u);
      else XB_SPIN(xb_ld(&bar[XB_TOPGEN]) == tg, bar);
      __builtin_amdgcn_fence(__ATOMIC_ACQUIRE, "agent");
      xb_add(&bar[XB_XGEN(b.x)], 1u);
      asm volatile("s_waitcnt vmcnt(0)" ::: "memory");
    } else {
      XB_SPIN(xb_ld(&bar[XB_XGEN(b.x)]) == gen, bar);
      __builtin_amdgcn_fence(__ATOMIC_ACQUIRE, "agent");
      asm volatile("s_waitcnt vmcnt(0)" ::: "memory");
    }
  }
  __syncthreads();
}

DI void transpose_tile(const float* __restrict__ src, int K, int N, bf16_t* __restrict__ dst, int mode, int kt, int nt, float* sm) {
  const int t = otid();
  const int k0 = kt * 64, n0 = nt * 64;
#pragma unroll
  for (int i = 0; i < 4; ++i) {
    const int idx = t + 256 * i, r = idx >> 4, c4 = idx & 15;
    float4 v = make_float4(0.f, 0.f, 0.f, 0.f);
    if (n0 + 4 * c4 < N) v = *(const float4*)(src + (size_t)(k0 + r) * N + n0 + 4 * c4);
    float* d = sm + r * 65 + 4 * c4;
    d[0] = v.x; d[1] = v.y; d[2] = v.z; d[3] = v.w;
  }
  __syncthreads();
#pragma unroll
  for (int i = 0; i < 2; ++i) {
    const int idx = t + 256 * i, nl = idx >> 3, kc = idx & 7;
    const int n = n0 + nl;
    if (n < N) {
      float x[8];
#pragma unroll
      for (int e = 0; e < 8; ++e) x[e] = sm[(8 * kc + e) * 65 + nl];
      uint4 w; w.x = pack2(x[0], x[1]); w.y = pack2(x[2], x[3]); w.z = pack2(x[4], x[5]); w.w = pack2(x[6], x[7]);
      int drow = n;
      if (mode == 1) drow = (n >> 4) * 32 + (n & 15);
      else if (mode == 2) drow = (n >> 4) * 32 + 16 + (n & 15);
      *(uint4*)(dst + (size_t)drow * K + k0 + 8 * kc) = w;
    }
  }
  __syncthreads();
}

DI void adaln_item(const Params& p, int it, float* sm) {
  const int t = otid();
  const int l = it / 72, chunk = it % 72, j0 = chunk * 128;
  float* scond = sm;
  float* red = sm + 3072;
  for (int i = t; i < 3072; i += 256) {
    const int c = i >> 10, k = i & 1023;
    const float v = (c == 0) ? p.in[8][k] : p.in[2][(c - 1) * 1024 + k];
    scond[i] = sigm_silu_acc(v);
  }
  __syncthreads();
  const int cgp = t & 31, kg = t >> 5;
  const float* w = p.in[9] + (size_t)l * 1024 * 9216 + j0 + 4 * cgp;
  float acc[3][4];
#pragma unroll
  for (int c = 0; c < 3; ++c)
#pragma unroll
    for (int e = 0; e < 4; ++e) acc[c][e] = 0.f;
#pragma unroll 8
  for (int kk = 0; kk < 128; ++kk) {
    const int k = kg * 128 + kk;
    const float4 wv = *(const float4*)(w + (size_t)k * 9216);
#pragma unroll
    for (int c = 0; c < 3; ++c) {
      const float s = scond[c * 1024 + k];
      acc[c][0] += s * wv.x; acc[c][1] += s * wv.y; acc[c][2] += s * wv.z; acc[c][3] += s * wv.w;
    }
  }
#pragma unroll
  for (int c = 0; c < 3; ++c)
#pragma unroll
    for (int e = 0; e < 4; ++e) red[(kg * 3 + c) * 128 + 4 * cgp + e] = acc[c][e];
  __syncthreads();
  float* mod = (float*)(p.ws + WS_MOD);
  for (int o = t; o < 384; o += 256) {
    const int c = o >> 7, j = o & 127;
    float s = p.in[10][l * 9216 + j0 + j];
#pragma unroll
    for (int g = 0; g < 8; ++g) s += red[(g * 3 + c) * 128 + j];
    mod[(l * 3 + c) * 9216 + j0 + j] = s;
  }
  __syncthreads();
}

DI void sincos_tab(float pos, float freq, float& cs, float& sn) {
  const double a = (double)pos * (double)freq;
  const double twopi = 6.283185307179586476925286766559;
  const double k = rint(a / twopi);
  const double r = (a - k * twopi) * 0.25;
  const double r2 = r * r;
  double s = r * (1.0 + r2 * (-1.0 / 6 + r2 * (1.0 / 120 + r2 * (-1.0 / 5040 + r2 * (1.0 / 362880 + r2 * (-1.0 / 39916800 + r2 * (1.0 / 6227020800.0)))))));
  double c = 1.0 + r2 * (-0.5 + r2 * (1.0 / 24 + r2 * (-1.0 / 720 + r2 * (1.0 / 40320 + r2 * (-1.0 / 3628800 + r2 * (1.0 / 479001600.0 + r2 * (-1.0 / 87178291200.0)))))));
  double s2 = 2.0 * s * c, c2 = 1.0 - 2.0 * s * s;
  double s4 = 2.0 * s2 * c2, c4 = 1.0 - 2.0 * s2 * s2;
  cs = (float)c4; sn = (float)s4;
}

struct TDesc { const float* src; bf16_t* dst; int K, N, mode, kt, nt; };
DI TDesc tile_desc(const Params& p, int r) {
  TDesc d;
  const int l = r / 5136; r -= l * 5136;
  if (r < 4224) {
    const int f = r / 2112; r -= f * 2112;
    const int which = r / 704; r -= which * 704;
    const int lf = l * 2 + f;
    if (which < 2) { d.src = p.in[which == 0 ? 12 : 13] + (size_t)lf * 1024 * 2816; d.dst = (bf16_t*)(p.ws + WS_WGU) + (size_t)lf * 5632 * 1024; d.K = 1024; d.N = 2816; d.mode = which + 1; d.kt = r / 44; d.nt = r % 44; }
    else { d.src = p.in[14] + (size_t)lf * 2816 * 1024; d.dst = (bf16_t*)(p.ws + WS_WD) + (size_t)lf * 1024 * 2816; d.K = 2816; d.N = 1024; d.mode = 0; d.kt = r / 16; d.nt = r % 16; }
  } else if (r < 4224 + 656) {
    r -= 4224;
    d.src = p.in[15] + (size_t)l * 1024 * PWR; d.dst = (bf16_t*)(p.ws + WS_WIN) + (size_t)l * PWR * 1024; d.K = 1024; d.N = PWR; d.mode = 3; d.kt = r / 41; d.nt = r % 41;
  } else {
    r -= 4224 + 656;
    d.src = p.in[25] + (size_t)l * 1024 * 1024; d.dst = (bf16_t*)(p.ws + WS_WOUT) + (size_t)l * 1024 * 1024; d.K = 1024; d.N = 1024; d.mode = 0; d.kt = r / 16; d.nt = r % 16;
  }
  return d;
}
DI void tile_load(const TDesc& d, int t, f32x4 (&v)[4]) {
  const int k0 = d.kt * 64, n0 = d.nt * 64;
#pragma unroll
  for (int i = 0; i < 4; ++i) {
    const int idx = t + 256 * i, r = idx >> 4, c4 = idx & 15;
    v[i] = (f32x4){0.f, 0.f, 0.f, 0.f};
    if (n0 + 4 * c4 < d.N) v[i] = __builtin_nontemporal_load((const f32x4*)(d.src + (size_t)(k0 + r) * d.N + n0 + 4 * c4));
  }
}
DI void tile_store(const TDesc& d, int t, const f32x4 (&v)[4], float* sm) {
  const int k0 = d.kt * 64, n0 = d.nt * 64;
#pragma unroll
  for (int i = 0; i < 4; ++i) {
    const int idx = t + 256 * i, r = idx >> 4, c4 = idx & 15;
    float* q = sm + r * 65 + 4 * c4;
    q[0] = v[i][0]; q[1] = v[i][1]; q[2] = v[i][2]; q[3] = v[i][3];
  }
  __syncthreads();
#pragma unroll
  for (int i = 0; i < 2; ++i) {
    const int idx = t + 256 * i, nl = idx >> 3, kc = idx & 7;
    const int n = n0 + nl;
    if (n < d.N) {
      float x[8];
#pragma unroll
      for (int e = 0; e < 8; ++e) x[e] = sm[(8 * kc + e) * 65 + nl];
      uint4 w; w.x = pack2(x[0], x[1]); w.y = pack2(x[2], x[3]); w.z = pack2(x[4], x[5]); w.w = pack2(x[6], x[7]);
      int drow = n;
      if (d.mode == 1) drow = (n >> 7) * 256 + (n & 127);
      else if (d.mode == 2) drow = (n >> 7) * 256 + 128 + (n & 127);
      else if (d.mode == 3) drow = n < 1152 ? n : (n < 1184 ? OFF_BGW + (n - 1152) : n - 32);
      *(uint4*)(d.dst + (size_t)drow * d.K + k0 + 8 * kc) = w;
    }
  }
  __syncthreads();
}

DI void convert_slice(const Params& p, int layer, int t_begin, int t_end, int first_blk, float* sm) {
  const int t = otid();
  const int nworkers = (gridDim.x - first_blk) * 2, w = (blockIdx.x - first_blk) * 2 + ohalf();
  int r = t_begin + w;
  f32x4 cur[4], nxt[4];
  TDesc dc = tile_desc(p, layer * 5136 + (r < t_end ? r : t_begin));
  if (r < t_end) tile_load(dc, t, cur);
#pragma unroll 1
  for (; r < t_end; r += nworkers) {
    const int rn = r + nworkers;
    TDesc dn = tile_desc(p, layer * 5136 + (rn < t_end ? rn : t_begin));
    if (rn < t_end) tile_load(dn, t, nxt);
    tile_store(dc, t, cur, sm);
    dc = dn;
#pragma unroll
    for (int i = 0; i < 4; ++i) cur[i] = nxt[i];
  }
}
DI void bias_from_f32(const Params& p, int layer, char* dsm) {
  const int tx = rtid(), lane = tx & 63, kc = tx >> 6;
  float* shl = (float*)dsm;
  float* red = shl + 3072;
  const float* mod = (const float*)(p.ws + WS_MOD);
  float* BIAS = (float*)(p.ws + WS_BIAS);
  const int nidle = gridDim.x - 192, me = blockIdx.x - 192;
#pragma unroll 1
  for (int task = me; task < 55; task += nidle) {
    const int mi = task / 11, ch = task - mi * 11;
    const int sub = mi < 2 ? 0 : (mi == 2 ? 1 : 2);
    const int N = mi == 2 ? PWR : 2816;
    const float* W = mi == 2 ? p.in[15] + (size_t)layer * 1024 * PWR
                             : p.in[(mi == 0 || mi == 3) ? 12 : 13] + (size_t)(layer * 2 + (mi < 2 ? 0 : 1)) * 1024 * 2816;
    __syncthreads();
    for (int i = tx; i < 3072; i += 512) { const int c = i >> 10, k = i & 1023; shl[i] = mod[((size_t)layer * 3 + c) * 9216 + (size_t)(3 * sub) * 1024 + k]; }
    __syncthreads();
    const int n = ch * 256 + lane * 4;
    f32x4 a0 = (f32x4){0.f, 0.f, 0.f, 0.f}, a1 = a0, a2 = a0;
    if (n < N) {
      const float* wp = W + (size_t)(kc * 128) * N + n;
#pragma unroll 8
      for (int i = 0; i < 128; ++i) {
        const f32x4 wv = *(const f32x4*)(wp + (size_t)i * N);
        const int k = kc * 128 + i;
        a0 += wv * shl[k]; a1 += wv * shl[1024 + k]; a2 += wv * shl[2048 + k];
      }
    }
    *(f32x4*)(red + (kc * 3 + 0) * 256 + lane * 4) = a0; *(f32x4*)(red + (kc * 3 + 1) * 256 + lane * 4) = a1; *(f32x4*)(red + (kc * 3 + 2) * 256 + lane * 4) = a2;
    __syncthreads();
    for (int o = tx; o < 768; o += 512) {
      const int c = o >> 8, j = o & 255, nn = ch * 256 + j;
      float s = 0.f;
#pragma unroll
      for (int g = 0; g < 8; ++g) s += red[(g * 3 + c) * 256 + j];
      if (nn < N) {
        int col;
        if (mi == 2) col = nn < 1152 ? nn : (nn < 1184 ? OFF_BGW + (nn - 1152) : nn - 32);
        else col = (nn >> 7) * 256 + (nn & 127) + ((mi == 1 || mi == 4) ? 128 : 0);
        BIAS[((size_t)(layer * 3 + sub) * 3 + c) * 5632 + col] = s;
      }
    }
  }
  __syncthreads();
}

DI void phase0(const Params& p, float* sm) {
  const int nb = vnb(), bid = obid(), t = otid();
#if PROBE == 6
  for (int prep_ = 0; prep_ < 2; ++prep_) {
#endif
  if (bid < 288) adaln_item(p, bid, sm);
  {
    const int n_tiles = 5136 + 3 * 2448;
    auto gid = [](int q) { return q < 5136 ? q : ((q - 5136) / 2448 + 1) * 5136 + 2688 + (q - 5136) % 2448; };
    int r, stride, lim;
    if (nb == 512) { if (bid < 288) { r = bid; stride = 288; lim = 5760; } else { r = 5760 + (bid - 288); stride = 224; lim = n_tiles; } }
    else { r = bid; stride = nb; lim = n_tiles; }
    f32x4 cur[4], nxt[4];
    TDesc dc = tile_desc(p, gid(r < lim ? r : 0));
    if (r < lim) tile_load(dc, t, cur);
#pragma unroll 1
    for (; r < lim; r += stride) {
      const int rn = r + stride;
      TDesc dn = tile_desc(p, gid(rn < lim ? rn : 0));
      if (rn < lim) tile_load(dn, t, nxt);
      tile_store(dc, t, cur, sm);
      dc = dn;
#pragma unroll
      for (int i = 0; i < 4; ++i) cur[i] = nxt[i];
    }
  }
#if PROBE == 6
  }
#endif
  #define gt ((size_t)(blockIdx.x * 512 + rtid()))
  const size_t gs = (size_t)gridDim.x * 512;
  {
    float4* dst = (float4*)p.out;
    const float4* s0 = (const float4*)p.in[0];
    const float4* s1 = (const float4*)p.in[1];
    const size_t n0 = (size_t)NCTX * 256, n1 = (size_t)NTOK * 256;
    for (size_t i = gt; i < n1; i += gs) dst[i] = (i < n0) ? s0[i] : s1[i - n0];
  }
  {
    bf16_t* kac = (bf16_t*)(p.ws + WS_KAC); bf16_t* vac = (bf16_t*)(p.ws + WS_VAC);
    for (size_t i = gt; i < 524288 / 4; i += gs) {
      const float4 a = ((const float4*)p.in[3])[i], b = ((const float4*)p.in[4])[i];
      uint2 wa, wb; wa.x = pack2(a.x, a.y); wa.y = pack2(a.z, a.w); wb.x = pack2(b.x, b.y); wb.y = pack2(b.z, b.w);
      ((uint2*)kac)[i] = wa; ((uint2*)vac)[i] = wb;
    }
    bf16_t* vcc = (bf16_t*)(p.ws + WS_VCC);
    for (size_t i = gt; i < 1572864 / 4; i += gs) {
      const float4 a = ((const float4*)p.in[6])[i];
      uint2 wa; wa.x = pack2(a.x, a.y); wa.y = pack2(a.z, a.w);
      ((uint2*)vcc)[i] = wa;
    }
    bf16_t* kcc = (bf16_t*)(p.ws + WS_KCC);
    for (size_t i = gt; i < 4096ull * 8 * 16; i += gs) {
      const size_t rv = i >> 4; const int g = (int)(i & 15);
      uint2 w = make_uint2(0, 0);
      if (g < 12) { const float4 a = *(const float4*)(p.in[5] + rv * 48 + 4 * g); w.x = pack2(a.x, a.y); w.y = pack2(a.z, a.w); }
      *(uint2*)(kcc + rv * 64 + 4 * g) = w;
    }
  }
  {
    float* rope = (float*)(p.ws + WS_ROPE);
    for (size_t i = gt; i < 1024 + 768; i += gs) {
      if (i < 1024) { const int pos = (int)i >> 4, f = (int)i & 15; float c, s; sincos_tab((float)pos, p.freqA[f], c, s); rope[i] = c; rope[1024 + i] = s; }
      else { const int j = (int)i - 1024; const int pos = j / 12, f = j % 12; float c, s; sincos_tab((float)pos, p.freqC[f], c, s); rope[2048 + j] = c; rope[2048 + 768 + j] = s; }
    }
    if (gt < 4) {
      const float* lc = p.in[23] + gt * 4 * 48;
      float s1 = 0.f, s2 = 0.f;
      for (int d = 0; d < 48; ++d) { s1 += lc[d] * lc[48 + d]; s2 += lc[96 + d] * lc[144 + d]; }
      ((float*)(p.ws + WS_MISC))[gt] = expf(s1) - expf(s2) + p.lam_init[gt];
      ((unsigned*)(p.ws + WS_MISC + 64))[gt] = 0u; ((unsigned*)(p.ws + WS_MISC + 64))[gt + 4] = 0u;
    }
  }
}
#undef gt

DI void norm0_bias_phase(const Params& p) {
  const int tx = rtid(); const int lane = tx & 63;
  const int gw = blockIdx.x * 8 + (tx >> 6), nw = gridDim.x * 8;
  const float* mod = (const float*)(p.ws + WS_MOD);
  {
    const float* g = p.in[11];
    bf16_t* H = (bf16_t*)(p.ws + WS_H);
    float* RS = (float*)(p.ws + WS_ROWSS);
    for (int row = gw; row < NTOK; row += nw) {
      const float* x = p.out + (size_t)row * 1024;
      float4 v[4]; float ss = 0.f;
#pragma unroll
      for (int c = 0; c < 4; ++c) { v[c] = *(const float4*)(x + c * 256 + lane * 4); ss += v[c].x * v[c].x + v[c].y * v[c].y + v[c].z * v[c].z + v[c].w * v[c].w; }
#pragma unroll
      for (int o = 32; o >= 1; o >>= 1) ss += __shfl_xor(ss, o);
      if (lane < 16) RS[(size_t)row * 16 + lane] = lane == 0 ? ss : 0.f;
      const float* mrow = mod + ((size_t)cond_of_row(row)) * 9216;
#pragma unroll
      for (int c = 0; c < 4; ++c) {
        const int j = c * 256 + lane * 4;
        const float4 gg = *(const float4*)(g + j), sc = *(const float4*)(mrow + 1024 + j);
        uint2 w; w.x = pack2(v[c].x * gg.x * (1.f + sc.x), v[c].y * gg.y * (1.f + sc.y)); w.y = pack2(v[c].z * gg.z * (1.f + sc.z), v[c].w * gg.w * (1.f + sc.w));
        *(uint2*)(H + (size_t)row * 1024 + j) = w;
      }
    }
  }
  {
    float* BIAS = (float*)(p.ws + WS_BIAS);
#pragma unroll 1
    for (int grp = 0; grp < 3; ++grp) {
      const int l = grp / 3, sub = grp - l * 3;
      const int ncol = sub == 1 ? PWR : 5632;
      const bf16_t* Wt = sub == 1 ? (const bf16_t*)(p.ws + WS_WIN) + (size_t)l * PWR * 1024 : (const bf16_t*)(p.ws + WS_WGU) + (size_t)(l * 2 + (sub >> 1)) * 5632 * 1024;
      float sh[3][16];
#pragma unroll
      for (int c = 0; c < 3; ++c) {
        const float* sp = mod + ((size_t)l * 3 + c) * 9216 + (size_t)(3 * sub) * 1024 + lane * 16;
#pragma unroll
        for (int q = 0; q < 4; ++q) { const float4 t = *(const float4*)(sp + 4 * q); sh[c][4 * q] = t.x; sh[c][4 * q + 1] = t.y; sh[c][4 * q + 2] = t.z; sh[c][4 * q + 3] = t.w; }
      }
#pragma unroll 2
      for (int n = gw; n < ncol; n += nw) {
        float w[16]; unpack8(*(const uint4*)(Wt + (size_t)n * 1024 + lane * 16), w); unpack8(*(const uint4*)(Wt + (size_t)n * 1024 + lane * 16 + 8), w + 8);
        float d0 = 0.f, d1 = 0.f, d2 = 0.f;
#pragma unroll
        for (int e = 0; e < 16; ++e) { d0 += sh[0][e] * w[e]; d1 += sh[1][e] * w[e]; d2 += sh[2][e] * w[e]; }
#pragma unroll
        for (int o = 32; o >= 1; o >>= 1) { d0 += __shfl_xor(d0, o); d1 += __shfl_xor(d1, o); d2 += __shfl_xor(d2, o); }
        if (lane < 3) BIAS[((size_t)grp * 3 + lane) * 5632 + n] = lane == 0 ? d0 : (lane == 1 ? d1 : d2);
      }
    }
  }
}

enum { EPI_SWIGLU = 0, EPI_RESID = 1, EPI_PROJ = 2 };

template <int EPI>
DI void gemm_phase(const Params& p, const bf16_t* __restrict__ A, int lda, const bf16_t* __restrict__ Bt, int K, int NT,
                   const float* __restrict__ gate_base  , float coef, char* smem) {
  const int tid = otid(), lane = tid & 63, wave = tid >> 6, wm = wave >> 1, wn = wave & 1;
  const int nb = vnb(), xcd = obid() & 7, slot = obid() >> 3, slots = nb >> 3;
  const int per_x = 12 * NT;
  const int nk = K >> 6;
  char* As = smem;
  char* Bs = smem + 32768;
  for (int q = slot; q < per_x; q += slots) {
    const int grp = q / (4 * NT), r = q - grp * 4 * NT, nt = r >> 2, mtl = r & 3, mt = (grp * 4 + mtl) * 8 + xcd;
    const int m0 = mt * 128, n0 = nt * 128;
    f32x4 acc[4][4];
#pragma unroll
    for (int i = 0; i < 4; ++i)
#pragma unroll
      for (int j = 0; j < 4; ++j) acc[i][j] = (f32x4){0.f, 0.f, 0.f, 0.f};
    const bf16_t* Ag = A + (size_t)(m0 + (tid >> 3)) * lda + (tid & 7) * 8;
    const bf16_t* Bg = Bt + (size_t)(n0 + (tid >> 3)) * K + (tid & 7) * 8;
    const int lrow = tid >> 3, lch = tid & 7;
    uint4 ra[4], rb[4];
#pragma unroll
    for (int i = 0; i < 4; ++i) { ra[i] = *(const uint4*)(Ag + (size_t)(32 * i) * lda); rb[i] = *(const uint4*)(Bg + (size_t)(32 * i) * K); }
#pragma unroll
    for (int i = 0; i < 4; ++i) {
      const int row = lrow + 32 * i; const int off = row * 128 + ((lch ^ (row & 7)) << 4);
      *(uint4*)(As + off) = ra[i]; *(uint4*)(Bs + off) = rb[i];
    }
    __syncthreads();
    for (int kt = 0; kt < nk; ++kt) {
      const int cur = kt & 1;
      if (kt + 1 < nk) {
        const int k0 = (kt + 1) * 64;
#pragma unroll
        for (int i = 0; i < 4; ++i) { ra[i] = *(const uint4*)(Ag + (size_t)(32 * i) * lda + k0); rb[i] = *(const uint4*)(Bg + (size_t)(32 * i) * K + k0); }
      }
      const char* as = As + cur * 16384; const char* bs = Bs + cur * 16384;
#pragma unroll
      for (int ks = 0; ks < 2; ++ks) {
        bf16x8 ax[4], bw[4];
        const int ch = ((ks * 4 + (lane >> 4)) ^ (lane & 7)) << 4;
#pragma unroll
        for (int i = 0; i < 4; ++i) {
          ax[i] = *(const bf16x8*)(as + (wm * 64 + i * 16 + (lane & 15)) * 128 + ch);
          bw[i] = *(const bf16x8*)(bs + (wn * 64 + i * 16 + (lane & 15)) * 128 + ch);
        }
#pragma unroll
        for (int mi = 0; mi < 4; ++mi)
#pragma unroll
          for (int ni = 0; ni < 4; ++ni) acc[mi][ni] = __builtin_amdgcn_mfma_f32_16x16x32_bf16(bw[ni], ax[mi], acc[mi][ni], 0, 0, 0);
      }
      if (kt + 1 < nk) {
        const int nxt = cur ^ 1;
#pragma unroll
        for (int i = 0; i < 4; ++i) {
          const int row = lrow + 32 * i; const int off = nxt * 16384 + row * 128 + ((lch ^ (row & 7)) << 4);
          *(uint4*)(As + off) = ra[i]; *(uint4*)(Bs + off) = rb[i];
        }
      }
      __syncthreads();
    }
    const int tok0 = m0 + wm * 64 + (lane & 15);
    const int nc0 = n0 + wn * 64 + (lane >> 4) * 4;
    if (EPI == EPI_SWIGLU) {
      bf16_t* ACT = (bf16_t*)(p.ws + WS_ACT);
#pragma unroll
      for (int mi = 0; mi < 4; ++mi) {
        const size_t rowoff = (size_t)(tok0 + mi * 16) * DFF;
#pragma unroll
        for (int pr = 0; pr < 2; ++pr) {
          const f32x4 g = acc[mi][2 * pr], u = acc[mi][2 * pr + 1];
          const int ffc = ((n0 + wn * 64) >> 1) + pr * 16 + (lane >> 4) * 4;
          uint2 w; w.x = pack2(silu_f(g[0]) * u[0], silu_f(g[1]) * u[1]); w.y = pack2(silu_f(g[2]) * u[2], silu_f(g[3]) * u[3]);
          *(uint2*)(ACT + rowoff + ffc) = w;
        }
      }
    } else if (EPI == EPI_RESID) {
      const float* gv = gate_base + (size_t)cond_of_row(m0) * 9216;
#pragma unroll
      for (int ni = 0; ni < 4; ++ni) {
        const int n = nc0 + ni * 16;
        const float4 gg = *(const float4*)(gv + n);
#pragma unroll
        for (int mi = 0; mi < 4; ++mi) {
          float* xp = p.out + (size_t)(tok0 + mi * 16) * 1024 + n;
          float4 xv = *(const float4*)xp;
          xv.x += coef * gg.x * acc[mi][ni][0]; xv.y += coef * gg.y * acc[mi][ni][1];
          xv.z += coef * gg.z * acc[mi][ni][2]; xv.w += coef * gg.w * acc[mi][ni][3];
          *(float4*)xp = xv;
        }
      }
    } else {
      bf16_t* PR = (bf16_t*)(p.ws + WS_PROJ);
#pragma unroll
      for (int ni = 0; ni < 4; ++ni) {
        const int n = nc0 + ni * 16;
        if (n < PW) {
#pragma unroll
          for (int mi = 0; mi < 4; ++mi) {
            uint2 w; w.x = pack2(acc[mi][ni][0], acc[mi][ni][1]); w.y = pack2(acc[mi][ni][2], acc[mi][ni][3]);
            *(uint2*)(PR + (size_t)(tok0 + mi * 16) * PW + n) = w;
          }
        }
      }
    }
  }
}


namespace pg8 {
#define PG8_LAS __attribute__((address_space(3)))
typedef unsigned short bf16_t;
typedef short bf16x8 __attribute__((ext_vector_type(8)));
typedef float f32x4 __attribute__((ext_vector_type(4)));
typedef unsigned u32x4 __attribute__((ext_vector_type(4)));
constexpr int BM = 256, BK = 64, HALF = 128, HTB = HALF * BK * 2  , STAGE_BYTES = 8 * HTB, NXCD = 8, WGM = 8;

__host__ __device__ __forceinline__ int lds_byte(int r, int c) { const int st = (r >> 4) * 2 + (c >> 5), rr = r & 15, cc = c & 31, ob = rr * 64 + cc * 2; return st * 1024 + (ob ^ (((ob >> 9) & 1) << 5)); }
__host__ __device__ __forceinline__ void stage_rc(int b, int& R, int& C) { const int st = b / 1024, sb = b % 1024, swz = sb ^ (((sb >> 9) & 1) << 5); R = (st >> 1) * 16 + swz / 64; C = (st & 1) * 32 + (swz % 64) / 2; }
__host__ __device__ __forceinline__ int perm32(int rho) { const int n = rho >> 4, i = rho & 15; return 8 * (i >> 2) + 4 * n + (i & 3); }

struct Unit { int pm, pn; };
struct Gemm { const bf16_t* A; const bf16_t* Bt; int M, N, K; };

struct StaticOrder {
    int nM, nN, nwg, G, c;
    __host__ __device__ void init(int M, int N, int G_, int c_) { nM = M / BM; nN = N / BM; nwg = nM * nN; G = G_; c = c_; }
    __host__ __device__ bool next(int i, Unit& u) const {
        const long L = (long)i * G + c; if (L >= nwg) return false;
        int wgid = (int)L; { const int q = nwg / NXCD, r = nwg % NXCD, xcd = wgid % NXCD, off = wgid / NXCD; wgid = (xcd < r ? xcd * (q + 1) : r * (q + 1) + (xcd - r) * q) + off; }
        const int nig = WGM * nN, gid = wgid / nig, fm = gid * WGM, gsz = (nM - fm) < WGM ? (nM - fm) : WGM;
        u.pm = fm + ((wgid % nig) % gsz); u.pn = (wgid % nig) / gsz; return true;
    }
    __device__ __forceinline__ void a_ready(const Unit&) const {}
    __device__ __forceinline__ void done(const Unit&) const {}
};
template <class Epi, class Sched, bool ALIGN_EPI = false, bool SP2 = false>
__device__ __forceinline__ void gemm_phase(PG8_LAS unsigned char* lds, const Gemm g, const Sched& S, const Epi& E) {
    const int tid = rtid(), wid = __builtin_amdgcn_readfirstlane(tid >> 6), lane = tid & 63, wr = wid >> 2, wc = wid & 3, fr = lane & 15, fq = lane >> 4;
    const int K = g.K, nt = K / BK;
    unsigned voffA[2], voffB[2];
#pragma unroll
    for (int i = 0; i < 2; ++i) { int R, C; stage_rc(tid * 16 + i * 8192, R, C); const int Rb = Epi::PERM ? ((R & ~31) + perm32(R & 31)) : R;
        voffA[i] = (unsigned)(R * K + C) * 2u; voffB[i] = (unsigned)(Rb * K + C) * 2u; }
    const size_t kstep = (size_t)(BK * 2);
    const size_t hstep = (size_t)HALF * K * 2;
    const size_t tstep = 2 * hstep;
    const unsigned ldsw = (unsigned)wid * 1024u;
    const int aoff = lds_byte(wr * 64 + fr, fq * 8), boff = lds_byte(wc * 32 + fr, fq * 8);
#define PG8_SA(b, h) (((b) * 2 + (h)) * HTB)
#define PG8_SB(b, h) ((4 + (b) * 2 + (h)) * HTB)
#define PG8_STAGE(bufoff, gbase, voff) do { _Pragma("unroll") for (int _i = 0; _i < 2; ++_i) \
        __builtin_amdgcn_global_load_lds((const unsigned*)((const char*)(gbase) + (voff)[_i]), (PG8_LAS unsigned*)(lds + (bufoff) + ldsw + _i * 8192), 16, 0, 0); } while (0)
#define PG8_LDA(dst, b, h) do { _Pragma("unroll") for (int m = 0; m < 4; ++m) _Pragma("unroll") for (int k = 0; k < 2; ++k) dst[m][k] = *(const PG8_LAS bf16x8*)(lds + PG8_SA(b, h) + aoff + m * 2048 + k * 1024); } while (0)
#define PG8_LDB(dst, b, h) do { _Pragma("unroll") for (int n = 0; n < 2; ++n) _Pragma("unroll") for (int k = 0; k < 2; ++k) dst[n][k] = *(const PG8_LAS bf16x8*)(lds + PG8_SB(b, h) + boff + n * 2048 + k * 1024); } while (0)
#define PG8_MMA(ai, bj, At, Bt) do { __builtin_amdgcn_s_setprio(1); _Pragma("unroll") for (int m = 0; m < 4; ++m) _Pragma("unroll") for (int n = 0; n < 2; ++n) _Pragma("unroll") for (int k = 0; k < 2; ++k) \
        acc[ai][bj][m][n] = __builtin_amdgcn_mfma_f32_16x16x32_bf16(Bt[n][k], At[m][k], acc[ai][bj][m][n], 0, 0, 0); __builtin_amdgcn_s_setprio(0); } while (0)
#define PG8_WAIT_V(n) asm volatile("s_waitcnt vmcnt(" #n ")" ::: "memory")
#define PG8_WAIT_L(n) asm volatile("s_waitcnt lgkmcnt(" #n ")" ::: "memory")
#define PG8_BAR __builtin_amdgcn_s_barrier()
#define PG8_SCHED __builtin_amdgcn_sched_barrier(0)
    Unit cur, nxt; int ui = 0;
    if (!S.next(0, cur)) return;
    f32x4 acc[2][2][4][2];
#pragma unroll
    for (int a = 0; a < 2; ++a)
#pragma unroll
        for (int b = 0; b < 2; ++b)
#pragma unroll
            for (int m = 0; m < 4; ++m)
#pragma unroll
                for (int n = 0; n < 2; ++n) acc[a][b][m][n] = (f32x4){0.f, 0.f, 0.f, 0.f};
    bf16x8 At[4][2], B0[2][2], B1[2][2];
    const char* cA = (const char*)g.A + (size_t)cur.pm * tstep; const char* cB = (const char*)g.Bt + (size_t)cur.pn * tstep;
    S.a_ready(cur);
    if constexpr (SP2) {
        PG8_STAGE(PG8_SB(0, 0), cB, voffB); PG8_STAGE(PG8_SB(0, 1), cB + hstep, voffB); PG8_STAGE(PG8_SA(0, 0), cA, voffA); PG8_STAGE(PG8_SA(0, 1), cA + hstep, voffA);
        if (wr == 1) PG8_BAR;
        PG8_WAIT_V(2); PG8_BAR;
        PG8_STAGE(PG8_SB(1, 0), cB + kstep, voffB); PG8_STAGE(PG8_SA(1, 0), cA + kstep, voffA); PG8_STAGE(PG8_SB(1, 1), cB + hstep + kstep, voffB);
        PG8_WAIT_V(6); PG8_BAR;
    } else {
        PG8_STAGE(PG8_SB(0, 0), cB, voffB); PG8_STAGE(PG8_SA(0, 0), cA, voffA); PG8_STAGE(PG8_SB(0, 1), cB + hstep, voffB); PG8_STAGE(PG8_SA(0, 1), cA + hstep, voffA);
        if (wr == 1) PG8_BAR;
        PG8_WAIT_V(4); PG8_BAR;
        PG8_STAGE(PG8_SB(1, 0), cB + kstep, voffB); PG8_STAGE(PG8_SA(1, 0), cA + kstep, voffA); PG8_STAGE(PG8_SB(1, 1), cB + hstep + kstep, voffB);
        PG8_WAIT_V(6); PG8_BAR;
    }
    for (;;) {
        const bool has_next = S.next(ui + 1, nxt);
        const char* nA = has_next ? (const char*)g.A + (size_t)nxt.pm * tstep : cA; const char* nB = has_next ? (const char*)g.Bt + (size_t)nxt.pn * tstep : cB;
        for (int t = 0; t < nt; t += 2) {
            const bool last = (t == nt - 2);
            const char* a1 = cA + (size_t)(t + 1) * kstep;
            const char* a2 = last ? nA : cA + (size_t)(t + 2) * kstep; const char* b2 = last ? nB : cB + (size_t)(t + 2) * kstep;
            const char* a3 = a2 + kstep; const char* b3 = b2 + kstep;
            if (last && has_next) S.a_ready(nxt);
            if constexpr (SP2) {
            PG8_LDB(B0, 0, 0); PG8_LDB(B1, 0, 1); PG8_SCHED; PG8_LDA(At, 0, 0); PG8_STAGE(PG8_SA(1, 1), a1 + hstep, voffA);
            PG8_WAIT_V(8); PG8_WAIT_L(0); PG8_BAR; PG8_MMA(0, 0, At, B0); PG8_MMA(0, 1, At, B1); PG8_BAR; PG8_SCHED;
            PG8_LDA(At, 0, 1); PG8_STAGE(PG8_SB(0, 0), b2, voffB); PG8_STAGE(PG8_SB(0, 1), b2 + hstep, voffB); PG8_STAGE(PG8_SA(0, 0), a2, voffA);
            PG8_WAIT_V(8); PG8_WAIT_L(0); PG8_BAR; PG8_MMA(1, 0, At, B0); PG8_MMA(1, 1, At, B1); PG8_BAR; PG8_SCHED;
            PG8_LDB(B0, 1, 0); PG8_LDB(B1, 1, 1); PG8_SCHED; PG8_LDA(At, 1, 0); PG8_STAGE(PG8_SA(0, 1), a2 + hstep, voffA);
            PG8_WAIT_V(8); PG8_WAIT_L(0); PG8_BAR; PG8_MMA(0, 0, At, B0); PG8_MMA(0, 1, At, B1); PG8_BAR; PG8_SCHED;
            PG8_LDA(At, 1, 1); PG8_STAGE(PG8_SB(1, 0), b3, voffB); PG8_STAGE(PG8_SB(1, 1), b3 + hstep, voffB); PG8_STAGE(PG8_SA(1, 0), a3, voffA);
            PG8_WAIT_V(8); PG8_WAIT_L(0); PG8_BAR; PG8_MMA(1, 0, At, B0); PG8_MMA(1, 1, At, B1); PG8_BAR; PG8_SCHED;
            } else {
            PG8_LDB(B0, 0, 0); PG8_SCHED; PG8_LDA(At, 0, 0); PG8_STAGE(PG8_SA(1, 1), a1 + hstep, voffA);
            PG8_WAIT_L(8); PG8_BAR; PG8_WAIT_L(0); PG8_MMA(0, 0, At, B0); PG8_BAR; PG8_SCHED;
            PG8_LDB(B1, 0, 1); PG8_STAGE(PG8_SB(0, 0), b2, voffB);
            PG8_BAR; PG8_WAIT_L(0); PG8_MMA(0, 1, At, B1); PG8_BAR;
            PG8_LDA(At, 0, 1); PG8_STAGE(PG8_SA(0, 0), a2, voffA);
            PG8_BAR; PG8_WAIT_L(0); PG8_MMA(1, 0, At, B0); PG8_BAR; PG8_SCHED;
            PG8_STAGE(PG8_SB(0, 1), b2 + hstep, voffB);
            PG8_WAIT_V(6); PG8_BAR; PG8_MMA(1, 1, At, B1); PG8_BAR;
            PG8_LDB(B0, 1, 0); PG8_SCHED; PG8_LDA(At, 1, 0); PG8_STAGE(PG8_SA(0, 1), a2 + hstep, voffA);
            PG8_WAIT_L(8); PG8_BAR; PG8_WAIT_L(0); PG8_MMA(0, 0, At, B0); PG8_BAR; PG8_SCHED;
            PG8_LDB(B1, 1, 1); PG8_STAGE(PG8_SB(1, 0), b3, voffB);
            PG8_BAR; PG8_WAIT_L(0); PG8_MMA(0, 1, At, B1); PG8_BAR;
            PG8_LDA(At, 1, 1); PG8_STAGE(PG8_SA(1, 0), a3, voffA);
            PG8_BAR; PG8_WAIT_L(0); PG8_MMA(1, 0, At, B0); PG8_BAR; PG8_SCHED;
            PG8_STAGE(PG8_SB(1, 1), b3 + hstep, voffB);
            PG8_WAIT_V(6); PG8_BAR; PG8_MMA(1, 1, At, B1); PG8_BAR;
            }
        }
        if constexpr (ALIGN_EPI) { if (wr == 0) PG8_BAR; }
        if constexpr (!Epi::AFTER_DRAIN) { E(acc, cur, wr, wc, fr, fq); S.done(cur); }
        if (!has_next) break;
#pragma unroll
        for (int a = 0; a < 2; ++a)
#pragma unroll
            for (int b = 0; b < 2; ++b)
#pragma unroll
                for (int m = 0; m < 4; ++m)
#pragma unroll
                    for (int n = 0; n < 2; ++n) acc[a][b][m][n] = (f32x4){0.f, 0.f, 0.f, 0.f};
        cur = nxt; cA = nA; cB = nB; ++ui;
        if constexpr (ALIGN_EPI) { if (wr == 1) PG8_BAR; }
    }
    PG8_WAIT_V(0);
    if constexpr (!ALIGN_EPI) { if (wr == 0) PG8_BAR; }
    PG8_BAR;
    if constexpr (Epi::AFTER_DRAIN) { E.fused(acc, cur, wr, wc, fr, fq, lds, wid, lane); S.done(cur); }
#undef PG8_SA
#undef PG8_SB
#undef PG8_STAGE
#undef PG8_LDA
#undef PG8_LDB
#undef PG8_MMA
#undef PG8_WAIT_V
#undef PG8_WAIT_L
#undef PG8_BAR
#undef PG8_SCHED
}
}

DI void wave_rstd(const float* RS, int rowbase  , int lane, float& r0, float& r1) {
  const float* a = RS + (size_t)(rowbase + lane) * 16; const float* b = a + 128 * 16;
  const float4 a0 = *(const float4*)a, a1 = *(const float4*)(a + 4), a2 = *(const float4*)(a + 8), a3 = *(const float4*)(a + 12);
  const float4 b0 = *(const float4*)b, b1 = *(const float4*)(b + 4), b2 = *(const float4*)(b + 8), b3 = *(const float4*)(b + 12);
  const float sa = ((a0.x + a0.y) + (a0.z + a0.w)) + ((a1.x + a1.y) + (a1.z + a1.w)) + ((a2.x + a2.y) + (a2.z + a2.w)) + ((a3.x + a3.y) + (a3.z + a3.w));
  const float sb = ((b0.x + b0.y) + (b0.z + b0.w)) + ((b1.x + b1.y) + (b1.z + b1.w)) + ((b2.x + b2.y) + (b2.z + b2.w)) + ((b3.x + b3.y) + (b3.z + b3.w));
  r0 = rsqrtf(sa * (1.f / 1024.f) + EPSN); r1 = rsqrtf(sb * (1.f / 1024.f) + EPSN);
}
struct EpiSwiglu {
  static constexpr bool PERM = true, AFTER_DRAIN = false;
  bf16_t* ACT; const float* RS; const float* bias  ;
  DI void operator()(const f32x4 (&acc)[2][2][4][2], const pg8::Unit& u, int wr, int wc, int fr, int fq) const {
    const int row0 = u.pm * 256 + wr * 64 + fr, lane = fq * 16 + fr;
    float rs[2]; wave_rstd(RS, u.pm * 256 + wr * 64, lane, rs[0], rs[1]);
    const float* bp = bias + (size_t)cond_of_row(u.pm * 256) * 5632 + u.pn * 256 + wc * 32 + 8 * fq;
    const f32x4 bg0 = *(const f32x4*)(bp), bg1 = *(const f32x4*)(bp + 4), bu0 = *(const f32x4*)(bp + 128), bu1 = *(const f32x4*)(bp + 132);
#pragma unroll
    for (int ai = 0; ai < 2; ++ai)
#pragma unroll
      for (int m = 0; m < 4; ++m) {
        const float r = __shfl(rs[ai], 16 * m + fr);
        const f32x4 g0 = acc[ai][0][m][0] * r + bg0, g1 = acc[ai][0][m][1] * r + bg1, v0 = acc[ai][1][m][0] * r + bu0, v1 = acc[ai][1][m][1] * r + bu1;
        uint4 w;
        w.x = pack2(silu_f(g0[0]) * v0[0], silu_f(g0[1]) * v0[1]); w.y = pack2(silu_f(g0[2]) * v0[2], silu_f(g0[3]) * v0[3]);
        w.z = pack2(silu_f(g1[0]) * v1[0], silu_f(g1[1]) * v1[1]); w.w = pack2(silu_f(g1[2]) * v1[2], silu_f(g1[3]) * v1[3]);
        *(uint4*)(ACT + (size_t)(row0 + ai * 128 + m * 16) * DFF + u.pn * 128 + wc * 32 + 8 * fq) = w;
      }
  }
};
struct EpiResid {
  static constexpr bool PERM = true, AFTER_DRAIN = false;
  float* X; const float* gate_base; float coef;
  bf16_t* H; float* RS; const float* nxt_g  ; const float* nxt_scale  ;
  DI void operator()(const f32x4 (&acc)[2][2][4][2], const pg8::Unit& u, int wr, int wc, int fr, int fq) const {
    const int row0 = u.pm * 256 + wr * 64 + fr, col0 = u.pn * 256 + wc * 32 + 8 * fq;
    const int cond = cond_of_row(u.pm * 256);
    const float* gv = gate_base + (size_t)cond * 9216 + col0;
    const bool has_next = nxt_g != nullptr;
    float ss[2][4];
#pragma unroll
    for (int ai = 0; ai < 2; ++ai)
#pragma unroll
      for (int m = 0; m < 4; ++m) ss[ai][m] = 0.f;
#pragma unroll
    for (int bj = 0; bj < 2; ++bj) {
      const int co = bj * 128;
      const float4 gg0 = *(const float4*)(gv + co), gg1 = *(const float4*)(gv + co + 4);
      float4 hv0 = make_float4(0.f, 0.f, 0.f, 0.f), hv1 = hv0;
      if (has_next) {
        const float* gp = nxt_g + col0 + co; const float* sp = nxt_scale + (size_t)cond * 9216 + col0 + co;
        const float4 g20 = *(const float4*)gp, g21 = *(const float4*)(gp + 4), s20 = *(const float4*)sp, s21 = *(const float4*)(sp + 4);
        hv0 = make_float4(g20.x * (1.f + s20.x), g20.y * (1.f + s20.y), g20.z * (1.f + s20.z), g20.w * (1.f + s20.w));
        hv1 = make_float4(g21.x * (1.f + s21.x), g21.y * (1.f + s21.y), g21.z * (1.f + s21.z), g21.w * (1.f + s21.w));
      }
#pragma unroll
      for (int ai = 0; ai < 2; ++ai)
#pragma unroll
        for (int m = 0; m < 4; ++m) {
          const size_t off = (size_t)(row0 + ai * 128 + m * 16) * 1024 + col0 + co;
          float4 x0 = *(const float4*)(X + off), x1 = *(const float4*)(X + off + 4);
          const f32x4 a0 = acc[ai][bj][m][0], a1 = acc[ai][bj][m][1];
          x0.x += coef * gg0.x * a0[0]; x0.y += coef * gg0.y * a0[1]; x0.z += coef * gg0.z * a0[2]; x0.w += coef * gg0.w * a0[3];
          x1.x += coef * gg1.x * a1[0]; x1.y += coef * gg1.y * a1[1]; x1.z += coef * gg1.z * a1[2]; x1.w += coef * gg1.w * a1[3];
          *(float4*)(X + off) = x0; *(float4*)(X + off + 4) = x1;
          if (has_next) {
            ss[ai][m] += ((x0.x * x0.x + x0.y * x0.y) + (x0.z * x0.z + x0.w * x0.w)) + ((x1.x * x1.x + x1.y * x1.y) + (x1.z * x1.z + x1.w * x1.w));
            uint4 w; w.x = pack2(x0.x * hv0.x, x0.y * hv0.y); w.y = pack2(x0.z * hv0.z, x0.w * hv0.w); w.z = pack2(x1.x * hv1.x, x1.y * hv1.y); w.w = pack2(x1.z * hv1.z, x1.w * hv1.w);
            *(uint4*)(H + off) = w;
          }
        }
    }
    if (has_next) {
#pragma unroll
      for (int ai = 0; ai < 2; ++ai)
#pragma unroll
        for (int m = 0; m < 4; ++m) {
          float s = ss[ai][m];
          s += __shfl_xor(s, 16); s += __shfl_xor(s, 32);
          if (fq == 0) RS[(size_t)(row0 + ai * 128 + m * 16) * 16 + u.pn * 4 + wc] = s;
        }
    }
  }
};
struct EpiProj {
  static constexpr bool PERM = true, AFTER_DRAIN = false;
  bf16_t* PR; const float* RS; const float* bias  ;
  DI void operator()(const f32x4 (&acc)[2][2][4][2], const pg8::Unit& u, int wr, int wc, int fr, int fq) const {
    const int row0 = u.pm * 256 + wr * 64 + fr, col0 = u.pn * 256 + wc * 32 + 8 * fq, lane = fq * 16 + fr;
    float rs[2]; wave_rstd(RS, u.pm * 256 + wr * 64, lane, rs[0], rs[1]);
    float rr[2][4];
#pragma unroll
    for (int ai = 0; ai < 2; ++ai)
#pragma unroll
      for (int m = 0; m < 4; ++m) rr[ai][m] = __shfl(rs[ai], 16 * m + fr);
    const float* bp = bias + (size_t)cond_of_row(u.pm * 256) * 5632;
#pragma unroll
    for (int bj = 0; bj < 2; ++bj) {
      const int col = col0 + bj * 128;
      if (col < PW) {
        const f32x4 b0 = *(const f32x4*)(bp + col), b1 = *(const f32x4*)(bp + col + 4);
#pragma unroll
        for (int ai = 0; ai < 2; ++ai)
#pragma unroll
          for (int m = 0; m < 4; ++m) {
            const f32x4 a0 = acc[ai][bj][m][0] * rr[ai][m] + b0, a1 = acc[ai][bj][m][1] * rr[ai][m] + b1;
            uint4 w; w.x = pack2(a0[0], a0[1]); w.y = pack2(a0[2], a0[3]); w.z = pack2(a1[0], a1[1]); w.w = pack2(a1[2], a1[3]);
            *(uint4*)(PR + (size_t)(row0 + ai * 128 + m * 16) * PW + col) = w;
          }
      }
    }
  }
};
template <class Epi>
DI void gemm8_run(const bf16_t* acts, const bf16_t* wts, int Nw, int K, const Epi& E, char* dsm) {
  pg8::Gemm g; g.A = acts; g.Bt = wts; g.M = NTOK; g.N = Nw; g.K = K;
  pg8::StaticOrder S; S.init(NTOK, Nw, (int)gridDim.x, (int)blockIdx.x);
  pg8::gemm_phase<Epi, pg8::StaticOrder, true, true>((LDSP unsigned char*)dsm, g, S, E);
}

DI void prep_gla_tile(const Params& p, int l, int tt, char* smem) {
  const int tid = otid();
  const bf16_t* PR = (const bf16_t*)(p.ws + WS_PROJ);
  float* GB = (float*)(p.ws + WS_GB); float* ATOT = (float*)(p.ws + WS_ATOT); float* U = (float*)(p.ws + WS_U);
  const int row0 = tt * 64;
  float* bg = (float*)smem;
  bf16_t* ks = (bf16_t*)(smem + 8192);
  bf16_t* vs = (bf16_t*)(smem + 8192 + 16384);
  {
    {
      const int lane = tid & 63, wv = tid >> 6, fr = lane & 15, fq = lane >> 4;
      const bf16_t* hp = (const bf16_t*)(p.ws + WS_H) + (size_t)(row0 + wv * 16 + fr) * 1024 + 8 * fq;
      const bf16_t* wp = (const bf16_t*)(p.ws + WS_WIN) + ((size_t)l * PWR + OFF_BGW + fr) * 1024 + 8 * fq;
      f32x4 c0 = (f32x4){0.f, 0.f, 0.f, 0.f}, c1 = c0;
#pragma unroll 8
      for (int ks = 0; ks < 32; ++ks) {
        const bf16x8 a = *(const bf16x8*)(hp + 32 * ks), b0 = *(const bf16x8*)(wp + 32 * ks), b1 = *(const bf16x8*)(wp + 16 * 1024 + 32 * ks);
        c0 = __builtin_amdgcn_mfma_f32_16x16x32_bf16(a, b0, c0, 0, 0, 0);
        c1 = __builtin_amdgcn_mfma_f32_16x16x32_bf16(a, b1, c1, 0, 0, 0);
      }
      const float* rsp = (const float*)(p.ws + WS_ROWSS) + (size_t)(row0 + wv * 16 + fr) * 16;
      const float4 r0 = *(const float4*)rsp, r1 = *(const float4*)(rsp + 4), r2 = *(const float4*)(rsp + 8), r3 = *(const float4*)(rsp + 12);
      const float rs = rsqrtf((((r0.x + r0.y) + (r0.z + r0.w)) + ((r1.x + r1.y) + (r1.z + r1.w)) + ((r2.x + r2.y) + (r2.z + r2.w)) + ((r3.x + r3.y) + (r3.z + r3.w))) * (1.f / 1024.f) + EPSN);
      const float* bp = (const float*)(p.ws + WS_BIAS) + ((size_t)(l * 3 + 1) * 3 + cond_of_row(row0)) * 5632 + OFF_BGW;
      const float bb0 = bp[fr], bb1 = bp[16 + fr];
#pragma unroll
      for (int r = 0; r < 4; ++r) {
        const float rr = __shfl(rs, 4 * fq + r);
        float* dst = bg + (wv * 16 + 4 * fq + r) * 32;
        dst[fr] = c0[r] * rr + bb0; dst[16 + fr] = c1[r] * rr + bb1;
      }
    }
#pragma unroll
    for (int q = 0; q < 4; ++q) { const int c = tid + 256 * q, row = c >> 4, ch = c & 15; *(uint4*)(ks + row * 128 + 8 * ch) = *(const uint4*)(PR + (size_t)(row0 + row) * PW + OFF_BK + 8 * ch); }
#pragma unroll
    for (int q = 0; q < 8; ++q) { const int c = tid + 256 * q, row = c >> 5, ch = c & 31; *(uint4*)(vs + row * 256 + 8 * ch) = *(const uint4*)(PR + (size_t)(row0 + row) * PW + OFF_BV + 8 * ch); }
  }
  __syncthreads();
  const int s = tid >> 7, k = tid & 127, h = k >> 5, d = k & 31;
  float w[16];
#pragma unroll
  for (int r = 0; r < 16; ++r) w[r] = p.in[18][((size_t)(l * 2 + s) * 16 + r) * 128 + k];
  const float bias = p.in[19][(l * 2 + s) * 128 + k];
  float acc[64];
#pragma unroll
  for (int x = 0; x < 64; ++x) acc[x] = 0.f;
  float run = 0.f;
#pragma unroll 2
  for (int ii = 0; ii < 64; ++ii) {
    const int j = s ? ii : 63 - ii;
    float z = bias;
#pragma unroll
    for (int r = 0; r < 16; ++r) z += bg[j * 32 + s * 16 + r] * w[r];
    const float ls = fminf(z, 0.f) - 0.6931471805599453f * __builtin_amdgcn_logf(1.f + fast_exp2(-fabsf(z) * LOG2E));
    GB[(size_t)(row0 + j) * 256 + s * 128 + k] = run;
    const float kd = bf2f(ks[j * 128 + k]) * fast_exp2(run * LOG2E);
    run += ls * (1.f / 16.f);
    const bf16_t* vr = vs + j * 256 + h * 64;
#pragma unroll
    for (int x8 = 0; x8 < 8; ++x8) {
      float vv[8]; unpack8(*(const uint4*)(vr + 8 * x8), vv);
#pragma unroll
      for (int e = 0; e < 8; ++e) acc[8 * x8 + e] += kd * vv[e];
    }
  }
  ATOT[tt * 256 + tid] = expf(run);
  ATOT[192 * 256 + tt * 256 + tid] = run;
  float* u = U + (((size_t)tt * 2 + s) * 4 + h) * 2048 + d * 64;
#pragma unroll
  for (int x4 = 0; x4 < 16; ++x4) *(float4*)(u + 4 * x4) = make_float4(acc[4 * x4], acc[4 * x4 + 1], acc[4 * x4 + 2], acc[4 * x4 + 3]);
  __syncthreads();
}

struct TokRaw { uint4 a; uint2 c0, c1, c2; uint4 av, cv; };
DI void tok_load(const bf16_t* PR, int r, int lane, bool ctx, TokRaw& t) {
  const bf16_t* pr = PR + (size_t)r * PW;
  t.a = *(const uint4*)(pr + (lane >> 3) * 64 + 8 * (lane & 7));
  const bf16_t* src = pr + OFF_CQ + (lane >> 2) * 48 + 12 * (lane & 3);
  t.c0 = *(const uint2*)(src); t.c1 = *(const uint2*)(src + 4); t.c2 = *(const uint2*)(src + 8);
  t.av = make_uint4(0, 0, 0, 0); t.cv = make_uint4(0, 0, 0, 0);
  if (ctx) { if (lane < 16) t.av = *(const uint4*)(pr + OFF_AV + 8 * lane); if (lane < 48) t.cv = *(const uint4*)(pr + OFF_CV + 8 * lane); }
}
DI void prep_token(const Params& p, int l, int r, int lane, const TokRaw& t) {
  bf16_t* QA = (bf16_t*)(p.ws + WS_QA); bf16_t* KA = (bf16_t*)(p.ws + WS_KA);
  bf16_t* QC = (bf16_t*)(p.ws + WS_QC); bf16_t* KC = (bf16_t*)(p.ws + WS_KC);
  const float* rope = (const float*)(p.ws + WS_ROPE);
  const float qsA = 0.125f * LOG2E, qsC = 0.14433756729740643f * LOG2E;
  const bool ctx = r < NCTX;
  const int b = ctx ? (r >> 8) : ((r - NCTX) >> 11);
  const int tq = ctx ? (r & 255) : ((r - NCTX) & 2047);
  const int rowpos = tq >> 6, colpos = tq & 63;
  float gA[8], cA[8], sA[8], gC[12], cC[12], sC[12];
  {
    const int vA = lane >> 3, sA_ = lane & 7, vC = lane >> 2, qdC = lane & 3;
    const float* ga = (vA < 6 ? p.in[16] : p.in[17]) + l * 64 + 8 * sA_;
    const float4 g0 = *(const float4*)ga, g1 = *(const float4*)(ga + 4);
    gA[0] = g0.x; gA[1] = g0.y; gA[2] = g0.z; gA[3] = g0.w; gA[4] = g1.x; gA[5] = g1.y; gA[6] = g1.z; gA[7] = g1.w;
    const float* gc = (vC < 8 ? p.in[21] : p.in[22]) + l * 96 + (vC & 1) * 48 + 12 * qdC;
    const float4 h0 = *(const float4*)gc, h1 = *(const float4*)(gc + 4), h2 = *(const float4*)(gc + 8);
    gC[0] = h0.x; gC[1] = h0.y; gC[2] = h0.z; gC[3] = h0.w; gC[4] = h1.x; gC[5] = h1.y; gC[6] = h1.z; gC[7] = h1.w; gC[8] = h2.x; gC[9] = h2.y; gC[10] = h2.z; gC[11] = h2.w;
#pragma unroll
    for (int e = 0; e < 8; ++e) { cA[e] = 1.f; sA[e] = 0.f; }
#pragma unroll
    for (int e = 0; e < 12; ++e) { cC[e] = 1.f; sC[e] = 0.f; }
    if (!ctx) {
      const int posA = (sA_ < 4) ? rowpos : colpos, posC = (qdC < 2) ? rowpos : colpos;
      const float* ct = rope + posA * 16 + (sA_ & 1) * 8; const float* st = rope + 1024 + posA * 16 + (sA_ & 1) * 8;
      const float4 c0 = *(const float4*)ct, c1 = *(const float4*)(ct + 4), s0 = *(const float4*)st, s1 = *(const float4*)(st + 4);
      cA[0] = c0.x; cA[1] = c0.y; cA[2] = c0.z; cA[3] = c0.w; cA[4] = c1.x; cA[5] = c1.y; cA[6] = c1.z; cA[7] = c1.w;
      sA[0] = s0.x; sA[1] = s0.y; sA[2] = s0.z; sA[3] = s0.w; sA[4] = s1.x; sA[5] = s1.y; sA[6] = s1.z; sA[7] = s1.w;
      const float* ct2 = rope + 2048 + posC * 12; const float* st2 = rope + 2048 + 768 + posC * 12;
      const float4 d0 = *(const float4*)ct2, d1 = *(const float4*)(ct2 + 4), d2 = *(const float4*)(ct2 + 8), e0 = *(const float4*)st2, e1 = *(const float4*)(st2 + 4), e2 = *(const float4*)(st2 + 8);
      cC[0] = d0.x; cC[1] = d0.y; cC[2] = d0.z; cC[3] = d0.w; cC[4] = d1.x; cC[5] = d1.y; cC[6] = d1.z; cC[7] = d1.w; cC[8] = d2.x; cC[9] = d2.y; cC[10] = d2.z; cC[11] = d2.w;
      sC[0] = e0.x; sC[1] = e0.y; sC[2] = e0.z; sC[3] = e0.w; sC[4] = e1.x; sC[5] = e1.y; sC[6] = e1.z; sC[7] = e1.w; sC[8] = e2.x; sC[9] = e2.y; sC[10] = e2.z; sC[11] = e2.w;
    }
  }
  {
    const int v = lane >> 3, s = lane & 7;
    float x[8]; unpack8(t.a, x);
    float ss = 0.f;
#pragma unroll
    for (int e = 0; e < 8; ++e) ss += x[e] * x[e];
    ss += __shfl_xor(ss, 1); ss += __shfl_xor(ss, 2); ss += __shfl_xor(ss, 4);
    const float rstd = rsqrtf(ss * (1.f / 64.f) + EPSN);
    float y[8];
#pragma unroll
    for (int e = 0; e < 8; ++e) y[e] = x[e] * rstd * gA[e];
    if (ctx) {
      if (v >= 6) {
        float* o = p.out + O_AK + ((size_t)(b * 4 + l) * 256 + tq) * 128 + (v - 6) * 64 + 8 * s;
        *(float4*)o = make_float4(y[0], y[1], y[2], y[3]); *(float4*)(o + 4) = make_float4(y[4], y[5], y[6], y[7]);
      }
    } else {
#pragma unroll
      for (int e = 0; e < 8; ++e) {
        const float yp = __shfl_xor(y[e], 2);
        const float c = cA[e], sn = sA[e];
        y[e] = (s & 2) ? (yp * sn + y[e] * c) : (y[e] * c - yp * sn);
      }
    }
    if (v < 6) {
#pragma unroll
      for (int e = 0; e < 8; ++e) y[e] *= qsA;
    }
    uint4 w; w.x = pack2(y[0], y[1]); w.y = pack2(y[2], y[3]); w.z = pack2(y[4], y[5]); w.w = pack2(y[6], y[7]);
    if (v < 6) *(uint4*)(QA + (size_t)r * 384 + v * 64 + 8 * s) = w;
    else *(uint4*)(KA + (size_t)r * 128 + (v - 6) * 64 + 8 * s) = w;
  }
  if (ctx && lane < 16) {
    float x[8]; unpack8(t.av, x);
    float* o = p.out + O_AV + ((size_t)(b * 4 + l) * 256 + tq) * 128 + 8 * lane;
    *(float4*)o = make_float4(x[0], x[1], x[2], x[3]); *(float4*)(o + 4) = make_float4(x[4], x[5], x[6], x[7]);
  }
  {
    const int v = lane >> 2, qd = lane & 3;
    float x[12];
    unpack4(t.c0, x); unpack4(t.c1, x + 4); unpack4(t.c2, x + 8);
    float ss = 0.f;
#pragma unroll
    for (int e = 0; e < 12; ++e) ss += x[e] * x[e];
    ss += __shfl_xor(ss, 1); ss += __shfl_xor(ss, 2);
    const float rstd = rsqrtf(ss * (1.f / 48.f) + EPSN);
    float y[12];
#pragma unroll
    for (int e = 0; e < 12; ++e) y[e] = x[e] * rstd * gC[e];
    if (ctx) {
      if (v >= 8) {
        float* o = p.out + O_CK + ((size_t)(b * 4 + l) * 256 + tq) * 384 + (v - 8) * 48 + 12 * qd;
        *(float4*)o = make_float4(y[0], y[1], y[2], y[3]); *(float4*)(o + 4) = make_float4(y[4], y[5], y[6], y[7]);
        *(float4*)(o + 8) = make_float4(y[8], y[9], y[10], y[11]);
      }
    } else {
#pragma unroll
      for (int e = 0; e < 12; ++e) {
        const float yp = __shfl_xor(y[e], 1);
        const float c = cC[e], sn = sC[e];
        y[e] = (qd & 1) ? (yp * sn + y[e] * c) : (y[e] * c - yp * sn);
      }
    }
    if (v < 8) {
#pragma unroll
      for (int e = 0; e < 12; ++e) y[e] *= qsC;
    }
    bf16_t* dst = (v < 8 ? QC : KC) + (size_t)r * 512 + (v & 7) * 64;
    uint2 w0, w1, w2; w0.x = pack2(y[0], y[1]); w0.y = pack2(y[2], y[3]); w1.x = pack2(y[4], y[5]); w1.y = pack2(y[6], y[7]);
    w2.x = pack2(y[8], y[9]); w2.y = pack2(y[10], y[11]);
    *(uint2*)(dst + 12 * qd) = w0; *(uint2*)(dst + 12 * qd + 4) = w1; *(uint2*)(dst + 12 * qd + 8) = w2;
    { unsigned z0; asm volatile("v_mov_b32 %0, 0" : "=v"(z0)); *(uint2*)(dst + 48 + 4 * qd) = make_uint2(z0, z0); }
  }
  if (ctx && lane < 48) {
    float x[8]; unpack8(t.cv, x);
    float* o = p.out + O_CV + ((size_t)(b * 4 + l) * 256 + tq) * 384 + 8 * lane;
    *(float4*)o = make_float4(x[0], x[1], x[2], x[3]); *(float4*)(o + 4) = make_float4(x[4], x[5], x[6], x[7]);
  }
}

DI void prep_phase(const Params& p, int l, char* smem) {
  int bx = blockIdx.x, gx = gridDim.x; asm volatile("" : "+s"(bx), "+s"(gx));
  if (gx > 96 && bx < 96) { prep_gla_tile(p, l, obid(), smem); return; }
  if (gx <= 96) for (int tt = obid(); tt < 192; tt += vnb()) prep_gla_tile(p, l, tt, smem);
  const int tx = rtid(), lane = tx & 63;
  const int fb = gx > 96 ? 96 : 0;
  const int gw = (bx - fb) * 8 + (tx >> 6), nw = (gx - fb) * 8;
  const bf16_t* PR = (const bf16_t*)(p.ws + WS_PROJ);
  int r = gw;
  TokRaw cur, nxt;
  if (r < NTOK) tok_load(PR, r, lane, r < NCTX, cur);
#pragma unroll 1
  for (; r < NTOK; r += nw) {
    const int rn = r + nw;
    if (rn < NTOK) tok_load(PR, rn, lane, rn < NCTX, nxt);
    prep_token(p, l, r, lane, cur);
    cur = nxt;
  }
}

typedef unsigned u32x4 __attribute__((ext_vector_type(4)));
struct KVSrc { const bf16_t* k1; const bf16_t* v1; const bf16_t* k2; const bf16_t* v2; int ks1, vs1, ks2, vs2, n1, n2; };
template <int NMAP, int NDT> struct FlashRegs { u32x4 k00, k01, k10, k11, v0, v1, v2; };

template <int NMAP, int NDT>
DI void fl_issue(int kt, const KVSrc& kv, FlashRegs<NMAP, NDT>& R) {
  constexpr int CPR = NDT * 2;
  kt = kt < kv.n1 + kv.n2 ? kt : kv.n1 + kv.n2 - 1;
  const int tid = otid();
  const bf16_t* kb; const bf16_t* vb; int ks, vs;
  if (kt < kv.n1) { kb = kv.k1 + (size_t)kt * 64 * kv.ks1; vb = kv.v1 + (size_t)kt * 64 * kv.vs1; ks = kv.ks1; vs = kv.vs1; }
  else { kb = kv.k2 + (size_t)(kt - kv.n1) * 64 * kv.ks2; vb = kv.v2 + (size_t)(kt - kv.n1) * 64 * kv.vs2; ks = kv.ks2; vs = kv.vs2; }
  R.k00 = *(const u32x4*)(kb + (size_t)(tid >> 3) * ks + (tid & 7) * 8);
  R.k01 = *(const u32x4*)(kb + (size_t)((tid >> 3) + 32) * ks + (tid & 7) * 8);
  if (NMAP == 2) {
    R.k10 = *(const u32x4*)(kb + 64 + (size_t)(tid >> 3) * ks + (tid & 7) * 8);
    R.k11 = *(const u32x4*)(kb + 64 + (size_t)((tid >> 3) + 32) * ks + (tid & 7) * 8);
  } else { R.k10 = R.k00; R.k11 = R.k01; }
  { const int c = tid; R.v0 = *(const u32x4*)(vb + (size_t)(c / CPR) * vs + (c % CPR) * 8); }
  { const int c = tid + 256; R.v1 = *(const u32x4*)(vb + (size_t)(c / CPR) * vs + (c % CPR) * 8); }
  if (NDT == 6) { const int c = tid + 512; R.v2 = *(const u32x4*)(vb + (size_t)(c / CPR) * vs + (c % CPR) * 8); } else R.v2 = R.v1;
}
template <int NMAP, int NDT>
DI void fl_write(char* buf, const FlashRegs<NMAP, NDT>& R) {
  constexpr int CPR = NDT * 2, VSB = NDT * 32 + 32;
  const int tid = otid();
  char* vbuf = buf + NMAP * 8192;
  { const int row = tid >> 3, ch = tid & 7; *(u32x4*)(buf + row * 128 + ((ch ^ (row & 7)) << 4)) = R.k00; }
  { const int row = (tid >> 3) + 32, ch = tid & 7; *(u32x4*)(buf + row * 128 + ((ch ^ (row & 7)) << 4)) = R.k01; }
  if (NMAP == 2) {
    { const int row = tid >> 3, ch = tid & 7; *(u32x4*)(buf + 8192 + row * 128 + ((ch ^ (row & 7)) << 4)) = R.k10; }
    { const int row = (tid >> 3) + 32, ch = tid & 7; *(u32x4*)(buf + 8192 + row * 128 + ((ch ^ (row & 7)) << 4)) = R.k11; }
  }
  { const int c = tid; *(u32x4*)(vbuf + (c / CPR) * VSB + (c % CPR) * 16) = R.v0; }
  { const int c = tid + 256; *(u32x4*)(vbuf + (c / CPR) * VSB + (c % CPR) * 16) = R.v1; }
  if (NDT == 6) { const int c = tid + 512; *(u32x4*)(vbuf + (c / CPR) * VSB + (c % CPR) * 16) = R.v2; }
}
template <int NMAP, int NDT, int NRT>
DI void fl_compute(const char* buf, const bf16x8 (&qf)[NRT][NMAP][2], f32x4 (&oacc)[NRT][NMAP][NDT], float (&mrun)[NRT][NMAP], float (&lsum)[NRT][NMAP], int lane) {
  constexpr int VSB = NDT * 32 + 32;
  const int g = lane >> 4, qq = (lane & 15) >> 2, pp = lane & 3;
  bf16x8 pf[NRT][NMAP][2];
#pragma unroll
  for (int m = 0; m < NMAP; ++m) {
    f32x4 sacc[NRT][4];
#pragma unroll
    for (int rt = 0; rt < NRT; ++rt)
#pragma unroll
      for (int t = 0; t < 4; ++t) sacc[rt][t] = (f32x4){0.f, 0.f, 0.f, 0.f};
#pragma unroll
    for (int ks = 0; ks < 2; ++ks) {
      const int ch = ((ks * 4 + g) ^ (lane & 7)) << 4;
#pragma unroll
      for (int t = 0; t < 4; ++t) {
        const bf16x8 kf = *(const bf16x8*)(buf + m * 8192 + (16 * t + (lane & 15)) * 128 + ch);
#pragma unroll
        for (int rt = 0; rt < NRT; ++rt) sacc[rt][t] = __builtin_amdgcn_mfma_f32_16x16x32_bf16(kf, qf[rt][m][ks], sacc[rt][t], 0, 0, 0);
      }
    }
#pragma unroll
    for (int rt = 0; rt < NRT; ++rt) {
      float mx = sacc[rt][0][0];
#pragma unroll
      for (int t = 0; t < 4; ++t)
#pragma unroll
        for (int r = 0; r < 4; ++r) mx = fmaxf(mx, sacc[rt][t][r]);
      mx = fmaxf(mx, __shfl_xor(mx, 16)); mx = fmaxf(mx, __shfl_xor(mx, 32));
      const float mnew = fmaxf(mrun[rt][m], mx);
      const float alpha = fast_exp2(mrun[rt][m] - mnew);
      mrun[rt][m] = mnew;
      float ps = 0.f;
#pragma unroll
      for (int t = 0; t < 4; ++t)
#pragma unroll
        for (int r = 0; r < 4; ++r) { const float pv = fast_exp2(sacc[rt][t][r] - mnew); sacc[rt][t][r] = pv; ps += pv; }
      lsum[rt][m] = lsum[rt][m] * alpha + ps;
#pragma unroll
      for (int d = 0; d < NDT; ++d) oacc[rt][m][d] *= alpha;
#pragma unroll
      for (int ks = 0; ks < 2; ++ks) {
        u32x4 pu;
        pu[0] = pack2(sacc[rt][2 * ks][0], sacc[rt][2 * ks][1]); pu[1] = pack2(sacc[rt][2 * ks][2], sacc[rt][2 * ks][3]);
        pu[2] = pack2(sacc[rt][2 * ks + 1][0], sacc[rt][2 * ks + 1][1]); pu[3] = pack2(sacc[rt][2 * ks + 1][2], sacc[rt][2 * ks + 1][3]);
        pf[rt][m][ks] = __builtin_bit_cast(bf16x8, pu);
      }
    }
  }
  const char* vbuf = buf + NMAP * 8192;
#pragma unroll
  for (int ks = 0; ks < 2; ++ks) {
    const char* vrow = vbuf + (32 * ks + 4 * g + qq) * VSB + pp * 8;
#pragma unroll
    for (int d = 0; d < NDT; ++d) {
      const s16x4 v0 = __builtin_amdgcn_ds_read_tr16_b64_v4i16((LDSP s16x4*)(vrow + d * 32));
      const s16x4 v1 = __builtin_amdgcn_ds_read_tr16_b64_v4i16((LDSP s16x4*)(vrow + 16 * VSB + d * 32));
      const bf16x8 vf = __builtin_shufflevector(v0, v1, 0, 1, 2, 3, 4, 5, 6, 7);
#pragma unroll
      for (int rt = 0; rt < NRT; ++rt)
#pragma unroll
        for (int m = 0; m < NMAP; ++m) oacc[rt][m][d] = __builtin_amdgcn_mfma_f32_16x16x32_bf16(vf, pf[rt][m][ks], oacc[rt][m][d], 0, 0, 0);
    }
  }
}

template <int NMAP, int NDT, int NRT>
DI void flash_run(const bf16_t* __restrict__ qptr, int qrt_stride  , const KVSrc& kv, f32x4 (&oacc)[NRT][NMAP][NDT], float (&linv)[NRT][NMAP], char* smem) {
  constexpr int BUFB = NMAP * 8192 + 64 * (NDT * 32 + 32);
  const int lane = otid() & 63;
  bf16x8 qf[NRT][NMAP][2];
  float mrun[NRT][NMAP], lsum[NRT][NMAP];
#pragma unroll
  for (int rt = 0; rt < NRT; ++rt)
#pragma unroll
    for (int m = 0; m < NMAP; ++m) {
      const bf16_t* qp = qptr + (size_t)rt * qrt_stride + 64 * m;
      qf[rt][m][0] = *(const bf16x8*)(qp); qf[rt][m][1] = *(const bf16x8*)(qp + 32);
      mrun[rt][m] = -INFINITY; lsum[rt][m] = 0.f;
#pragma unroll
      for (int d = 0; d < NDT; ++d) oacc[rt][m][d] = (f32x4){0.f, 0.f, 0.f, 0.f};
    }
  const int nt = kv.n1 + kv.n2;
  FlashRegs<NMAP, NDT> R0, R1;
  fl_issue<NMAP, NDT>(0, kv, R0);
  fl_issue<NMAP, NDT>(1, kv, R1);
  __syncthreads();
  fl_write<NMAP, NDT>(smem, R0);
  fl_issue<NMAP, NDT>(2, kv, R0);
  __syncthreads();
#pragma unroll 1
  for (int t = 0; t < nt; t += 2) {
    fl_compute<NMAP, NDT, NRT>(smem, qf, oacc, mrun, lsum, lane);
    fl_write<NMAP, NDT>(smem + BUFB, R1);
    fl_issue<NMAP, NDT>(t + 3, kv, R1);
    __syncthreads();
    fl_compute<NMAP, NDT, NRT>(smem + BUFB, qf, oacc, mrun, lsum, lane);
    fl_write<NMAP, NDT>(smem, R0);
    fl_issue<NMAP, NDT>(t + 4, kv, R0);
    __syncthreads();
  }
#pragma unroll
  for (int rt = 0; rt < NRT; ++rt)
#pragma unroll
    for (int m = 0; m < NMAP; ++m) { float l = lsum[rt][m]; l += __shfl_xor(l, 16); l += __shfl_xor(l, 32); linv[rt][m] = 1.f / l; }
}

DI void attn_a_item(const Params& p, int l, bool ctx, int b, int h, int qt, char* smem) {
  const int lane = otid() & 63, wave = otid() >> 6;
  const int seq0 = ctx ? b * 256 : NCTX + b * 2048;
  const int qrow = seq0 + qt * 128 + wave * 32 + (lane & 15);
  const int kvh = h / 3;
  const bf16_t* PR = (const bf16_t*)(p.ws + WS_PROJ);
  KVSrc kv;
  kv.k1 = (const bf16_t*)(p.ws + WS_KA) + (size_t)seq0 * 128 + kvh * 64; kv.ks1 = 128;
  kv.v1 = PR + (size_t)seq0 * PW + OFF_AV + kvh * 64; kv.vs1 = PW;
  kv.n1 = ctx ? 4 : 32; kv.n2 = ctx ? 0 : 8;
  kv.k2 = (const bf16_t*)(p.ws + WS_KAC) + (size_t)((b & 1) * 4 + l) * 512 * 128 + kvh * 64; kv.ks2 = 128;
  kv.v2 = (const bf16_t*)(p.ws + WS_VAC) + (size_t)((b & 1) * 4 + l) * 512 * 128 + kvh * 64; kv.vs2 = 128;
  f32x4 o[2][1][4]; float linv[2][1];
  flash_run<1, 4, 2>((const bf16_t*)(p.ws + WS_QA) + (size_t)qrow * 384 + h * 64 + 8 * (lane >> 4), 16 * 384, kv, o, linv, smem);
#pragma unroll
  for (int rt = 0; rt < 2; ++rt) {
    bf16_t* dst = (bf16_t*)(p.ws + WS_MIX) + (size_t)(qrow + 16 * rt) * 1024 + h * 64 + 4 * (lane >> 4);
    const float li = linv[rt][0];
#pragma unroll
    for (int d = 0; d < 4; ++d) { uint2 w; w.x = pack2(o[rt][0][d][0] * li, o[rt][0][d][1] * li); w.y = pack2(o[rt][0][d][2] * li, o[rt][0][d][3] * li); *(uint2*)(dst + 16 * d) = w; }
  }
}

DI void attn_c_item(const Params& p, int l, bool ctx, int b, int h, int qt, char* smem) {
  const int lane = otid() & 63, wave = otid() >> 6;
  const int seq0 = ctx ? b * 256 : NCTX + b * 2048;
  const int qrow = seq0 + qt * 64 + wave * 16 + (lane & 15);
  const bf16_t* PR = (const bf16_t*)(p.ws + WS_PROJ);
  KVSrc kv;
  kv.ks1 = 512; kv.vs1 = PW; kv.ks2 = 512; kv.vs2 = 384;
  kv.n1 = ctx ? 4 : 32; kv.n2 = ctx ? 0 : 8;
  kv.v1 = PR + (size_t)seq0 * PW + OFF_CV + h * 96;
  kv.v2 = (const bf16_t*)(p.ws + WS_VCC) + (size_t)((b & 1) * 4 + l) * 512 * 384 + h * 96;
  kv.k1 = (const bf16_t*)(p.ws + WS_KC) + (size_t)seq0 * 512 + (h * 2) * 64;
  kv.k2 = (const bf16_t*)(p.ws + WS_KCC) + (size_t)((b & 1) * 4 + l) * 512 * 512 + (h * 2) * 64;
  f32x4 o3[1][2][6]; float linv3[1][2];
  flash_run<2, 6, 1>((const bf16_t*)(p.ws + WS_QC) + (size_t)qrow * 512 + (h * 2) * 64 + 8 * (lane >> 4), 0, kv, o3, linv3, smem);
  f32x4 (&o)[2][6] = o3[0]; float (&linv)[2] = linv3[0];
  const float lam = ((const float*)(p.ws + WS_MISC))[l];
  const float li0 = linv[0], l1 = linv[1] * lam;
  float ss = 0.f;
#pragma unroll
  for (int d = 0; d < 6; ++d)
#pragma unroll
    for (int r = 0; r < 4; ++r) { const float v = o[0][d][r] * li0 - o[1][d][r] * l1; o[0][d][r] = v; ss += v * v; }
  ss += __shfl_xor(ss, 16); ss += __shfl_xor(ss, 32);
  const float sc = rsqrtf(ss * (1.f / 96.f) + EPSN) * (1.f - p.lam_init[l]);
  const float* g = p.in[24] + l * 96 + 4 * (lane >> 4);
  bf16_t* dst = (bf16_t*)(p.ws + WS_MIX) + (size_t)qrow * 1024 + 640 + h * 96 + 4 * (lane >> 4);
  float4 gg[6];
#pragma unroll
  for (int d = 0; d < 6; ++d) gg[d] = *(const float4*)(g + 16 * d);
#pragma unroll
  for (int d = 0; d < 6; ++d) {
    uint2 w; w.x = pack2(o[0][d][0] * sc * gg[d].x, o[0][d][1] * sc * gg[d].y); w.y = pack2(o[0][d][2] * sc * gg[d].z, o[0][d][3] * sc * gg[d].w);
    *(uint2*)(dst + 16 * d) = w;
  }
}

DI void gla_item(const Params& p, int l, bool ctx, int b, int h, int c, char* smem) {
  const int tid = otid();
  const int seq0 = ctx ? b * 256 : NCTX + b * 2048;
  const int nch = ctx ? 4 : 32;
  const int row0 = seq0 + c * 64, tt0 = seq0 >> 6, tt = tt0 + c;
  const bf16_t* PR = (const bf16_t*)(p.ws + WS_PROJ);
  const float* GB = (const float*)(p.ws + WS_GB); const float* ATOT = (const float*)(p.ws + WS_ATOT); const float* U = (const float*)(p.ws + WS_U);
  float* qd = (float*)smem;
  float* kd = qd + 64 * 36;
  float* vv = kd + 64 * 36;
  float* S = vv + 4096;
  float* sc = S + 2048;
  const int ib = tid >> 4, xb = tid & 15, i0 = ib * 4, x0 = xb * 4;
  float o[4][4];
#pragma unroll
  for (int a = 0; a < 4; ++a)
#pragma unroll
    for (int e = 0; e < 4; ++e) o[a][e] = 0.f;
  for (int s = 0; s < 2; ++s) {
    {
      const int j = tid >> 2, part = tid & 3, kk = h * 32 + part * 8;
      const size_t prow = (size_t)(row0 + j) * PW;
      const uint4 qraw = *(const uint4*)(PR + prow + OFF_BQ + kk), kraw = *(const uint4*)(PR + prow + OFF_BK + kk);
      const float* gbp = GB + (size_t)(row0 + j) * 256 + s * 128 + kk;
      const float* ttp = ATOT + 192 * 256 + tt * 256 + s * 128 + kk;
      const float4 g0 = *(const float4*)gbp, g1 = *(const float4*)(gbp + 4), t0 = *(const float4*)ttp, t1 = *(const float4*)(ttp + 4);
      uint4 vraw0 = make_uint4(0, 0, 0, 0), vraw1 = vraw0;
      if (s == 0) { vraw0 = *(const uint4*)(PR + prow + OFF_BV + h * 64 + part * 16); vraw1 = *(const uint4*)(PR + prow + OFF_BV + h * 64 + part * 16 + 8); }
      float qv[8], kv[8]; unpack8(qraw, qv); unpack8(kraw, kv);
      const float cum[8] = {t0.x - g0.x, t0.y - g0.y, t0.z - g0.z, t0.w - g0.w, t1.x - g1.x, t1.y - g1.y, t1.z - g1.z, t1.w - g1.w};
      float qo[8], ko[8];
#pragma unroll
      for (int e = 0; e < 8; ++e) { qo[e] = qv[e] * 0.17677669529663687f * fast_exp2(cum[e] * LOG2E); ko[e] = kv[e] * fast_exp2(-cum[e] * LOG2E); }
      float* qp = qd + j * 36 + part * 8; float* kp = kd + j * 36 + part * 8;
      *(float4*)qp = make_float4(qo[0], qo[1], qo[2], qo[3]); *(float4*)(qp + 4) = make_float4(qo[4], qo[5], qo[6], qo[7]);
      *(float4*)kp = make_float4(ko[0], ko[1], ko[2], ko[3]); *(float4*)(kp + 4) = make_float4(ko[4], ko[5], ko[6], ko[7]);
      if (s == 0) {
        float x[16]; unpack8(vraw0, x); unpack8(vraw1, x + 8);
        float* vp = vv + j * 64 + part * 16;
#pragma unroll
        for (int e = 0; e < 4; ++e) *(float4*)(vp + 4 * e) = make_float4(x[4 * e], x[4 * e + 1], x[4 * e + 2], x[4 * e + 3]);
      }
    }
    {
      const int d = tid >> 3, v0 = (tid & 7) * 8;
      float S8[8];
      if (ctx) {
#pragma unroll
        for (int e = 0; e < 8; ++e) S8[e] = 0.f;
      } else {
        const float* s0 = p.in[7] + ((((size_t)b * 4 + l) * 2 + s) * 4 + h) * 2048 + d * 64 + v0;
        const float4 a = *(const float4*)s0, bq = *(const float4*)(s0 + 4);
        S8[0] = a.x; S8[1] = a.y; S8[2] = a.z; S8[3] = a.w; S8[4] = bq.x; S8[5] = bq.y; S8[6] = bq.z; S8[7] = bq.w;
      }
      const int nfold = s == 0 ? c : nch - 1 - c;
#pragma unroll 8
      for (int f = 0; f < nfold; ++f) {
        const int t2 = s == 0 ? tt0 + f : tt0 + nch - 1 - f;
        const float a = ATOT[t2 * 256 + s * 128 + h * 32 + d];
        const float* u = U + (((size_t)t2 * 2 + s) * 4 + h) * 2048 + d * 64 + v0;
        const float4 u0 = *(const float4*)u, u1 = *(const float4*)(u + 4);
        S8[0] = a * S8[0] + u0.x; S8[1] = a * S8[1] + u0.y; S8[2] = a * S8[2] + u0.z; S8[3] = a * S8[3] + u0.w;
        S8[4] = a * S8[4] + u1.x; S8[5] = a * S8[5] + u1.y; S8[6] = a * S8[6] + u1.z; S8[7] = a * S8[7] + u1.w;
      }
      *(float4*)(S + d * 64 + v0) = make_float4(S8[0], S8[1], S8[2], S8[3]);
      *(float4*)(S + d * 64 + v0 + 4) = make_float4(S8[4], S8[5], S8[6], S8[7]);
      if (ctx && ((s == 0 && c == nch - 1) || (s == 1 && c == 0))) {
        const float a = ATOT[tt * 256 + s * 128 + h * 32 + d];
        const float* u = U + (((size_t)tt * 2 + s) * 4 + h) * 2048 + d * 64 + v0;
        const float4 u0 = *(const float4*)u, u1 = *(const float4*)(u + 4);
        float* dst = p.out + O_ST + ((((size_t)b * 4 + l) * 2 + s) * 4 + h) * 2048 + d * 64 + v0;
        *(float4*)dst = make_float4(a * S8[0] + u0.x, a * S8[1] + u0.y, a * S8[2] + u0.z, a * S8[3] + u0.w);
        *(float4*)(dst + 4) = make_float4(a * S8[4] + u1.x, a * S8[5] + u1.y, a * S8[6] + u1.z, a * S8[7] + u1.w);
      }
    }
    __syncthreads();
    {
      float a4[4][4];
#pragma unroll
      for (int a = 0; a < 4; ++a)
#pragma unroll
        for (int e = 0; e < 4; ++e) a4[a][e] = 0.f;
#pragma unroll 2
      for (int d4 = 0; d4 < 8; ++d4) {
        float4 q4[4], k4[4];
#pragma unroll
        for (int a = 0; a < 4; ++a) { q4[a] = *(const float4*)(qd + (i0 + a) * 36 + 4 * d4); k4[a] = *(const float4*)(kd + (x0 + a) * 36 + 4 * d4); }
#pragma unroll
        for (int a = 0; a < 4; ++a)
#pragma unroll
          for (int e = 0; e < 4; ++e) a4[a][e] += q4[a].x * k4[e].x + q4[a].y * k4[e].y + q4[a].z * k4[e].z + q4[a].w * k4[e].w;
      }
#pragma unroll
      for (int a = 0; a < 4; ++a) {
        float r4[4];
#pragma unroll
        for (int e = 0; e < 4; ++e) { const int i = i0 + a, j = x0 + e; const bool keep = (s == 0) ? (j <= i) : (j >= i); r4[e] = keep ? a4[a][e] : 0.f; }
        *(float4*)(sc + (i0 + a) * 68 + x0) = make_float4(r4[0], r4[1], r4[2], r4[3]);
      }
    }
    __syncthreads();
    {
#pragma unroll 2
      for (int j = 0; j < 64; j += 4) {
        float4 s4[4], v4[4];
#pragma unroll
        for (int a = 0; a < 4; ++a) { s4[a] = *(const float4*)(sc + (i0 + a) * 68 + j); v4[a] = *(const float4*)(vv + (j + a) * 64 + x0); }
#pragma unroll
        for (int a = 0; a < 4; ++a) {
          o[a][0] += s4[a].x * v4[0].x + s4[a].y * v4[1].x + s4[a].z * v4[2].x + s4[a].w * v4[3].x;
          o[a][1] += s4[a].x * v4[0].y + s4[a].y * v4[1].y + s4[a].z * v4[2].y + s4[a].w * v4[3].y;
          o[a][2] += s4[a].x * v4[0].z + s4[a].y * v4[1].z + s4[a].z * v4[2].z + s4[a].w * v4[3].z;
          o[a][3] += s4[a].x * v4[0].w + s4[a].y * v4[1].w + s4[a].z * v4[2].w + s4[a].w * v4[3].w;
        }
      }
#pragma unroll 2
      for (int d = 0; d < 32; d += 4) {
        float4 q4[4], v4[4];
#pragma unroll
        for (int a = 0; a < 4; ++a) { q4[a] = *(const float4*)(qd + (i0 + a) * 36 + d); v4[a] = *(const float4*)(S + (d + a) * 64 + x0); }
#pragma unroll
        for (int a = 0; a < 4; ++a) {
          o[a][0] += q4[a].x * v4[0].x + q4[a].y * v4[1].x + q4[a].z * v4[2].x + q4[a].w * v4[3].x;
          o[a][1] += q4[a].x * v4[0].y + q4[a].y * v4[1].y + q4[a].z * v4[2].y + q4[a].w * v4[3].y;
          o[a][2] += q4[a].x * v4[0].z + q4[a].y * v4[1].z + q4[a].z * v4[2].z + q4[a].w * v4[3].z;
          o[a][3] += q4[a].x * v4[0].w + q4[a].y * v4[1].w + q4[a].z * v4[2].w + q4[a].w * v4[3].w;
        }
      }
    }
    __syncthreads();
  }
  const float4 gg = *(const float4*)(p.in[20] + l * 64 + x0);
#pragma unroll
  for (int a = 0; a < 4; ++a) {
    float ss = o[a][0] * o[a][0] + o[a][1] * o[a][1] + o[a][2] * o[a][2] + o[a][3] * o[a][3];
    ss += __shfl_xor(ss, 1); ss += __shfl_xor(ss, 2); ss += __shfl_xor(ss, 4); ss += __shfl_xor(ss, 8);
    const float rstd = rsqrtf(ss * (1.f / 64.f) + EPSN);
    const size_t row = row0 + i0 + a;
    float br[4]; unpack4(*(const uint2*)(PR + row * PW + OFF_BR + h * 64 + x0), br);
    uint2 w;
    w.x = pack2(o[a][0] * rstd * gg.x * sigm_silu_acc(br[0]), o[a][1] * rstd * gg.y * sigm_silu_acc(br[1]));
    w.y = pack2(o[a][2] * rstd * gg.z * sigm_silu_acc(br[2]), o[a][3] * rstd * gg.w * sigm_silu_acc(br[3]));
    *(uint2*)((bf16_t*)(p.ws + WS_MIX) + row * 1024 + 384 + h * 64 + x0) = w;
  }
}

DI void gla_item_mfma(const Params& p, int l, bool ctx, int b, int h, int c, char* smem) {
  const int tid = otid(), lane = tid & 63, wave = tid >> 6, g = lane >> 4, fr = lane & 15, qq = fr >> 2, pp = lane & 3;
  const int seq0 = ctx ? b * 256 : NCTX + b * 2048;
  const int nch = ctx ? 4 : 32;
  const int row0 = seq0 + c * 64, tt0 = seq0 >> 6, tt = tt0 + c;
  const bf16_t* PR = (const bf16_t*)(p.ws + WS_PROJ);
  const float* GB = (const float*)(p.ws + WS_GB); const float* ATOT = (const float*)(p.ws + WS_ATOT); const float* U = (const float*)(p.ws + WS_U);
  char* qdb = smem;
  char* kdb = smem + 4096;
  char* vvb = smem + 8192;
  char* Sb = smem + 8192 + 10240;
  f32x4 oacc[4];
#pragma unroll
  for (int vt = 0; vt < 4; ++vt) oacc[vt] = (f32x4){0.f, 0.f, 0.f, 0.f};
#pragma unroll 1
  for (int s = 0; s < 2; ++s) {
    {
      const int j = tid >> 2, part = tid & 3, kk = h * 32 + part * 8;
      const size_t prow = (size_t)(row0 + j) * PW;
      const uint4 qraw = *(const uint4*)(PR + prow + OFF_BQ + kk), kraw = *(const uint4*)(PR + prow + OFF_BK + kk);
      const float* gbp = GB + (size_t)(row0 + j) * 256 + s * 128 + kk;
      const float* ttp = ATOT + 192 * 256 + tt * 256 + s * 128 + kk;
      const float4 g0 = *(const float4*)gbp, g1 = *(const float4*)(gbp + 4), t0 = *(const float4*)ttp, t1 = *(const float4*)(ttp + 4);
      if (s == 0) {
        const uint4 v0 = *(const uint4*)(PR + prow + OFF_BV + h * 64 + part * 16), v1 = *(const uint4*)(PR + prow + OFF_BV + h * 64 + part * 16 + 8);
        *(uint4*)(vvb + j * 160 + part * 32) = v0; *(uint4*)(vvb + j * 160 + part * 32 + 16) = v1;
      }
      float qv[8], kv[8]; unpack8(qraw, qv); unpack8(kraw, kv);
      const float cum[8] = {t0.x - g0.x, t0.y - g0.y, t0.z - g0.z, t0.w - g0.w, t1.x - g1.x, t1.y - g1.y, t1.z - g1.z, t1.w - g1.w};
      float qo[8], ko[8];
#pragma unroll
      for (int e = 0; e < 8; ++e) { qo[e] = qv[e] * 0.17677669529663687f * fast_exp2(cum[e] * LOG2E); ko[e] = kv[e] * fast_exp2(-cum[e] * LOG2E); }
      uint4 qw, kw;
      qw.x = pack2(qo[0], qo[1]); qw.y = pack2(qo[2], qo[3]); qw.z = pack2(qo[4], qo[5]); qw.w = pack2(qo[6], qo[7]);
      kw.x = pack2(ko[0], ko[1]); kw.y = pack2(ko[2], ko[3]); kw.z = pack2(ko[4], ko[5]); kw.w = pack2(ko[6], ko[7]);
      *(uint4*)(qdb + j * 64 + part * 16) = qw; *(uint4*)(kdb + j * 64 + part * 16) = kw;
    }
    {
      const int d = tid >> 3, v0 = (tid & 7) * 8;
      float S8[8];
      if (ctx) {
#pragma unroll
        for (int e = 0; e < 8; ++e) S8[e] = 0.f;
      } else {
        const float* s0 = p.in[7] + ((((size_t)b * 4 + l) * 2 + s) * 4 + h) * 2048 + d * 64 + v0;
        const float4 a = *(const float4*)s0, bq = *(const float4*)(s0 + 4);
        S8[0] = a.x; S8[1] = a.y; S8[2] = a.z; S8[3] = a.w; S8[4] = bq.x; S8[5] = bq.y; S8[6] = bq.z; S8[7] = bq.w;
      }
      const int nfold = s == 0 ? c : nch - 1 - c;
      const float* ap = ATOT + s * 128 + h * 32 + d;
      const float* up = U + ((size_t)s * 4 + h) * 2048 + d * 64 + v0;
      const int tstart = s == 0 ? tt0 : tt0 + nch - 1, tstep = s == 0 ? 1 : -1;
      int f = 0;
#pragma unroll 1
      for (; f + 4 <= nfold; f += 4) {
        float a4[4]; float4 ua[4], ub[4];
#pragma unroll
        for (int q = 0; q < 4; ++q) {
          const int t2 = tstart + tstep * (f + q);
          a4[q] = ap[t2 * 256];
          const float* u = up + (size_t)t2 * 2 * 4 * 2048;
          ua[q] = *(const float4*)u; ub[q] = *(const float4*)(u + 4);
        }
#pragma unroll
        for (int q = 0; q < 4; ++q) {
          const float a = a4[q];
          S8[0] = a * S8[0] + ua[q].x; S8[1] = a * S8[1] + ua[q].y; S8[2] = a * S8[2] + ua[q].z; S8[3] = a * S8[3] + ua[q].w;
          S8[4] = a * S8[4] + ub[q].x; S8[5] = a * S8[5] + ub[q].y; S8[6] = a * S8[6] + ub[q].z; S8[7] = a * S8[7] + ub[q].w;
        }
      }
#pragma unroll 1
      for (; f < nfold; ++f) {
        const int t2 = tstart + tstep * f;
        const float a = ap[t2 * 256];
        const float* u = up + (size_t)t2 * 2 * 4 * 2048;
        const float4 u0 = *(const float4*)u, u1 = *(const float4*)(u + 4);
        S8[0] = a * S8[0] + u0.x; S8[1] = a * S8[1] + u0.y; S8[2] = a * S8[2] + u0.z; S8[3] = a * S8[3] + u0.w;
        S8[4] = a * S8[4] + u1.x; S8[5] = a * S8[5] + u1.y; S8[6] = a * S8[6] + u1.z; S8[7] = a * S8[7] + u1.w;
      }
      uint4 sw; sw.x = pack2(S8[0], S8[1]); sw.y = pack2(S8[2], S8[3]); sw.z = pack2(S8[4], S8[5]); sw.w = pack2(S8[6], S8[7]);
      *(uint4*)(Sb + d * 160 + v0 * 2) = sw;
      if (ctx && ((s == 0 && c == nch - 1) || (s == 1 && c == 0))) {
        const float a = ATOT[tt * 256 + s * 128 + h * 32 + d];
        const float* u = U + (((size_t)tt * 2 + s) * 4 + h) * 2048 + d * 64 + v0;
        const float4 u0 = *(const float4*)u, u1 = *(const float4*)(u + 4);
        float* dst = p.out + O_ST + ((((size_t)b * 4 + l) * 2 + s) * 4 + h) * 2048 + d * 64 + v0;
        *(float4*)dst = make_float4(a * S8[0] + u0.x, a * S8[1] + u0.y, a * S8[2] + u0.z, a * S8[3] + u0.w);
        *(float4*)(dst + 4) = make_float4(a * S8[4] + u1.x, a * S8[5] + u1.y, a * S8[6] + u1.z, a * S8[7] + u1.w);
      }
    }
    __syncthreads();
    {
      const int iq = 16 * wave + fr;
      const bf16x8 qf = *(const bf16x8*)(qdb + iq * 64 + g * 16);
      bf16x8 pf[2];
#pragma unroll
      for (int ks = 0; ks < 2; ++ks) {
        u32x4 pu;
#pragma unroll
        for (int hh = 0; hh < 2; ++hh) {
          const int t = 2 * ks + hh;
          const bf16x8 kf = *(const bf16x8*)(kdb + (16 * t + fr) * 64 + g * 16);
          f32x4 sc = __builtin_amdgcn_mfma_f32_16x16x32_bf16(kf, qf, (f32x4){0.f, 0.f, 0.f, 0.f}, 0, 0, 0);
#pragma unroll
          for (int r = 0; r < 4; ++r) { const int j = 16 * t + 4 * g + r; const bool keep = (s == 0) ? (j <= iq) : (j >= iq); sc[r] = keep ? sc[r] : 0.f; }
          pu[2 * hh] = pack2(sc[0], sc[1]); pu[2 * hh + 1] = pack2(sc[2], sc[3]);
        }
        pf[ks] = __builtin_bit_cast(bf16x8, pu);
      }
#pragma unroll
      for (int ks = 0; ks < 2; ++ks) {
        const char* vrow = vvb + (32 * ks + 4 * g + qq) * 160 + pp * 8;
#pragma unroll
        for (int vt = 0; vt < 4; ++vt) {
          const s16x4 v0 = __builtin_amdgcn_ds_read_tr16_b64_v4i16((LDSP s16x4*)(vrow + vt * 32));
          const s16x4 v1 = __builtin_amdgcn_ds_read_tr16_b64_v4i16((LDSP s16x4*)(vrow + 16 * 160 + vt * 32));
          const bf16x8 vf = __builtin_shufflevector(v0, v1, 0, 1, 2, 3, 4, 5, 6, 7);
          oacc[vt] = __builtin_amdgcn_mfma_f32_16x16x32_bf16(vf, pf[ks], oacc[vt], 0, 0, 0);
        }
      }
      {
        const s16x4 qa = *(const s16x4*)(qdb + iq * 64 + (4 * g) * 2), qb = *(const s16x4*)(qdb + iq * 64 + (16 + 4 * g) * 2);
        const bf16x8 qp = __builtin_shufflevector(qa, qb, 0, 1, 2, 3, 4, 5, 6, 7);
        const char* srow = Sb + (4 * g + qq) * 160 + pp * 8;
#pragma unroll
        for (int vt = 0; vt < 4; ++vt) {
          const s16x4 s0 = __builtin_amdgcn_ds_read_tr16_b64_v4i16((LDSP s16x4*)(srow + vt * 32));
          const s16x4 s1 = __builtin_amdgcn_ds_read_tr16_b64_v4i16((LDSP s16x4*)(srow + 16 * 160 + vt * 32));
          const bf16x8 sf = __builtin_shufflevector(s0, s1, 0, 1, 2, 3, 4, 5, 6, 7);
          oacc[vt] = __builtin_amdgcn_mfma_f32_16x16x32_bf16(sf, qp, oacc[vt], 0, 0, 0);
        }
      }
    }
    __syncthreads();
  }
  float ss = 0.f;
#pragma unroll
  for (int vt = 0; vt < 4; ++vt)
#pragma unroll
    for (int r = 0; r < 4; ++r) ss += oacc[vt][r] * oacc[vt][r];
  ss += __shfl_xor(ss, 16); ss += __shfl_xor(ss, 32);
  const float rstd = rsqrtf(ss * (1.f / 64.f) + EPSN);
  const size_t row = row0 + 16 * wave + fr;
  float4 ggv[4]; uint2 brv[4];
#pragma unroll
  for (int vt = 0; vt < 4; ++vt) { const int v = 16 * vt + 4 * g; ggv[vt] = *(const float4*)(p.in[20] + l * 64 + v); brv[vt] = *(const uint2*)(PR + row * PW + OFF_BR + h * 64 + v); }
#pragma unroll
  for (int vt = 0; vt < 4; ++vt) {
    const int v = 16 * vt + 4 * g;
    const float4 gg = ggv[vt];
    float br[4]; unpack4(brv[vt], br);
    uint2 w;
    w.x = pack2(oacc[vt][0] * rstd * gg.x * sigm_silu_acc(br[0]), oacc[vt][1] * rstd * gg.y * sigm_silu_acc(br[1]));
    w.y = pack2(oacc[vt][2] * rstd * gg.z * sigm_silu_acc(br[2]), oacc[vt][3] * rstd * gg.w * sigm_silu_acc(br[3]));
    *(uint2*)((bf16_t*)(p.ws + WS_MIX) + row * 1024 + 384 + h * 64 + v) = w;
  }
}

DI void mixer_phase(const Params& p, int l, int cidx, char* smem) {
  unsigned* ctr = (unsigned*)(p.ws + WS_MISC + 64) + cidx;
  extern __shared__ __attribute__((aligned(16))) char dsm[];
  LDSP int* sidx = (LDSP int*)(dsm + 131072 + 16);
  constexpr int M_CL = PROBE == 21 ? 2 : 1, M_AL = PROBE == 22 ? 2 : 1, M_GL = PROBE == 23 ? 2 : 1, M_CC = PROBE == 24 ? 2 : 1, M_AC = PROBE == 25 ? 2 : 1, M_GC = PROBE == 26 ? 2 : 1;
  constexpr int N_CL = 256 * M_CL, N_AL = 192 * M_AL, N_GL = 256 * M_GL, N_CC = 512 * M_CC, N_AC = 384 * M_AC, N_GC = 512 * M_GC;
  constexpr int E0 = N_CL, E1 = E0 + N_AL, E2 = E1 + N_GL, E3 = E2 + N_CC, E4 = E3 + N_AC, E5 = E4 + N_GC;
  for (;;) {
    __syncthreads();
    if (threadIdx.x == 0) *sidx = (int)atomicAdd(ctr, 2u);
    __syncthreads();
    const int it = *sidx + ohalf();
    if (it >= E5) break;
    int typ, r; bool ctx;
    if (it < E0) { typ = 0; r = (it) % 256; ctx = false; }
    else if (it < E1) { typ = 1; r = (it - E0) % 192; ctx = false; }
    else if (it < E2) { typ = 2; r = (it - E1) % 256; ctx = false; }
    else if (it < E3) { typ = 0; r = (it - E2) % 512; ctx = true; }
    else if (it < E4) { typ = 1; r = (it - E3) % 384; ctx = true; }
    else { typ = 2; r = (it - E4) % 512; ctx = true; }
    const int sh = (ctx ? 2 : 5) - (typ == 1 ? 1 : 0), nq = 1 << sh;
    const int sub = r & (nq - 1), bh = r >> sh;
    if (typ == 0) attn_c_item(p, l, ctx, bh >> 2, bh & 3, sub, smem);
    else if (typ == 1) attn_a_item(p, l, ctx, bh / 6, bh % 6, sub, smem);
    else gla_item_mfma(p, l, ctx, bh >> 2, bh & 3, sub, smem);
  }
}

constexpr int DYN_LDS = 131072 + 64;
typedef const __attribute__((address_space(4))) Params* ParamsK;
DI ParamsK kparams() { ParamsK q = (ParamsK)__builtin_amdgcn_kernarg_segment_ptr(); asm volatile("" : "+s"(q)); return q; }
__global__ void __launch_bounds__(512, 2) fwd_megakernel(Params p_unused) {
  extern __shared__ __attribute__((aligned(16))) char dsm[];
  cg::grid_group grid = cg::this_grid();
  if (gridDim.y == 2) grid.sync();
  const Params& p = *(const Params*)kparams();
  volatile LDSP unsigned* xbw = (volatile LDSP unsigned*)(dsm + 131072);
  if (threadIdx.x == 0) { xbw[0] = 0u; xbw[1] = 0u; xbw[2] = 0u; xbw[3] = 0u; }
  __syncthreads();
  const XcdBarrier xb = xcd_barrier_post((unsigned*)(p.ws + WS_BAR), xbw);
  char* smem = dsm + ohalf() * 65536;
  phase0(p, (float*)smem);
  xcd_barrier(xb);
#pragma unroll 1
  for (int ph = 0; ph < 44; ++ph) {
    const int l = ph / 11, q = ph - l * 11;
    const Params& p = *(const Params*)kparams();
    const float* mod = (const float*)(p.ws + WS_MOD);
    const bf16_t* H = (const bf16_t*)(p.ws + WS_H);
    const bf16_t* ACT = (const bf16_t*)(p.ws + WS_ACT);
    const bf16_t* MIX = (const bf16_t*)(p.ws + WS_MIX);
    const float* modl = mod + (size_t)l * 3 * 9216;
    int nrep = 1;
#if PROBE
    if (PROBE == 1) nrep = (q == 1 || q == 9 || q == 2 || q == 10 || q == 7 || q == 4) ? 2 : 1;
    if (PROBE == 2) nrep = (q == 6) ? 2 : 1;
    if (PROBE == 3) nrep = (q == 5) ? 2 : 1;
    if (PROBE == 4) nrep = (q == 0 || q == 3 || q == 8) ? 2 : 1;
    if (PROBE == 5) nrep = 2;
#endif
#pragma unroll 1
    for (int rep = 0; rep < nrep; ++rep) {
#if PROBE == 5
    if (rep == 1) { xcd_barrier(xb); xcd_barrier(xb); xcd_barrier(xb); continue; }
#endif
    if (q == 3 || q == 8 || (q == 0 && l > 0)) continue;
    const float* RS = (const float*)(p.ws + WS_ROWSS);
    const float* BIAS = (const float*)(p.ws + WS_BIAS);
    if (q == 0) {
      norm0_bias_phase(p);
    } else if (q == 1 || q == 9) {
      const int f = q == 1 ? 0 : 1;
      { EpiSwiglu E; E.ACT = (bf16_t*)(p.ws + WS_ACT); E.RS = RS; E.bias = BIAS + (size_t)(l * 3 + (f ? 2 : 0)) * 3 * 5632;
        gemm8_run(H, (const bf16_t*)(p.ws + WS_WGU) + (size_t)(l * 2 + f) * 5632 * 1024, 5632, 1024, E, dsm); }
      if (l < 3 && rep == 0 && blockIdx.x >= 32) convert_slice(p, l + 1, f * 1344, f * 1344 + 1344, 32, (float*)smem);
    } else if (q == 2 || q == 10 || q == 7) {
      const bf16_t* A; const bf16_t* Bt; int lda, K; const float* gb; float coef; int nl, nsub;
      if (q == 7) { A = MIX; lda = 1024; K = 1024; Bt = (const bf16_t*)(p.ws + WS_WOUT) + (size_t)l * 1024 * 1024; gb = modl + 5 * 1024; coef = 1.0f; nl = l; nsub = 2; }
      else { const int f = q == 2 ? 0 : 1; A = ACT; lda = DFF; K = DFF; Bt = (const bf16_t*)(p.ws + WS_WD) + (size_t)(l * 2 + f) * 1024 * 2816; gb = modl + (f == 0 ? 2 : 8) * 1024; coef = 0.5f;
             nl = f == 0 ? l : l + 1; nsub = f == 0 ? 1 : 0; }
      (void)lda;
      if (l < 3 && rep == 0 && q == 10 && blockIdx.x >= 192) bias_from_f32(p, l + 1, dsm);
      { EpiResid E; E.X = p.out; E.gate_base = gb; E.coef = rep ? 0.f : coef; E.H = (bf16_t*)(p.ws + WS_H); E.RS = (float*)(p.ws + WS_ROWSS);
        E.nxt_g = nl < 4 ? p.in[11] + (nl * 3 + nsub) * 1024 : nullptr; E.nxt_scale = mod + (size_t)(nl < 4 ? nl : 0) * 3 * 9216 + (3 * nsub + 1) * 1024;
        gemm8_run(A, Bt, 1024, K, E, dsm); }
    } else if (q == 4) {
      { EpiProj E; E.PR = (bf16_t*)(p.ws + WS_PROJ); E.RS = RS; E.bias = BIAS + (size_t)(l * 3 + 1) * 3 * 5632;
        gemm8_run(H, (const bf16_t*)(p.ws + WS_WIN) + (size_t)l * PWR * 1024, PWP, 1024, E, dsm); }
    } else if (q == 5) {
      prep_phase(p, l, smem);
    } else {
      mixer_phase(p, l, l + 4 * rep, smem);
    }
    xcd_barrier(xb);
    }
  }
}

extern "C" void kernel_launch(void* const* d_in, const int* in_sizes, int n_in,
                              void* d_out, int out_size, void* d_ws, size_t ws_size,
                              hipStream_t stream) {
  static int grid_blocks = 0;
  if (!grid_blocks) {
    int dev = 0, cus = 0, per_cu = 0;
    (void)hipGetDevice(&dev);
    (void)hipDeviceGetAttribute(&cus, hipDeviceAttributeMultiprocessorCount, dev);
    (void)hipFuncSetAttribute((const void*)fwd_megakernel, hipFuncAttributeMaxDynamicSharedMemorySize, DYN_LDS);
    (void)hipOccupancyMaxActiveBlocksPerMultiprocessor(&per_cu, fwd_megakernel, 512, DYN_LDS);
    if (per_cu < 1) per_cu = 1;
    grid_blocks = cus;
    grid_blocks -= grid_blocks % 8;
  }
  Params p{};
  for (int i = 0; i < 26; ++i) p.in[i] = (const float*)d_in[i];
  p.out = (float*)d_out;
  p.ws = (char*)d_ws;
  for (int i = 0; i < 16; ++i) p.freqA[i] = powf(10000.0f, -(float)i / 16.0f);
  for (int i = 0; i < 12; ++i) p.freqC[i] = powf(10000.0f, -(float)i / 12.0f);
  for (int l = 0; l < 4; ++l) p.lam_init[l] = (float)(0.8 - 0.6 * exp(-0.3 * l));
  (void)hipMemsetAsync((char*)d_ws + WS_BAR, 0, XCD_BAR_WORDS_C * 4, stream);
  void* args[] = {&p};
  hipError_t e = hipLaunchCooperativeKernel((void*)fwd_megakernel, dim3(grid_blocks), dim3(512), args, DYN_LDS, stream);
  if (e != hipSuccess) fprintf(stderr, "cooperative launch failed: %s (grid %d)\n", hipGetErrorString(e), grid_blocks);
}
```
